# Optimizing an MI355X kernel written in HIP

```python
import math
import jax, jax.numpy as jnp
from jax import lax
import numpy as np

D_MODEL = 2048
BATCH = 4
SEQ = 4096
DEPTH = 1

HEAD_DIM = 64
N_Q_HEADS = 16
N_KV_HEADS = 4
Q_PER_KV = N_Q_HEADS // N_KV_HEADS
ATTN_WIDTH = N_Q_HEADS * HEAD_DIM
KV_WIDTH = N_KV_HEADS * HEAD_DIM
WINDOW = 128
BLOCK = 128
SSM_WIDTH = D_MODEL - ATTN_WIDTH
SSM_GROUP = 16
SSM_GROUPS = SSM_WIDTH // SSM_GROUP
SSM_STATE = 64
MIX_WIDTH = ATTN_WIDTH + SSM_WIDTH
IN_WIDTH = ATTN_WIDTH + 2 * KV_WIDTH + SSM_WIDTH
FF_HIDDEN = -(-8 * D_MODEL // (3 * 256)) * 256
REL_BUCKETS = 32
REL_MAX_DISTANCE = 128
EPS = 1e-6

kernel_name = "hymba_s5_swa_sink_hybrid"


def _rmsnorm(x, g):
    xf = x.astype(jnp.float32)
    y = xf * lax.rsqrt(jnp.mean(xf * xf, axis=-1, keepdims=True) + EPS)
    return (y * g.astype(jnp.float32)).astype(x.dtype)


def _t5_bucket(dist):
    n = np.maximum(dist, 0)
    max_exact = REL_BUCKETS // 2
    nf = np.maximum(n, 1).astype(np.float32)
    large = max_exact + (np.log(nf / max_exact) / math.log(REL_MAX_DISTANCE / max_exact)
                         * (REL_BUCKETS - max_exact)).astype(np.int32)
    large = np.minimum(large, REL_BUCKETS - 1)
    return np.where(n < max_exact, n, large).astype(np.int32)


def _sliding_window_attention(q, k, v, sinks, rel_bias):
    bsz, L = q.shape[0], q.shape[1]
    nb = L // BLOCK
    qb = q.reshape(bsz, nb, BLOCK, N_KV_HEADS, Q_PER_KV, HEAD_DIM)
    pad = ((0, 0), (BLOCK, 0), (0, 0), (0, 0))
    kp = jnp.pad(k, pad).reshape(bsz, nb + 1, BLOCK, N_KV_HEADS, HEAD_DIM)
    vp = jnp.pad(v, pad).reshape(bsz, nb + 1, BLOCK, N_KV_HEADS, HEAD_DIM)
    kb = jnp.concatenate([kp[:, :-1], kp[:, 1:]], axis=2)
    vb = jnp.concatenate([vp[:, :-1], vp[:, 1:]], axis=2)
    logits = jnp.einsum('bnqkgd,bnskd->bnkgqs', qb, kb).astype(jnp.float32) * (HEAD_DIM ** -0.5)

    qi = np.arange(BLOCK)[:, None]
    sj = np.arange(2 * BLOCK)[None, :]
    dist = qi + BLOCK - sj
    bucket = _t5_bucket(dist)
    bias = jnp.transpose(rel_bias[bucket].astype(jnp.float32), (2, 0, 1))
    bias = bias.reshape(N_KV_HEADS, Q_PER_KV, BLOCK, 2 * BLOCK)
    in_window = (dist >= 0) & (dist < WINDOW)
    key_pos = np.arange(nb)[:, None] * BLOCK - BLOCK + np.arange(2 * BLOCK)[None, :]
    valid = in_window[None] & (key_pos >= 0)[:, None, :]
    logits = jnp.where(valid[None, :, None, None], logits + bias, -jnp.inf)

    sink = sinks.astype(jnp.float32).reshape(N_KV_HEADS, Q_PER_KV, 1, 1)
    m = jnp.maximum(jnp.max(logits, axis=-1, keepdims=True), sink)
    p = jnp.exp(logits - m)
    w = p / (jnp.sum(p, axis=-1, keepdims=True) + jnp.exp(sink - m))
    out = jnp.einsum('bnkgqs,bnskd->bnqkgd', w.astype(v.dtype), vb)
    return out.reshape(bsz, L, ATTN_WIDTH)


def _scan_combine(a, b):
    a_re, a_im, x_re, x_im = a
    b_re, b_im, y_re, y_im = b
    n_re = b_re * a_re - b_im * a_im
    n_im = b_re * a_im + b_im * a_re
    o_re = b_re * x_re - b_im * x_im + y_re
    o_im = b_re * x_im + b_im * x_re + y_im
    return (n_re, n_im, o_re, o_im)


def _s5_mixer(u, a_re, a_im, log_dt, b_re, b_im, c_re, c_im, d, w_glu):
    bsz, L = u.shape[0], u.shape[1]
    f32 = jnp.float32
    uf = u.reshape(bsz, L, SSM_GROUPS, SSM_GROUP).astype(f32)
    a_re = a_re.astype(f32)
    a_im = a_im.astype(f32)
    dt = jnp.exp(log_dt.astype(f32))[:, None]
    mag = jnp.exp(a_re * dt)
    ang = a_im * dt
    lb_re, lb_im = mag * jnp.cos(ang), mag * jnp.sin(ang)
    nr, ni = lb_re - 1.0, lb_im
    den = a_re * a_re + a_im * a_im
    f_re = (nr * a_re + ni * a_im) / den
    f_im = (ni * a_re - nr * a_im) / den
    b_re = b_re.astype(f32)
    b_im = b_im.astype(f32)
    bb_re = f_re[..., None] * b_re - f_im[..., None] * b_im
    bb_im = f_re[..., None] * b_im + f_im[..., None] * b_re
    bu_re = jnp.einsum('blgp,gnp->blgn', uf, bb_re)
    bu_im = jnp.einsum('blgp,gnp->blgn', uf, bb_im)
    shape_a = (1, L, SSM_GROUPS, SSM_STATE)
    elems = (jnp.broadcast_to(lb_re, shape_a), jnp.broadcast_to(lb_im, shape_a), bu_re, bu_im)
    _, _, h_re, h_im = lax.associative_scan(_scan_combine, elems, axis=1)
    y = (jnp.einsum('blgn,gpn->blgp', h_re, c_re.astype(f32))
         - jnp.einsum('blgn,gpn->blgp', h_im, c_im.astype(f32))
         + d.astype(f32) * uf)
    y = jax.nn.gelu(y.reshape(bsz, L, SSM_WIDTH)).astype(u.dtype)
    return y * jax.nn.sigmoid(y @ w_glu)


def _layer(x, rel_bias, ln1_g, w_in, q_norm_g, k_norm_g, attn_sinks, ssm_a_re, ssm_a_im,
           ssm_log_dt, ssm_b_re, ssm_b_im, ssm_c_re, ssm_c_im, ssm_d, w_glu,
           attn_out_g, ssm_out_g, w_out, ln2_g, w_ff_gate, w_ff_up, w_ff_down):
    bsz, L = x.shape[0], x.shape[1]
    h = _rmsnorm(x, ln1_g)
    proj = h @ w_in
    q, k, v, u = jnp.split(proj, [ATTN_WIDTH, ATTN_WIDTH + KV_WIDTH, ATTN_WIDTH + 2 * KV_WIDTH], axis=-1)
    q = _rmsnorm(q.reshape(bsz, L, N_Q_HEADS, HEAD_DIM), q_norm_g)
    k = _rmsnorm(k.reshape(bsz, L, N_KV_HEADS, HEAD_DIM), k_norm_g)
    v = v.reshape(bsz, L, N_KV_HEADS, HEAD_DIM)
    y_attn = _sliding_window_attention(q, k, v, attn_sinks, rel_bias)
    y_ssm = _s5_mixer(u, ssm_a_re, ssm_a_im, ssm_log_dt, ssm_b_re, ssm_b_im,
                      ssm_c_re, ssm_c_im, ssm_d, w_glu)
    mixed = jnp.concatenate([_rmsnorm(y_attn, attn_out_g), _rmsnorm(y_ssm, ssm_out_g)], axis=-1)
    x = x + mixed @ w_out
    h2 = _rmsnorm(x, ln2_g)
    ff = (jax.nn.silu(h2 @ w_ff_gate) * (h2 @ w_ff_up)) @ w_ff_down
    return x + ff


def setup_inputs(seed: int = 0) -> dict:
    key = jax.random.key(seed)
    ks = jax.random.split(key, 24)
    f32 = jnp.float32
    nrm = lambda k, s, sc: jax.random.normal(k, s, f32) * sc
    Dp = DEPTH
    n_idx = jnp.arange(SSM_STATE, dtype=f32)
    return {
        "x": nrm(ks[0], (BATCH, SEQ, D_MODEL), 1.0),
        "rel_bias": nrm(ks[1], (REL_BUCKETS, N_Q_HEADS), 0.5),
        "ln1_g": 1.0 + nrm(ks[2], (Dp, D_MODEL), 0.02),
        "w_in": nrm(ks[3], (Dp, D_MODEL, IN_WIDTH), D_MODEL ** -0.5),
        "q_norm_g": 1.0 + nrm(ks[4], (Dp, HEAD_DIM), 0.02),
        "k_norm_g": 1.0 + nrm(ks[5], (Dp, HEAD_DIM), 0.02),
        "attn_sinks": nrm(ks[6], (Dp, N_Q_HEADS), 0.5),
        "ssm_a_re": -0.5 + nrm(ks[7], (Dp, SSM_GROUPS, SSM_STATE), 0.01),
        "ssm_a_im": math.pi * n_idx + nrm(ks[8], (Dp, SSM_GROUPS, SSM_STATE), 0.01),
        "ssm_log_dt": jax.random.uniform(ks[9], (Dp, SSM_GROUPS), f32, math.log(1e-3), math.log(1e-1)),
        "ssm_b_re": nrm(ks[10], (Dp, SSM_GROUPS, SSM_STATE, SSM_GROUP), (2 * SSM_GROUP) ** -0.5),
        "ssm_b_im": nrm(ks[11], (Dp, SSM_GROUPS, SSM_STATE, SSM_GROUP), (2 * SSM_GROUP) ** -0.5),
        "ssm_c_re": nrm(ks[12], (Dp, SSM_GROUPS, SSM_GROUP, SSM_STATE), (2 * SSM_STATE) ** -0.5),
        "ssm_c_im": nrm(ks[13], (Dp, SSM_GROUPS, SSM_GROUP, SSM_STATE), (2 * SSM_STATE) ** -0.5),
        "ssm_d": nrm(ks[14], (Dp, SSM_GROUPS, SSM_GROUP), 1.0),
        "w_glu": nrm(ks[15], (Dp, SSM_WIDTH, SSM_WIDTH), SSM_WIDTH ** -0.5),
        "attn_out_g": 1.0 + nrm(ks[16], (Dp, ATTN_WIDTH), 0.02),
        "ssm_out_g": 1.0 + nrm(ks[17], (Dp, SSM_WIDTH), 0.02),
        "w_out": nrm(ks[18], (Dp, MIX_WIDTH, D_MODEL), MIX_WIDTH ** -0.5),
        "ln2_g": 1.0 + nrm(ks[19], (Dp, D_MODEL), 0.02),
        "w_ff_gate": nrm(ks[20], (Dp, D_MODEL, FF_HIDDEN), D_MODEL ** -0.5),
        "w_ff_up": nrm(ks[21], (Dp, D_MODEL, FF_HIDDEN), D_MODEL ** -0.5),
        "w_ff_down": nrm(ks[22], (Dp, FF_HIDDEN, D_MODEL), FF_HIDDEN ** -0.5),
    }


def reference(x, rel_bias, ln1_g, w_in, q_norm_g, k_norm_g, attn_sinks, ssm_a_re, ssm_a_im,
              ssm_log_dt, ssm_b_re, ssm_b_im, ssm_c_re, ssm_c_im, ssm_d, w_glu,
              attn_out_g, ssm_out_g, w_out, ln2_g, w_ff_gate, w_ff_up, w_ff_down):
    for l in range(DEPTH):
        x = _layer(x, rel_bias, ln1_g[l], w_in[l], q_norm_g[l], k_norm_g[l], attn_sinks[l],
                   ssm_a_re[l], ssm_a_im[l], ssm_log_dt[l], ssm_b_re[l], ssm_b_im[l],
                   ssm_c_re[l], ssm_c_im[l], ssm_d[l], w_glu[l], attn_out_g[l], ssm_out_g[l],
                   w_out[l], ln2_g[l], w_ff_gate[l], w_ff_up[l], w_ff_down[l])
    return x
```

```cpp
#include <hip/hip_runtime.h>
#include <cstdio>
#include <cstdint>
#include <cmath>

namespace ref {
constexpr int D_MODEL = 2048, BATCH = 4, SEQ = 4096, M = BATCH * SEQ;
constexpr int HD = 64, NQH = 16, NKVH = 4, ATTN_W = 1024, KV_W = 256, WINDOW = 128;
constexpr int SSM_W = 1024, SSM_P = 16, SSM_G = 64, SSM_N = 64, IN_W = 2560, FF = 5632;
constexpr float EPS = 1e-6f;

__device__ const unsigned char kBucket[128] = {0, 1, 2, 3, 4, 5, 6, 7, 8, 9, 10, 11, 12, 13, 14, 15, 16, 16, 16, 17, 17, 18, 18, 18, 19, 19, 19, 20, 20, 20, 20, 21, 21, 21, 21, 22, 22, 22, 22, 22, 23, 23, 23, 23, 23, 23, 24, 24, 24, 24, 24, 24, 25, 25, 25, 25, 25, 25, 25, 26, 26, 26, 26, 26, 26, 26, 26, 27, 27, 27, 27, 27, 27, 27, 27, 27, 27, 28, 28, 28, 28, 28, 28, 28, 28, 28, 28, 29, 29, 29, 29, 29, 29, 29, 29, 29, 29, 29, 29, 30, 30, 30, 30, 30, 30, 30, 30, 30, 30, 30, 30, 30, 30, 31, 31, 31, 31, 31, 31, 31, 31, 31, 31, 31, 31, 31, 31, 31};

__device__ __forceinline__ float wave_sum(float v) {
#pragma unroll
    for (int o = 1; o < 64; o <<= 1) v += __shfl_xor(v, o);
    return v;
}
__device__ __forceinline__ float wave_max(float v) {
#pragma unroll
    for (int o = 1; o < 64; o <<= 1) v = fmaxf(v, __shfl_xor(v, o));
    return v;
}

__global__ void __launch_bounds__(256) rmsnorm_rows(const float* x, int ldx, const float* g, float* out, int ldo, int ncols) {
    __shared__ float red[4];
    const int r = blockIdx.x, tid = threadIdx.x;
    const float* xr = x + (size_t)r * ldx;
    float s = 0.f;
    for (int c = tid; c < ncols; c += 256) { const float v = xr[c]; s += v * v; }
    s = wave_sum(s);
    if ((tid & 63) == 0) red[tid >> 6] = s;
    __syncthreads();
    const float tot = red[0] + red[1] + red[2] + red[3];
    const float rstd = 1.0f / sqrtf(tot / (float)ncols + EPS);
    float* orow = out + (size_t)r * ldo;
    for (int c = tid; c < ncols; c += 256) orow[c] = xr[c] * rstd * g[c];
}

template <bool ACC>
__global__ void __launch_bounds__(256) gemm_nn(const float* __restrict__ A, int lda, const float* __restrict__ B, int ldb, float* C, int ldc, int K) {
    __shared__ float As[16][132];
    __shared__ float Bs[16][128];
    const int tid = threadIdx.x, tx = tid & 15, ty = tid >> 4;
    const int m0 = blockIdx.y * 128, n0 = blockIdx.x * 128;
    float acc[8][8];
#pragma unroll
    for (int i = 0; i < 8; ++i)
#pragma unroll
        for (int j = 0; j < 8; ++j) acc[i][j] = 0.f;
    for (int k0 = 0; k0 < K; k0 += 16) {
#pragma unroll
        for (int p = 0; p < 2; ++p) {
            const int row = (tid >> 2) + p * 64, kq = (tid & 3) * 4;
            const float4 v = *(const float4*)(A + (size_t)(m0 + row) * lda + k0 + kq);
            As[kq + 0][row] = v.x; As[kq + 1][row] = v.y; As[kq + 2][row] = v.z; As[kq + 3][row] = v.w;
        }
#pragma unroll
        for (int p = 0; p < 2; ++p) {
            const int kk = (tid >> 5) + p * 8, nq = (tid & 31) * 4;
            *(float4*)&Bs[kk][nq] = *(const float4*)(B + (size_t)(k0 + kk) * ldb + n0 + nq);
        }
        __syncthreads();
#pragma unroll
        for (int kk = 0; kk < 16; ++kk) {
            float a[8], b[8];
            const float4 a0 = *(const float4*)&As[kk][ty * 4], a1 = *(const float4*)&As[kk][64 + ty * 4];
            const float4 b0 = *(const float4*)&Bs[kk][tx * 4], b1 = *(const float4*)&Bs[kk][64 + tx * 4];
            a[0] = a0.x; a[1] = a0.y; a[2] = a0.z; a[3] = a0.w; a[4] = a1.x; a[5] = a1.y; a[6] = a1.z; a[7] = a1.w;
            b[0] = b0.x; b[1] = b0.y; b[2] = b0.z; b[3] = b0.w; b[4] = b1.x; b[5] = b1.y; b[6] = b1.z; b[7] = b1.w;
#pragma unroll
            for (int i = 0; i < 8; ++i)
#pragma unroll
                for (int j = 0; j < 8; ++j) acc[i][j] = fmaf(a[i], b[j], acc[i][j]);
        }
        __syncthreads();
    }
#pragma unroll
    for (int i = 0; i < 8; ++i) {
        const int row = m0 + (i < 4 ? ty * 4 + i : 64 + ty * 4 + (i - 4));
#pragma unroll
        for (int jh = 0; jh < 2; ++jh) {
            float* cp = C + (size_t)row * ldc + n0 + jh * 64 + tx * 4;
            float4 v = make_float4(acc[i][jh * 4 + 0], acc[i][jh * 4 + 1], acc[i][jh * 4 + 2], acc[i][jh * 4 + 3]);
            if (ACC) { const float4 o = *(const float4*)cp; v.x += o.x; v.y += o.y; v.z += o.z; v.w += o.w; }
            *(float4*)cp = v;
        }
    }
}

__global__ void __launch_bounds__(128) attn_naive(const float* __restrict__ proj, const float* __restrict__ qg, const float* __restrict__ kg, const float* __restrict__ sinks,
                                                  const float* __restrict__ rel_bias, float* __restrict__ out  ) {
    __shared__ float qn[64];
    __shared__ float w[128];
    __shared__ float red[2];
    const int h = blockIdx.x & 15, tok = blockIdx.x >> 4, t = tok & (SEQ - 1), kvh = h >> 2;
    const int tid = threadIdx.x, lane = tid & 63;
    if (tid < 64) {
        const float qv = proj[(size_t)tok * IN_W + h * 64 + tid];
        const float ss = wave_sum(qv * qv);
        qn[tid] = qv * (1.0f / sqrtf(ss * (1.0f / 64.0f) + EPS)) * qg[tid];
    }
    __syncthreads();
    const int j = t - tid;
    float logit = -INFINITY;
    if (j >= 0) {
        const float* kr = proj + (size_t)(tok - tid) * IN_W + ATTN_W + kvh * 64;
        float ss = 0.f, dot = 0.f;
#pragma unroll 8
        for (int d = 0; d < 64; ++d) { const float kv = kr[d]; ss += kv * kv; dot += kv * kg[d] * qn[d]; }
        const float rstd = 1.0f / sqrtf(ss * (1.0f / 64.0f) + EPS);
        logit = dot * rstd * 0.125f + rel_bias[(int)kBucket[tid] * NQH + h];
    }
    const float sink = sinks[h];
    float mx = wave_max(logit);
    if (lane == 0) red[tid >> 6] = mx;
    __syncthreads();
    mx = fmaxf(fmaxf(red[0], red[1]), sink);
    __syncthreads();
    const float p = (j >= 0) ? expf(logit - mx) : 0.f;
    float sm = wave_sum(p);
    if (lane == 0) red[tid >> 6] = sm;
    w[tid] = p;
    __syncthreads();
    const float denom = red[0] + red[1] + expf(sink - mx);
    if (tid < 64) {
        float o = 0.f;
        const int nk = (t + 1 < 128) ? t + 1 : 128;
        for (int i = 0; i < nk; ++i) o += w[i] * proj[(size_t)(tok - i) * IN_W + ATTN_W + KV_W + kvh * 64 + tid];
        out[(size_t)tok * ATTN_W + h * 64 + tid] = o / denom;
    }
}

__device__ __forceinline__ float gelu_tanh(float x) {
    const float u = 0.7978845608028654f * (x + 0.044715f * x * x * x);
    return 0.5f * x * (1.0f + tanhf(u));
}

__global__ void __launch_bounds__(64) ssm_naive(const float* __restrict__ proj, const float* __restrict__ a_re, const float* __restrict__ a_im, const float* __restrict__ log_dt,
                                                const float* __restrict__ b_re, const float* __restrict__ b_im, const float* __restrict__ c_re, const float* __restrict__ c_im,
                                                const float* __restrict__ dd, float* __restrict__ yg) {
    const int g = blockIdx.x & 63, b = blockIdx.x >> 6, n = threadIdx.x;
    const float dt = expf(log_dt[g]);
    const float are = a_re[g * 64 + n], aim = a_im[g * 64 + n];
    const float mag = expf(are * dt), ang = aim * dt;
    const float lre = mag * cosf(ang), lim = mag * sinf(ang);
    const float nr = lre - 1.0f, ni = lim, den = are * are + aim * aim;
    const float fre = (nr * are + ni * aim) / den, fim = (ni * are - nr * aim) / den;
    float bbr[16], bbi[16], cr[16], ci[16];
#pragma unroll
    for (int p = 0; p < 16; ++p) {
        const float br = b_re[(g * 64 + n) * 16 + p], bi = b_im[(g * 64 + n) * 16 + p];
        bbr[p] = fre * br - fim * bi; bbi[p] = fre * bi + fim * br;
        cr[p] = c_re[(g * 16 + p) * 64 + n]; ci[p] = c_im[(g * 16 + p) * 64 + n];
    }
    const float dmy = (n < 16) ? dd[g * 16 + n] : 0.f;
    float hre = 0.f, him = 0.f;
    for (int t = 0; t < SEQ; ++t) {
        const float* ur = proj + (size_t)(b * SEQ + t) * IN_W + 1536 + g * 16;
        float u[16];
#pragma unroll
        for (int p = 0; p < 16; ++p) u[p] = ur[p];
        float bur = 0.f, bui = 0.f;
#pragma unroll
        for (int p = 0; p < 16; ++p) { bur = fmaf(bbr[p], u[p], bur); bui = fmaf(bbi[p], u[p], bui); }
        const float nre = lre * hre - lim * him + bur, nim = lre * him + lim * hre + bui;
        hre = nre; him = nim;
        float myy = 0.f;
#pragma unroll
        for (int p = 0; p < 16; ++p) {
            const float v = wave_sum(cr[p] * hre - ci[p] * him);
            if (n == p) myy = v;
        }
        if (n < 16) {
            const float uu = ur[n];
            yg[(size_t)(b * SEQ + t) * SSM_W + g * 16 + n] = gelu_tanh(myy + dmy * uu);
        }
    }
}

__global__ void glu_elem(const float* __restrict__ y, const float* __restrict__ z, float* __restrict__ s, size_t n) {
    for (size_t i = (size_t)blockIdx.x * blockDim.x + threadIdx.x; i < n; i += (size_t)gridDim.x * blockDim.x) { const float yv = y[i]; s[i] = yv / (1.0f + expf(-z[i])); }
}
__global__ void swiglu_elem(float* __restrict__ g, const float* __restrict__ u, size_t n) {
    for (size_t i = (size_t)blockIdx.x * blockDim.x + threadIdx.x; i < n; i += (size_t)gridDim.x * blockDim.x) { const float gv = g[i]; g[i] = gv / (1.0f + expf(-gv)) * u[i]; }
}
__global__ void copy_f4(const float4* __restrict__ a, float4* __restrict__ o, size_t n4) {
    for (size_t i = (size_t)blockIdx.x * blockDim.x + threadIdx.x; i < n4; i += (size_t)gridDim.x * blockDim.x) o[i] = a[i];
}

static void gemm(hipStream_t st, bool acc, const float* A, int lda, const float* B, int ldb, float* C, int ldc, int Mr, int N, int K) {
    dim3 grid(N / 128, Mr / 128);
    if (acc) hipLaunchKernelGGL(gemm_nn<true>, grid, dim3(256), 0, st, A, lda, B, ldb, C, ldc, K);
    else hipLaunchKernelGGL(gemm_nn<false>, grid, dim3(256), 0, st, A, lda, B, ldb, C, ldc, K);
}

static void forward(void* const* d_in, float* out, unsigned char* ws, hipStream_t st) {
    const float* x = (const float*)d_in[0]; const float* rel_bias = (const float*)d_in[1]; const float* ln1_g = (const float*)d_in[2]; const float* w_in = (const float*)d_in[3];
    const float* qg = (const float*)d_in[4]; const float* kg = (const float*)d_in[5]; const float* sinks = (const float*)d_in[6];
    const float* a_re = (const float*)d_in[7]; const float* a_im = (const float*)d_in[8]; const float* log_dt = (const float*)d_in[9];
    const float* b_re = (const float*)d_in[10]; const float* b_im = (const float*)d_in[11]; const float* c_re = (const float*)d_in[12]; const float* c_im = (const float*)d_in[13];
    const float* dd = (const float*)d_in[14]; const float* w_glu = (const float*)d_in[15]; const float* ag = (const float*)d_in[16]; const float* sg = (const float*)d_in[17];
    const float* w_out = (const float*)d_in[18]; const float* ln2_g = (const float*)d_in[19]; const float* wg = (const float*)d_in[20]; const float* wu = (const float*)d_in[21]; const float* wd = (const float*)d_in[22];
    constexpr size_t MB = 1u << 20;
    float* xn = (float*)(ws + 0 * MB);
    float* proj = (float*)(ws + 128 * MB);
    float* a = (float*)(ws + 288 * MB);
    float* yg = (float*)(ws + 352 * MB);
    float* z = (float*)(ws + 416 * MB);
    float* mixed = xn; float* h2 = proj; float* gc = a; float* uc = z;
    hipLaunchKernelGGL(rmsnorm_rows, dim3(M), dim3(256), 0, st, x, D_MODEL, ln1_g, xn, D_MODEL, D_MODEL);
    gemm(st, false, xn, D_MODEL, w_in, IN_W, proj, IN_W, M, IN_W, D_MODEL);
    hipLaunchKernelGGL(attn_naive, dim3(M * NQH), dim3(128), 0, st, proj, qg, kg, sinks, rel_bias, a);
    hipLaunchKernelGGL(ssm_naive, dim3(BATCH * SSM_G), dim3(64), 0, st, proj, a_re, a_im, log_dt, b_re, b_im, c_re, c_im, dd, yg);
    gemm(st, false, yg, SSM_W, w_glu, SSM_W, z, SSM_W, M, SSM_W, SSM_W);
    hipLaunchKernelGGL(glu_elem, dim3(2048), dim3(256), 0, st, yg, z, z, (size_t)M * SSM_W);
    hipLaunchKernelGGL(rmsnorm_rows, dim3(M), dim3(256), 0, st, a, ATTN_W, ag, mixed, 2048, ATTN_W);
    hipLaunchKernelGGL(rmsnorm_rows, dim3(M), dim3(256), 0, st, z, SSM_W, sg, mixed + 1024, 2048, SSM_W);
    hipLaunchKernelGGL(copy_f4, dim3(2048), dim3(256), 0, st, (const float4*)x, (float4*)out, (size_t)M * D_MODEL / 4);
    gemm(st, true, mixed, 2048, w_out, D_MODEL, out, D_MODEL, M, D_MODEL, 2048);
    hipLaunchKernelGGL(rmsnorm_rows, dim3(M), dim3(256), 0, st, out, D_MODEL, ln2_g, h2, D_MODEL, D_MODEL);
    constexpr int CH = 1408;
    for (int c = 0; c < FF / CH; ++c) {
        gemm(st, false, h2, D_MODEL, wg + c * CH, FF, gc, CH, M, CH, D_MODEL);
        gemm(st, false, h2, D_MODEL, wu + c * CH, FF, uc, CH, M, CH, D_MODEL);
        hipLaunchKernelGGL(swiglu_elem, dim3(2048), dim3(256), 0, st, gc, uc, (size_t)M * CH);
        gemm(st, true, gc, CH, wd + (size_t)c * CH * D_MODEL, D_MODEL, out, D_MODEL, M, D_MODEL, CH);
    }
}
}

extern "C" void kernel_launch(void* const* d_in, const int* in_sizes, int n_in, void* d_out, int out_size, void* d_ws, size_t ws_size, hipStream_t stream) {
    if (n_in != 23 || out_size != ref::M * ref::D_MODEL || ws_size < (size_t)504 * (1u << 20)) { fprintf(stderr, "kernel_launch: unexpected sizes n_in %d out %d ws %zu\n", n_in, out_size, ws_size); return; }
    ref::forward(d_in, (float*)d_out, (unsigned char*)d_ws, stream);
}
```

```cpp
#include <hip/hip_runtime.h>
#include <hip/hip_cooperative_groups.h>
#include <cstdio>
#include <cstdint>
namespace cg = cooperative_groups;

#ifndef MK_N_LAUNCHES
#define MK_N_LAUNCHES 1
#endif

#define LAS __attribute__((address_space(3)))
typedef unsigned short bf16_t;
typedef short bf16x8 __attribute__((ext_vector_type(8)));
typedef float f32x4 __attribute__((ext_vector_type(4)));
typedef float f32x2 __attribute__((ext_vector_type(2)));
typedef float f32x16 __attribute__((ext_vector_type(16)));
typedef unsigned u32x4 __attribute__((ext_vector_type(4)));
typedef unsigned u32x2 __attribute__((ext_vector_type(2)));

constexpr int D_MODEL = 2048, BATCH = 4, SEQ = 4096, M = BATCH * SEQ;
constexpr int HD = 64, NQH = 16, NKVH = 4, ATTN_W = 1024, KV_W = 256;
constexpr int SSM_W = 1024, SSM_P = 16, SSM_G = 64, SSM_N = 64, IN_W = 2560, FF = 5632;
constexpr int CH_T = 16;
constexpr int SSM_KA = CH_T * SSM_P + 2 * SSM_N;
constexpr float EPS = 1e-6f;
constexpr float LOG2E = 1.4426950408889634f;

__device__ const unsigned char kBucket[128] = {0, 1, 2, 3, 4, 5, 6, 7, 8, 9, 10, 11, 12, 13, 14, 15, 16, 16, 16, 17, 17, 18, 18, 18, 19, 19, 19, 20, 20, 20, 20, 21, 21, 21, 21, 22, 22, 22, 22, 22, 23, 23, 23, 23, 23, 23, 24, 24, 24, 24, 24, 24, 25, 25, 25, 25, 25, 25, 25, 26, 26, 26, 26, 26, 26, 26, 26, 27, 27, 27, 27, 27, 27, 27, 27, 27, 27, 28, 28, 28, 28, 28, 28, 28, 28, 28, 28, 29, 29, 29, 29, 29, 29, 29, 29, 29, 29, 29, 29, 30, 30, 30, 30, 30, 30, 30, 30, 30, 30, 30, 30, 30, 30, 31, 31, 31, 31, 31, 31, 31, 31, 31, 31, 31, 31, 31, 31, 31};

__device__ __forceinline__ unsigned cvt_pk_bf16(float lo, float hi) { unsigned r; asm volatile("v_cvt_pk_bf16_f32 %0, %1, %2" : "=v"(r) : "v"(lo), "v"(hi)); return r; }
__device__ __forceinline__ float bf_lo(unsigned w) { return __builtin_bit_cast(float, w << 16); }
__device__ __forceinline__ float bf_hi(unsigned w) { return __builtin_bit_cast(float, w & 0xffff0000u); }
__device__ __forceinline__ float fast_rcp(float x) { return __builtin_amdgcn_rcpf(x); }
__device__ __forceinline__ float fast_exp2(float x) { return __builtin_amdgcn_exp2f(x); }
__device__ __forceinline__ float sigmoidf_fast(float x) { return fast_rcp(1.0f + fast_exp2(-LOG2E * x)); }
__device__ __forceinline__ float gelu_tanh(float x) {
    const float u2 = 1.5957691216057308f * (x + 0.044715f * x * x * x);
    return x * sigmoidf_fast(u2);
}

__device__ __forceinline__ int lane_id() { int l = __builtin_amdgcn_mbcnt_hi(~0u, __builtin_amdgcn_mbcnt_lo(~0u, 0u)); asm volatile("" : "+v"(l)); return l; }

namespace pg8 {
constexpr int BM = 256, BK = 64, HALF = 128, HTB = HALF * BK * 2  , STAGE_BYTES = 8 * HTB, NXCD = 8, WGM = 8;
__host__ __device__ __forceinline__ int lds_byte(int r, int c) { const int st = (r >> 4) * 2 + (c >> 5), rr = r & 15, cc = c & 31, ob = rr * 64 + cc * 2; return st * 1024 + (ob ^ (((ob >> 9) & 1) << 5)); }
__host__ __device__ __forceinline__ void stage_rc(int b, int& R, int& C) { const int st = b / 1024, sb = b % 1024, swz = sb ^ (((sb >> 9) & 1) << 5); R = (st >> 1) * 16 + swz / 64; C = (st & 1) * 32 + (swz % 64) / 2; }
__host__ __device__ __forceinline__ int perm32(int rho) { const int n = rho >> 4, i = rho & 15; return 8 * (i >> 2) + 4 * n + (i & 3); }

struct Unit { int pm, pn; unsigned aofs, bofs; int part; };
struct Gemm { const char* A; const char* B; int K; unsigned a_rs, a_cs, a_ks, b_rs; };

struct StaticOrder {
    int nM, nN, nwg, G, c;
    __device__ void init(int Mr, int N, int G_, int c_) { nM = Mr / BM; nN = N / BM; nwg = nM * nN; G = G_; c = c_; }
    __device__ bool next(int i, Unit& u) const {
        const long L = (long)i * G + c; if (L >= nwg) return false;
        int wgid = (int)L; { const int q = nwg / NXCD, r = nwg % NXCD, xcd = wgid % NXCD, off = wgid / NXCD; wgid = (xcd < r ? xcd * (q + 1) : r * (q + 1) + (xcd - r) * q) + off; }
        const int nig = WGM * nN, gid = wgid / nig, fm = gid * WGM, gsz = (nM - fm) < WGM ? (nM - fm) : WGM;
        u.pm = fm + ((wgid % nig) % gsz); u.pn = (wgid % nig) / gsz; u.aofs = 0; u.bofs = 0; u.part = 0; return true;
    }
};
struct TwoPartOrder {
    StaticOrder S; unsigned kofs;
    __device__ bool next(int i, Unit& u) const { if (!S.next(i >> 1, u)) return false; u.part = i & 1; u.aofs = u.bofs = (i & 1) ? kofs : 0u; return true; }
};
struct OneUnit {
    int pm, pn;
    __device__ bool next(int i, Unit& u) const { if (i) return false; u.pm = pm; u.pn = pn; u.aofs = 0; u.bofs = 0; u.part = 0; return true; }
};

template <class Epi, class Sched, bool ALIGN_EPI>
__device__ __forceinline__ void gemm_phase(LAS unsigned char* lds, const int wid  , const Gemm g, const Sched& S, const Epi& E) {
    const int lane = lane_id(), tid = wid * 64 + lane, wr = wid >> 2, wc = wid & 3, fr = lane & 15, fq = lane >> 4;
    const int nt = g.K / BK;
    unsigned voffA[2], voffB[2];
#pragma unroll
    for (int i = 0; i < 2; ++i) { int R, C; stage_rc(tid * 16 + i * 8192, R, C); const int Rb = Epi::PERM ? ((R & ~31) + perm32(R & 31)) : R;
        voffA[i] = (unsigned)R * g.a_rs + (unsigned)(C >> 4) * g.a_cs + (unsigned)(C & 15) * 2u; voffB[i] = (unsigned)Rb * g.b_rs + (unsigned)C * 2u; }
    const size_t kstepA = g.a_ks, kstepB = (size_t)(BK * 2);
    const size_t hstepA = (size_t)HALF * g.a_rs, hstepB = (size_t)HALF * g.b_rs, tstepA = 2 * hstepA, tstepB = 2 * hstepB;
    const unsigned ldsw = (unsigned)wid * 1024u;
    const int aoff = lds_byte(wr * 64 + fr, fq * 8), boff = lds_byte(wc * 32 + fr, fq * 8);
#define PG8_SA(b, h) (((b) * 2 + (h)) * HTB)
#define PG8_SB(b, h) ((4 + (b) * 2 + (h)) * HTB)
#define PG8_STAGE(bufoff, gbase, voff) do { _Pragma("unroll") for (int _i = 0; _i < 2; ++_i) \
        __builtin_amdgcn_global_load_lds((const unsigned*)((const char*)(gbase) + (voff)[_i]), (LAS unsigned*)(lds + (bufoff) + ldsw + _i * 8192), 16, 0, 0); } while (0)
#define PG8_LDA(dst, b, h) do { _Pragma("unroll") for (int m = 0; m < 4; ++m) _Pragma("unroll") for (int k = 0; k < 2; ++k) dst[m][k] = *(const LAS bf16x8*)(lds + PG8_SA(b, h) + aoff + m * 2048 + k * 1024); } while (0)
#define PG8_LDB(dst, b, h) do { _Pragma("unroll") for (int n = 0; n < 2; ++n) _Pragma("unroll") for (int k = 0; k < 2; ++k) dst[n][k] = *(const LAS bf16x8*)(lds + PG8_SB(b, h) + boff + n * 2048 + k * 1024); } while (0)
#define PG8_MMA(ai, bj, At, Bt) do { __builtin_amdgcn_s_setprio(1); _Pragma("unroll") for (int m = 0; m < 4; ++m) _Pragma("unroll") for (int n = 0; n < 2; ++n) _Pragma("unroll") for (int k = 0; k < 2; ++k) \
        acc[ai][bj][m][n] = __builtin_amdgcn_mfma_f32_16x16x32_bf16(Bt[n][k], At[m][k], acc[ai][bj][m][n], 0, 0, 0); __builtin_amdgcn_s_setprio(0); } while (0)
#define PG8_WAIT_V(n) asm volatile("s_waitcnt vmcnt(" #n ")" ::: "memory")
#define PG8_WAIT_L(n) asm volatile("s_waitcnt lgkmcnt(" #n ")" ::: "memory")
#define PG8_BAR __builtin_amdgcn_s_barrier()
#define PG8_SCHED __builtin_amdgcn_sched_barrier(0)
    Unit cur, nxt; int ui = 0;
    if (!S.next(0, cur)) return;
    f32x4 acc[2][2][4][2];
#pragma unroll
    for (int a = 0; a < 2; ++a)
#pragma unroll
        for (int b = 0; b < 2; ++b)
#pragma unroll
            for (int m = 0; m < 4; ++m)
#pragma unroll
                for (int n = 0; n < 2; ++n) acc[a][b][m][n] = (f32x4){0.f, 0.f, 0.f, 0.f};
    bf16x8 At[4][2], B0[2][2], B1[2][2];
    const char* cA = g.A + (size_t)cur.pm * tstepA + cur.aofs; const char* cB = g.B + (size_t)cur.pn * tstepB + cur.bofs;
    PG8_STAGE(PG8_SB(0, 0), cB, voffB); PG8_STAGE(PG8_SB(0, 1), cB + hstepB, voffB); PG8_STAGE(PG8_SA(0, 0), cA, voffA); PG8_STAGE(PG8_SA(0, 1), cA + hstepA, voffA);
    if (wr == 1) PG8_BAR;
    PG8_WAIT_V(2); PG8_BAR;
    PG8_STAGE(PG8_SB(1, 0), cB + kstepB, voffB); PG8_STAGE(PG8_SA(1, 0), cA + kstepA, voffA); PG8_STAGE(PG8_SB(1, 1), cB + hstepB + kstepB, voffB);
    PG8_WAIT_V(6); PG8_BAR;
    for (;;) {
        const bool has_next = S.next(ui + 1, nxt);
        const char* nA = has_next ? g.A + (size_t)nxt.pm * tstepA + nxt.aofs : cA; const char* nB = has_next ? g.B + (size_t)nxt.pn * tstepB + nxt.bofs : cB;
        for (int t = 0; t < nt; t += 2) {
            const bool last = (t == nt - 2);
            const char* a1 = cA + (size_t)(t + 1) * kstepA;
            const char* a2 = last ? nA : cA + (size_t)(t + 2) * kstepA; const char* b2 = last ? nB : cB + (size_t)(t + 2) * kstepB;
            const char* a3 = a2 + kstepA; const char* b3 = b2 + kstepB;
            PG8_LDB(B0, 0, 0); PG8_LDB(B1, 0, 1); PG8_SCHED; PG8_LDA(At, 0, 0); PG8_STAGE(PG8_SA(1, 1), a1 + hstepA, voffA);
            PG8_WAIT_V(8); PG8_WAIT_L(0); PG8_BAR; PG8_MMA(0, 0, At, B0); PG8_MMA(0, 1, At, B1); PG8_BAR; PG8_SCHED;
            PG8_LDA(At, 0, 1); PG8_STAGE(PG8_SB(0, 0), b2, voffB); PG8_STAGE(PG8_SB(0, 1), b2 + hstepB, voffB); PG8_STAGE(PG8_SA(0, 0), a2, voffA);
            PG8_WAIT_V(8); PG8_WAIT_L(0); PG8_BAR; PG8_MMA(1, 0, At, B0); PG8_MMA(1, 1, At, B1); PG8_BAR; PG8_SCHED;
            PG8_LDB(B0, 1, 0); PG8_LDB(B1, 1, 1); PG8_SCHED; PG8_LDA(At, 1, 0); PG8_STAGE(PG8_SA(0, 1), a2 + hstepA, voffA);
            PG8_WAIT_V(8); PG8_WAIT_L(0); PG8_BAR; PG8_MMA(0, 0, At, B0); PG8_MMA(0, 1, At, B1); PG8_BAR; PG8_SCHED;
            PG8_LDA(At, 1, 1); PG8_STAGE(PG8_SB(1, 0), b3, voffB); PG8_STAGE(PG8_SB(1, 1), b3 + hstepB, voffB); PG8_STAGE(PG8_SA(1, 0), a3, voffA);
            PG8_WAIT_V(8); PG8_WAIT_L(0); PG8_BAR; PG8_MMA(1, 0, At, B0); PG8_MMA(1, 1, At, B1); PG8_BAR; PG8_SCHED;
        }
        if constexpr (ALIGN_EPI) { if (wr == 0) PG8_BAR; }
        E(acc, cur, wr, wc, fr, fq);
        if (!has_next) break;
#pragma unroll
        for (int a = 0; a < 2; ++a)
#pragma unroll
            for (int b = 0; b < 2; ++b)
#pragma unroll
                for (int m = 0; m < 4; ++m)
#pragma unroll
                    for (int n = 0; n < 2; ++n) acc[a][b][m][n] = (f32x4){0.f, 0.f, 0.f, 0.f};
        cur = nxt; cA = nA; cB = nB; ++ui;
        if constexpr (ALIGN_EPI) { if (wr == 1) PG8_BAR; }
    }
    PG8_WAIT_V(0);
    if constexpr (!ALIGN_EPI) { if (wr == 0) PG8_BAR; }
    PG8_BAR;
#undef PG8_SA
#undef PG8_SB
#undef PG8_STAGE
#undef PG8_LDA
#undef PG8_LDB
#undef PG8_MMA
#undef PG8_WAIT_V
#undef PG8_WAIT_L
#undef PG8_BAR
#undef PG8_SCHED
}
}

constexpr size_t MiB = 1u << 20;
constexpr size_t WS_CTL = 0, CTL_ZERO_BYTES = 1 * MiB;
constexpr size_t WS_SSQ_A = 256 * 1024, WS_SSQ_S = 320 * 1024, WS_SSQ_X = 384 * 1024;
constexpr size_t WS_WIN = 2 * MiB;
constexpr size_t WS_WGLU = 12 * MiB;
constexpr size_t WS_WOUT = 14 * MiB;
constexpr size_t WS_WGU = 22 * MiB;
constexpr size_t WS_WDN = 66 * MiB;
constexpr size_t WS_BG = 88 * MiB;
constexpr size_t WS_PG = 100 * MiB;
constexpr size_t WS_L16 = 108 * MiB;
constexpr size_t WS_SSCR = 109 * MiB;
constexpr size_t WS_XN = 141 * MiB;
constexpr size_t WS_Q = 205 * MiB;
constexpr size_t WS_K = 237 * MiB;
constexpr size_t WS_V = 245 * MiB;
constexpr size_t WS_AG = 253 * MiB;
constexpr size_t WS_YG = 301 * MiB;
constexpr size_t WS_MIX = 333 * MiB;
constexpr size_t WS_H = 205 * MiB;
constexpr size_t WS_END = 397 * MiB;
static_assert(WS_H + (size_t)M * FF * 2 <= WS_END, "ws map");

constexpr int RING_BYTES = 131072;
constexpr int LDS_BYTES = 147456;
constexpr int NWAVES = 8;
constexpr int LDSCTL_OFF = RING_BYTES, MISC_OFF = LDSCTL_OFF + 320;

struct Frame {
    LAS unsigned char* lds;
    int wave, vcu, G;
    const float* const* in; float* out; unsigned char* ws;
};

__device__ __forceinline__ float wave_sum(float v) {
#pragma unroll
    for (int o = 1; o < 64; o <<= 1) v += __shfl_xor(v, o);
    return v;
}
__device__ __forceinline__ unsigned f2bf(float f) { unsigned u = __builtin_bit_cast(unsigned, f); return (u + 0x7fffu + ((u >> 16) & 1u)) >> 16; }
__device__ __forceinline__ unsigned pk2(float lo, float hi) { return f2bf(lo) | (f2bf(hi) << 16); }

__device__ __forceinline__ void p0_transpose_item(const float* W, int K, int N, bf16_t* WT, const float* gain, int rmul, int radd, LAS float* scr, int item, int lane) {
    const int nblk = N / 32, kb = item / nblk, nb = item % nblk, k0 = 64 * kb, n0 = 32 * nb;
#pragma unroll 8
    for (int i = 0; i < 32; ++i) { const int kk = 2 * i + (lane >> 5); scr[kk * 33 + (lane & 31)] = W[(size_t)(k0 + kk) * N + n0 + (lane & 31)]; }
    asm volatile("s_waitcnt lgkmcnt(0)" ::: "memory");
    const int c = lane & 7;
    float gv[8];
#pragma unroll
    for (int i = 0; i < 8; ++i) gv[i] = gain ? gain[k0 + 8 * c + i] : 1.0f;
#pragma unroll
    for (int j = 0; j < 4; ++j) { const int n = (lane >> 3) + 8 * j; const LAS float* s = scr + (8 * c) * 33 + n; const int nn = n0 + n; const int row = (nn >> 7) * rmul + radd + (nn & 127);
        u32x4 o; o.x = pk2(s[0 * 33] * gv[0], s[1 * 33] * gv[1]); o.y = pk2(s[2 * 33] * gv[2], s[3 * 33] * gv[3]); o.z = pk2(s[4 * 33] * gv[4], s[5 * 33] * gv[5]); o.w = pk2(s[6 * 33] * gv[6], s[7 * 33] * gv[7]);
        *(u32x4*)(WT + (size_t)row * K + k0 + 8 * c) = o; }
    asm volatile("s_waitcnt lgkmcnt(0)" ::: "memory");
}
__device__ __forceinline__ void rms_row_to_bf16(const float* xrow, const float* gain, bf16_t* orow, int lane) {
    const f32x4* xr = (const f32x4*)xrow + lane; const f32x4* gr = (const f32x4*)gain + lane;
    f32x4 v[8]; float s = 0.f;
#pragma unroll
    for (int j = 0; j < 8; ++j) { v[j] = xr[64 * j]; s += (v[j].x * v[j].x + v[j].y * v[j].y) + (v[j].z * v[j].z + v[j].w * v[j].w); }
    const float rstd = 1.0f / sqrtf(wave_sum(s) * (1.0f / D_MODEL) + EPS);
    u32x2* o8 = (u32x2*)orow + lane;
#pragma unroll
    for (int j = 0; j < 8; ++j) { const f32x4 gg = gr[64 * j]; u32x2 w; w.x = pk2(v[j].x * rstd * gg.x, v[j].y * rstd * gg.y); w.y = pk2(v[j].z * rstd * gg.z, v[j].w * rstd * gg.w); o8[64 * j] = w; }
}
__device__ __forceinline__ void p0_ssm_tables(Frame& F, int g, int qr) {
    LAS float* LP = (LAS float*)F.lds; LAS float* BB = LP + 17 * 64 * 2; LAS float* CC = BB + 64 * 16 * 2; LAS float* KT = CC + 16 * 64 * 2;
    const float* a_re = F.in[7]; const float* a_im = F.in[8]; const float* log_dt = F.in[9]; const float* b_re = F.in[10]; const float* b_im = F.in[11]; const float* c_re = F.in[12]; const float* c_im = F.in[13];
    const int tid = F.wave * 64 + lane_id();
    if (tid < 64) {
        const int n = tid;
        const double dt = exp((double)log_dt[g]);
        const double are = (double)a_re[g * 64 + n], aim = (double)a_im[g * 64 + n];
        const double mag = exp(are * dt), ang = aim * dt;
        const double lre = mag * cos(ang), lim = mag * sin(ang);
        const double nr = lre - 1.0, ni = lim, den = are * are + aim * aim;
        const double fre = (nr * are + ni * aim) / den, fim = (ni * are - nr * aim) / den;
        double pr = 1.0, pi = 0.0;
        for (int t = 0; t <= 16; ++t) { LP[(t * 64 + n) * 2] = (float)pr; LP[(t * 64 + n) * 2 + 1] = (float)pi; const double nre = pr * lre - pi * lim, nim = pr * lim + pi * lre; pr = nre; pi = nim; }
        if (qr == 0) { float* l16 = (float*)(F.ws + WS_L16) + (g * 64 + n) * 2; l16[0] = LP[(16 * 64 + n) * 2]; l16[1] = LP[(16 * 64 + n) * 2 + 1]; }
        for (int p = 0; p < 16; ++p) { const double br = (double)b_re[(g * 64 + n) * 16 + p], bi = (double)b_im[(g * 64 + n) * 16 + p];
            BB[(n * 16 + p) * 2] = (float)(fre * br - fim * bi); BB[(n * 16 + p) * 2 + 1] = (float)(fre * bi + fim * br); }
    }
    for (int e = tid; e < 1024; e += 512) { CC[e * 2] = c_re[g * 1024 + e]; CC[e * 2 + 1] = c_im[g * 1024 + e]; }
    __syncthreads();
    for (int e = tid; e < 4096; e += 512) {
        const int tau = e >> 8, p = (e >> 4) & 15, q = e & 15; float sacc = 0.f;
        for (int n = 0; n < 64; ++n) {
            const float cr = CC[(p * 64 + n) * 2], ci = CC[(p * 64 + n) * 2 + 1], lr = LP[(tau * 64 + n) * 2], li = LP[(tau * 64 + n) * 2 + 1];
            const float clr = cr * lr - ci * li, cli = cr * li + ci * lr;
            sacc += clr * BB[(n * 16 + q) * 2] - cli * BB[(n * 16 + q) * 2 + 1];
        }
        KT[e] = sacc;
    }
    __syncthreads();
    bf16_t* Bg = (bf16_t*)(F.ws + WS_BG) + (size_t)g * 256 * SSM_KA;
    for (int ch = tid; ch < 64 * 48; ch += 512) {
        const int rl = ch / 48, c8 = ch % 48, t = 4 * qr + (rl >> 4), p = rl & 15; float v[8];
        if (c8 < 32) { const int s = c8 >> 1, q0 = (c8 & 1) * 8;
#pragma unroll
            for (int i = 0; i < 8; ++i) v[i] = (s <= t) ? KT[((t - s) * 16 + p) * 16 + q0 + i] : 0.f;
        } else { const int n0 = (c8 - 32) * 4;
#pragma unroll
            for (int i = 0; i < 4; ++i) { const int n = n0 + i; const float cr = CC[(p * 64 + n) * 2], ci = CC[(p * 64 + n) * 2 + 1], lr = LP[((t + 1) * 64 + n) * 2], li = LP[((t + 1) * 64 + n) * 2 + 1];
                v[2 * i] = cr * lr - ci * li; v[2 * i + 1] = -(cr * li + ci * lr); }
        }
        u32x4 o; o.x = pk2(v[0], v[1]); o.y = pk2(v[2], v[3]); o.z = pk2(v[4], v[5]); o.w = pk2(v[6], v[7]);
        *(u32x4*)(Bg + (size_t)(t * 16 + p) * SSM_KA + c8 * 8) = o;
    }
    bf16_t* Pg = (bf16_t*)(F.ws + WS_PG) + (size_t)g * 256 * 256;
    for (int ch = tid; ch < 32 * 32; ch += 512) {
        const int rl = ch >> 5, c8 = ch & 31, n = 16 * qr + (rl >> 1), ri = rl & 1, s = c8 >> 1, q0 = (c8 & 1) * 8; float v[8];
        const float lr = LP[((15 - s) * 64 + n) * 2], li = LP[((15 - s) * 64 + n) * 2 + 1];
#pragma unroll
        for (int i = 0; i < 8; ++i) { const float br = BB[(n * 16 + q0 + i) * 2], bi = BB[(n * 16 + q0 + i) * 2 + 1]; v[i] = ri ? (lr * bi + li * br) : (lr * br - li * bi); }
        u32x4 o; o.x = pk2(v[0], v[1]); o.y = pk2(v[2], v[3]); o.z = pk2(v[4], v[5]); o.w = pk2(v[6], v[7]);
        *(u32x4*)(Pg + (size_t)(2 * n + ri) * 256 + c8 * 8) = o;
        *(u32x4*)(Pg + (size_t)(128 + 32 * qr + rl) * 256 + c8 * 8) = (u32x4){0u, 0u, 0u, 0u};
    }
    __syncthreads();
}
__device__ __forceinline__ void p0_prologue(Frame& F) {
    for (int it = F.vcu; it < 256; it += F.G) p0_ssm_tables(F, it >> 2, it & 3);
    LAS float* scr = (LAS float*)(F.lds + F.wave * 16384);
    const int lane = lane_id();
    const int gw = F.vcu * NWAVES + F.wave, NGW = F.G * NWAVES;
    constexpr int I_IN = (D_MODEL / 64) * (IN_W / 32), I_GLU = (SSM_W / 64) * (SSM_W / 32), I_OUT = (2048 / 64) * (D_MODEL / 32), I_G = (D_MODEL / 64) * (FF / 32), I_D = (FF / 64) * (D_MODEL / 32);
    constexpr int NITEMS = I_IN + I_GLU + I_OUT + 2 * I_G + I_D;
    bf16_t* win = (bf16_t*)(F.ws + WS_WIN); bf16_t* wglu = (bf16_t*)(F.ws + WS_WGLU); bf16_t* wout = (bf16_t*)(F.ws + WS_WOUT); bf16_t* wgu = (bf16_t*)(F.ws + WS_WGU); bf16_t* wdn = (bf16_t*)(F.ws + WS_WDN);
    for (int it = gw; it < NITEMS; it += NGW) {
        int r = it;
        if (r < I_IN) { p0_transpose_item(F.in[3], D_MODEL, IN_W, win, nullptr, 128, 0, scr, r, lane); continue; } r -= I_IN;
        if (r < I_GLU) { p0_transpose_item(F.in[15], SSM_W, SSM_W, wglu, nullptr, 128, 0, scr, r, lane); continue; } r -= I_GLU;
        if (r < I_OUT) {
            const int kb = r / (D_MODEL / 32); const float* gn = (kb < 16) ? F.in[16] : (F.in[17] - 1024);
            p0_transpose_item(F.in[18], 2048, D_MODEL, wout, gn, 128, 0, scr, r, lane); continue; } r -= I_OUT;
        if (r < I_G) { p0_transpose_item(F.in[20], D_MODEL, FF, wgu, F.in[19], 256, 0, scr, r, lane); continue; } r -= I_G;
        if (r < I_G) { p0_transpose_item(F.in[21], D_MODEL, FF, wgu, F.in[19], 256, 128, scr, r, lane); continue; } r -= I_G;
        p0_transpose_item(F.in[22], FF, D_MODEL, wdn, nullptr, 128, 0, scr, r, lane);
    }
    bf16_t* xn = (bf16_t*)(F.ws + WS_XN);
    for (int m = gw; m < M; m += NGW) rms_row_to_bf16(F.in[0] + (size_t)m * D_MODEL, F.in[2], xn + (size_t)m * D_MODEL, lane);
}

using pg8::Unit;
struct EpiIn {
    static constexpr bool PERM = true;
    bf16_t* Q; bf16_t* Kb; bf16_t* Vb; bf16_t* Ag;
    __device__ __forceinline__ void operator()(const f32x4 (&acc)[2][2][4][2], const Unit& u, int wr, int wc, int fr, int fq) const {
        const int row0 = u.pm * 256 + wr * 64 + fr, pn = u.pn;
#pragma unroll
        for (int ai = 0; ai < 2; ++ai)
#pragma unroll
            for (int m = 0; m < 4; ++m) { const int row = row0 + ai * 128 + m * 16;
#pragma unroll
                for (int bj = 0; bj < 2; ++bj) { const int col = bj * 128 + wc * 32 + 8 * fq; const f32x4 v0 = acc[ai][bj][m][0], v1 = acc[ai][bj][m][1];
                    u32x4 w; w.x = cvt_pk_bf16(v0[0], v0[1]); w.y = cvt_pk_bf16(v0[2], v0[3]); w.z = cvt_pk_bf16(v1[0], v1[1]); w.w = cvt_pk_bf16(v1[2], v1[3]);
                    bf16_t* dst;
                    if (pn < 4) dst = Q + (size_t)row * ATTN_W + pn * 256 + col;
                    else if (pn == 4) dst = Kb + (size_t)row * KV_W + col;
                    else if (pn == 5) dst = Vb + (size_t)row * KV_W + col;
                    else { const int c = (pn - 6) * 256 + col; dst = Ag + ((size_t)(c >> 4) * 1024 + (row >> 4)) * SSM_KA + (row & 15) * 16 + (c & 15); }
                    *(u32x4*)dst = w; } }
    }
};
struct EpiS {
    static constexpr bool PERM = false;
    float* S;
    __device__ __forceinline__ void operator()(const f32x4 (&acc)[2][2][4][2], const Unit& u, int wr, int wc, int fr, int fq) const {
#pragma unroll
        for (int ai = 0; ai < 2; ++ai)
#pragma unroll
            for (int m = 0; m < 4; ++m) { const int r = ai * 128 + wr * 64 + m * 16 + fr;
#pragma unroll
                for (int n = 0; n < 2; ++n) *(f32x4*)(S + r * 128 + wc * 32 + n * 16 + 4 * fq) = acc[ai][0][m][n]; }
    }
};
struct EpiY {
    static constexpr bool PERM = true;
    const bf16_t* Ag; const float* dd; bf16_t* Yg;
    __device__ __forceinline__ void operator()(const f32x4 (&acc)[2][2][4][2], const Unit& u, int wr, int wc, int fr, int fq) const {
        const int g = u.pm >> 2; const int p0 = (8 * fq) & 15;
        const f32x4 d0 = *(const f32x4*)(dd + g * 16 + p0), d1 = *(const f32x4*)(dd + g * 16 + p0 + 4);
#pragma unroll
        for (int ai = 0; ai < 2; ++ai)
#pragma unroll
            for (int m = 0; m < 4; ++m) { const size_t grow = (size_t)u.pm * 256 + ai * 128 + wr * 64 + m * 16 + fr;
#pragma unroll
                for (int bj = 0; bj < 2; ++bj) { const int col = bj * 128 + wc * 32 + 8 * fq;
                    const u32x4 uu = *(const u32x4*)(Ag + grow * SSM_KA + col); const f32x4 v0 = acc[ai][bj][m][0], v1 = acc[ai][bj][m][1];
                    const float y0 = gelu_tanh(v0[0] + d0[0] * bf_lo(uu.x)), y1 = gelu_tanh(v0[1] + d0[1] * bf_hi(uu.x)), y2 = gelu_tanh(v0[2] + d0[2] * bf_lo(uu.y)), y3 = gelu_tanh(v0[3] + d0[3] * bf_hi(uu.y));
                    const float y4 = gelu_tanh(v1[0] + d1[0] * bf_lo(uu.z)), y5 = gelu_tanh(v1[1] + d1[1] * bf_hi(uu.z)), y6 = gelu_tanh(v1[2] + d1[2] * bf_lo(uu.w)), y7 = gelu_tanh(v1[3] + d1[3] * bf_hi(uu.w));
                    u32x4 w; w.x = cvt_pk_bf16(y0, y1); w.y = cvt_pk_bf16(y2, y3); w.z = cvt_pk_bf16(y4, y5); w.w = cvt_pk_bf16(y6, y7);
                    *(u32x4*)(Yg + grow * 256 + col) = w; } }
    }
};
struct EpiGlu {
    static constexpr bool PERM = true;
    const bf16_t* Yg; bf16_t* mixed; float* ssq;
    __device__ __forceinline__ void operator()(const f32x4 (&acc)[2][2][4][2], const Unit& u, int wr, int wc, int fr, int fq) const {
#pragma unroll
        for (int ai = 0; ai < 2; ++ai)
#pragma unroll
            for (int m = 0; m < 4; ++m) { const int row = u.pm * 256 + ai * 128 + wr * 64 + m * 16 + fr; float sq = 0.f;
#pragma unroll
                for (int bj = 0; bj < 2; ++bj) { const int c = u.pn * 256 + bj * 128 + wc * 32 + 8 * fq;
                    const u32x4 yy = *(const u32x4*)(Yg + ((size_t)(c >> 4) * M + row) * 16 + (c & 15)); const f32x4 v0 = acc[ai][bj][m][0], v1 = acc[ai][bj][m][1];
                    const float s0 = bf_lo(yy.x) * sigmoidf_fast(v0[0]), s1 = bf_hi(yy.x) * sigmoidf_fast(v0[1]), s2 = bf_lo(yy.y) * sigmoidf_fast(v0[2]), s3 = bf_hi(yy.y) * sigmoidf_fast(v0[3]);
                    const float s4 = bf_lo(yy.z) * sigmoidf_fast(v1[0]), s5 = bf_hi(yy.z) * sigmoidf_fast(v1[1]), s6 = bf_lo(yy.w) * sigmoidf_fast(v1[2]), s7 = bf_hi(yy.w) * sigmoidf_fast(v1[3]);
                    sq += (s0 * s0 + s1 * s1) + (s2 * s2 + s3 * s3) + (s4 * s4 + s5 * s5) + (s6 * s6 + s7 * s7);
                    u32x4 w; w.x = cvt_pk_bf16(s0, s1); w.y = cvt_pk_bf16(s2, s3); w.z = cvt_pk_bf16(s4, s5); w.w = cvt_pk_bf16(s6, s7);
                    *(u32x4*)(mixed + (size_t)row * 2048 + 1024 + c) = w; }
                sq += __shfl_xor(sq, 16); sq += __shfl_xor(sq, 32);
                if (fq == 0) atomicAdd(ssq + row, sq); }
    }
};
struct EpiOut {
    static constexpr bool PERM = true;
    const float* x; float* out; bf16_t* x1b; const float* ssq_a; const float* ssq_s; float* ssq_x;
    __device__ __forceinline__ void operator()(const f32x4 (&acc)[2][2][4][2], const Unit& u, int wr, int wc, int fr, int fq) const {
        const float* ssq = u.part ? ssq_s : ssq_a;
#pragma unroll
        for (int ai = 0; ai < 2; ++ai)
#pragma unroll
            for (int m = 0; m < 4; ++m) { const int row = u.pm * 256 + ai * 128 + wr * 64 + m * 16 + fr; const float rstd = 1.0f / sqrtf(ssq[row] * (1.0f / 1024.0f) + EPS); float sq = 0.f;
#pragma unroll
                for (int bj = 0; bj < 2; ++bj) { const size_t off = (size_t)row * D_MODEL + u.pn * 256 + bj * 128 + wc * 32 + 8 * fq;
                    const float* base = u.part ? out : x;
                    const f32x4 b0 = *(const f32x4*)(base + off), b1 = *(const f32x4*)(base + off + 4);
                    const f32x4 o0 = b0 + acc[ai][bj][m][0] * rstd, o1 = b1 + acc[ai][bj][m][1] * rstd;
                    *(f32x4*)(out + off) = o0; *(f32x4*)(out + off + 4) = o1;
                    if (u.part) { sq += (o0[0] * o0[0] + o0[1] * o0[1]) + (o0[2] * o0[2] + o0[3] * o0[3]) + (o1[0] * o1[0] + o1[1] * o1[1]) + (o1[2] * o1[2] + o1[3] * o1[3]);
                        u32x4 w; w.x = cvt_pk_bf16(o0[0], o0[1]); w.y = cvt_pk_bf16(o0[2], o0[3]); w.z = cvt_pk_bf16(o1[0], o1[1]); w.w = cvt_pk_bf16(o1[2], o1[3]);
                        *(u32x4*)(x1b + off) = w; } }
                if (u.part) { sq += __shfl_xor(sq, 16); sq += __shfl_xor(sq, 32); if (fq == 0) atomicAdd(ssq_x + row, sq); } }
    }
};
struct EpiGU {
    static constexpr bool PERM = true;
    const float* ssq_x; bf16_t* H;
    __device__ __forceinline__ void operator()(const f32x4 (&acc)[2][2][4][2], const Unit& u, int wr, int wc, int fr, int fq) const {
#pragma unroll
        for (int ai = 0; ai < 2; ++ai)
#pragma unroll
            for (int m = 0; m < 4; ++m) { const int row = u.pm * 256 + ai * 128 + wr * 64 + m * 16 + fr; const float rstd = 1.0f / sqrtf(ssq_x[row] * (1.0f / 2048.0f) + EPS);
                float h[8];
#pragma unroll
                for (int n = 0; n < 2; ++n)
#pragma unroll
                    for (int i = 0; i < 4; ++i) { const float gv = acc[ai][0][m][n][i] * rstd, uv = acc[ai][1][m][n][i] * rstd; h[4 * n + i] = gv * sigmoidf_fast(gv) * uv; }
                u32x4 w; w.x = cvt_pk_bf16(h[0], h[1]); w.y = cvt_pk_bf16(h[2], h[3]); w.z = cvt_pk_bf16(h[4], h[5]); w.w = cvt_pk_bf16(h[6], h[7]);
                *(u32x4*)(H + (size_t)row * FF + u.pn * 128 + wc * 32 + 8 * fq) = w; }
    }
};
struct EpiDown {
    static constexpr bool PERM = true;
    float* out;
    __device__ __forceinline__ void operator()(const f32x4 (&acc)[2][2][4][2], const Unit& u, int wr, int wc, int fr, int fq) const {
#pragma unroll
        for (int ai = 0; ai < 2; ++ai)
#pragma unroll
            for (int m = 0; m < 4; ++m) { const int row = u.pm * 256 + ai * 128 + wr * 64 + m * 16 + fr;
#pragma unroll
                for (int bj = 0; bj < 2; ++bj) { float* p = out + (size_t)row * D_MODEL + u.pn * 256 + bj * 128 + wc * 32 + 8 * fq;
                    const f32x4 b0 = *(const f32x4*)p, b1 = *(const f32x4*)(p + 4);
                    *(f32x4*)p = b0 + acc[ai][bj][m][0]; *(f32x4*)(p + 4) = b1 + acc[ai][bj][m][1]; } }
    }
};

constexpr int ATT_KROW = 144, ATT_VROW = 520, ATT_K_OFF = 0, ATT_V_OFF = 256 * ATT_KROW, ATT_B_OFF = ATT_V_OFF + 64 * ATT_VROW;
static_assert(ATT_B_OFF + 2048 <= RING_BYTES, "attention LDS");
__device__ __forceinline__ void attn_unit(Frame& F, int b, int qb, int kvh) {
    LAS unsigned char* lds = F.lds;
    const int lane = lane_id(), wave = F.wave, tid = wave * 64 + lane;
    const bf16_t* Q = (const bf16_t*)(F.ws + WS_Q); const bf16_t* Kb = (const bf16_t*)(F.ws + WS_K); const bf16_t* Vb = (const bf16_t*)(F.ws + WS_V);
    bf16_t* mixed = (bf16_t*)(F.ws + WS_MIX); float* ssq_a = (float*)(F.ws + WS_SSQ_A);
    const int T0 = b * SEQ + qb * 128;
    {
        const int key = tid & 255; const bool valid = (qb > 0) || (key >= 128);
        const size_t tok = (size_t)(T0 - 128 + key);
        u32x4 c[8];
        const bf16_t* src = ((tid < 256) ? Kb : Vb) + tok * KV_W + kvh * 64;
#pragma unroll
        for (int i = 0; i < 8; ++i) c[i] = valid ? *(const u32x4*)(src + 8 * i) : (u32x4){0u, 0u, 0u, 0u};
        if (tid < 256) {
            float ss = 0.f;
#pragma unroll
            for (int i = 0; i < 8; ++i) { const float a0 = bf_lo(c[i].x), a1 = bf_hi(c[i].x), a2 = bf_lo(c[i].y), a3 = bf_hi(c[i].y), a4 = bf_lo(c[i].z), a5 = bf_hi(c[i].z), a6 = bf_lo(c[i].w), a7 = bf_hi(c[i].w);
                ss += (a0 * a0 + a1 * a1) + (a2 * a2 + a3 * a3) + (a4 * a4 + a5 * a5) + (a6 * a6 + a7 * a7); }
            const float rstd = 1.0f / sqrtf(ss * (1.0f / 64.0f) + EPS);
            const float* kg = F.in[5];
#pragma unroll
            for (int i = 0; i < 8; ++i) { const f32x4 g0 = *(const f32x4*)(kg + 8 * i), g1 = *(const f32x4*)(kg + 8 * i + 4);
                u32x4 w; w.x = cvt_pk_bf16(bf_lo(c[i].x) * rstd * g0[0], bf_hi(c[i].x) * rstd * g0[1]); w.y = cvt_pk_bf16(bf_lo(c[i].y) * rstd * g0[2], bf_hi(c[i].y) * rstd * g0[3]);
                w.z = cvt_pk_bf16(bf_lo(c[i].z) * rstd * g1[0], bf_hi(c[i].z) * rstd * g1[1]); w.w = cvt_pk_bf16(bf_lo(c[i].w) * rstd * g1[2], bf_hi(c[i].w) * rstd * g1[3]);
                *(LAS u32x4*)(lds + ATT_K_OFF + key * ATT_KROW + i * 16) = w; }
        } else {
#pragma unroll
            for (int i = 0; i < 8; ++i) { const unsigned w4[4] = {c[i].x, c[i].y, c[i].z, c[i].w};
#pragma unroll
                for (int j = 0; j < 4; ++j) { *(LAS unsigned short*)(lds + ATT_V_OFF + (8 * i + 2 * j) * ATT_VROW + key * 2) = (unsigned short)(w4[j] & 0xffffu);
                    *(LAS unsigned short*)(lds + ATT_V_OFF + (8 * i + 2 * j + 1) * ATT_VROW + key * 2) = (unsigned short)(w4[j] >> 16); } }
        }
        { const int hl = tid >> 7, dist = tid & 127; ((LAS float*)(lds + ATT_B_OFF))[tid] = F.in[1][(int)kBucket[dist] * NQH + kvh * 4 + hl] * LOG2E; }
    }
    __syncthreads();
    const int q = lane & 31, hh = lane >> 5;
    for (int it = 0; it < 2; ++it) {
        const int task = wave + 8 * it, hl = task >> 2, grp = task & 3, hq = kvh * 4 + hl, qi = 32 * grp + q;
        bf16x8 qf[4];
        {
            const bf16_t* qp = Q + (size_t)(T0 + qi) * ATTN_W + hq * 64 + hh * 8; u32x4 raw[4]; float ss = 0.f;
#pragma unroll
            for (int ks = 0; ks < 4; ++ks) { raw[ks] = *(const u32x4*)(qp + 16 * ks);
                const float a0 = bf_lo(raw[ks].x), a1 = bf_hi(raw[ks].x), a2 = bf_lo(raw[ks].y), a3 = bf_hi(raw[ks].y), a4 = bf_lo(raw[ks].z), a5 = bf_hi(raw[ks].z), a6 = bf_lo(raw[ks].w), a7 = bf_hi(raw[ks].w);
                ss += (a0 * a0 + a1 * a1) + (a2 * a2 + a3 * a3) + (a4 * a4 + a5 * a5) + (a6 * a6 + a7 * a7); }
            ss += __shfl_xor(ss, 32);
            const float sc = (1.0f / sqrtf(ss * (1.0f / 64.0f) + EPS)) * (0.125f * LOG2E);
            const float* qg = F.in[4];
#pragma unroll
            for (int ks = 0; ks < 4; ++ks) { const f32x4 g0 = *(const f32x4*)(qg + 16 * ks + 8 * hh), g1 = *(const f32x4*)(qg + 16 * ks + 8 * hh + 4);
                u32x4 w; w.x = cvt_pk_bf16(bf_lo(raw[ks].x) * sc * g0[0], bf_hi(raw[ks].x) * sc * g0[1]); w.y = cvt_pk_bf16(bf_lo(raw[ks].y) * sc * g0[2], bf_hi(raw[ks].y) * sc * g0[3]);
                w.z = cvt_pk_bf16(bf_lo(raw[ks].z) * sc * g1[0], bf_hi(raw[ks].z) * sc * g1[1]); w.w = cvt_pk_bf16(bf_lo(raw[ks].w) * sc * g1[2], bf_hi(raw[ks].w) * sc * g1[3]);
                qf[ks] = __builtin_bit_cast(bf16x8, w); }
        }
        f32x16 s[5];
#pragma unroll
        for (int kt = 0; kt < 5; ++kt) {
            f32x16 a = {};
#pragma unroll
            for (int ks = 0; ks < 4; ++ks) { const bf16x8 kf = *(const LAS bf16x8*)(lds + ATT_K_OFF + (32 * (grp + kt) + q) * ATT_KROW + (16 * ks + 8 * hh) * 2);
                a = __builtin_amdgcn_mfma_f32_32x32x16_bf16(kf, qf[ks], a, 0, 0, 0); }
            s[kt] = a;
        }
        const LAS float* b2 = (const LAS float*)(lds + ATT_B_OFF) + hl * 128;
        const float sink2 = F.in[6][hq] * LOG2E;
        float mx = sink2;
#pragma unroll
        for (int kt = 0; kt < 5; ++kt)
#pragma unroll
            for (int r = 0; r < 16; ++r) { const int sj = 32 * (grp + kt) + (r & 3) + 8 * (r >> 2) + 4 * hh; const int dist = qi + 128 - sj;
                const bool ok = ((unsigned)dist < 128u) && ((qb > 0) || (sj >= 128));
                const float v = ok ? s[kt][r] + b2[dist & 127] : -INFINITY; s[kt][r] = v; mx = fmaxf(mx, v); }
        mx = fmaxf(mx, __shfl_xor(mx, 32));
        float l = 0.f;
#pragma unroll
        for (int kt = 0; kt < 5; ++kt)
#pragma unroll
            for (int r = 0; r < 16; ++r) { const float p = fast_exp2(s[kt][r] - mx); s[kt][r] = p; l += p; }
        l += __shfl_xor(l, 32);
        l += fast_exp2(sink2 - mx);
        f32x16 o[2]; o[0] = (f32x16){}; o[1] = (f32x16){};
#pragma unroll
        for (int kt = 0; kt < 5; ++kt)
#pragma unroll
            for (int s2 = 0; s2 < 2; ++s2) {
                u32x4 pw; pw.x = cvt_pk_bf16(s[kt][8 * s2 + 0], s[kt][8 * s2 + 1]); pw.y = cvt_pk_bf16(s[kt][8 * s2 + 2], s[kt][8 * s2 + 3]); pw.z = cvt_pk_bf16(s[kt][8 * s2 + 4], s[kt][8 * s2 + 5]); pw.w = cvt_pk_bf16(s[kt][8 * s2 + 6], s[kt][8 * s2 + 7]);
                const bf16x8 pb = __builtin_bit_cast(bf16x8, pw);
#pragma unroll
                for (int d0 = 0; d0 < 2; ++d0) { const LAS unsigned char* vp = lds + ATT_V_OFF + (32 * d0 + q) * ATT_VROW + (32 * (grp + kt) + 16 * s2 + 4 * hh) * 2;
                    const u32x2 lo = *(const LAS u32x2*)vp, hi = *(const LAS u32x2*)(vp + 16);
                    const u32x4 vv = {lo.x, lo.y, hi.x, hi.y};
                    o[d0] = __builtin_amdgcn_mfma_f32_32x32x16_bf16(__builtin_bit_cast(bf16x8, vv), pb, o[d0], 0, 0, 0); }
            }
        const float inv = 1.0f / l; float sq = 0.f;
        bf16_t* op = mixed + (size_t)(T0 + qi) * 2048 + hq * 64 + 4 * hh;
#pragma unroll
        for (int d0 = 0; d0 < 2; ++d0)
#pragma unroll
            for (int r4 = 0; r4 < 4; ++r4) { const float v0 = o[d0][4 * r4] * inv, v1 = o[d0][4 * r4 + 1] * inv, v2 = o[d0][4 * r4 + 2] * inv, v3 = o[d0][4 * r4 + 3] * inv;
                sq += (v0 * v0 + v1 * v1) + (v2 * v2 + v3 * v3);
                u32x2 w; w.x = cvt_pk_bf16(v0, v1); w.y = cvt_pk_bf16(v2, v3); *(u32x2*)(op + 32 * d0 + 8 * r4) = w; }
        sq += __shfl_xor(sq, 32);
        if (hh == 0) atomicAdd(ssq_a + T0 + qi, sq);
    }
    __syncthreads();
}

__device__ __forceinline__ void ssm_unit(Frame& F, int pm) {
    const int g = pm >> 2;
    float* S = (float*)(F.ws + WS_SSCR) + (size_t)pm * 256 * 128;
    bf16_t* Ag = (bf16_t*)(F.ws + WS_AG);
    {
        int Kc = 256; asm volatile("" : "+s"(Kc));
        pg8::Gemm gm{(const char*)Ag, (const char*)(F.ws + WS_PG), Kc, SSM_KA * 2, 32, 128, 256 * 2};
        pg8::OneUnit S1{pm, g}; EpiS E{S};
        pg8::gemm_phase<EpiS, pg8::OneUnit, false>(F.lds, F.wave, gm, S1, E);
    }
    asm volatile("s_waitcnt vmcnt(0)" ::: "memory");
    __syncthreads();
    if (F.wave == 0) {
        const int n = lane_id();
        const f32x2 l16 = *((const f32x2*)(F.ws + WS_L16) + g * 64 + n);
        float hr = 0.f, hi = 0.f;
        unsigned* hp = (unsigned*)(Ag + (size_t)pm * 256 * SSM_KA + 256) + n;
        const f32x2* sp = (const f32x2*)S + n;
        for (int c0 = 0; c0 < 256; c0 += 8) {
            f32x2 sv[8];
#pragma unroll
            for (int j = 0; j < 8; ++j) sv[j] = sp[(size_t)(c0 + j) * 64];
#pragma unroll
            for (int j = 0; j < 8; ++j) { hp[(size_t)(c0 + j) * (SSM_KA / 2)] = cvt_pk_bf16(hr, hi);
                const float nr = l16.x * hr - l16.y * hi + sv[j].x, ni = l16.x * hi + l16.y * hr + sv[j].y; hr = nr; hi = ni; }
        }
    }
    asm volatile("s_waitcnt vmcnt(0)" ::: "memory");
    __syncthreads();
    {
        int Kc = SSM_KA; asm volatile("" : "+s"(Kc));
        pg8::Gemm gm{(const char*)Ag, (const char*)(F.ws + WS_BG), Kc, SSM_KA * 2, 32, 128, SSM_KA * 2};
        pg8::OneUnit S1{pm, g}; EpiY E{Ag, F.in[14], (bf16_t*)(F.ws + WS_YG)};
        pg8::gemm_phase<EpiY, pg8::OneUnit, false>(F.lds, F.wave, gm, S1, E);
    }
}


#define XB_TMO      128
#define XB_XCNT(j)  (256  + 64 * (j))
#define XB_XSUB(j)  (1280 + 64 * (j))
#define XB_XGEN(j)  (2304 + 64 * (j))
#define XB_TOP      3328
#define XB_TOPGEN   3392
#define XCD_BAR_WORDS 3456
#define XB_SPIN_CAP (1u << 22)
constexpr size_t WS_BAR = 16384;
__device__ __forceinline__ unsigned xb_ld(unsigned* p)              { return __hip_atomic_load(p, __ATOMIC_RELAXED, __HIP_MEMORY_SCOPE_AGENT); }
__device__ __forceinline__ unsigned xb_add(unsigned* p, unsigned v) { return __hip_atomic_fetch_add(p, v, __ATOMIC_RELAXED, __HIP_MEMORY_SCOPE_AGENT); }
__device__ __forceinline__ unsigned xb_xcc_id() { return (unsigned)__builtin_amdgcn_s_getreg((3 << 11) | 20) & 0xFu; }
#define XB_SPIN(cond, bar) do { unsigned _sp = 0; while (cond) { __builtin_amdgcn_s_sleep(1); \
    if ((++_sp & 255u) == 0u) { if (xb_ld(&(bar)[XB_TMO])) break; if (_sp > XB_SPIN_CAP) { atomicAdd(&(bar)[XB_TMO], 1u); break; } } } } while (0)
struct XcdBarrier { unsigned* bar; unsigned x; volatile LAS unsigned* st; };
__device__ __forceinline__ XcdBarrier xcd_barrier_post(unsigned* bar, volatile LAS unsigned* st) {
    XcdBarrier b; b.bar = bar; b.x = xb_xcc_id(); b.st = st;
    if (threadIdx.x == 0) (void)xb_add(&bar[XB_XCNT(b.x)], 1u);
    return b;
}
__device__ __forceinline__ void xcd_barrier_complete(unsigned* bar, unsigned x, unsigned& nloc, unsigned& nx) {
    const unsigned G = gridDim.x * gridDim.y * gridDim.z;
    unsigned sum, cnt, mine, sp = 0u;
    for (;;) {
        sum = 0u; cnt = 0u; mine = 0u;
#pragma unroll
        for (unsigned j = 0; j < 16; ++j) { const unsigned c = xb_ld(&bar[XB_XCNT(j)]); sum += c; cnt += (c > 0u) ? 1u : 0u; mine = (j == x) ? c : mine; }
        if (sum == G) break;
        __builtin_amdgcn_s_sleep(1);
        if ((++sp & 255u) == 0u) { if (xb_ld(&bar[XB_TMO])) break; if (sp > XB_SPIN_CAP) { atomicAdd(&bar[XB_TMO], 1u); break; } }
    }
    nloc = mine > 0u ? mine : 1u; nx = cnt > 0u ? cnt : 1u;
}
__device__ __forceinline__ void xcd_barrier(const XcdBarrier& b, int wave) {
    asm volatile("s_waitcnt vmcnt(0)" ::: "memory");
    __syncthreads();
    if (wave == 0 && lane_id() == 0) {
        unsigned* bar = b.bar;
        __builtin_amdgcn_s_waitcnt(0);
        unsigned nloc = b.st[0], nx = b.st[1];
        if (nloc == 0u) { xcd_barrier_complete(bar, b.x, nloc, nx); b.st[0] = nloc; b.st[1] = nx; }
        const unsigned old = xb_add(&bar[XB_XSUB(b.x)], 1u);
        const unsigned gen = old / nloc;
        if (old + 1u == (gen + 1u) * nloc) {
            __builtin_amdgcn_fence(__ATOMIC_RELEASE, "agent");
            asm volatile("s_waitcnt vmcnt(0)" ::: "memory");
            const unsigned og = xb_add(&bar[XB_TOP], 1u);
            const unsigned tg = og / nx;
            if (og + 1u == (tg + 1u) * nx) xb_add(&bar[XB_TOPGEN], 1u);
            else XB_SPIN(xb_ld(&bar[XB_TOPGEN]) == tg, bar);
            __builtin_amdgcn_fence(__ATOMIC_ACQUIRE, "agent");
            xb_add(&bar[XB_XGEN(b.x)], 1u);
            asm volatile("s_waitcnt vmcnt(0)" ::: "memory");
        } else {
            XB_SPIN(xb_ld(&bar[XB_XGEN(b.x)]) == gen, bar);
            __builtin_amdgcn_fence(__ATOMIC_ACQUIRE, "agent");
            asm volatile("s_waitcnt vmcnt(0)" ::: "memory");
        }
    }
    __syncthreads();
}

struct Args { const float* in[23]; float* out; unsigned char* ws; int ph_lo, ph_hi; };
__global__ void __launch_bounds__(NWAVES * 64, 2) hymba_fwd(Args args) {
    extern __shared__ __attribute__((aligned(16))) unsigned char lds_raw[];
    Frame F;
    F.lds = (LAS unsigned char*)lds_raw;
    F.wave = __builtin_amdgcn_readfirstlane((int)threadIdx.x >> 6);
    F.G = gridDim.x; { const int bx = blockIdx.x; F.vcu = (F.G % 8 == 0) ? (bx % 8) * (F.G / 8) + bx / 8 : bx; }
    F.in = args.in; F.out = args.out; F.ws = args.ws;
    const int lo = args.ph_lo, hi = args.ph_hi;
    for (int u = threadIdx.x; u < (LDS_BYTES - LDSCTL_OFF) / 4; u += NWAVES * 64) ((LAS unsigned*)(F.lds + LDSCTL_OFF))[u] = 0u;
    __syncthreads();
    XcdBarrier bar; bar.bar = (unsigned*)(F.ws + WS_BAR); bar.x = 0; bar.st = nullptr;
    if (MK_N_LAUNCHES == 1) bar = xcd_barrier_post((unsigned*)(F.ws + WS_BAR), (volatile LAS unsigned*)(F.lds + MISC_OFF) + 8);
#define IN(k) (lo <= (k) && (k) < hi)
#define GRID_BAR(k) do { if (IN(k) && IN((k) + 1)) xcd_barrier(bar, F.wave); } while (0)
    unsigned char* ws = F.ws;
    if (IN(0)) { p0_prologue(F); }
    if (IN(0) && IN(1)) cg::this_grid().sync();
    if (IN(1)) {
        pg8::Gemm g{(const char*)(ws + WS_XN), (const char*)(ws + WS_WIN), D_MODEL, D_MODEL * 2, 32, 128, D_MODEL * 2};
        pg8::StaticOrder S; S.init(M, IN_W, F.G, (int)blockIdx.x);
        EpiIn E{(bf16_t*)(ws + WS_Q), (bf16_t*)(ws + WS_K), (bf16_t*)(ws + WS_V), (bf16_t*)(ws + WS_AG)};
        pg8::gemm_phase<EpiIn, pg8::StaticOrder, true>(F.lds, F.wave, g, S, E);
    }
    GRID_BAR(1);
    if (IN(2)) {
        for (int u = F.vcu; u < BATCH * 32 * NKVH; u += F.G) attn_unit(F, u >> 7, (u >> 2) & 31, u & 3);
        if (F.vcu < 256) ssm_unit(F, F.vcu);
    }
    GRID_BAR(2);
    if (IN(3)) {
        pg8::Gemm g{(const char*)(ws + WS_YG), (const char*)(ws + WS_WGLU), SSM_W, 32, (unsigned)(M * 32), (unsigned)(4 * M * 32), SSM_W * 2};
        pg8::StaticOrder S; S.init(M, SSM_W, F.G, (int)blockIdx.x);
        EpiGlu E{(const bf16_t*)(ws + WS_YG), (bf16_t*)(ws + WS_MIX), (float*)(ws + WS_SSQ_S)};
        pg8::gemm_phase<EpiGlu, pg8::StaticOrder, true>(F.lds, F.wave, g, S, E);
    }
    GRID_BAR(3);
    if (IN(4)) {
        pg8::Gemm g{(const char*)(ws + WS_MIX), (const char*)(ws + WS_WOUT), 1024, 2048 * 2, 32, 128, 2048 * 2};
        pg8::TwoPartOrder S; S.S.init(M, D_MODEL, F.G, (int)blockIdx.x); S.kofs = 1024 * 2;
        EpiOut E{F.in[0], F.out, (bf16_t*)(ws + WS_XN), (const float*)(ws + WS_SSQ_A), (const float*)(ws + WS_SSQ_S), (float*)(ws + WS_SSQ_X)};
        pg8::gemm_phase<EpiOut, pg8::TwoPartOrder, true>(F.lds, F.wave, g, S, E);
    }
    GRID_BAR(4);
    if (IN(5)) {
        pg8::Gemm g{(const char*)(ws + WS_XN), (const char*)(ws + WS_WGU), D_MODEL, D_MODEL * 2, 32, 128, D_MODEL * 2};
        pg8::StaticOrder S; S.init(M, 2 * FF, F.G, (int)blockIdx.x);
        EpiGU E{(const float*)(ws + WS_SSQ_X), (bf16_t*)(ws + WS_H)};
        pg8::gemm_phase<EpiGU, pg8::StaticOrder, true>(F.lds, F.wave, g, S, E);
    }
    GRID_BAR(5);
    if (IN(6)) {
        pg8::Gemm g{(const char*)(ws + WS_H), (const char*)(ws + WS_WDN), FF, FF * 2, 32, 128, FF * 2};
        pg8::StaticOrder S; S.init(M, D_MODEL, F.G, (int)blockIdx.x);
        EpiDown E{F.out};
        pg8::gemm_phase<EpiDown, pg8::StaticOrder, true>(F.lds, F.wave, g, S, E);
    }
#undef IN
#undef GRID_BAR
}

extern "C" void kernel_launch(void* const* d_in, const int* in_sizes, int n_in, void* d_out, int out_size, void* d_ws, size_t ws_size, hipStream_t stream) {
    static int grid = 0;
    if (grid == 0) {
        if (n_in != 23 || in_sizes[0] != M * D_MODEL || out_size != M * D_MODEL || ws_size < WS_END) { fprintf(stderr, "kernel_launch: unexpected sizes (n_in %d, out %d, ws %zu); nothing launched\n", n_in, out_size, ws_size); grid = -1; return; }
        int dev = 0, cus = 0, per_cu = 0;
        if (hipGetDevice(&dev) != hipSuccess || hipDeviceGetAttribute(&cus, hipDeviceAttributeMultiprocessorCount, dev) != hipSuccess) { grid = -1; return; }
        if (hipFuncSetAttribute((const void*)hymba_fwd, hipFuncAttributeMaxDynamicSharedMemorySize, LDS_BYTES) != hipSuccess) { fprintf(stderr, "kernel_launch: hipFuncSetAttribute failed\n"); grid = -1; return; }
        if (hipOccupancyMaxActiveBlocksPerMultiprocessor(&per_cu, (const void*)hymba_fwd, NWAVES * 64, LDS_BYTES) != hipSuccess || per_cu < 1) { fprintf(stderr, "kernel_launch: occupancy query failed (%d)\n", per_cu); (void)hipGetLastError(); grid = -1; return; }
        grid = cus;
        if (grid < 256) { fprintf(stderr, "kernel_launch: this kernel needs >= 256 CUs (got %d); nothing launched\n", grid); grid = -1; return; }
    }
    if (grid < 0) return;
    (void)hipMemsetAsync((char*)d_ws + WS_CTL, 0, CTL_ZERO_BYTES, stream);
    Args a{};
    for (int i = 0; i < 23; ++i) a.in[i] = (const float*)d_in[i];
    a.out = (float*)d_out; a.ws = (unsigned char*)d_ws;
    constexpr int NPH = 7;
    for (int li = 0; li < MK_N_LAUNCHES; ++li) {
        a.ph_lo = (MK_N_LAUNCHES == 1) ? 0 : li; a.ph_hi = (MK_N_LAUNCHES == 1) ? NPH : li + 1;
        void* kargs[] = {&a};
        const hipError_t e = hipLaunchCooperativeKernel((const void*)hymba_fwd, dim3(grid), dim3(NWAVES * 64), kargs, LDS_BYTES, stream);
        if (e != hipSuccess) { fprintf(stderr, "kernel_launch: cooperative launch failed: %s (grid %d)\n", hipGetErrorString(e), grid); break; }
    }
}
```

```cpp
#include <hip/hip_runtime.h>
#include <hip/hip_cooperative_groups.h>
#include <cstdio>
#include <cstdint>
namespace cg = cooperative_groups;

#ifndef PROBE_REP
#define PROBE_REP -1
#endif
#ifndef MK_N_LAUNCHES
#define MK_N_LAUNCHES 1
#endif

#define LAS __attribute__((address_space(3)))
typedef unsigned short bf16_t;
typedef short bf16x8 __attribute__((ext_vector_type(8)));
typedef float f32x4 __attribute__((ext_vector_type(4)));
typedef float f32x2 __attribute__((ext_vector_type(2)));
typedef float f32x16 __attribute__((ext_vector_type(16)));
typedef unsigned u32x4 __attribute__((ext_vector_type(4)));
typedef unsigned u32x2 __attribute__((ext_vector_type(2)));

constexpr int D_MODEL = 2048, BATCH = 4, SEQ = 4096, M = BATCH * SEQ;
constexpr int HD = 64, NQH = 16, NKVH = 4, ATTN_W = 1024, KV_W = 256;
constexpr int SSM_W = 1024, SSM_P = 16, SSM_G = 64, SSM_N = 64, IN_W = 2560, FF = 5632;
constexpr int CH_T = 16;
constexpr int SSM_KA = CH_T * SSM_P + 2 * SSM_N;
constexpr float EPS = 1e-6f;
constexpr float LOG2E = 1.4426950408889634f;

__device__ const unsigned char kBucket[128] = {0, 1, 2, 3, 4, 5, 6, 7, 8, 9, 10, 11, 12, 13, 14, 15, 16, 16, 16, 17, 17, 18, 18, 18, 19, 19, 19, 20, 20, 20, 20, 21, 21, 21, 21, 22, 22, 22, 22, 22, 23, 23, 23, 23, 23, 23, 24, 24, 24, 24, 24, 24, 25, 25, 25, 25, 25, 25, 25, 26, 26, 26, 26, 26, 26, 26, 26, 27, 27, 27, 27, 27, 27, 27, 27, 27, 27, 28, 28, 28, 28, 28, 28, 28, 28, 28, 28, 29, 29, 29, 29, 29, 29, 29, 29, 29, 29, 29, 29, 30, 30, 30, 30, 30, 30, 30, 30, 30, 30, 30, 30, 30, 30, 31, 31, 31, 31, 31, 31, 31, 31, 31, 31, 31, 31, 31, 31, 31};

__device__ __forceinline__ unsigned cvt_pk_bf16(float lo, float hi) { unsigned r; asm volatile("v_cvt_pk_bf16_f32 %0, %1, %2" : "=v"(r) : "v"(lo), "v"(hi)); return r; }
__device__ __forceinline__ float bf_lo(unsigned w) { return __builtin_bit_cast(float, w << 16); }
__device__ __forceinline__ float bf_hi(unsigned w) { return __builtin_bit_cast(float, w & 0xffff0000u); }
__device__ __forceinline__ float fast_rcp(float x) { return __builtin_amdgcn_rcpf(x); }
__device__ __forceinline__ float fast_exp2(float x) { return __builtin_amdgcn_exp2f(x); }
__device__ __forceinline__ float sigmoidf_fast(float x) { return fast_rcp(1.0f + fast_exp2(-LOG2E * x)); }
__device__ __forceinline__ float gelu_tanh(float x) {
    const float u2 = 1.5957691216057308f * (x + 0.044715f * x * x * x);
    return x * sigmoidf_fast(u2);
}

__device__ __forceinline__ int lane_id() { int l = __builtin_amdgcn_mbcnt_hi(~0u, __builtin_amdgcn_mbcnt_lo(~0u, 0u)); asm volatile("" : "+v"(l)); return l; }

namespace pg8 {
constexpr int BM = 256, BK = 64, HALF = 128, HTB = HALF * BK * 2  , STAGE_BYTES = 8 * HTB, NXCD = 8, WGM = 8;
__host__ __device__ __forceinline__ int lds_byte(int r, int c) { const int st = (r >> 4) * 2 + (c >> 5), rr = r & 15, cc = c & 31, ob = rr * 64 + cc * 2; return st * 1024 + (ob ^ (((ob >> 9) & 1) << 5)); }
__host__ __device__ __forceinline__ void stage_rc(int b, int& R, int& C) { const int st = b / 1024, sb = b % 1024, swz = sb ^ (((sb >> 9) & 1) << 5); R = (st >> 1) * 16 + swz / 64; C = (st & 1) * 32 + (swz % 64) / 2; }
__host__ __device__ __forceinline__ int perm32(int rho) { const int n = rho >> 4, i = rho & 15; return 8 * (i >> 2) + 4 * n + (i & 3); }

struct Unit { int pm, pn; unsigned aofs, bofs; int part; };
struct Gemm { const char* A; const char* B; int K; unsigned a_rs, a_cs, a_ks, b_rs; };

struct StaticOrder {
    int nM, nN, nwg, G, c;
    __device__ void init(int Mr, int N, int G_, int c_) { nM = Mr / BM; nN = N / BM; nwg = nM * nN; G = G_; c = c_; }
    __device__ bool next(int i, Unit& u) const {
        const long L = (long)i * G + c; if (L >= nwg) return false;
        int wgid = (int)L; { const int q = nwg / NXCD, r = nwg % NXCD, xcd = wgid % NXCD, off = wgid / NXCD; wgid = (xcd < r ? xcd * (q + 1) : r * (q + 1) + (xcd - r) * q) + off; }
        const int nig = WGM * nN, gid = wgid / nig, fm = gid * WGM, gsz = (nM - fm) < WGM ? (nM - fm) : WGM;
        u.pm = fm + ((wgid % nig) % gsz); u.pn = (wgid % nig) / gsz; u.aofs = 0; u.bofs = 0; u.part = 0; return true;
    }
};
struct TwoPartOrder {
    StaticOrder S; unsigned kofs;
    __device__ bool next(int i, Unit& u) const { if (!S.next(i >> 1, u)) return false; u.part = i & 1; u.aofs = u.bofs = (i & 1) ? kofs : 0u; return true; }
};
struct OneUnit {
    int pm, pn;
    __device__ bool next(int i, Unit& u) const { if (i) return false; u.pm = pm; u.pn = pn; u.aofs = 0; u.bofs = 0; u.part = 0; return true; }
};

template <class Epi, class Sched, bool ALIGN_EPI>
__device__ __forceinline__ void gemm_phase(LAS unsigned char* lds, const int wid  , const Gemm g, const Sched& S, const Epi& E) {
    const int lane = lane_id(), tid = wid * 64 + lane, wr = wid >> 2, wc = wid & 3, fr = lane & 15, fq = lane >> 4;
    const int nt = g.K / BK;
    unsigned voffA[2], voffB[2];
#pragma unroll
    for (int i = 0; i < 2; ++i) { int R, C; stage_rc(tid * 16 + i * 8192, R, C); const int Rb = Epi::PERM ? ((R & ~31) + perm32(R & 31)) : R;
        voffA[i] = (unsigned)R * g.a_rs + (unsigned)(C >> 4) * g.a_cs + (unsigned)(C & 15) * 2u; voffB[i] = (unsigned)Rb * g.b_rs + (unsigned)C * 2u; }
    const size_t kstepA = g.a_ks, kstepB = (size_t)(BK * 2);
    const size_t hstepA = (size_t)HALF * g.a_rs, hstepB = (size_t)HALF * g.b_rs, tstepA = 2 * hstepA, tstepB = 2 * hstepB;
    const unsigned ldsw = (unsigned)wid * 1024u;
    const int aoff = lds_byte(wr * 64 + fr, fq * 8), boff = lds_byte(wc * 32 + fr, fq * 8);
#define PG8_SA(b, h) (((b) * 2 + (h)) * HTB)
#define PG8_SB(b, h) ((4 + (b) * 2 + (h)) * HTB)
#define PG8_STAGE(bufoff, gbase, voff) do { _Pragma("unroll") for (int _i = 0; _i < 2; ++_i) \
        __builtin_amdgcn_global_load_lds((const unsigned*)((const char*)(gbase) + (voff)[_i]), (LAS unsigned*)(lds + (bufoff) + ldsw + _i * 8192), 16, 0, 0); } while (0)
#define PG8_LDA(dst, b, h) do { _Pragma("unroll") for (int m = 0; m < 4; ++m) _Pragma("unroll") for (int k = 0; k < 2; ++k) dst[m][k] = *(const LAS bf16x8*)(lds + PG8_SA(b, h) + aoff + m * 2048 + k * 1024); } while (0)
#define PG8_LDB(dst, b, h) do { _Pragma("unroll") for (int n = 0; n < 2; ++n) _Pragma("unroll") for (int k = 0; k < 2; ++k) dst[n][k] = *(const LAS bf16x8*)(lds + PG8_SB(b, h) + boff + n * 2048 + k * 1024); } while (0)
#define PG8_MMA(ai, bj, At, Bt) do { __builtin_amdgcn_s_setprio(1); _Pragma("unroll") for (int m = 0; m < 4; ++m) _Pragma("unroll") for (int n = 0; n < 2; ++n) _Pragma("unroll") for (int k = 0; k < 2; ++k) \
        acc[ai][bj][m][n] = __builtin_amdgcn_mfma_f32_16x16x32_bf16(Bt[n][k], At[m][k], acc[ai][bj][m][n], 0, 0, 0); __builtin_amdgcn_s_setprio(0); } while (0)
#define PG8_WAIT_V(n) asm volatile("s_waitcnt vmcnt(" #n ")" ::: "memory")
#define PG8_WAIT_L(n) asm volatile("s_waitcnt lgkmcnt(" #n ")" ::: "memory")
#define PG8_BAR __builtin_amdgcn_s_barrier()
#define PG8_SCHED __builtin_amdgcn_sched_barrier(0)
    Unit cur, nxt; int ui = 0;
    if (!S.next(0, cur)) return;
    f32x4 acc[2][2][4][2];
#pragma unroll
    for (int a = 0; a < 2; ++a)
#pragma unroll
        for (int b = 0; b < 2; ++b)
#pragma unroll
            for (int m = 0; m < 4; ++m)
#pragma unroll
                for (int n = 0; n < 2; ++n) acc[a][b][m][n] = (f32x4){0.f, 0.f, 0.f, 0.f};
    bf16x8 At[4][2], B0[2][2], B1[2][2];
    const char* cA = g.A + (size_t)cur.pm * tstepA + cur.aofs; const char* cB = g.B + (size_t)cur.pn * tstepB + cur.bofs;
    PG8_STAGE(PG8_SB(0, 0), cB, voffB); PG8_STAGE(PG8_SB(0, 1), cB + hstepB, voffB); PG8_STAGE(PG8_SA(0, 0), cA, voffA); PG8_STAGE(PG8_SA(0, 1), cA + hstepA, voffA);
    if (wr == 1) PG8_BAR;
    PG8_WAIT_V(2); PG8_BAR;
    PG8_STAGE(PG8_SB(1, 0), cB + kstepB, voffB); PG8_STAGE(PG8_SA(1, 0), cA + kstepA, voffA); PG8_STAGE(PG8_SB(1, 1), cB + hstepB + kstepB, voffB);
    PG8_WAIT_V(6); PG8_BAR;
    for (;;) {
        const bool has_next = S.next(ui + 1, nxt);
        const char* nA = has_next ? g.A + (size_t)nxt.pm * tstepA + nxt.aofs : cA; const char* nB = has_next ? g.B + (size_t)nxt.pn * tstepB + nxt.bofs : cB;
        for (int t = 0; t < nt; t += 2) {
            if constexpr (Epi::MID_T > 0) { if (t == Epi::MID_T) E.mid(acc, cur, wr, wc, fr, fq); }
            const bool last = (t == nt - 2);
            const char* a1 = cA + (size_t)(t + 1) * kstepA;
            const char* a2 = last ? nA : cA + (size_t)(t + 2) * kstepA; const char* b2 = last ? nB : cB + (size_t)(t + 2) * kstepB;
            const char* a3 = a2 + kstepA; const char* b3 = b2 + kstepB;
            PG8_LDB(B0, 0, 0); PG8_LDB(B1, 0, 1); PG8_SCHED; PG8_LDA(At, 0, 0); PG8_STAGE(PG8_SA(1, 1), a1 + hstepA, voffA);
            PG8_WAIT_V(8); PG8_WAIT_L(0); PG8_BAR; PG8_MMA(0, 0, At, B0); PG8_MMA(0, 1, At, B1); PG8_BAR; PG8_SCHED;
            PG8_LDA(At, 0, 1); PG8_STAGE(PG8_SB(0, 0), b2, voffB); PG8_STAGE(PG8_SB(0, 1), b2 + hstepB, voffB); PG8_STAGE(PG8_SA(0, 0), a2, voffA);
            PG8_WAIT_V(8); PG8_WAIT_L(0); PG8_BAR; PG8_MMA(1, 0, At, B0); PG8_MMA(1, 1, At, B1); PG8_BAR; PG8_SCHED;
            PG8_LDB(B0, 1, 0); PG8_LDB(B1, 1, 1); PG8_SCHED; PG8_LDA(At, 1, 0); PG8_STAGE(PG8_SA(0, 1), a2 + hstepA, voffA);
            PG8_WAIT_V(8); PG8_WAIT_L(0); PG8_BAR; PG8_MMA(0, 0, At, B0); PG8_MMA(0, 1, At, B1); PG8_BAR; PG8_SCHED;
            PG8_LDA(At, 1, 1); PG8_STAGE(PG8_SB(1, 0), b3, voffB); PG8_STAGE(PG8_SB(1, 1), b3 + hstepB, voffB); PG8_STAGE(PG8_SA(1, 0), a3, voffA);
            PG8_WAIT_V(8); PG8_WAIT_L(0); PG8_BAR; PG8_MMA(1, 0, At, B0); PG8_MMA(1, 1, At, B1); PG8_BAR; PG8_SCHED;
        }
        if constexpr (ALIGN_EPI) { if (wr == 0) PG8_BAR; }
        if constexpr (!Epi::AFTER_DRAIN) E(acc, cur, wr, wc, fr, fq);
        if (!has_next) break;
#pragma unroll
        for (int a = 0; a < 2; ++a)
#pragma unroll
            for (int b = 0; b < 2; ++b)
#pragma unroll
                for (int m = 0; m < 4; ++m)
#pragma unroll
                    for (int n = 0; n < 2; ++n) acc[a][b][m][n] = (f32x4){0.f, 0.f, 0.f, 0.f};
        cur = nxt; cA = nA; cB = nB; ++ui;
        if constexpr (ALIGN_EPI) { if (wr == 1) PG8_BAR; }
    }
    PG8_WAIT_V(0);
    if constexpr (!ALIGN_EPI) { if (wr == 0) PG8_BAR; }
    PG8_BAR;
    if constexpr (Epi::AFTER_DRAIN) E.fused(acc, cur, wr, wc, fr, fq, lds);
#undef PG8_SA
#undef PG8_SB
#undef PG8_STAGE
#undef PG8_LDA
#undef PG8_LDB
#undef PG8_MMA
#undef PG8_WAIT_V
#undef PG8_WAIT_L
#undef PG8_BAR
#undef PG8_SCHED
}
}

constexpr size_t MiB = 1u << 20;
constexpr size_t WS_CTL = 0, CTL_ZERO_BYTES = 1 * MiB;
constexpr size_t WS_SSQ_A = 256 * 1024, WS_SSQ_S = 320 * 1024, WS_SSQ_X = 384 * 1024, WS_SSQ_T = 448 * 1024  ;
constexpr size_t WS_WIN = 2 * MiB;
constexpr size_t WS_WGLU = 12 * MiB;
constexpr size_t WS_WOUT = 14 * MiB;
constexpr size_t WS_WGU = 22 * MiB;
constexpr size_t WS_WDN = 66 * MiB;
constexpr size_t WS_BG = 88 * MiB;
constexpr size_t WS_PG = 100 * MiB;
constexpr size_t WS_L16 = 108 * MiB;
constexpr size_t WS_SSCR = 109 * MiB;
constexpr size_t WS_XN = 141 * MiB;
constexpr size_t WS_Q = 205 * MiB;
constexpr size_t WS_K = 237 * MiB;
constexpr size_t WS_V = 245 * MiB;
constexpr size_t WS_AG = 253 * MiB;
constexpr size_t WS_YG = 301 * MiB;
constexpr size_t WS_MIX = 333 * MiB;
constexpr size_t WS_H = 205 * MiB;
constexpr size_t WS_END = 397 * MiB;
static_assert(WS_H + (size_t)M * FF * 2 <= WS_END, "ws map");

constexpr int RING_BYTES = 131072;
constexpr int LDS_BYTES = 147456;
constexpr int NWAVES = 8;
constexpr int LDSCTL_OFF = RING_BYTES, MISC_OFF = LDSCTL_OFF + 320;

struct Frame {
    LAS unsigned char* lds;
    int wave, vcu, G;
    const float* const* in; float* out; unsigned char* ws;
};

__device__ __forceinline__ float wave_sum(float v) {
#pragma unroll
    for (int o = 1; o < 64; o <<= 1) v += __shfl_xor(v, o);
    return v;
}
__device__ __forceinline__ unsigned f2bf(float f) { unsigned u = __builtin_bit_cast(unsigned, f); return (u + 0x7fffu + ((u >> 16) & 1u)) >> 16; }
__device__ __forceinline__ unsigned pk2(float lo, float hi) { return f2bf(lo) | (f2bf(hi) << 16); }

__device__ __forceinline__ void p0_transpose_item(const float* W, int K, int N, bf16_t* WT, const float* gain, int rmul, int radd, LAS float* scr, int item, int lane) {
    const int nblk = N / 32, kb = item / nblk, nb = item % nblk, k0 = 64 * kb, n0 = 32 * nb;
#pragma unroll 8
    for (int i = 0; i < 32; ++i) { const int kk = 2 * i + (lane >> 5); scr[kk * 33 + (lane & 31)] = W[(size_t)(k0 + kk) * N + n0 + (lane & 31)]; }
    asm volatile("s_waitcnt lgkmcnt(0)" ::: "memory");
    const int c = lane & 7;
    float gv[8];
#pragma unroll
    for (int i = 0; i < 8; ++i) gv[i] = gain ? gain[k0 + 8 * c + i] : 1.0f;
#pragma unroll
    for (int j = 0; j < 4; ++j) { const int n = (lane >> 3) + 8 * j; const LAS float* s = scr + (8 * c) * 33 + n; const int nn = n0 + n; const int row = (nn >> 7) * rmul + radd + (nn & 127);
        u32x4 o; o.x = pk2(s[0 * 33] * gv[0], s[1 * 33] * gv[1]); o.y = pk2(s[2 * 33] * gv[2], s[3 * 33] * gv[3]); o.z = pk2(s[4 * 33] * gv[4], s[5 * 33] * gv[5]); o.w = pk2(s[6 * 33] * gv[6], s[7 * 33] * gv[7]);
        *(u32x4*)(WT + (size_t)row * K + k0 + 8 * c) = o; }
    asm volatile("s_waitcnt lgkmcnt(0)" ::: "memory");
}
__device__ __forceinline__ void rms_row_to_bf16(const float* xrow, const float* gain, bf16_t* orow, int lane) {
    const f32x4* xr = (const f32x4*)xrow + lane; const f32x4* gr = (const f32x4*)gain + lane;
    f32x4 v[8]; float s = 0.f;
#pragma unroll
    for (int j = 0; j < 8; ++j) { v[j] = xr[64 * j]; s += (v[j].x * v[j].x + v[j].y * v[j].y) + (v[j].z * v[j].z + v[j].w * v[j].w); }
    const float rstd = 1.0f / sqrtf(wave_sum(s) * (1.0f / D_MODEL) + EPS);
    u32x2* o8 = (u32x2*)orow + lane;
#pragma unroll
    for (int j = 0; j < 8; ++j) { const f32x4 gg = gr[64 * j]; u32x2 w; w.x = pk2(v[j].x * rstd * gg.x, v[j].y * rstd * gg.y); w.y = pk2(v[j].z * rstd * gg.z, v[j].w * rstd * gg.w); o8[64 * j] = w; }
}
__device__ __forceinline__ void p0_ssm_tables(Frame& F, int g, int qr) {
    LAS float* LP = (LAS float*)F.lds; LAS float* BB = LP + 17 * 64 * 2; LAS float* CC = BB + 64 * 16 * 2; LAS float* KT = CC + 16 * 64 * 2;
    const float* a_re = F.in[7]; const float* a_im = F.in[8]; const float* log_dt = F.in[9]; const float* b_re = F.in[10]; const float* b_im = F.in[11]; const float* c_re = F.in[12]; const float* c_im = F.in[13];
    const int tid = F.wave * 64 + lane_id();
    if (tid < 64) {
        const int n = tid;
        const double dt = exp((double)log_dt[g]);
        const double are = (double)a_re[g * 64 + n], aim = (double)a_im[g * 64 + n];
        const double mag = exp(are * dt), ang = aim * dt;
        const double lre = mag * cos(ang), lim = mag * sin(ang);
        const double nr = lre - 1.0, ni = lim, den = are * are + aim * aim;
        const double fre = (nr * are + ni * aim) / den, fim = (ni * are - nr * aim) / den;
        double pr = 1.0, pi = 0.0;
        for (int t = 0; t <= 16; ++t) { LP[(t * 64 + n) * 2] = (float)pr; LP[(t * 64 + n) * 2 + 1] = (float)pi; const double nre = pr * lre - pi * lim, nim = pr * lim + pi * lre; pr = nre; pi = nim; }
        if (qr == 0) { float* l16 = (float*)(F.ws + WS_L16) + (g * 64 + n) * 2; l16[0] = LP[(16 * 64 + n) * 2]; l16[1] = LP[(16 * 64 + n) * 2 + 1]; }
        for (int p = 0; p < 16; ++p) { const double br = (double)b_re[(g * 64 + n) * 16 + p], bi = (double)b_im[(g * 64 + n) * 16 + p];
            BB[(n * 16 + p) * 2] = (float)(fre * br - fim * bi); BB[(n * 16 + p) * 2 + 1] = (float)(fre * bi + fim * br); }
    }
    for (int e = tid; e < 1024; e += 512) { CC[e * 2] = c_re[g * 1024 + e]; CC[e * 2 + 1] = c_im[g * 1024 + e]; }
    __syncthreads();
    for (int e = tid; e < 4096; e += 512) {
        const int tau = e >> 8, p = (e >> 4) & 15, q = e & 15; float sacc = 0.f;
        for (int n = 0; n < 64; ++n) {
            const float cr = CC[(p * 64 + n) * 2], ci = CC[(p * 64 + n) * 2 + 1], lr = LP[(tau * 64 + n) * 2], li = LP[(tau * 64 + n) * 2 + 1];
            const float clr = cr * lr - ci * li, cli = cr * li + ci * lr;
            sacc += clr * BB[(n * 16 + q) * 2] - cli * BB[(n * 16 + q) * 2 + 1];
        }
        KT[e] = sacc;
    }
    __syncthreads();
    bf16_t* Bg = (bf16_t*)(F.ws + WS_BG) + (size_t)g * 256 * SSM_KA;
    for (int ch = tid; ch < 64 * 48; ch += 512) {
        const int rl = ch / 48, c8 = ch % 48, t = 4 * qr + (rl >> 4), p = rl & 15; float v[8];
        if (c8 < 32) { const int s = c8 >> 1, q0 = (c8 & 1) * 8;
#pragma unroll
            for (int i = 0; i < 8; ++i) v[i] = (s <= t) ? KT[((t - s) * 16 + p) * 16 + q0 + i] : 0.f;
        } else { const int n0 = (c8 - 32) * 4;
#pragma unroll
            for (int i = 0; i < 4; ++i) { const int n = n0 + i; const float cr = CC[(p * 64 + n) * 2], ci = CC[(p * 64 + n) * 2 + 1], lr = LP[((t + 1) * 64 + n) * 2], li = LP[((t + 1) * 64 + n) * 2 + 1];
                v[2 * i] = cr * lr - ci * li; v[2 * i + 1] = -(cr * li + ci * lr); }
        }
        u32x4 o; o.x = pk2(v[0], v[1]); o.y = pk2(v[2], v[3]); o.z = pk2(v[4], v[5]); o.w = pk2(v[6], v[7]);
        *(u32x4*)(Bg + (size_t)(t * 16 + p) * SSM_KA + c8 * 8) = o;
    }
    bf16_t* Pg = (bf16_t*)(F.ws + WS_PG) + (size_t)g * 256 * 256;
    for (int ch = tid; ch < 32 * 32; ch += 512) {
        const int rl = ch >> 5, c8 = ch & 31, n = 16 * qr + (rl >> 1), ri = rl & 1, s = c8 >> 1, q0 = (c8 & 1) * 8; float v[8];
        const float lr = LP[((15 - s) * 64 + n) * 2], li = LP[((15 - s) * 64 + n) * 2 + 1];
#pragma unroll
        for (int i = 0; i < 8; ++i) { const float br = BB[(n * 16 + q0 + i) * 2], bi = BB[(n * 16 + q0 + i) * 2 + 1]; v[i] = ri ? (lr * bi + li * br) : (lr * br - li * bi); }
        u32x4 o; o.x = pk2(v[0], v[1]); o.y = pk2(v[2], v[3]); o.z = pk2(v[4], v[5]); o.w = pk2(v[6], v[7]);
        *(u32x4*)(Pg + (size_t)(2 * n + ri) * 256 + c8 * 8) = o;
        *(u32x4*)(Pg + (size_t)(128 + 32 * qr + rl) * 256 + c8 * 8) = (u32x4){0u, 0u, 0u, 0u};
    }
    __syncthreads();
}
__device__ __forceinline__ void p0_prologue(Frame& F) {
    for (int it = F.vcu; it < 256; it += F.G) p0_ssm_tables(F, it >> 2, it & 3);
    LAS float* scr = (LAS float*)(F.lds + F.wave * 16384);
    const int lane = lane_id();
    const int gw = F.vcu * NWAVES + F.wave, NGW = F.G * NWAVES;
    constexpr int I_IN = (D_MODEL / 64) * (IN_W / 32), I_GLU = (SSM_W / 64) * (SSM_W / 32), I_OUT = (2048 / 64) * (D_MODEL / 32), I_G = (D_MODEL / 64) * (FF / 32), I_D = (FF / 64) * (D_MODEL / 32);
    constexpr int NITEMS = I_IN + I_GLU + I_OUT + 2 * I_G + I_D;
    bf16_t* win = (bf16_t*)(F.ws + WS_WIN); bf16_t* wglu = (bf16_t*)(F.ws + WS_WGLU); bf16_t* wout = (bf16_t*)(F.ws + WS_WOUT); bf16_t* wgu = (bf16_t*)(F.ws + WS_WGU); bf16_t* wdn = (bf16_t*)(F.ws + WS_WDN);
    for (int it = gw; it < NITEMS; it += NGW) {
        int r = it;
        if (r < I_IN) { p0_transpose_item(F.in[3], D_MODEL, IN_W, win, nullptr, 128, 0, scr, r, lane); continue; } r -= I_IN;
        if (r < I_GLU) { p0_transpose_item(F.in[15], SSM_W, SSM_W, wglu, nullptr, 128, 0, scr, r, lane); continue; } r -= I_GLU;
        if (r < I_OUT) {
            const int kb = r / (D_MODEL / 32); const float* gn = (kb < 16) ? F.in[16] : (F.in[17] - 1024);
            p0_transpose_item(F.in[18], 2048, D_MODEL, wout, gn, 128, 0, scr, r, lane); continue; } r -= I_OUT;
        if (r < I_G) { p0_transpose_item(F.in[20], D_MODEL, FF, wgu, F.in[19], 256, 0, scr, r, lane); continue; } r -= I_G;
        if (r < I_G) { p0_transpose_item(F.in[21], D_MODEL, FF, wgu, F.in[19], 256, 128, scr, r, lane); continue; } r -= I_G;
        p0_transpose_item(F.in[22], FF, D_MODEL, wdn, nullptr, 128, 0, scr, r, lane);
    }
    bf16_t* xn = (bf16_t*)(F.ws + WS_XN);
    for (int m = gw; m < M; m += NGW) rms_row_to_bf16(F.in[0] + (size_t)m * D_MODEL, F.in[2], xn + (size_t)m * D_MODEL, lane);
}

using pg8::Unit;
struct EpiIn {
    static constexpr bool PERM = true, AFTER_DRAIN = false; static constexpr int MID_T = 0;
    bf16_t* Q; bf16_t* Kb; bf16_t* Vb; bf16_t* Ag;
    __device__ __forceinline__ void operator()(const f32x4 (&acc)[2][2][4][2], const Unit& u, int wr, int wc, int fr, int fq) const {
        asm volatile("" : "+v"(fr), "+v"(fq));
        const int row0 = u.pm * 256 + wr * 64 + fr, pn = u.pn;
#pragma unroll
        for (int ai = 0; ai < 2; ++ai)
#pragma unroll
            for (int m = 0; m < 4; ++m) { const int row = row0 + ai * 128 + m * 16;
#pragma unroll
                for (int bj = 0; bj < 2; ++bj) { const int col = bj * 128 + wc * 32 + 8 * fq; const f32x4 v0 = acc[ai][bj][m][0], v1 = acc[ai][bj][m][1];
                    u32x4 w; w.x = cvt_pk_bf16(v0[0], v0[1]); w.y = cvt_pk_bf16(v0[2], v0[3]); w.z = cvt_pk_bf16(v1[0], v1[1]); w.w = cvt_pk_bf16(v1[2], v1[3]);
                    bf16_t* dst;
                    if (pn < 4) dst = Q + (size_t)row * ATTN_W + pn * 256 + col;
                    else if (pn == 4) dst = Kb + (size_t)row * KV_W + col;
                    else if (pn == 5) dst = Vb + (size_t)row * KV_W + col;
                    else { const int c = (pn - 6) * 256 + col; dst = Ag + ((size_t)(c >> 4) * 1024 + (row >> 4)) * SSM_KA + (row & 15) * 16 + (c & 15); }
                    *(u32x4*)dst = w; } }
    }
};
struct EpiS {
    static constexpr bool PERM = false, AFTER_DRAIN = true; static constexpr int MID_T = 0;
    __device__ __forceinline__ void operator()(const f32x4 (&acc)[2][2][4][2], const Unit& u, int wr, int wc, int fr, int fq) const {}
    __device__ __forceinline__ void fused(const f32x4 (&acc)[2][2][4][2], const Unit& u, int wr, int wc, int fr, int fq, LAS unsigned char* lds) const {
        asm volatile("" : "+v"(fr), "+v"(fq));
#pragma unroll
        for (int ai = 0; ai < 2; ++ai)
#pragma unroll
            for (int m = 0; m < 4; ++m) { const int r = ai * 128 + wr * 64 + m * 16 + fr;
#pragma unroll
                for (int n = 0; n < 2; ++n) *(LAS f32x4*)(lds + r * 512 + (((wc * 32 + n * 16 + 4 * fq) * 4) ^ ((r & 7) << 4))) = acc[ai][0][m][n]; }
    }
};
struct EpiY {
    static constexpr bool PERM = true, AFTER_DRAIN = false; static constexpr int MID_T = 0;
    const bf16_t* Ag; const float* dd; bf16_t* Yg;
    __device__ __forceinline__ void operator()(const f32x4 (&acc)[2][2][4][2], const Unit& u, int wr, int wc, int fr, int fq) const {
        asm volatile("" : "+v"(fr), "+v"(fq));
        const int g = u.pm >> 2; const int p0 = (8 * fq) & 15;
        const f32x4 d0 = *(const f32x4*)(dd + g * 16 + p0), d1 = *(const f32x4*)(dd + g * 16 + p0 + 4);
#pragma unroll
        for (int ai = 0; ai < 2; ++ai)
#pragma unroll
            for (int m = 0; m < 4; ++m) { const size_t grow = (size_t)u.pm * 256 + ai * 128 + wr * 64 + m * 16 + fr;
#pragma unroll
                for (int bj = 0; bj < 2; ++bj) { const int col = bj * 128 + wc * 32 + 8 * fq;
                    const u32x4 uu = *(const u32x4*)(Ag + grow * SSM_KA + col); const f32x4 v0 = acc[ai][bj][m][0], v1 = acc[ai][bj][m][1];
                    const float y0 = gelu_tanh(v0[0] + d0[0] * bf_lo(uu.x)), y1 = gelu_tanh(v0[1] + d0[1] * bf_hi(uu.x)), y2 = gelu_tanh(v0[2] + d0[2] * bf_lo(uu.y)), y3 = gelu_tanh(v0[3] + d0[3] * bf_hi(uu.y));
                    const float y4 = gelu_tanh(v1[0] + d1[0] * bf_lo(uu.z)), y5 = gelu_tanh(v1[1] + d1[1] * bf_hi(uu.z)), y6 = gelu_tanh(v1[2] + d1[2] * bf_lo(uu.w)), y7 = gelu_tanh(v1[3] + d1[3] * bf_hi(uu.w));
                    u32x4 w; w.x = cvt_pk_bf16(y0, y1); w.y = cvt_pk_bf16(y2, y3); w.z = cvt_pk_bf16(y4, y5); w.w = cvt_pk_bf16(y6, y7);
                    *(u32x4*)(Yg + grow * 256 + col) = w; } }
    }
};
struct EpiGlu {
    static constexpr bool PERM = true, AFTER_DRAIN = false; static constexpr int MID_T = 0;
    const bf16_t* Yg; bf16_t* mixed; float* ssq;
    __device__ __forceinline__ void operator()(const f32x4 (&acc)[2][2][4][2], const Unit& u, int wr, int wc, int fr, int fq) const {
        asm volatile("" : "+v"(fr), "+v"(fq));
#pragma unroll
        for (int ai = 0; ai < 2; ++ai)
#pragma unroll
            for (int m = 0; m < 4; ++m) { const int row = u.pm * 256 + ai * 128 + wr * 64 + m * 16 + fr; float sq = 0.f;
#pragma unroll
                for (int bj = 0; bj < 2; ++bj) { const int c = u.pn * 256 + bj * 128 + wc * 32 + 8 * fq;
                    const u32x4 yy = *(const u32x4*)(Yg + ((size_t)(c >> 4) * M + row) * 16 + (c & 15)); const f32x4 v0 = acc[ai][bj][m][0], v1 = acc[ai][bj][m][1];
                    const float s0 = bf_lo(yy.x) * sigmoidf_fast(v0[0]), s1 = bf_hi(yy.x) * sigmoidf_fast(v0[1]), s2 = bf_lo(yy.y) * sigmoidf_fast(v0[2]), s3 = bf_hi(yy.y) * sigmoidf_fast(v0[3]);
                    const float s4 = bf_lo(yy.z) * sigmoidf_fast(v1[0]), s5 = bf_hi(yy.z) * sigmoidf_fast(v1[1]), s6 = bf_lo(yy.w) * sigmoidf_fast(v1[2]), s7 = bf_hi(yy.w) * sigmoidf_fast(v1[3]);
                    sq += (s0 * s0 + s1 * s1) + (s2 * s2 + s3 * s3) + (s4 * s4 + s5 * s5) + (s6 * s6 + s7 * s7);
                    u32x4 w; w.x = cvt_pk_bf16(s0, s1); w.y = cvt_pk_bf16(s2, s3); w.z = cvt_pk_bf16(s4, s5); w.w = cvt_pk_bf16(s6, s7);
                    *(u32x4*)(mixed + (size_t)row * 2048 + 1024 + c) = w; }
                sq += __shfl_xor(sq, 16); sq += __shfl_xor(sq, 32);
                if (fq == 0) atomicAdd(ssq + row, sq); }
    }
};
struct EpiOut {
    static constexpr bool PERM = true, AFTER_DRAIN = false; static constexpr int MID_T = 16;
    const float* x; bf16_t* x1b; const float* ssq_a; const float* ssq_s; float* ssq_x;
    __device__ __forceinline__ void mid(f32x4 (&acc)[2][2][4][2], const Unit& u, int wr, int wc, int fr, int fq) const {
        asm volatile("" : "+v"(fr), "+v"(fq));
#pragma unroll
        for (int ai = 0; ai < 2; ++ai)
#pragma unroll
            for (int m = 0; m < 4; ++m) { const int row = u.pm * 256 + ai * 128 + wr * 64 + m * 16 + fr;
                const float f = sqrtf((ssq_s[row] * (1.0f / 1024.0f) + EPS) / (ssq_a[row] * (1.0f / 1024.0f) + EPS));
#pragma unroll
                for (int bj = 0; bj < 2; ++bj)
#pragma unroll
                    for (int n = 0; n < 2; ++n) acc[ai][bj][m][n] *= f; }
    }
    __device__ __forceinline__ void operator()(const f32x4 (&acc)[2][2][4][2], const Unit& u, int wr, int wc, int fr, int fq) const {
        asm volatile("" : "+v"(fr), "+v"(fq));
#pragma unroll
        for (int ai = 0; ai < 2; ++ai)
#pragma unroll
            for (int m = 0; m < 4; ++m) { const int row = u.pm * 256 + ai * 128 + wr * 64 + m * 16 + fr; const float rstd = 1.0f / sqrtf(ssq_s[row] * (1.0f / 1024.0f) + EPS); float sq = 0.f;
#pragma unroll
                for (int bj = 0; bj < 2; ++bj) { const size_t off = (size_t)row * D_MODEL + u.pn * 256 + bj * 128 + wc * 32 + 8 * fq;
                    const f32x4 b0 = *(const f32x4*)(x + off), b1 = *(const f32x4*)(x + off + 4);
                    const f32x4 o0 = b0 + acc[ai][bj][m][0] * rstd, o1 = b1 + acc[ai][bj][m][1] * rstd;
                    sq += (o0[0] * o0[0] + o0[1] * o0[1]) + (o0[2] * o0[2] + o0[3] * o0[3]) + (o1[0] * o1[0] + o1[1] * o1[1]) + (o1[2] * o1[2] + o1[3] * o1[3]);
                    u32x4 w; w.x = cvt_pk_bf16(o0[0], o0[1]); w.y = cvt_pk_bf16(o0[2], o0[3]); w.z = cvt_pk_bf16(o1[0], o1[1]); w.w = cvt_pk_bf16(o1[2], o1[3]);
                    *(u32x4*)(x1b + off) = w; }
                sq += __shfl_xor(sq, 16); sq += __shfl_xor(sq, 32); if (fq == 0) atomicAdd(ssq_x + row, sq); }
    }
};
struct EpiGU {
    static constexpr bool PERM = true, AFTER_DRAIN = false; static constexpr int MID_T = 0;
    const float* ssq_x; bf16_t* H;
    __device__ __forceinline__ void operator()(const f32x4 (&acc)[2][2][4][2], const Unit& u, int wr, int wc, int fr, int fq) const {
        asm volatile("" : "+v"(fr), "+v"(fq));
#pragma unroll
        for (int ai = 0; ai < 2; ++ai)
#pragma unroll
            for (int m = 0; m < 4; ++m) { const int row = u.pm * 256 + ai * 128 + wr * 64 + m * 16 + fr; const float rstd = 1.0f / sqrtf(ssq_x[row] * (1.0f / 2048.0f) + EPS);
                float h[8];
#pragma unroll
                for (int n = 0; n < 2; ++n)
#pragma unroll
                    for (int i = 0; i < 4; ++i) { const float gv = acc[ai][0][m][n][i] * rstd, uv = acc[ai][1][m][n][i] * rstd; h[4 * n + i] = gv * sigmoidf_fast(gv) * uv; }
                u32x4 w; w.x = cvt_pk_bf16(h[0], h[1]); w.y = cvt_pk_bf16(h[2], h[3]); w.z = cvt_pk_bf16(h[4], h[5]); w.w = cvt_pk_bf16(h[6], h[7]);
                *(u32x4*)(H + (size_t)row * FF + u.pn * 128 + wc * 32 + 8 * fq) = w; }
    }
};
template <bool DRY> struct EpiDown {
    static constexpr bool PERM = true, AFTER_DRAIN = false; static constexpr int MID_T = 0;
    const bf16_t* x1b; float* out; float* trash;
    __device__ __forceinline__ void operator()(const f32x4 (&acc)[2][2][4][2], const Unit& u, int wr, int wc, int fr, int fq) const {
        asm volatile("" : "+v"(fr), "+v"(fq));
#pragma unroll
        for (int ai = 0; ai < 2; ++ai)
#pragma unroll
            for (int m = 0; m < 4; ++m) { const int row = u.pm * 256 + ai * 128 + wr * 64 + m * 16 + fr;
#pragma unroll
                for (int bj = 0; bj < 2; ++bj) { const size_t off = (size_t)row * D_MODEL + u.pn * 256 + bj * 128 + wc * 32 + 8 * fq;
                    const u32x4 xb = *(const u32x4*)(x1b + off);
                    const f32x4 b0 = {bf_lo(xb.x), bf_hi(xb.x), bf_lo(xb.y), bf_hi(xb.y)}, b1 = {bf_lo(xb.z), bf_hi(xb.z), bf_lo(xb.w), bf_hi(xb.w)};
                    float* q = DRY ? trash + (off & ((8u << 20) - 1)) : out + off;
                    *(f32x4*)q = b0 + acc[ai][bj][m][0]; *(f32x4*)(q + 4) = b1 + acc[ai][bj][m][1]; } }
    }
};

constexpr int ATT_KROW = 144, ATT_VROW = 520, ATT_K_OFF = 0, ATT_V_OFF = 256 * ATT_KROW, ATT_B_OFF = ATT_V_OFF + 64 * ATT_VROW;
static_assert(ATT_B_OFF + 2048 <= RING_BYTES, "attention LDS");
__device__ __forceinline__ void attn_unit(Frame& F, int b, int qb, int kvh, float* ssq_a) {
    LAS unsigned char* lds = F.lds;
    const int lane = lane_id(), wave = F.wave, tid = wave * 64 + lane;
    const bf16_t* Q = (const bf16_t*)(F.ws + WS_Q); const bf16_t* Kb = (const bf16_t*)(F.ws + WS_K); const bf16_t* Vb = (const bf16_t*)(F.ws + WS_V);
    bf16_t* mixed = (bf16_t*)(F.ws + WS_MIX);
    const int T0 = b * SEQ + qb * 128;
    {
        const int key = tid & 255; const bool valid = (qb > 0) || (key >= 128);
        const size_t tok = (size_t)(T0 - 128 + key);
        u32x4 c[8];
        const bf16_t* src = ((tid < 256) ? Kb : Vb) + tok * KV_W + kvh * 64;
#pragma unroll
        for (int i = 0; i < 8; ++i) c[i] = valid ? *(const u32x4*)(src + 8 * i) : (u32x4){0u, 0u, 0u, 0u};
        if (tid < 256) {
            float ss = 0.f;
#pragma unroll
            for (int i = 0; i < 8; ++i) { const float a0 = bf_lo(c[i].x), a1 = bf_hi(c[i].x), a2 = bf_lo(c[i].y), a3 = bf_hi(c[i].y), a4 = bf_lo(c[i].z), a5 = bf_hi(c[i].z), a6 = bf_lo(c[i].w), a7 = bf_hi(c[i].w);
                ss += (a0 * a0 + a1 * a1) + (a2 * a2 + a3 * a3) + (a4 * a4 + a5 * a5) + (a6 * a6 + a7 * a7); }
            const float rstd = 1.0f / sqrtf(ss * (1.0f / 64.0f) + EPS);
            const float* kg = F.in[5];
#pragma unroll
            for (int i = 0; i < 8; ++i) { const f32x4 g0 = *(const f32x4*)(kg + 8 * i), g1 = *(const f32x4*)(kg + 8 * i + 4);
                u32x4 w; w.x = cvt_pk_bf16(bf_lo(c[i].x) * rstd * g0[0], bf_hi(c[i].x) * rstd * g0[1]); w.y = cvt_pk_bf16(bf_lo(c[i].y) * rstd * g0[2], bf_hi(c[i].y) * rstd * g0[3]);
                w.z = cvt_pk_bf16(bf_lo(c[i].z) * rstd * g1[0], bf_hi(c[i].z) * rstd * g1[1]); w.w = cvt_pk_bf16(bf_lo(c[i].w) * rstd * g1[2], bf_hi(c[i].w) * rstd * g1[3]);
                *(LAS u32x4*)(lds + ATT_K_OFF + key * ATT_KROW + i * 16) = w; }
        } else {
#pragma unroll
            for (int i = 0; i < 8; ++i) { const unsigned w4[4] = {c[i].x, c[i].y, c[i].z, c[i].w};
#pragma unroll
                for (int j = 0; j < 4; ++j) { *(LAS unsigned short*)(lds + ATT_V_OFF + (8 * i + 2 * j) * ATT_VROW + key * 2) = (unsigned short)(w4[j] & 0xffffu);
                    *(LAS unsigned short*)(lds + ATT_V_OFF + (8 * i + 2 * j + 1) * ATT_VROW + key * 2) = (unsigned short)(w4[j] >> 16); } }
        }
        { const int hl = tid >> 7, dist = tid & 127; ((LAS float*)(lds + ATT_B_OFF))[tid] = F.in[1][(int)kBucket[dist] * NQH + kvh * 4 + hl] * LOG2E; }
    }
    __syncthreads();
    const int q = lane & 31, hh = lane >> 5;
    for (int it = 0; it < 2; ++it) {
        const int task = wave + 8 * it, hl = task >> 2, grp = task & 3, hq = kvh * 4 + hl, qi = 32 * grp + q;
        bf16x8 qf[4];
        {
            const bf16_t* qp = Q + (size_t)(T0 + qi) * ATTN_W + hq * 64 + hh * 8; u32x4 raw[4]; float ss = 0.f;
#pragma unroll
            for (int ks = 0; ks < 4; ++ks) { raw[ks] = *(const u32x4*)(qp + 16 * ks);
                const float a0 = bf_lo(raw[ks].x), a1 = bf_hi(raw[ks].x), a2 = bf_lo(raw[ks].y), a3 = bf_hi(raw[ks].y), a4 = bf_lo(raw[ks].z), a5 = bf_hi(raw[ks].z), a6 = bf_lo(raw[ks].w), a7 = bf_hi(raw[ks].w);
                ss += (a0 * a0 + a1 * a1) + (a2 * a2 + a3 * a3) + (a4 * a4 + a5 * a5) + (a6 * a6 + a7 * a7); }
            ss += __shfl_xor(ss, 32);
            const float sc = (1.0f / sqrtf(ss * (1.0f / 64.0f) + EPS)) * (0.125f * LOG2E);
            const float* qg = F.in[4];
#pragma unroll
            for (int ks = 0; ks < 4; ++ks) { const f32x4 g0 = *(const f32x4*)(qg + 16 * ks + 8 * hh), g1 = *(const f32x4*)(qg + 16 * ks + 8 * hh + 4);
                u32x4 w; w.x = cvt_pk_bf16(bf_lo(raw[ks].x) * sc * g0[0], bf_hi(raw[ks].x) * sc * g0[1]); w.y = cvt_pk_bf16(bf_lo(raw[ks].y) * sc * g0[2], bf_hi(raw[ks].y) * sc * g0[3]);
                w.z = cvt_pk_bf16(bf_lo(raw[ks].z) * sc * g1[0], bf_hi(raw[ks].z) * sc * g1[1]); w.w = cvt_pk_bf16(bf_lo(raw[ks].w) * sc * g1[2], bf_hi(raw[ks].w) * sc * g1[3]);
                qf[ks] = __builtin_bit_cast(bf16x8, w); }
        }
        f32x16 s[5];
#pragma unroll
        for (int kt = 0; kt < 5; ++kt) {
            f32x16 a = {};
#pragma unroll
            for (int ks = 0; ks < 4; ++ks) { const bf16x8 kf = *(const LAS bf16x8*)(lds + ATT_K_OFF + (32 * (grp + kt) + q) * ATT_KROW + (16 * ks + 8 * hh) * 2);
                a = __builtin_amdgcn_mfma_f32_32x32x16_bf16(kf, qf[ks], a, 0, 0, 0); }
            s[kt] = a;
        }
        const LAS float* b2 = (const LAS float*)(lds + ATT_B_OFF) + hl * 128;
        const float sink2 = F.in[6][hq] * LOG2E;
        float mx = sink2;
#pragma unroll
        for (int kt = 0; kt < 5; ++kt)
#pragma unroll
            for (int r = 0; r < 16; ++r) { const int sj = 32 * (grp + kt) + (r & 3) + 8 * (r >> 2) + 4 * hh; const int dist = qi + 128 - sj;
                const bool ok = ((unsigned)dist < 128u) && ((qb > 0) || (sj >= 128));
                const float v = ok ? s[kt][r] + b2[dist & 127] : -INFINITY; s[kt][r] = v; mx = fmaxf(mx, v); }
        mx = fmaxf(mx, __shfl_xor(mx, 32));
        float l = 0.f;
#pragma unroll
        for (int kt = 0; kt < 5; ++kt)
#pragma unroll
            for (int r = 0; r < 16; ++r) { const float p = fast_exp2(s[kt][r] - mx); s[kt][r] = p; l += p; }
        l += __shfl_xor(l, 32);
        l += fast_exp2(sink2 - mx);
        f32x16 o[2]; o[0] = (f32x16){}; o[1] = (f32x16){};
#pragma unroll
        for (int kt = 0; kt < 5; ++kt)
#pragma unroll
            for (int s2 = 0; s2 < 2; ++s2) {
                u32x4 pw; pw.x = cvt_pk_bf16(s[kt][8 * s2 + 0], s[kt][8 * s2 + 1]); pw.y = cvt_pk_bf16(s[kt][8 * s2 + 2], s[kt][8 * s2 + 3]); pw.z = cvt_pk_bf16(s[kt][8 * s2 + 4], s[kt][8 * s2 + 5]); pw.w = cvt_pk_bf16(s[kt][8 * s2 + 6], s[kt][8 * s2 + 7]);
                const bf16x8 pb = __builtin_bit_cast(bf16x8, pw);
#pragma unroll
                for (int d0 = 0; d0 < 2; ++d0) { const LAS unsigned char* vp = lds + ATT_V_OFF + (32 * d0 + q) * ATT_VROW + (32 * (grp + kt) + 16 * s2 + 4 * hh) * 2;
                    const u32x2 lo = *(const LAS u32x2*)vp, hi = *(const LAS u32x2*)(vp + 16);
                    const u32x4 vv = {lo.x, lo.y, hi.x, hi.y};
                    o[d0] = __builtin_amdgcn_mfma_f32_32x32x16_bf16(__builtin_bit_cast(bf16x8, vv), pb, o[d0], 0, 0, 0); }
            }
        const float inv = 1.0f / l; float sq = 0.f;
        bf16_t* op = mixed + (size_t)(T0 + qi) * 2048 + hq * 64 + 4 * hh;
#pragma unroll
        for (int d0 = 0; d0 < 2; ++d0)
#pragma unroll
            for (int r4 = 0; r4 < 4; ++r4) { const float v0 = o[d0][4 * r4] * inv, v1 = o[d0][4 * r4 + 1] * inv, v2 = o[d0][4 * r4 + 2] * inv, v3 = o[d0][4 * r4 + 3] * inv;
                sq += (v0 * v0 + v1 * v1) + (v2 * v2 + v3 * v3);
                u32x2 w; w.x = cvt_pk_bf16(v0, v1); w.y = cvt_pk_bf16(v2, v3); *(u32x2*)(op + 32 * d0 + 8 * r4) = w; }
        sq += __shfl_xor(sq, 32);
        if (hh == 0) atomicAdd(ssq_a + T0 + qi, sq);
    }
    __syncthreads();
}

__device__ __forceinline__ void ssm_unit(Frame& F, int pm) {
    const int g = pm >> 2;
    bf16_t* Ag = (bf16_t*)(F.ws + WS_AG);
    {
        int Kc = 256; asm volatile("" : "+s"(Kc));
        pg8::Gemm gm{(const char*)Ag, (const char*)(F.ws + WS_PG), Kc, SSM_KA * 2, 32, 128, 256 * 2};
        pg8::OneUnit S1{pm, g}; EpiS E{};
        pg8::gemm_phase<EpiS, pg8::OneUnit, false>(F.lds, F.wave, gm, S1, E);
    }
    asm volatile("s_waitcnt lgkmcnt(0)" ::: "memory");
    __syncthreads();
    if (F.wave == 0) {
        const int n = lane_id();
        const f32x2 l16 = *((const f32x2*)(F.ws + WS_L16) + g * 64 + n);
        float hr = 0.f, hi = 0.f;
        unsigned* hp = (unsigned*)(Ag + (size_t)pm * 256 * SSM_KA + 256) + n;
        for (int c0 = 0; c0 < 256; c0 += 8) {
            f32x2 sv[8];
#pragma unroll
            for (int j = 0; j < 8; ++j) sv[j] = *(const LAS f32x2*)(F.lds + (c0 + j) * 512 + ((8 * n) ^ (j << 4)));
#pragma unroll
            for (int j = 0; j < 8; ++j) { hp[(size_t)(c0 + j) * (SSM_KA / 2)] = cvt_pk_bf16(hr, hi);
                const float nr = l16.x * hr - l16.y * hi + sv[j].x, ni = l16.x * hi + l16.y * hr + sv[j].y; hr = nr; hi = ni; }
        }
    }
    asm volatile("s_waitcnt vmcnt(0) lgkmcnt(0)" ::: "memory");
    __syncthreads();
    {
        int Kc = SSM_KA; asm volatile("" : "+s"(Kc));
        pg8::Gemm gm{(const char*)Ag, (const char*)(F.ws + WS_BG), Kc, SSM_KA * 2, 32, 128, SSM_KA * 2};
        pg8::OneUnit S1{pm, g}; EpiY E{Ag, F.in[14], (bf16_t*)(F.ws + WS_YG)};
        pg8::gemm_phase<EpiY, pg8::OneUnit, false>(F.lds, F.wave, gm, S1, E);
    }
}


#define XB_TMO      128
#define XB_XCNT(j)  (256  + 64 * (j))
#define XB_XSUB(j)  (1280 + 64 * (j))
#define XB_XGEN(j)  (2304 + 64 * (j))
#define XB_TOP      3328
#define XB_TOPGEN   3392
#define XCD_BAR_WORDS 3456
#define XB_SPIN_CAP (1u << 22)
constexpr size_t WS_BAR = 16384;
__device__ __forceinline__ unsigned xb_ld(unsigned* p)              { return __hip_atomic_load(p, __ATOMIC_RELAXED, __HIP_MEMORY_SCOPE_AGENT); }
__device__ __forceinline__ unsigned xb_add(unsigned* p, unsigned v) { return __hip_atomic_fetch_add(p, v, __ATOMIC_RELAXED, __HIP_MEMORY_SCOPE_AGENT); }
__device__ __forceinline__ unsigned xb_xcc_id() { return (unsigned)__builtin_amdgcn_s_getreg((3 << 11) | 20) & 0xFu; }
#define XB_SPIN(cond, bar) do { unsigned _sp = 0; while (cond) { __builtin_amdgcn_s_sleep(1); \
    if ((++_sp & 255u) == 0u) { if (xb_ld(&(bar)[XB_TMO])) break; if (_sp > XB_SPIN_CAP) { atomicAdd(&(bar)[XB_TMO], 1u); break; } } } } while (0)
struct XcdBarrier { unsigned* bar; unsigned x; volatile LAS unsigned* st; };
__device__ __forceinline__ XcdBarrier xcd_barrier_post(unsigned* bar, volatile LAS unsigned* st) {
    XcdBarrier b; b.bar = bar; b.x = xb_xcc_id(); b.st = st;
    if (threadIdx.x == 0) (void)xb_add(&bar[XB_XCNT(b.x)], 1u);
    return b;
}
__device__ __forceinline__ void xcd_barrier_complete(unsigned* bar, unsigned x, unsigned& nloc, unsigned& nx) {
    const unsigned G = gridDim.x * gridDim.y * gridDim.z;
    unsigned sum, cnt, mine, sp = 0u;
    for (;;) {
        sum = 0u; cnt = 0u; mine = 0u;
#pragma unroll
        for (unsigned j = 0; j < 16; ++j) { const unsigned c = xb_ld(&bar[XB_XCNT(j)]); sum += c; cnt += (c > 0u) ? 1u : 0u; mine = (j == x) ? c : mine; }
        if (sum == G) break;
        __builtin_amdgcn_s_sleep(1);
        if ((++sp & 255u) == 0u) { if (xb_ld(&bar[XB_TMO])) break; if (sp > XB_SPIN_CAP) { atomicAdd(&bar[XB_TMO], 1u); break; } }
    }
    nloc = mine > 0u ? mine : 1u; nx = cnt > 0u ? cnt : 1u;
}
__device__ __forceinline__ void xcd_barrier(const XcdBarrier& b, int wave) {
    asm volatile("s_waitcnt vmcnt(0)" ::: "memory");
    __syncthreads();
    if (wave == 0 && lane_id() == 0) {
        unsigned* bar = b.bar;
        __builtin_amdgcn_s_waitcnt(0);
        unsigned nloc = b.st[0], nx = b.st[1];
        if (nloc == 0u) { xcd_barrier_complete(bar, b.x, nloc, nx); b.st[0] = nloc; b.st[1] = nx; }
        const unsigned old = xb_add(&bar[XB_XSUB(b.x)], 1u);
        const unsigned gen = old / nloc;
        if (old + 1u == (gen + 1u) * nloc) {
            __builtin_amdgcn_fence(__ATOMIC_RELEASE, "agent");
            asm volatile("s_waitcnt vmcnt(0)" ::: "memory");
            const unsigned og = xb_add(&bar[XB_TOP], 1u);
            const unsigned tg = og / nx;
            if (og + 1u == (tg + 1u) * nx) xb_add(&bar[XB_TOPGEN], 1u);
            else XB_SPIN(xb_ld(&bar[XB_TOPGEN]) == tg, bar);
            __builtin_amdgcn_fence(__ATOMIC_ACQUIRE, "agent");
            xb_add(&bar[XB_XGEN(b.x)], 1u);
            asm volatile("s_waitcnt vmcnt(0)" ::: "memory");
        } else {
            XB_SPIN(xb_ld(&bar[XB_XGEN(b.x)]) == gen, bar);
            __builtin_amdgcn_fence(__ATOMIC_ACQUIRE, "agent");
            asm volatile("s_waitcnt vmcnt(0)" ::: "memory");
        }
    }
    __syncthreads();
}

struct Args { const float* in[23]; float* out; unsigned char* ws; int ph_lo, ph_hi; };
__global__ void __launch_bounds__(NWAVES * 64, 2) hymba_fwd(Args args) {
    extern __shared__ __attribute__((aligned(16))) unsigned char lds_raw[];
    Frame F;
    F.lds = (LAS unsigned char*)lds_raw;
    F.wave = __builtin_amdgcn_readfirstlane((int)threadIdx.x >> 6);
    F.G = gridDim.x; { const int bx = blockIdx.x; F.vcu = (F.G % 8 == 0) ? (bx % 8) * (F.G / 8) + bx / 8 : bx; }
    F.in = args.in; F.out = args.out; F.ws = args.ws;
    const int lo = args.ph_lo, hi = args.ph_hi;
    for (int u = threadIdx.x; u < (LDS_BYTES - LDSCTL_OFF) / 4; u += NWAVES * 64) ((LAS unsigned*)(F.lds + LDSCTL_OFF))[u] = 0u;
    __syncthreads();
    XcdBarrier bar; bar.bar = (unsigned*)(F.ws + WS_BAR); bar.x = 0; bar.st = nullptr;
    if (MK_N_LAUNCHES == 1) bar = xcd_barrier_post((unsigned*)(F.ws + WS_BAR), (volatile LAS unsigned*)(F.lds + MISC_OFF) + 8);
#define IN(k) (lo <= (k) && (k) < hi)
#define GRID_BAR(k) do { if (IN(k) && IN((k) + 1)) xcd_barrier(bar, F.wave); } while (0)
    unsigned char* ws = F.ws;
    float* const ssq_trash = (float*)(ws + WS_SSQ_T);
#define PHASE0(DRY) { p0_prologue(F); }
#define PHASE1(DRY) {     \
        pg8::Gemm g{(const char*)(ws + WS_XN), (const char*)(ws + WS_WIN), D_MODEL, D_MODEL * 2, 32, 128, D_MODEL * 2}; \
        pg8::StaticOrder S; S.init(M, IN_W, F.G, (int)blockIdx.x); \
        EpiIn E{(bf16_t*)(ws + WS_Q), (bf16_t*)(ws + WS_K), (bf16_t*)(ws + WS_V), (bf16_t*)(ws + WS_AG)}; \
        pg8::gemm_phase<EpiIn, pg8::StaticOrder, true>(F.lds, F.wave, g, S, E); }
#define PHASE2(DRY) { \
        float* const sa_ = (DRY) ? ssq_trash : (float*)(ws + WS_SSQ_A); \
        for (int u = F.vcu; u < BATCH * 32 * NKVH; u += F.G) attn_unit(F, u >> 7, (u >> 2) & 31, u & 3, sa_); \
        if (F.vcu < 256) ssm_unit(F, F.vcu);     }
#define PHASE3(DRY) {     \
        pg8::Gemm g{(const char*)(ws + WS_YG), (const char*)(ws + WS_WGLU), SSM_W, 32, (unsigned)(M * 32), (unsigned)(4 * M * 32), SSM_W * 2}; \
        pg8::StaticOrder S; S.init(M, SSM_W, F.G, (int)blockIdx.x); \
        EpiGlu E{(const bf16_t*)(ws + WS_YG), (bf16_t*)(ws + WS_MIX), (DRY) ? ssq_trash : (float*)(ws + WS_SSQ_S)}; \
        pg8::gemm_phase<EpiGlu, pg8::StaticOrder, true>(F.lds, F.wave, g, S, E); }
#define PHASE4(DRY) {     \
        pg8::Gemm g{(const char*)(ws + WS_MIX), (const char*)(ws + WS_WOUT), 2048, 2048 * 2, 32, 128, 2048 * 2}; \
        pg8::StaticOrder S; S.init(M, D_MODEL, F.G, (int)blockIdx.x); \
        EpiOut E{F.in[0], (bf16_t*)(ws + WS_XN), (const float*)(ws + WS_SSQ_A), (const float*)(ws + WS_SSQ_S), (DRY) ? ssq_trash : (float*)(ws + WS_SSQ_X)}; \
        pg8::gemm_phase<EpiOut, pg8::StaticOrder, true>(F.lds, F.wave, g, S, E); }
#define PHASE5(DRY) {     \
        pg8::Gemm g{(const char*)(ws + WS_XN), (const char*)(ws + WS_WGU), D_MODEL, D_MODEL * 2, 32, 128, D_MODEL * 2}; \
        pg8::StaticOrder S; S.init(M, 2 * FF, F.G, (int)blockIdx.x); \
        EpiGU E{(const float*)(ws + WS_SSQ_X), (bf16_t*)(ws + WS_H)}; \
        pg8::gemm_phase<EpiGU, pg8::StaticOrder, true>(F.lds, F.wave, g, S, E); }
#define PHASE6(DRY) {     \
        pg8::Gemm g{(const char*)(ws + WS_H), (const char*)(ws + WS_WDN), FF, FF * 2, 32, 128, FF * 2}; \
        pg8::StaticOrder S; S.init(M, D_MODEL, F.G, (int)blockIdx.x); \
        EpiDown<(DRY)> E{(const bf16_t*)(ws + WS_XN), F.out, (float*)(ws + WS_SSCR)}; \
        pg8::gemm_phase<EpiDown<(DRY)>, pg8::StaticOrder, true>(F.lds, F.wave, g, S, E); }
#define PHASE2A(DRY) { for (int u = F.vcu; u < BATCH * 32 * NKVH; u += F.G) attn_unit(F, u >> 7, (u >> 2) & 31, u & 3, ssq_trash); }
#define PHASE2S(DRY) { if (F.vcu < 256) ssm_unit(F, F.vcu); }
#define RUN_PHASE(k, BODY) do { if (PROBE_REP == (k) && IN(k)) { BODY(1); xcd_barrier(bar, F.wave); } if (IN(k)) { BODY(0); } } while (0)
    RUN_PHASE(0, PHASE0);
    if (IN(0) && IN(1)) cg::this_grid().sync();
    RUN_PHASE(1, PHASE1);
    GRID_BAR(1);
    if (PROBE_REP == 20 && IN(2)) { PHASE2A(1); xcd_barrier(bar, F.wave); }
    if (PROBE_REP == 21 && IN(2)) { PHASE2S(1); xcd_barrier(bar, F.wave); }
    RUN_PHASE(2, PHASE2);
    GRID_BAR(2);
    RUN_PHASE(3, PHASE3);
    GRID_BAR(3);
    RUN_PHASE(4, PHASE4);
    GRID_BAR(4);
    RUN_PHASE(5, PHASE5);
    GRID_BAR(5);
    RUN_PHASE(6, PHASE6);
#undef IN
#undef GRID_BAR
}

extern "C" void kernel_launch(void* const* d_in, const int* in_sizes, int n_in, void* d_out, int out_size, void* d_ws, size_t ws_size, hipStream_t stream) {
    static int grid = 0;
    if (grid == 0) {
        if (n_in != 23 || in_sizes[0] != M * D_MODEL || out_size != M * D_MODEL || ws_size < WS_END) { fprintf(stderr, "kernel_launch: unexpected sizes (n_in %d, out %d, ws %zu); nothing launched\n", n_in, out_size, ws_size); grid = -1; return; }
        int dev = 0, cus = 0, per_cu = 0;
        if (hipGetDevice(&dev) != hipSuccess || hipDeviceGetAttribute(&cus, hipDeviceAttributeMultiprocessorCount, dev) != hipSuccess) { grid = -1; return; }
        if (hipFuncSetAttribute((const void*)hymba_fwd, hipFuncAttributeMaxDynamicSharedMemorySize, LDS_BYTES) != hipSuccess) { fprintf(stderr, "kernel_launch: hipFuncSetAttribute failed\n"); grid = -1; return; }
        if (hipOccupancyMaxActiveBlocksPerMultiprocessor(&per_cu, (const void*)hymba_fwd, NWAVES * 64, LDS_BYTES) != hipSuccess || per_cu < 1) { fprintf(stderr, "kernel_launch: occupancy query failed (%d)\n", per_cu); (void)hipGetLastError(); grid = -1; return; }
        grid = cus;
        if (grid < 256) { fprintf(stderr, "kernel_launch: this kernel needs >= 256 CUs (got %d); nothing launched\n", grid); grid = -1; return; }
    }
    if (grid < 0) return;
    (void)hipMemsetAsync((char*)d_ws + WS_CTL, 0, CTL_ZERO_BYTES, stream);
    Args a{};
    for (int i = 0; i < 23; ++i) a.in[i] = (const float*)d_in[i];
    a.out = (float*)d_out; a.ws = (unsigned char*)d_ws;
    constexpr int NPH = 7;
    for (int li = 0; li < MK_N_LAUNCHES; ++li) {
        a.ph_lo = (MK_N_LAUNCHES == 1) ? 0 : li; a.ph_hi = (MK_N_LAUNCHES == 1) ? NPH : li + 1;
        void* kargs[] = {&a};
        const hipError_t e = hipLaunchCooperativeKernel((const void*)hymba_fwd, dim3(grid), dim3(NWAVES * 64), kargs, LDS_BYTES, stream);
        if (e != hipSuccess) { fprintf(stderr, "kernel_launch: cooperative launch failed: %s (grid %d)\n", hipGetErrorString(e), grid); break; }
    }
}
```

```cpp
#include <hip/hip_runtime.h>
#include <hip/hip_cooperative_groups.h>
#include <cstdio>
#include <cstdint>
namespace cg = cooperative_groups;

#ifndef PROBE_REP
#define PROBE_REP -1
#endif
#ifndef MK_N_LAUNCHES
#define MK_N_LAUNCHES 1
#endif

#define LAS __attribute__((address_space(3)))
typedef unsigned short bf16_t;
typedef short bf16x8 __attribute__((ext_vector_type(8)));
typedef float f32x4 __attribute__((ext_vector_type(4)));
typedef float f32x2 __attribute__((ext_vector_type(2)));
typedef float f32x16 __attribute__((ext_vector_type(16)));
typedef unsigned u32x4 __attribute__((ext_vector_type(4)));
typedef unsigned u32x2 __attribute__((ext_vector_type(2)));

constexpr int D_MODEL = 2048, BATCH = 4, SEQ = 4096, M = BATCH * SEQ;
constexpr int HD = 64, NQH = 16, NKVH = 4, ATTN_W = 1024, KV_W = 256;
constexpr int SSM_W = 1024, SSM_P = 16, SSM_G = 64, SSM_N = 64, IN_W = 2560, FF = 5632;
constexpr int CH_T = 16;
constexpr int SSM_KA = CH_T * SSM_P + 2 * SSM_N;
constexpr float EPS = 1e-6f;
constexpr float LOG2E = 1.4426950408889634f;

__device__ const unsigned char kBucket[128] = {0, 1, 2, 3, 4, 5, 6, 7, 8, 9, 10, 11, 12, 13, 14, 15, 16, 16, 16, 17, 17, 18, 18, 18, 19, 19, 19, 20, 20, 20, 20, 21, 21, 21, 21, 22, 22, 22, 22, 22, 23, 23, 23, 23, 23, 23, 24, 24, 24, 24, 24, 24, 25, 25, 25, 25, 25, 25, 25, 26, 26, 26, 26, 26, 26, 26, 26, 27, 27, 27, 27, 27, 27, 27, 27, 27, 27, 28, 28, 28, 28, 28, 28, 28, 28, 28, 28, 29, 29, 29, 29, 29, 29, 29, 29, 29, 29, 29, 29, 30, 30, 30, 30, 30, 30, 30, 30, 30, 30, 30, 30, 30, 30, 31, 31, 31, 31, 31, 31, 31, 31, 31, 31, 31, 31, 31, 31, 31};

__device__ __forceinline__ unsigned cvt_pk_bf16(float lo, float hi) { unsigned r; asm volatile("v_cvt_pk_bf16_f32 %0, %1, %2" : "=v"(r) : "v"(lo), "v"(hi)); return r; }
__device__ __forceinline__ float bf_lo(unsigned w) { return __builtin_bit_cast(float, w << 16); }
__device__ __forceinline__ float bf_hi(unsigned w) { return __builtin_bit_cast(float, w & 0xffff0000u); }
__device__ __forceinline__ float fast_rcp(float x) { return __builtin_amdgcn_rcpf(x); }
__device__ __forceinline__ float fast_exp2(float x) { return __builtin_amdgcn_exp2f(x); }
__device__ __forceinline__ float sigmoidf_fast(float x) { return fast_rcp(1.0f + fast_exp2(-LOG2E * x)); }
__device__ __forceinline__ float gelu_tanh(float x) {
    const float u2 = 1.5957691216057308f * (x + 0.044715f * x * x * x);
    return x * sigmoidf_fast(u2);
}

__device__ __forceinline__ int lane_id() { int l = __builtin_amdgcn_mbcnt_hi(~0u, __builtin_amdgcn_mbcnt_lo(~0u, 0u)); asm volatile("" : "+v"(l)); return l; }

namespace pg8 {
constexpr int BM = 256, BK = 64, HALF = 128, HTB = HALF * BK * 2  , STAGE_BYTES = 8 * HTB, NXCD = 8, WGM = 8;
__host__ __device__ __forceinline__ int lds_byte(int r, int c) { const int st = (r >> 4) * 2 + (c >> 5), rr = r & 15, cc = c & 31, ob = rr * 64 + cc * 2; return st * 1024 + (ob ^ (((ob >> 9) & 1) << 5)); }
__host__ __device__ __forceinline__ void stage_rc(int b, int& R, int& C) { const int st = b / 1024, sb = b % 1024, swz = sb ^ (((sb >> 9) & 1) << 5); R = (st >> 1) * 16 + swz / 64; C = (st & 1) * 32 + (swz % 64) / 2; }
__host__ __device__ __forceinline__ int perm32(int rho) { const int n = rho >> 4, i = rho & 15; return 8 * (i >> 2) + 4 * n + (i & 3); }

struct Unit { int pm, pn; unsigned aofs, bofs; int part; };
struct Gemm { const char* A; const char* B; int K; unsigned a_rs, a_cs, a_ks, b_rs; };

struct StaticOrder {
    int nM, nN, nwg, G, c;
    __device__ void init(int Mr, int N, int G_, int c_) { nM = Mr / BM; nN = N / BM; nwg = nM * nN; G = G_; c = c_; }
    __device__ bool next(int i, Unit& u) const {
        const long L = (long)i * G + c; if (L >= nwg) return false;
        int wgid = (int)L; { const int q = nwg / NXCD, r = nwg % NXCD, xcd = wgid % NXCD, off = wgid / NXCD; wgid = (xcd < r ? xcd * (q + 1) : r * (q + 1) + (xcd - r) * q) + off; }
        const int nig = WGM * nN, gid = wgid / nig, fm = gid * WGM, gsz = (nM - fm) < WGM ? (nM - fm) : WGM;
        u.pm = fm + ((wgid % nig) % gsz); u.pn = (wgid % nig) / gsz; u.aofs = 0; u.bofs = 0; u.part = 0; return true;
    }
};
struct TwoPartOrder {
    StaticOrder S; unsigned kofs;
    __device__ bool next(int i, Unit& u) const { if (!S.next(i >> 1, u)) return false; u.part = i & 1; u.aofs = u.bofs = (i & 1) ? kofs : 0u; return true; }
};
struct OneUnit {
    int pm, pn;
    __device__ bool next(int i, Unit& u) const { if (i) return false; u.pm = pm; u.pn = pn; u.aofs = 0; u.bofs = 0; u.part = 0; return true; }
};

template <class Epi, class Sched, bool ALIGN_EPI>
__device__ __forceinline__ void gemm_phase(LAS unsigned char* lds, const int wid  , const Gemm g, const Sched& S, const Epi& E) {
    const int lane = lane_id(), tid = wid * 64 + lane, wr = wid >> 2, wc = wid & 3, fr = lane & 15, fq = lane >> 4;
    const int nt = g.K / BK;
    unsigned voffA[2], voffB[2];
#pragma unroll
    for (int i = 0; i < 2; ++i) { int R, C; stage_rc(tid * 16 + i * 8192, R, C); const int Rb = Epi::PERM ? ((R & ~31) + perm32(R & 31)) : R;
        voffA[i] = (unsigned)R * g.a_rs + (unsigned)(C >> 4) * g.a_cs + (unsigned)(C & 15) * 2u; voffB[i] = (unsigned)Rb * g.b_rs + (unsigned)C * 2u; }
    const size_t kstepA = g.a_ks, kstepB = (size_t)(BK * 2);
    const size_t hstepA = (size_t)HALF * g.a_rs, hstepB = (size_t)HALF * g.b_rs, tstepA = 2 * hstepA, tstepB = 2 * hstepB;
    const unsigned ldsw = (unsigned)wid * 1024u;
    const int aoff = lds_byte(wr * 64 + fr, fq * 8), boff = lds_byte(wc * 32 + fr, fq * 8);
#define PG8_SA(b, h) (((b) * 2 + (h)) * HTB)
#define PG8_SB(b, h) ((4 + (b) * 2 + (h)) * HTB)
#define PG8_STAGE(bufoff, gbase, voff) do { _Pragma("unroll") for (int _i = 0; _i < 2; ++_i) \
        __builtin_amdgcn_global_load_lds((const unsigned*)((const char*)(gbase) + (voff)[_i]), (LAS unsigned*)(lds + (bufoff) + ldsw + _i * 8192), 16, 0, 0); } while (0)
#define PG8_LDA(dst, b, h) do { _Pragma("unroll") for (int m = 0; m < 4; ++m) _Pragma("unroll") for (int k = 0; k < 2; ++k) dst[m][k] = *(const LAS bf16x8*)(lds + PG8_SA(b, h) + aoff + m * 2048 + k * 1024); } while (0)
#define PG8_LDB(dst, b, h) do { _Pragma("unroll") for (int n = 0; n < 2; ++n) _Pragma("unroll") for (int k = 0; k < 2; ++k) dst[n][k] = *(const LAS bf16x8*)(lds + PG8_SB(b, h) + boff + n * 2048 + k * 1024); } while (0)
#define PG8_MMA(ai, bj, At, Bt) do { __builtin_amdgcn_s_setprio(1); _Pragma("unroll") for (int m = 0; m < 4; ++m) _Pragma("unroll") for (int n = 0; n < 2; ++n) _Pragma("unroll") for (int k = 0; k < 2; ++k) \
        acc[ai][bj][m][n] = __builtin_amdgcn_mfma_f32_16x16x32_bf16(Bt[n][k], At[m][k], acc[ai][bj][m][n], 0, 0, 0); __builtin_amdgcn_s_setprio(0); } while (0)
#define PG8_WAIT_V(n) asm volatile("s_waitcnt vmcnt(" #n ")" ::: "memory")
#define PG8_WAIT_L(n) asm volatile("s_waitcnt lgkmcnt(" #n ")" ::: "memory")
#define PG8_BAR __builtin_amdgcn_s_barrier()
#define PG8_SCHED __builtin_amdgcn_sched_barrier(0)
    Unit cur, nxt; int ui = 0;
    if (!S.next(0, cur)) return;
    f32x4 acc[2][2][4][2];
#pragma unroll
    for (int a = 0; a < 2; ++a)
#pragma unroll
        for (int b = 0; b < 2; ++b)
#pragma unroll
            for (int m = 0; m < 4; ++m)
#pragma unroll
                for (int n = 0; n < 2; ++n) acc[a][b][m][n] = (f32x4){0.f, 0.f, 0.f, 0.f};
    bf16x8 At[4][2], B0[2][2], B1[2][2];
    const char* cA = g.A + (size_t)cur.pm * tstepA + cur.aofs; const char* cB = g.B + (size_t)cur.pn * tstepB + cur.bofs;
    PG8_STAGE(PG8_SB(0, 0), cB, voffB); PG8_STAGE(PG8_SB(0, 1), cB + hstepB, voffB); PG8_STAGE(PG8_SA(0, 0), cA, voffA); PG8_STAGE(PG8_SA(0, 1), cA + hstepA, voffA);
    if (wr == 1) PG8_BAR;
    PG8_WAIT_V(2); PG8_BAR;
    PG8_STAGE(PG8_SB(1, 0), cB + kstepB, voffB); PG8_STAGE(PG8_SA(1, 0), cA + kstepA, voffA); PG8_STAGE(PG8_SB(1, 1), cB + hstepB + kstepB, voffB);
    PG8_WAIT_V(6); PG8_BAR;
    for (;;) {
        const bool has_next = S.next(ui + 1, nxt);
        const char* nA = has_next ? g.A + (size_t)nxt.pm * tstepA + nxt.aofs : cA; const char* nB = has_next ? g.B + (size_t)nxt.pn * tstepB + nxt.bofs : cB;
        for (int t = 0; t < nt; t += 2) {
            if constexpr (Epi::MID_T > 0) { if (t == Epi::MID_T) E.mid(acc, cur, wr, wc, fr, fq); }
            const bool last = (t == nt - 2);
            const char* a1 = cA + (size_t)(t + 1) * kstepA;
            const char* a2 = last ? nA : cA + (size_t)(t + 2) * kstepA; const char* b2 = last ? nB : cB + (size_t)(t + 2) * kstepB;
            const char* a3 = a2 + kstepA; const char* b3 = b2 + kstepB;
            PG8_LDB(B0, 0, 0); PG8_LDB(B1, 0, 1); PG8_SCHED; PG8_LDA(At, 0, 0); PG8_STAGE(PG8_SA(1, 1), a1 + hstepA, voffA);
            PG8_WAIT_V(8); PG8_WAIT_L(0); PG8_BAR; PG8_MMA(0, 0, At, B0); PG8_MMA(0, 1, At, B1); PG8_BAR; PG8_SCHED;
            PG8_LDA(At, 0, 1); PG8_STAGE(PG8_SB(0, 0), b2, voffB); PG8_STAGE(PG8_SB(0, 1), b2 + hstepB, voffB); PG8_STAGE(PG8_SA(0, 0), a2, voffA);
            PG8_WAIT_V(8); PG8_WAIT_L(0); PG8_BAR; PG8_MMA(1, 0, At, B0); PG8_MMA(1, 1, At, B1); PG8_BAR; PG8_SCHED;
            PG8_LDB(B0, 1, 0); PG8_LDB(B1, 1, 1); PG8_SCHED; PG8_LDA(At, 1, 0); PG8_STAGE(PG8_SA(0, 1), a2 + hstepA, voffA);
            PG8_WAIT_V(8); PG8_WAIT_L(0); PG8_BAR; PG8_MMA(0, 0, At, B0); PG8_MMA(0, 1, At, B1); PG8_BAR; PG8_SCHED;
            PG8_LDA(At, 1, 1); PG8_STAGE(PG8_SB(1, 0), b3, voffB); PG8_STAGE(PG8_SB(1, 1), b3 + hstepB, voffB); PG8_STAGE(PG8_SA(1, 0), a3, voffA);
            PG8_WAIT_V(8); PG8_WAIT_L(0); PG8_BAR; PG8_MMA(1, 0, At, B0); PG8_MMA(1, 1, At, B1); PG8_BAR; PG8_SCHED;
        }
        if constexpr (ALIGN_EPI) { if (wr == 0) PG8_BAR; }
        if constexpr (!Epi::AFTER_DRAIN) E(acc, cur, wr, wc, fr, fq);
        if (!has_next) break;
#pragma unroll
        for (int a = 0; a < 2; ++a)
#pragma unroll
            for (int b = 0; b < 2; ++b)
#pragma unroll
                for (int m = 0; m < 4; ++m)
#pragma unroll
                    for (int n = 0; n < 2; ++n) acc[a][b][m][n] = (f32x4){0.f, 0.f, 0.f, 0.f};
        cur = nxt; cA = nA; cB = nB; ++ui;
        if constexpr (ALIGN_EPI) { if (wr == 1) PG8_BAR; }
    }
    PG8_WAIT_V(0);
    if constexpr (!ALIGN_EPI) { if (wr == 0) PG8_BAR; }
    PG8_BAR;
    if constexpr (Epi::AFTER_DRAIN) E.fused(acc, cur, wr, wc, fr, fq, lds);
#undef PG8_SA
#undef PG8_SB
#undef PG8_STAGE
#undef PG8_LDA
#undef PG8_LDB
#undef PG8_MMA
#undef PG8_WAIT_V
#undef PG8_WAIT_L
#undef PG8_BAR
#undef PG8_SCHED
}
}

constexpr size_t MiB = 1u << 20;
constexpr size_t WS_CTL = 0, CTL_ZERO_BYTES = 1 * MiB;
constexpr size_t WS_SSQ_A = 256 * 1024, WS_SSQ_S = 320 * 1024, WS_SSQ_X = 384 * 1024, WS_SSQ_T = 448 * 1024  ;
constexpr size_t WS_WIN = 2 * MiB;
constexpr size_t WS_WGLU = 12 * MiB;
constexpr size_t WS_WOUT = 14 * MiB;
constexpr size_t WS_WGU = 22 * MiB;
constexpr size_t WS_WDN = 66 * MiB;
constexpr size_t WS_BG = 88 * MiB;
constexpr size_t WS_PG = 100 * MiB;
constexpr size_t WS_L16 = 108 * MiB;
constexpr size_t WS_SSCR = 109 * MiB;
constexpr size_t WS_XN = 141 * MiB;
constexpr size_t WS_Q = 205 * MiB;
constexpr size_t WS_K = 237 * MiB;
constexpr size_t WS_V = 245 * MiB;
constexpr size_t WS_AG = 253 * MiB;
constexpr size_t WS_YG = 301 * MiB;
constexpr size_t WS_MIX = 333 * MiB;
constexpr size_t WS_H = 205 * MiB;
constexpr size_t WS_END = 397 * MiB;
static_assert(WS_H + (size_t)M * FF * 2 <= WS_END, "ws map");

constexpr int RING_BYTES = 131072;
constexpr int LDS_BYTES = 147456;
constexpr int NWAVES = 8;
constexpr int LDSCTL_OFF = RING_BYTES, MISC_OFF = LDSCTL_OFF + 320;

struct Frame {
    LAS unsigned char* lds;
    int wave, vcu, G;
    const float* const* in; float* out; unsigned char* ws;
};

__device__ __forceinline__ float wave_sum(float v) {
#pragma unroll
    for (int o = 1; o < 64; o <<= 1) v += __shfl_xor(v, o);
    return v;
}
__device__ __forceinline__ unsigned f2bf(float f) { unsigned u = __builtin_bit_cast(unsigned, f); return (u + 0x7fffu + ((u >> 16) & 1u)) >> 16; }
__device__ __forceinline__ unsigned pk2(float lo, float hi) { return f2bf(lo) | (f2bf(hi) << 16); }

__device__ __forceinline__ void p0_transpose_item(const float* W, int K, int N, bf16_t* WT, const float* gain, int rmul, int radd, LAS float* scr, int item, int lane) {
    const int nblk = N / 32, kb = item / nblk, nb = item % nblk, k0 = 64 * kb, n0 = 32 * nb;
#pragma unroll 8
    for (int i = 0; i < 32; ++i) { const int kk = 2 * i + (lane >> 5); scr[kk * 33 + (lane & 31)] = W[(size_t)(k0 + kk) * N + n0 + (lane & 31)]; }
    asm volatile("s_waitcnt lgkmcnt(0)" ::: "memory");
    const int c = lane & 7;
    float gv[8];
#pragma unroll
    for (int i = 0; i < 8; ++i) gv[i] = gain ? gain[k0 + 8 * c + i] : 1.0f;
#pragma unroll
    for (int j = 0; j < 4; ++j) { const int n = (lane >> 3) + 8 * j; const LAS float* s = scr + (8 * c) * 33 + n; const int nn = n0 + n; const int row = (nn >> 7) * rmul + radd + (nn & 127);
        u32x4 o; o.x = pk2(s[0 * 33] * gv[0], s[1 * 33] * gv[1]); o.y = pk2(s[2 * 33] * gv[2], s[3 * 33] * gv[3]); o.z = pk2(s[4 * 33] * gv[4], s[5 * 33] * gv[5]); o.w = pk2(s[6 * 33] * gv[6], s[7 * 33] * gv[7]);
        *(u32x4*)(WT + (size_t)row * K + k0 + 8 * c) = o; }
    asm volatile("s_waitcnt lgkmcnt(0)" ::: "memory");
}
__device__ __forceinline__ void rms_row_to_bf16(const float* xrow, const float* gain, bf16_t* orow, int lane) {
    const f32x4* xr = (const f32x4*)xrow + lane; const f32x4* gr = (const f32x4*)gain + lane;
    f32x4 v[8]; float s = 0.f;
#pragma unroll
    for (int j = 0; j < 8; ++j) { v[j] = xr[64 * j]; s += (v[j].x * v[j].x + v[j].y * v[j].y) + (v[j].z * v[j].z + v[j].w * v[j].w); }
    const float rstd = 1.0f / sqrtf(wave_sum(s) * (1.0f / D_MODEL) + EPS);
    u32x2* o8 = (u32x2*)orow + lane;
#pragma unroll
    for (int j = 0; j < 8; ++j) { const f32x4 gg = gr[64 * j]; u32x2 w; w.x = pk2(v[j].x * rstd * gg.x, v[j].y * rstd * gg.y); w.y = pk2(v[j].z * rstd * gg.z, v[j].w * rstd * gg.w); o8[64 * j] = w; }
}
__device__ __forceinline__ void p0_ssm_tables(Frame& F, int g, int qr) {
    LAS float* LP = (LAS float*)F.lds; LAS float* BB = LP + 17 * 64 * 2; LAS float* CC = BB + 64 * 16 * 2; LAS float* KT = CC + 16 * 64 * 2;
    const float* a_re = F.in[7]; const float* a_im = F.in[8]; const float* log_dt = F.in[9]; const float* b_re = F.in[10]; const float* b_im = F.in[11]; const float* c_re = F.in[12]; const float* c_im = F.in[13];
    const int tid = F.wave * 64 + lane_id();
    if (tid < 64) {
        const int n = tid;
        const double dt = exp((double)log_dt[g]);
        const double are = (double)a_re[g * 64 + n], aim = (double)a_im[g * 64 + n];
        const double mag = exp(are * dt), ang = aim * dt;
        const double lre = mag * cos(ang), lim = mag * sin(ang);
        const double nr = lre - 1.0, ni = lim, den = are * are + aim * aim;
        const double fre = (nr * are + ni * aim) / den, fim = (ni * are - nr * aim) / den;
        double pr = 1.0, pi = 0.0;
        for (int t = 0; t <= 16; ++t) { LP[(t * 64 + n) * 2] = (float)pr; LP[(t * 64 + n) * 2 + 1] = (float)pi; const double nre = pr * lre - pi * lim, nim = pr * lim + pi * lre; pr = nre; pi = nim; }
        if (qr == 0) { float* l16 = (float*)(F.ws + WS_L16) + (g * 64 + n) * 2; l16[0] = LP[(16 * 64 + n) * 2]; l16[1] = LP[(16 * 64 + n) * 2 + 1]; }
        for (int p = 0; p < 16; ++p) { const double br = (double)b_re[(g * 64 + n) * 16 + p], bi = (double)b_im[(g * 64 + n) * 16 + p];
            BB[(n * 16 + p) * 2] = (float)(fre * br - fim * bi); BB[(n * 16 + p) * 2 + 1] = (float)(fre * bi + fim * br); }
    }
    for (int e = tid; e < 1024; e += 512) { CC[e * 2] = c_re[g * 1024 + e]; CC[e * 2 + 1] = c_im[g * 1024 + e]; }
    __syncthreads();
    {
        const int p = (tid >> 4) & 15, q = tid & 15, th = tid >> 8; float ka[8];
#pragma unroll
        for (int j = 0; j < 8; ++j) ka[j] = 0.f;
        for (int n = 0; n < 64; ++n) {
            const f32x2 c = *(const LAS f32x2*)(CC + (p * 64 + n) * 2), bb = *(const LAS f32x2*)(BB + (n * 16 + q) * 2);
            const float cbr = c.x * bb.x - c.y * bb.y, cbi = c.x * bb.y + c.y * bb.x;
#pragma unroll
            for (int j = 0; j < 8; ++j) { const f32x2 l = *(const LAS f32x2*)(LP + ((8 * th + j) * 64 + n) * 2); ka[j] += cbr * l.x - cbi * l.y; }
        }
#pragma unroll
        for (int j = 0; j < 8; ++j) KT[((8 * th + j) * 16 + p) * 16 + q] = ka[j];
    }
    __syncthreads();
    bf16_t* Bg = (bf16_t*)(F.ws + WS_BG) + (size_t)g * 256 * SSM_KA;
    for (int ch = tid; ch < 64 * 48; ch += 512) {
        const int rl = ch / 48, c8 = ch % 48, t = 4 * qr + (rl >> 4), p = rl & 15; float v[8];
        if (c8 < 32) { const int s = c8 >> 1, q0 = (c8 & 1) * 8;
#pragma unroll
            for (int i = 0; i < 8; ++i) v[i] = (s <= t) ? KT[((t - s) * 16 + p) * 16 + q0 + i] : 0.f;
        } else { const int n0 = (c8 - 32) * 4;
#pragma unroll
            for (int i = 0; i < 4; ++i) { const int n = n0 + i; const float cr = CC[(p * 64 + n) * 2], ci = CC[(p * 64 + n) * 2 + 1], lr = LP[((t + 1) * 64 + n) * 2], li = LP[((t + 1) * 64 + n) * 2 + 1];
                v[2 * i] = cr * lr - ci * li; v[2 * i + 1] = -(cr * li + ci * lr); }
        }
        u32x4 o; o.x = pk2(v[0], v[1]); o.y = pk2(v[2], v[3]); o.z = pk2(v[4], v[5]); o.w = pk2(v[6], v[7]);
        *(u32x4*)(Bg + (size_t)(t * 16 + p) * SSM_KA + c8 * 8) = o;
    }
    bf16_t* Pg = (bf16_t*)(F.ws + WS_PG) + (size_t)g * 256 * 256;
    for (int ch = tid; ch < 32 * 32; ch += 512) {
        const int rl = ch >> 5, c8 = ch & 31, n = 16 * qr + (rl >> 1), ri = rl & 1, s = c8 >> 1, q0 = (c8 & 1) * 8; float v[8];
        const float lr = LP[((15 - s) * 64 + n) * 2], li = LP[((15 - s) * 64 + n) * 2 + 1];
#pragma unroll
        for (int i = 0; i < 8; ++i) { const float br = BB[(n * 16 + q0 + i) * 2], bi = BB[(n * 16 + q0 + i) * 2 + 1]; v[i] = ri ? (lr * bi + li * br) : (lr * br - li * bi); }
        u32x4 o; o.x = pk2(v[0], v[1]); o.y = pk2(v[2], v[3]); o.z = pk2(v[4], v[5]); o.w = pk2(v[6], v[7]);
        *(u32x4*)(Pg + (size_t)(2 * n + ri) * 256 + c8 * 8) = o;
        *(u32x4*)(Pg + (size_t)(128 + 32 * qr + rl) * 256 + c8 * 8) = (u32x4){0u, 0u, 0u, 0u};
    }
    __syncthreads();
}
__device__ __forceinline__ void p0_prologue(Frame& F) {
    for (int it = F.vcu; it < 256; it += F.G) p0_ssm_tables(F, it >> 2, it & 3);
    LAS float* scr = (LAS float*)(F.lds + F.wave * 16384);
    const int lane = lane_id();
    const int gw = F.vcu * NWAVES + F.wave, NGW = F.G * NWAVES;
    constexpr int I_IN = (D_MODEL / 64) * (IN_W / 32);
    bf16_t* win = (bf16_t*)(F.ws + WS_WIN);
    for (int it = gw; it < I_IN; it += NGW) p0_transpose_item(F.in[3], D_MODEL, IN_W, win, nullptr, 128, 0, scr, it, lane);
    bf16_t* xn = (bf16_t*)(F.ws + WS_XN);
    for (int m = gw; m < M; m += NGW) rms_row_to_bf16(F.in[0] + (size_t)m * D_MODEL, F.in[2], xn + (size_t)m * D_MODEL, lane);
}
__device__ __forceinline__ void convert_late_weights(Frame& F, int w, int nw) {
    LAS float* scr = (LAS float*)(F.lds + F.wave * 16384);
    const int lane = lane_id();
    constexpr int I_GLU = (SSM_W / 64) * (SSM_W / 32), I_OUT = (2048 / 64) * (D_MODEL / 32), I_G = (D_MODEL / 64) * (FF / 32), I_D = (FF / 64) * (D_MODEL / 32);
    constexpr int NITEMS = I_GLU + I_OUT + 2 * I_G + I_D;
    bf16_t* wglu = (bf16_t*)(F.ws + WS_WGLU); bf16_t* wout = (bf16_t*)(F.ws + WS_WOUT); bf16_t* wgu = (bf16_t*)(F.ws + WS_WGU); bf16_t* wdn = (bf16_t*)(F.ws + WS_WDN);
    for (int it = w; it < NITEMS; it += nw) {
        int r = it;
        if (r < I_GLU) { p0_transpose_item(F.in[15], SSM_W, SSM_W, wglu, nullptr, 128, 0, scr, r, lane); continue; } r -= I_GLU;
        if (r < I_OUT) {
            const int kb = r / (D_MODEL / 32); const float* gn = (kb < 16) ? F.in[16] : (F.in[17] - 1024);
            p0_transpose_item(F.in[18], 2048, D_MODEL, wout, gn, 128, 0, scr, r, lane); continue; } r -= I_OUT;
        if (r < I_G) { p0_transpose_item(F.in[20], D_MODEL, FF, wgu, F.in[19], 256, 0, scr, r, lane); continue; } r -= I_G;
        if (r < I_G) { p0_transpose_item(F.in[21], D_MODEL, FF, wgu, F.in[19], 256, 128, scr, r, lane); continue; } r -= I_G;
        p0_transpose_item(F.in[22], FF, D_MODEL, wdn, nullptr, 128, 0, scr, r, lane);
    }
}

using pg8::Unit;
struct EpiIn {
    static constexpr bool PERM = true, AFTER_DRAIN = false; static constexpr int MID_T = 0;
    bf16_t* Q; bf16_t* Kb; bf16_t* Vb; bf16_t* Ag;
    __device__ __forceinline__ void operator()(const f32x4 (&acc)[2][2][4][2], const Unit& u, int wr, int wc, int fr, int fq) const {
        asm volatile("" : "+v"(fr), "+v"(fq));
        const int row0 = u.pm * 256 + wr * 64 + fr, pn = u.pn;
#pragma unroll
        for (int ai = 0; ai < 2; ++ai)
#pragma unroll
            for (int m = 0; m < 4; ++m) { const int row = row0 + ai * 128 + m * 16;
#pragma unroll
                for (int bj = 0; bj < 2; ++bj) { const int col = bj * 128 + wc * 32 + 8 * fq; const f32x4 v0 = acc[ai][bj][m][0], v1 = acc[ai][bj][m][1];
                    u32x4 w; w.x = cvt_pk_bf16(v0[0], v0[1]); w.y = cvt_pk_bf16(v0[2], v0[3]); w.z = cvt_pk_bf16(v1[0], v1[1]); w.w = cvt_pk_bf16(v1[2], v1[3]);
                    bf16_t* dst;
                    if (pn < 4) dst = Q + (size_t)row * ATTN_W + pn * 256 + col;
                    else if (pn == 4) dst = Kb + (size_t)row * KV_W + col;
                    else if (pn == 5) dst = Vb + (size_t)row * KV_W + col;
                    else { const int c = (pn - 6) * 256 + col; dst = Ag + ((size_t)(c >> 4) * 1024 + (row >> 4)) * SSM_KA + (row & 15) * 16 + (c & 15); }
                    *(u32x4*)dst = w; } }
    }
};
struct EpiS {
    static constexpr bool PERM = false, AFTER_DRAIN = true; static constexpr int MID_T = 0;
    __device__ __forceinline__ void operator()(const f32x4 (&acc)[2][2][4][2], const Unit& u, int wr, int wc, int fr, int fq) const {}
    __device__ __forceinline__ void fused(const f32x4 (&acc)[2][2][4][2], const Unit& u, int wr, int wc, int fr, int fq, LAS unsigned char* lds) const {
        asm volatile("" : "+v"(fr), "+v"(fq));
#pragma unroll
        for (int ai = 0; ai < 2; ++ai)
#pragma unroll
            for (int m = 0; m < 4; ++m) { const int r = ai * 128 + wr * 64 + m * 16 + fr;
#pragma unroll
                for (int n = 0; n < 2; ++n) *(LAS f32x4*)(lds + r * 512 + (((wc * 32 + n * 16 + 4 * fq) * 4) ^ ((r & 7) << 4))) = acc[ai][0][m][n]; }
    }
};
struct EpiY {
    static constexpr bool PERM = true, AFTER_DRAIN = false; static constexpr int MID_T = 0;
    const bf16_t* Ag; const float* dd; bf16_t* Yg;
    __device__ __forceinline__ void operator()(const f32x4 (&acc)[2][2][4][2], const Unit& u, int wr, int wc, int fr, int fq) const {
        asm volatile("" : "+v"(fr), "+v"(fq));
        const int g = u.pm >> 2; const int p0 = (8 * fq) & 15;
        const f32x4 d0 = *(const f32x4*)(dd + g * 16 + p0), d1 = *(const f32x4*)(dd + g * 16 + p0 + 4);
        const size_t grow0 = (size_t)u.pm * 256 + wr * 64 + fr; const int col0 = wc * 32 + 8 * fq;
        u32x4 uu[2][4][2];
#pragma unroll
        for (int ai = 0; ai < 2; ++ai)
#pragma unroll
            for (int m = 0; m < 4; ++m)
#pragma unroll
                for (int bj = 0; bj < 2; ++bj) uu[ai][m][bj] = *(const u32x4*)(Ag + (grow0 + ai * 128 + m * 16) * SSM_KA + bj * 128 + col0);
#pragma unroll
        for (int ai = 0; ai < 2; ++ai)
#pragma unroll
            for (int m = 0; m < 4; ++m) { const size_t grow = grow0 + ai * 128 + m * 16;
#pragma unroll
                for (int bj = 0; bj < 2; ++bj) { const u32x4 w_ = uu[ai][m][bj]; const f32x4 v0 = acc[ai][bj][m][0], v1 = acc[ai][bj][m][1];
                    const float y0 = gelu_tanh(v0[0] + d0[0] * bf_lo(w_.x)), y1 = gelu_tanh(v0[1] + d0[1] * bf_hi(w_.x)), y2 = gelu_tanh(v0[2] + d0[2] * bf_lo(w_.y)), y3 = gelu_tanh(v0[3] + d0[3] * bf_hi(w_.y));
                    const float y4 = gelu_tanh(v1[0] + d1[0] * bf_lo(w_.z)), y5 = gelu_tanh(v1[1] + d1[1] * bf_hi(w_.z)), y6 = gelu_tanh(v1[2] + d1[2] * bf_lo(w_.w)), y7 = gelu_tanh(v1[3] + d1[3] * bf_hi(w_.w));
                    u32x4 w; w.x = cvt_pk_bf16(y0, y1); w.y = cvt_pk_bf16(y2, y3); w.z = cvt_pk_bf16(y4, y5); w.w = cvt_pk_bf16(y6, y7);
                    *(u32x4*)(Yg + grow * 256 + bj * 128 + col0) = w; } }
    }
};
struct EpiGlu {
    static constexpr bool PERM = true, AFTER_DRAIN = false; static constexpr int MID_T = 0;
    const bf16_t* Yg; bf16_t* mixed; float* ssq;
    __device__ __forceinline__ void operator()(const f32x4 (&acc)[2][2][4][2], const Unit& u, int wr, int wc, int fr, int fq) const {
        asm volatile("" : "+v"(fr), "+v"(fq));
        const int row0 = u.pm * 256 + wr * 64 + fr, c0 = u.pn * 256 + wc * 32 + 8 * fq;
        u32x4 yy[2][4][2];
#pragma unroll
        for (int ai = 0; ai < 2; ++ai)
#pragma unroll
            for (int m = 0; m < 4; ++m)
#pragma unroll
                for (int bj = 0; bj < 2; ++bj) { const int c = c0 + bj * 128; yy[ai][m][bj] = *(const u32x4*)(Yg + ((size_t)(c >> 4) * M + row0 + ai * 128 + m * 16) * 16 + (c & 15)); }
#pragma unroll
        for (int ai = 0; ai < 2; ++ai)
#pragma unroll
            for (int m = 0; m < 4; ++m) { const int row = row0 + ai * 128 + m * 16; float sq = 0.f;
#pragma unroll
                for (int bj = 0; bj < 2; ++bj) { const int c = c0 + bj * 128; const u32x4 y_ = yy[ai][m][bj]; const f32x4 v0 = acc[ai][bj][m][0], v1 = acc[ai][bj][m][1];
                    const float s0 = bf_lo(y_.x) * sigmoidf_fast(v0[0]), s1 = bf_hi(y_.x) * sigmoidf_fast(v0[1]), s2 = bf_lo(y_.y) * sigmoidf_fast(v0[2]), s3 = bf_hi(y_.y) * sigmoidf_fast(v0[3]);
                    const float s4 = bf_lo(y_.z) * sigmoidf_fast(v1[0]), s5 = bf_hi(y_.z) * sigmoidf_fast(v1[1]), s6 = bf_lo(y_.w) * sigmoidf_fast(v1[2]), s7 = bf_hi(y_.w) * sigmoidf_fast(v1[3]);
                    sq += (s0 * s0 + s1 * s1) + (s2 * s2 + s3 * s3) + (s4 * s4 + s5 * s5) + (s6 * s6 + s7 * s7);
                    u32x4 w; w.x = cvt_pk_bf16(s0, s1); w.y = cvt_pk_bf16(s2, s3); w.z = cvt_pk_bf16(s4, s5); w.w = cvt_pk_bf16(s6, s7);
                    *(u32x4*)(mixed + (size_t)row * 2048 + 1024 + c) = w; }
                sq += __shfl_xor(sq, 16); sq += __shfl_xor(sq, 32);
                if (fq == 0) atomicAdd(ssq + row, sq); }
    }
};
struct EpiOut {
    static constexpr bool PERM = true, AFTER_DRAIN = false; static constexpr int MID_T = 16;
    const float* x; bf16_t* x1b; const float* ssq_a; const float* ssq_s; float* ssq_x;
    __device__ __forceinline__ void mid(f32x4 (&acc)[2][2][4][2], const Unit& u, int wr, int wc, int fr, int fq) const {
        asm volatile("" : "+v"(fr), "+v"(fq));
#pragma unroll
        for (int ai = 0; ai < 2; ++ai)
#pragma unroll
            for (int m = 0; m < 4; ++m) { const int row = u.pm * 256 + ai * 128 + wr * 64 + m * 16 + fr;
                const float f = sqrtf((ssq_s[row] * (1.0f / 1024.0f) + EPS) / (ssq_a[row] * (1.0f / 1024.0f) + EPS));
#pragma unroll
                for (int bj = 0; bj < 2; ++bj)
#pragma unroll
                    for (int n = 0; n < 2; ++n) acc[ai][bj][m][n] *= f; }
    }
    __device__ __forceinline__ void operator()(const f32x4 (&acc)[2][2][4][2], const Unit& u, int wr, int wc, int fr, int fq) const {
        asm volatile("" : "+v"(fr), "+v"(fq));
        const int row0 = u.pm * 256 + wr * 64 + fr; const size_t cofs = (size_t)u.pn * 256 + wc * 32 + 8 * fq;
        float sv[2][4];
#pragma unroll
        for (int ai = 0; ai < 2; ++ai)
#pragma unroll
            for (int m = 0; m < 4; ++m) sv[ai][m] = ssq_s[row0 + ai * 128 + m * 16];
#pragma unroll
        for (int ai = 0; ai < 2; ++ai) {
            f32x4 xb[4][2][2];
#pragma unroll
            for (int m = 0; m < 4; ++m)
#pragma unroll
                for (int bj = 0; bj < 2; ++bj) { const float* p = x + (size_t)(row0 + ai * 128 + m * 16) * D_MODEL + cofs + bj * 128; xb[m][bj][0] = *(const f32x4*)p; xb[m][bj][1] = *(const f32x4*)(p + 4); }
#pragma unroll
            for (int m = 0; m < 4; ++m) { const int row = row0 + ai * 128 + m * 16; const float rstd = 1.0f / sqrtf(sv[ai][m] * (1.0f / 1024.0f) + EPS); float sq = 0.f;
#pragma unroll
                for (int bj = 0; bj < 2; ++bj) { const size_t off = (size_t)row * D_MODEL + cofs + bj * 128;
                    const f32x4 o0 = xb[m][bj][0] + acc[ai][bj][m][0] * rstd, o1 = xb[m][bj][1] + acc[ai][bj][m][1] * rstd;
                    sq += (o0[0] * o0[0] + o0[1] * o0[1]) + (o0[2] * o0[2] + o0[3] * o0[3]) + (o1[0] * o1[0] + o1[1] * o1[1]) + (o1[2] * o1[2] + o1[3] * o1[3]);
                    u32x4 w; w.x = cvt_pk_bf16(o0[0], o0[1]); w.y = cvt_pk_bf16(o0[2], o0[3]); w.z = cvt_pk_bf16(o1[0], o1[1]); w.w = cvt_pk_bf16(o1[2], o1[3]);
                    *(u32x4*)(x1b + off) = w; }
                sq += __shfl_xor(sq, 16); sq += __shfl_xor(sq, 32); if (fq == 0) atomicAdd(ssq_x + row, sq); }
        }
    }
};
struct EpiGU {
    static constexpr bool PERM = true, AFTER_DRAIN = false; static constexpr int MID_T = 0;
    const float* ssq_x; bf16_t* H;
    __device__ __forceinline__ void operator()(const f32x4 (&acc)[2][2][4][2], const Unit& u, int wr, int wc, int fr, int fq) const {
        asm volatile("" : "+v"(fr), "+v"(fq));
        const int row0 = u.pm * 256 + wr * 64 + fr;
        float sv[2][4];
#pragma unroll
        for (int ai = 0; ai < 2; ++ai)
#pragma unroll
            for (int m = 0; m < 4; ++m) sv[ai][m] = ssq_x[row0 + ai * 128 + m * 16];
#pragma unroll
        for (int ai = 0; ai < 2; ++ai)
#pragma unroll
            for (int m = 0; m < 4; ++m) { const int row = row0 + ai * 128 + m * 16; const float rstd = 1.0f / sqrtf(sv[ai][m] * (1.0f / 2048.0f) + EPS);
                float h[8];
#pragma unroll
                for (int n = 0; n < 2; ++n)
#pragma unroll
                    for (int i = 0; i < 4; ++i) { const float gv = acc[ai][0][m][n][i] * rstd, uv = acc[ai][1][m][n][i] * rstd; h[4 * n + i] = gv * sigmoidf_fast(gv) * uv; }
                u32x4 w; w.x = cvt_pk_bf16(h[0], h[1]); w.y = cvt_pk_bf16(h[2], h[3]); w.z = cvt_pk_bf16(h[4], h[5]); w.w = cvt_pk_bf16(h[6], h[7]);
                *(u32x4*)(H + (size_t)row * FF + u.pn * 128 + wc * 32 + 8 * fq) = w; }
    }
};
template <bool DRY> struct EpiDown {
    static constexpr bool PERM = true, AFTER_DRAIN = false; static constexpr int MID_T = 0;
    const bf16_t* x1b; float* out; float* trash;
    __device__ __forceinline__ void operator()(const f32x4 (&acc)[2][2][4][2], const Unit& u, int wr, int wc, int fr, int fq) const {
        asm volatile("" : "+v"(fr), "+v"(fq));
        const int row0 = u.pm * 256 + wr * 64 + fr; const size_t cofs = (size_t)u.pn * 256 + wc * 32 + 8 * fq;
        u32x4 xb[2][4][2];
#pragma unroll
        for (int ai = 0; ai < 2; ++ai)
#pragma unroll
            for (int m = 0; m < 4; ++m)
#pragma unroll
                for (int bj = 0; bj < 2; ++bj) xb[ai][m][bj] = *(const u32x4*)(x1b + (size_t)(row0 + ai * 128 + m * 16) * D_MODEL + cofs + bj * 128);
#pragma unroll
        for (int ai = 0; ai < 2; ++ai)
#pragma unroll
            for (int m = 0; m < 4; ++m) { const int row = row0 + ai * 128 + m * 16;
#pragma unroll
                for (int bj = 0; bj < 2; ++bj) { const size_t off = (size_t)row * D_MODEL + cofs + bj * 128; const u32x4 x_ = xb[ai][m][bj];
                    const f32x4 b0 = {bf_lo(x_.x), bf_hi(x_.x), bf_lo(x_.y), bf_hi(x_.y)}, b1 = {bf_lo(x_.z), bf_hi(x_.z), bf_lo(x_.w), bf_hi(x_.w)};
                    float* q = DRY ? trash + (off & ((8u << 20) - 1)) : out + off;
                    *(f32x4*)q = b0 + acc[ai][bj][m][0]; *(f32x4*)(q + 4) = b1 + acc[ai][bj][m][1]; } }
    }
};

constexpr int ATT_KROW = 144, ATT_VROW = 520, ATT_K_OFF = 0, ATT_V_OFF = 256 * ATT_KROW, ATT_B_OFF = ATT_V_OFF + 64 * ATT_VROW;
constexpr int ATT_TAB = 192;
static_assert(ATT_B_OFF + 4 * ATT_TAB * 4 <= RING_BYTES, "attention LDS");
template <int STG_REPS = 1, int TASK_REPS = 1>
__device__ __forceinline__ void attn_unit(Frame& F, int b, int qb, int kvh, float* ssq_real) {
    LAS unsigned char* lds = F.lds;
    const int lane = lane_id(), wave = F.wave, tid = wave * 64 + lane;
    const bf16_t* Q = (const bf16_t*)(F.ws + WS_Q); const bf16_t* Kb = (const bf16_t*)(F.ws + WS_K); const bf16_t* Vb = (const bf16_t*)(F.ws + WS_V);
    bf16_t* mixed = (bf16_t*)(F.ws + WS_MIX);
    const int T0 = b * SEQ + qb * 128;
    const int q = lane & 31, hh = lane >> 5;
    u32x4 qraw[2][4];
#pragma unroll
    for (int it = 0; it < 2; ++it) { const int task = wave + 8 * it; const bf16_t* qp = Q + (size_t)(T0 + 32 * (task & 3) + q) * ATTN_W + (kvh * 4 + (task >> 2)) * 64 + hh * 8;
#pragma unroll
        for (int ks = 0; ks < 4; ++ks) qraw[it][ks] = *(const u32x4*)(qp + 16 * ks); }
    for (int srep = 0; srep < STG_REPS; ++srep)
    {
        const int key = tid & 255; const bool valid = (qb > 0) || (key >= 128);
        const size_t tok = (size_t)(T0 - 128 + key);
        u32x4 c[8];
        const bf16_t* src = ((tid < 256) ? Kb : Vb) + tok * KV_W + kvh * 64;
#pragma unroll
        for (int i = 0; i < 8; ++i) c[i] = valid ? *(const u32x4*)(src + 8 * i) : (u32x4){0u, 0u, 0u, 0u};
        if (tid < 256) {
            float ss = 0.f;
#pragma unroll
            for (int i = 0; i < 8; ++i) { const float a0 = bf_lo(c[i].x), a1 = bf_hi(c[i].x), a2 = bf_lo(c[i].y), a3 = bf_hi(c[i].y), a4 = bf_lo(c[i].z), a5 = bf_hi(c[i].z), a6 = bf_lo(c[i].w), a7 = bf_hi(c[i].w);
                ss += (a0 * a0 + a1 * a1) + (a2 * a2 + a3 * a3) + (a4 * a4 + a5 * a5) + (a6 * a6 + a7 * a7); }
            const float rstd = 1.0f / sqrtf(ss * (1.0f / 64.0f) + EPS);
            const float* kg = F.in[5];
#pragma unroll
            for (int i = 0; i < 8; ++i) { const f32x4 g0 = *(const f32x4*)(kg + 8 * i), g1 = *(const f32x4*)(kg + 8 * i + 4);
                u32x4 w; w.x = cvt_pk_bf16(bf_lo(c[i].x) * rstd * g0[0], bf_hi(c[i].x) * rstd * g0[1]); w.y = cvt_pk_bf16(bf_lo(c[i].y) * rstd * g0[2], bf_hi(c[i].y) * rstd * g0[3]);
                w.z = cvt_pk_bf16(bf_lo(c[i].z) * rstd * g1[0], bf_hi(c[i].z) * rstd * g1[1]); w.w = cvt_pk_bf16(bf_lo(c[i].w) * rstd * g1[2], bf_hi(c[i].w) * rstd * g1[3]);
                *(LAS u32x4*)(lds + ATT_K_OFF + key * ATT_KROW + i * 16) = w; }
        } else {
#pragma unroll
            for (int i = 0; i < 8; ++i) { const unsigned w4[4] = {c[i].x, c[i].y, c[i].z, c[i].w};
#pragma unroll
                for (int j = 0; j < 4; ++j) { *(LAS unsigned short*)(lds + ATT_V_OFF + (8 * i + 2 * j) * ATT_VROW + key * 2) = (unsigned short)(w4[j] & 0xffffu);
                    *(LAS unsigned short*)(lds + ATT_V_OFF + (8 * i + 2 * j + 1) * ATT_VROW + key * 2) = (unsigned short)(w4[j] >> 16); } }
        }
        for (int e = tid; e < 4 * ATT_TAB; e += NWAVES * 64) { const int hl = e / ATT_TAB, dist = e % ATT_TAB - 32;
            ((LAS float*)(lds + ATT_B_OFF))[e] = ((unsigned)dist < 128u) ? F.in[1][(int)kBucket[dist & 127] * NQH + kvh * 4 + hl] * LOG2E : -INFINITY; }
    }
    bf16x8 qf2[2][4];
    { const float* qg = F.in[4]; f32x4 gq[4][2];
#pragma unroll
      for (int ks = 0; ks < 4; ++ks) { gq[ks][0] = *(const f32x4*)(qg + 16 * ks + 8 * hh); gq[ks][1] = *(const f32x4*)(qg + 16 * ks + 8 * hh + 4); }
#pragma unroll
      for (int it = 0; it < 2; ++it) { float ss = 0.f;
#pragma unroll
        for (int ks = 0; ks < 4; ++ks) { const u32x4 w_ = qraw[it][ks];
            const float a0 = bf_lo(w_.x), a1 = bf_hi(w_.x), a2 = bf_lo(w_.y), a3 = bf_hi(w_.y), a4 = bf_lo(w_.z), a5 = bf_hi(w_.z), a6 = bf_lo(w_.w), a7 = bf_hi(w_.w);
            ss += (a0 * a0 + a1 * a1) + (a2 * a2 + a3 * a3) + (a4 * a4 + a5 * a5) + (a6 * a6 + a7 * a7); }
        ss += __shfl_xor(ss, 32);
        const float sc = (1.0f / sqrtf(ss * (1.0f / 64.0f) + EPS)) * (0.125f * LOG2E);
#pragma unroll
        for (int ks = 0; ks < 4; ++ks) { const u32x4 w_ = qraw[it][ks]; const f32x4 g0 = gq[ks][0], g1 = gq[ks][1];
            u32x4 w; w.x = cvt_pk_bf16(bf_lo(w_.x) * sc * g0[0], bf_hi(w_.x) * sc * g0[1]); w.y = cvt_pk_bf16(bf_lo(w_.y) * sc * g0[2], bf_hi(w_.y) * sc * g0[3]);
            w.z = cvt_pk_bf16(bf_lo(w_.z) * sc * g1[0], bf_hi(w_.z) * sc * g1[1]); w.w = cvt_pk_bf16(bf_lo(w_.w) * sc * g1[2], bf_hi(w_.w) * sc * g1[3]);
            qf2[it][ks] = __builtin_bit_cast(bf16x8, w); } } }
    __syncthreads();
    for (int trep = 0; trep < TASK_REPS; ++trep)
#pragma unroll
    for (int it = 0; it < 2; ++it) {
        float* ssq_a = (trep == TASK_REPS - 1) ? ssq_real : (float*)(F.ws + WS_SSQ_T);
        const int task = wave + 8 * it, hl = task >> 2, grp = task & 3, hq = kvh * 4 + hl, qi = 32 * grp + q;
        const bf16x8 (&qf)[4] = qf2[it];
        const LAS float* tb = (const LAS float*)(lds + ATT_B_OFF) + hl * ATT_TAB + (q + 128 - 4 * hh + 32 - 155);
        const float sink2 = F.in[6][hq] * LOG2E;
        f32x16 s[5];
#pragma unroll
        for (int kt = 0; kt < 5; ++kt) {
            f32x16 a;
#pragma unroll
            for (int r = 0; r < 16; ++r) a[r] = tb[155 - 32 * kt - ((r & 3) + 8 * (r >> 2))];
#pragma unroll
            for (int ks = 0; ks < 4; ++ks) { const bf16x8 kf = *(const LAS bf16x8*)(lds + ATT_K_OFF + (32 * (grp + kt) + q) * ATT_KROW + (16 * ks + 8 * hh) * 2);
                a = __builtin_amdgcn_mfma_f32_32x32x16_bf16(kf, qf[ks], a, 0, 0, 0); }
            if (qb == 0 && grp + kt < 4) {
#pragma unroll
                for (int r = 0; r < 16; ++r) a[r] = -INFINITY; }
            s[kt] = a;
        }
        float mx = sink2;
#pragma unroll
        for (int kt = 0; kt < 5; ++kt)
#pragma unroll
            for (int r = 0; r < 16; ++r) mx = fmaxf(mx, s[kt][r]);
        mx = fmaxf(mx, __shfl_xor(mx, 32));
        float l = 0.f;
#pragma unroll
        for (int kt = 0; kt < 5; ++kt)
#pragma unroll
            for (int r = 0; r < 16; ++r) { const float p = fast_exp2(s[kt][r] - mx); s[kt][r] = p; l += p; }
        l += __shfl_xor(l, 32);
        l += fast_exp2(sink2 - mx);
        f32x16 o[2]; o[0] = (f32x16){}; o[1] = (f32x16){};
#pragma unroll
        for (int kt = 0; kt < 5; ++kt)
#pragma unroll
            for (int s2 = 0; s2 < 2; ++s2) {
                u32x4 pw; pw.x = cvt_pk_bf16(s[kt][8 * s2 + 0], s[kt][8 * s2 + 1]); pw.y = cvt_pk_bf16(s[kt][8 * s2 + 2], s[kt][8 * s2 + 3]); pw.z = cvt_pk_bf16(s[kt][8 * s2 + 4], s[kt][8 * s2 + 5]); pw.w = cvt_pk_bf16(s[kt][8 * s2 + 6], s[kt][8 * s2 + 7]);
                const bf16x8 pb = __builtin_bit_cast(bf16x8, pw);
#pragma unroll
                for (int d0 = 0; d0 < 2; ++d0) { const LAS unsigned char* vp = lds + ATT_V_OFF + (32 * d0 + q) * ATT_VROW + (32 * (grp + kt) + 16 * s2 + 4 * hh) * 2;
                    const u32x2 lo = *(const LAS u32x2*)vp, hi = *(const LAS u32x2*)(vp + 16);
                    const u32x4 vv = {lo.x, lo.y, hi.x, hi.y};
                    o[d0] = __builtin_amdgcn_mfma_f32_32x32x16_bf16(__builtin_bit_cast(bf16x8, vv), pb, o[d0], 0, 0, 0); }
            }
        const float inv = 1.0f / l; float sq = 0.f;
        bf16_t* op = mixed + (size_t)(T0 + qi) * 2048 + hq * 64 + 4 * hh;
#pragma unroll
        for (int d0 = 0; d0 < 2; ++d0)
#pragma unroll
            for (int r4 = 0; r4 < 4; ++r4) { const float v0 = o[d0][4 * r4] * inv, v1 = o[d0][4 * r4 + 1] * inv, v2 = o[d0][4 * r4 + 2] * inv, v3 = o[d0][4 * r4 + 3] * inv;
                sq += (v0 * v0 + v1 * v1) + (v2 * v2 + v3 * v3);
                u32x2 w; w.x = cvt_pk_bf16(v0, v1); w.y = cvt_pk_bf16(v2, v3); *(u32x2*)(op + 32 * d0 + 8 * r4) = w; }
        sq += __shfl_xor(sq, 32);
        if (hh == 0) atomicAdd(ssq_a + T0 + qi, sq);
    }
    __syncthreads();
}

template <int MODE = 7>
__device__ __forceinline__ void ssm_unit(Frame& F, int pm) {
    const int g = pm >> 2;
    bf16_t* Ag = (bf16_t*)(F.ws + WS_AG);
    if constexpr (MODE & 1) {
        int Kc = 256; asm volatile("" : "+s"(Kc));
        pg8::Gemm gm{(const char*)Ag, (const char*)(F.ws + WS_PG), Kc, SSM_KA * 2, 32, 128, 256 * 2};
        pg8::OneUnit S1{pm, g}; EpiS E{};
        pg8::gemm_phase<EpiS, pg8::OneUnit, false>(F.lds, F.wave, gm, S1, E);
    }
    asm volatile("s_waitcnt lgkmcnt(0)" ::: "memory");
    __syncthreads();
    if ((MODE & 2) && F.wave == 0) {
        const int n = lane_id();
        const f32x2 l16 = *((const f32x2*)(F.ws + WS_L16) + g * 64 + n);
        float hr = 0.f, hi = 0.f;
        unsigned* hp = (unsigned*)(Ag + (size_t)pm * 256 * SSM_KA + 256) + n;
        for (int c0 = 0; c0 < 256; c0 += 8) {
            f32x2 sv[8];
#pragma unroll
            for (int j = 0; j < 8; ++j) sv[j] = *(const LAS f32x2*)(F.lds + (c0 + j) * 512 + ((8 * n) ^ (j << 4)));
#pragma unroll
            for (int j = 0; j < 8; ++j) { hp[(size_t)(c0 + j) * (SSM_KA / 2)] = cvt_pk_bf16(hr, hi);
                const float nr = l16.x * hr - l16.y * hi + sv[j].x, ni = l16.x * hi + l16.y * hr + sv[j].y; hr = nr; hi = ni; }
        }
    }
    asm volatile("s_waitcnt vmcnt(0) lgkmcnt(0)" ::: "memory");
    __syncthreads();
    if constexpr (MODE & 4) {
        int Kc = SSM_KA; asm volatile("" : "+s"(Kc));
        pg8::Gemm gm{(const char*)Ag, (const char*)(F.ws + WS_BG), Kc, SSM_KA * 2, 32, 128, SSM_KA * 2};
        pg8::OneUnit S1{pm, g}; EpiY E{Ag, F.in[14], (bf16_t*)(F.ws + WS_YG)};
        pg8::gemm_phase<EpiY, pg8::OneUnit, false>(F.lds, F.wave, gm, S1, E);
    }
}


#define XB_TMO      128
#define XB_XCNT(j)  (256  + 64 * (j))
#define XB_XSUB(j)  (1280 + 64 * (j))
#define XB_XGEN(j)  (2304 + 64 * (j))
#define XB_TOP      3328
#define XB_TOPGEN   3392
#define XCD_BAR_WORDS 3456
#define XB_SPIN_CAP (1u << 22)
constexpr size_t WS_BAR = 16384;
__device__ __forceinline__ unsigned xb_ld(unsigned* p)              { return __hip_atomic_load(p, __ATOMIC_RELAXED, __HIP_MEMORY_SCOPE_AGENT); }
__device__ __forceinline__ unsigned xb_add(unsigned* p, unsigned v) { return __hip_atomic_fetch_add(p, v, __ATOMIC_RELAXED, __HIP_MEMORY_SCOPE_AGENT); }
__device__ __forceinline__ unsigned xb_xcc_id() { return (unsigned)__builtin_amdgcn_s_getreg((3 << 11) | 20) & 0xFu; }
#define XB_SPIN(cond, bar) do { unsigned _sp = 0; while (cond) { __builtin_amdgcn_s_sleep(1); \
    if ((++_sp & 255u) == 0u) { if (xb_ld(&(bar)[XB_TMO])) break; if (_sp > XB_SPIN_CAP) { atomicAdd(&(bar)[XB_TMO], 1u); break; } } } } while (0)
struct XcdBarrier { unsigned* bar; unsigned x; volatile LAS unsigned* st; };
__device__ __forceinline__ XcdBarrier xcd_barrier_post(unsigned* bar, volatile LAS unsigned* st) {
    XcdBarrier b; b.bar = bar; b.x = xb_xcc_id(); b.st = st;
    if (threadIdx.x == 0) (void)xb_add(&bar[XB_XCNT(b.x)], 1u);
    return b;
}
__device__ __forceinline__ void xcd_barrier_complete(unsigned* bar, unsigned x, unsigned& nloc, unsigned& nx) {
    const unsigned G = gridDim.x * gridDim.y * gridDim.z;
    unsigned sum, cnt, mine, sp = 0u;
    for (;;) {
        sum = 0u; cnt = 0u; mine = 0u;
#pragma unroll
        for (unsigned j = 0; j < 16; ++j) { const unsigned c = xb_ld(&bar[XB_XCNT(j)]); sum += c; cnt += (c > 0u) ? 1u : 0u; mine = (j == x) ? c : mine; }
        if (sum == G) break;
        __builtin_amdgcn_s_sleep(1);
        if ((++sp & 255u) == 0u) { if (xb_ld(&bar[XB_TMO])) break; if (sp > XB_SPIN_CAP) { atomicAdd(&bar[XB_TMO], 1u); break; } }
    }
    nloc = mine > 0u ? mine : 1u; nx = cnt > 0u ? cnt : 1u;
}
__device__ __forceinline__ void xcd_barrier(const XcdBarrier& b, int wave) {
    asm volatile("s_waitcnt vmcnt(0)" ::: "memory");
    __syncthreads();
    if (wave == 0 && lane_id() == 0) {
        unsigned* bar = b.bar;
        __builtin_amdgcn_s_waitcnt(0);
        unsigned nloc = b.st[0], nx = b.st[1];
        if (nloc == 0u) { xcd_barrier_complete(bar, b.x, nloc, nx); b.st[0] = nloc; b.st[1] = nx; }
        const unsigned old = xb_add(&bar[XB_XSUB(b.x)], 1u);
        const unsigned gen = old / nloc;
        if (old + 1u == (gen + 1u) * nloc) {
            __builtin_amdgcn_fence(__ATOMIC_RELEASE, "agent");
            asm volatile("s_waitcnt vmcnt(0)" ::: "memory");
            const unsigned og = xb_add(&bar[XB_TOP], 1u);
            const unsigned tg = og / nx;
            if (og + 1u == (tg + 1u) * nx) xb_add(&bar[XB_TOPGEN], 1u);
            else XB_SPIN(xb_ld(&bar[XB_TOPGEN]) == tg, bar);
            __builtin_amdgcn_fence(__ATOMIC_ACQUIRE, "agent");
            xb_add(&bar[XB_XGEN(b.x)], 1u);
            asm volatile("s_waitcnt vmcnt(0)" ::: "memory");
        } else {
            XB_SPIN(xb_ld(&bar[XB_XGEN(b.x)]) == gen, bar);
            __builtin_amdgcn_fence(__ATOMIC_ACQUIRE, "agent");
            asm volatile("s_waitcnt vmcnt(0)" ::: "memory");
        }
    }
    __syncthreads();
}

struct Args { const float* in[23]; float* out; unsigned char* ws; int ph_lo, ph_hi; };
__global__ void __launch_bounds__(NWAVES * 64, 2) hymba_fwd(Args args) {
    extern __shared__ __attribute__((aligned(16))) unsigned char lds_raw[];
    Frame F;
    F.lds = (LAS unsigned char*)lds_raw;
    F.wave = __builtin_amdgcn_readfirstlane((int)threadIdx.x >> 6);
    F.G = gridDim.x; { const int bx = blockIdx.x; F.vcu = (F.G % 8 == 0) ? (bx % 8) * (F.G / 8) + bx / 8 : bx; }
    F.in = args.in; F.out = args.out; F.ws = args.ws;
    const int lo = args.ph_lo, hi = args.ph_hi;
    for (int u = threadIdx.x; u < (LDS_BYTES - LDSCTL_OFF) / 4; u += NWAVES * 64) ((LAS unsigned*)(F.lds + LDSCTL_OFF))[u] = 0u;
    __syncthreads();
    XcdBarrier bar; bar.bar = (unsigned*)(F.ws + WS_BAR); bar.x = 0; bar.st = nullptr;
    if (MK_N_LAUNCHES == 1) bar = xcd_barrier_post((unsigned*)(F.ws + WS_BAR), (volatile LAS unsigned*)(F.lds + MISC_OFF) + 8);
#define IN(k) (lo <= (k) && (k) < hi)
#define GRID_BAR(k) do { if (IN(k) && IN((k) + 1)) xcd_barrier(bar, F.wave); } while (0)
    unsigned char* ws = F.ws;
    float* const ssq_trash = (float*)(ws + WS_SSQ_T);
#define PHASE0(DRY) { p0_prologue(F); }
#define PHASE1(DRY) {     \
        pg8::Gemm g{(const char*)(ws + WS_XN), (const char*)(ws + WS_WIN), D_MODEL, D_MODEL * 2, 32, 128, D_MODEL * 2}; \
        pg8::StaticOrder S; S.init(M, IN_W, F.G, (int)blockIdx.x); \
        EpiIn E{(bf16_t*)(ws + WS_Q), (bf16_t*)(ws + WS_K), (bf16_t*)(ws + WS_V), (bf16_t*)(ws + WS_AG)}; \
        pg8::gemm_phase<EpiIn, pg8::StaticOrder, true>(F.lds, F.wave, g, S, E); \
        { const int nwg_ = (M / 256) * (IN_W / 256), maxu_ = (nwg_ + F.G - 1) / F.G, nheavy_ = nwg_ - (maxu_ - 1) * F.G, nlight_ = F.G - nheavy_, c_ = (int)blockIdx.x;     \
          if (nlight_ == 0) convert_late_weights(F, c_ * NWAVES + F.wave, F.G * NWAVES); \
          else if (c_ >= nheavy_) convert_late_weights(F, (c_ - nheavy_) * NWAVES + F.wave, nlight_ * NWAVES); } }
#define PHASE2(DRY) { \
        float* const sa_ = (DRY) ? ssq_trash : (float*)(ws + WS_SSQ_A); \
        for (int u = F.vcu; u < BATCH * 32 * NKVH; u += F.G) attn_unit<(PROBE_REP == 25 ? 2 : 1), (PROBE_REP == 26 ? 2 : 1)>(F, u >> 7, (u >> 2) & 31, u & 3, sa_); \
        if (F.vcu < 256) ssm_unit(F, F.vcu);     }
#define PHASE3(DRY) {     \
        pg8::Gemm g{(const char*)(ws + WS_YG), (const char*)(ws + WS_WGLU), SSM_W, 32, (unsigned)(M * 32), (unsigned)(4 * M * 32), SSM_W * 2}; \
        pg8::StaticOrder S; S.init(M, SSM_W, F.G, (int)blockIdx.x); \
        EpiGlu E{(const bf16_t*)(ws + WS_YG), (bf16_t*)(ws + WS_MIX), (DRY) ? ssq_trash : (float*)(ws + WS_SSQ_S)}; \
        pg8::gemm_phase<EpiGlu, pg8::StaticOrder, true>(F.lds, F.wave, g, S, E); }
#define PHASE4(DRY) {     \
        pg8::Gemm g{(const char*)(ws + WS_MIX), (const char*)(ws + WS_WOUT), 2048, 2048 * 2, 32, 128, 2048 * 2}; \
        pg8::StaticOrder S; S.init(M, D_MODEL, F.G, (int)blockIdx.x); \
        EpiOut E{F.in[0], (bf16_t*)(ws + WS_XN), (const float*)(ws + WS_SSQ_A), (const float*)(ws + WS_SSQ_S), (DRY) ? ssq_trash : (float*)(ws + WS_SSQ_X)}; \
        pg8::gemm_phase<EpiOut, pg8::StaticOrder, true>(F.lds, F.wave, g, S, E); }
#define PHASE5(DRY) {     \
        pg8::Gemm g{(const char*)(ws + WS_XN), (const char*)(ws + WS_WGU), D_MODEL, D_MODEL * 2, 32, 128, D_MODEL * 2}; \
        pg8::StaticOrder S; S.init(M, 2 * FF, F.G, (int)blockIdx.x); \
        EpiGU E{(const float*)(ws + WS_SSQ_X), (bf16_t*)(ws + WS_H)}; \
        pg8::gemm_phase<EpiGU, pg8::StaticOrder, true>(F.lds, F.wave, g, S, E); }
#define PHASE6(DRY) {     \
        pg8::Gemm g{(const char*)(ws + WS_H), (const char*)(ws + WS_WDN), FF, FF * 2, 32, 128, FF * 2}; \
        pg8::StaticOrder S; S.init(M, D_MODEL, F.G, (int)blockIdx.x); \
        EpiDown<(DRY)> E{(const bf16_t*)(ws + WS_XN), F.out, (float*)(ws + WS_SSCR)}; \
        pg8::gemm_phase<EpiDown<(DRY)>, pg8::StaticOrder, true>(F.lds, F.wave, g, S, E); }
#define PHASE2A(DRY) { for (int u = F.vcu; u < BATCH * 32 * NKVH; u += F.G) attn_unit(F, u >> 7, (u >> 2) & 31, u & 3, ssq_trash); }
#define PHASE2S(DRY) { if (F.vcu < 256) ssm_unit(F, F.vcu); }
#define RUN_PHASE(k, BODY) do { if (PROBE_REP == (k) && IN(k)) { BODY(1); xcd_barrier(bar, F.wave); } if (IN(k)) { BODY(0); } } while (0)
    RUN_PHASE(0, PHASE0);
    if (IN(0) && IN(1)) cg::this_grid().sync();
    RUN_PHASE(1, PHASE1);
    GRID_BAR(1);
    if (PROBE_REP == 22 && IN(2)) { if (F.vcu < 256) ssm_unit<1>(F, F.vcu); xcd_barrier(bar, F.wave); }
    if (PROBE_REP == 23 && IN(2)) { if (F.vcu < 256) ssm_unit<2>(F, F.vcu); xcd_barrier(bar, F.wave); }
    if (PROBE_REP == 24 && IN(2)) { if (F.vcu < 256) ssm_unit<4>(F, F.vcu); xcd_barrier(bar, F.wave); }
    if (PROBE_REP == 20 && IN(2)) { PHASE2A(1); xcd_barrier(bar, F.wave); }
    if (PROBE_REP == 21 && IN(2)) { PHASE2S(1); xcd_barrier(bar, F.wave); }
    RUN_PHASE(2, PHASE2);
    GRID_BAR(2);
    RUN_PHASE(3, PHASE3);
    GRID_BAR(3);
    RUN_PHASE(4, PHASE4);
    GRID_BAR(4);
    RUN_PHASE(5, PHASE5);
    GRID_BAR(5);
    RUN_PHASE(6, PHASE6);
#undef IN
#undef GRID_BAR
}

extern "C" void kernel_launch(void* const* d_in, const int* in_sizes, int n_in, void* d_out, int out_size, void* d_ws, size_t ws_size, hipStream_t stream) {
    static int grid = 0;
    if (grid == 0) {
        if (n_in != 23 || in_sizes[0] != M * D_MODEL || out_size != M * D_MODEL || ws_size < WS_END) { fprintf(stderr, "kernel_launch: unexpected sizes (n_in %d, out %d, ws %zu); nothing launched\n", n_in, out_size, ws_size); grid = -1; return; }
        int dev = 0, cus = 0, per_cu = 0;
        if (hipGetDevice(&dev) != hipSuccess || hipDeviceGetAttribute(&cus, hipDeviceAttributeMultiprocessorCount, dev) != hipSuccess) { grid = -1; return; }
        if (hipFuncSetAttribute((const void*)hymba_fwd, hipFuncAttributeMaxDynamicSharedMemorySize, LDS_BYTES) != hipSuccess) { fprintf(stderr, "kernel_launch: hipFuncSetAttribute failed\n"); grid = -1; return; }
        if (hipOccupancyMaxActiveBlocksPerMultiprocessor(&per_cu, (const void*)hymba_fwd, NWAVES * 64, LDS_BYTES) != hipSuccess || per_cu < 1) { fprintf(stderr, "kernel_launch: occupancy query failed (%d)\n", per_cu); (void)hipGetLastError(); grid = -1; return; }
        grid = cus;
        if (grid < 256) { fprintf(stderr, "kernel_launch: this kernel needs >= 256 CUs (got %d); nothing launched\n", grid); grid = -1; return; }
    }
    if (grid < 0) return;
    (void)hipMemsetAsync((char*)d_ws + WS_CTL, 0, CTL_ZERO_BYTES, stream);
    Args a{};
    for (int i = 0; i < 23; ++i) a.in[i] = (const float*)d_in[i];
    a.out = (float*)d_out; a.ws = (unsigned char*)d_ws;
    constexpr int NPH = 7;
    for (int li = 0; li < MK_N_LAUNCHES; ++li) {
        a.ph_lo = (MK_N_LAUNCHES == 1) ? 0 : li; a.ph_hi = (MK_N_LAUNCHES == 1) ? NPH : li + 1;
        void* kargs[] = {&a};
        const hipError_t e = hipLaunchCooperativeKernel((const void*)hymba_fwd, dim3(grid), dim3(NWAVES * 64), kargs, LDS_BYTES, stream);
        if (e != hipSuccess) { fprintf(stderr, "kernel_launch: cooperative launch failed: %s (grid %d)\n", hipGetErrorString(e), grid); break; }
    }
}
```

```cpp
#include <hip/hip_runtime.h>
#include <hip/hip_cooperative_groups.h>
#include <cstdio>
#include <cstdint>
namespace cg = cooperative_groups;

#ifndef PROBE_REP
#define PROBE_REP -1
#endif
#ifndef MK_N_LAUNCHES
#define MK_N_LAUNCHES 1
#endif

#define LAS __attribute__((address_space(3)))
typedef unsigned short bf16_t;
typedef short bf16x8 __attribute__((ext_vector_type(8)));
typedef float f32x4 __attribute__((ext_vector_type(4)));
typedef float f32x2 __attribute__((ext_vector_type(2)));
typedef float f32x16 __attribute__((ext_vector_type(16)));
typedef unsigned u32x4 __attribute__((ext_vector_type(4)));
typedef unsigned u32x2 __attribute__((ext_vector_type(2)));

constexpr int D_MODEL = 2048, BATCH = 4, SEQ = 4096, M = BATCH * SEQ;
constexpr int HD = 64, NQH = 16, NKVH = 4, ATTN_W = 1024, KV_W = 256;
constexpr int SSM_W = 1024, SSM_P = 16, SSM_G = 64, SSM_N = 64, IN_W = 2560, FF = 5632;
constexpr int CH_T = 16;
constexpr int SSM_KA = CH_T * SSM_P + 2 * SSM_N;
constexpr float EPS = 1e-6f;
constexpr float LOG2E = 1.4426950408889634f;

__device__ const unsigned char kBucket[128] = {0, 1, 2, 3, 4, 5, 6, 7, 8, 9, 10, 11, 12, 13, 14, 15, 16, 16, 16, 17, 17, 18, 18, 18, 19, 19, 19, 20, 20, 20, 20, 21, 21, 21, 21, 22, 22, 22, 22, 22, 23, 23, 23, 23, 23, 23, 24, 24, 24, 24, 24, 24, 25, 25, 25, 25, 25, 25, 25, 26, 26, 26, 26, 26, 26, 26, 26, 27, 27, 27, 27, 27, 27, 27, 27, 27, 27, 28, 28, 28, 28, 28, 28, 28, 28, 28, 28, 29, 29, 29, 29, 29, 29, 29, 29, 29, 29, 29, 29, 30, 30, 30, 30, 30, 30, 30, 30, 30, 30, 30, 30, 30, 30, 31, 31, 31, 31, 31, 31, 31, 31, 31, 31, 31, 31, 31, 31, 31};

__device__ __forceinline__ unsigned cvt_pk_bf16(float lo, float hi) { unsigned r; asm volatile("v_cvt_pk_bf16_f32 %0, %1, %2" : "=v"(r) : "v"(lo), "v"(hi)); return r; }
__device__ __forceinline__ float bf_lo(unsigned w) { return __builtin_bit_cast(float, w << 16); }
__device__ __forceinline__ float bf_hi(unsigned w) { return __builtin_bit_cast(float, w & 0xffff0000u); }
__device__ __forceinline__ float fast_rcp(float x) { return __builtin_amdgcn_rcpf(x); }
__device__ __forceinline__ float fast_exp2(float x) { return __builtin_amdgcn_exp2f(x); }
__device__ __forceinline__ float sigmoidf_fast(float x) { return fast_rcp(1.0f + fast_exp2(-LOG2E * x)); }
__device__ __forceinline__ float gelu_tanh(float x) {
    const float u2 = 1.5957691216057308f * (x + 0.044715f * x * x * x);
    return x * sigmoidf_fast(u2);
}

__device__ __forceinline__ int lane_id() { int l = __builtin_amdgcn_mbcnt_hi(~0u, __builtin_amdgcn_mbcnt_lo(~0u, 0u)); asm volatile("" : "+v"(l)); return l; }

namespace pg8 {
constexpr int BM = 256, BK = 64, HALF = 128, HTB = HALF * BK * 2  , STAGE_BYTES = 8 * HTB, NXCD = 8, WGM = 8;
__host__ __device__ __forceinline__ int lds_byte(int r, int c) { const int st = (r >> 4) * 2 + (c >> 5), rr = r & 15, cc = c & 31, ob = rr * 64 + cc * 2; return st * 1024 + (ob ^ (((ob >> 9) & 1) << 5)); }
__host__ __device__ __forceinline__ void stage_rc(int b, int& R, int& C) { const int st = b / 1024, sb = b % 1024, swz = sb ^ (((sb >> 9) & 1) << 5); R = (st >> 1) * 16 + swz / 64; C = (st & 1) * 32 + (swz % 64) / 2; }
__host__ __device__ __forceinline__ int perm32(int rho) { const int n = rho >> 4, i = rho & 15; return 8 * (i >> 2) + 4 * n + (i & 3); }

struct Unit { int pm, pn; unsigned aofs, bofs; int part; };
struct Gemm { const char* A; const char* B; int K; unsigned a_rs, a_cs, a_ks, b_rs; };

struct StaticOrder {
    int nM, nN, nwg, G, c;
    __device__ void init(int Mr, int N, int G_, int c_) { nM = Mr / BM; nN = N / BM; nwg = nM * nN; G = G_; c = c_; }
    __device__ bool next(int i, Unit& u) const {
        const long L = (long)i * G + c; if (L >= nwg) return false;
        int wgid = (int)L; { const int q = nwg / NXCD, r = nwg % NXCD, xcd = wgid % NXCD, off = wgid / NXCD; wgid = (xcd < r ? xcd * (q + 1) : r * (q + 1) + (xcd - r) * q) + off; }
        const int nig = WGM * nN, gid = wgid / nig, fm = gid * WGM, gsz = (nM - fm) < WGM ? (nM - fm) : WGM;
        u.pm = fm + ((wgid % nig) % gsz); u.pn = (wgid % nig) / gsz; u.aofs = 0; u.bofs = 0; u.part = 0; return true;
    }
};
struct TwoPartOrder {
    StaticOrder S; unsigned kofs;
    __device__ bool next(int i, Unit& u) const { if (!S.next(i >> 1, u)) return false; u.part = i & 1; u.aofs = u.bofs = (i & 1) ? kofs : 0u; return true; }
};
struct OneUnit {
    int pm, pn;
    __device__ bool next(int i, Unit& u) const { if (i) return false; u.pm = pm; u.pn = pn; u.aofs = 0; u.bofs = 0; u.part = 0; return true; }
};

template <class Epi, class Sched, bool ALIGN_EPI>
__device__ __forceinline__ void gemm_phase(LAS unsigned char* lds, const int wid  , const Gemm g, const Sched& S, const Epi& E) {
    const int lane = lane_id(), tid = wid * 64 + lane, wr = wid >> 2, wc = wid & 3, fr = lane & 15, fq = lane >> 4;
    const int nt = g.K / BK;
    unsigned voffA[2], voffB[2];
#pragma unroll
    for (int i = 0; i < 2; ++i) { int R, C; stage_rc(tid * 16 + i * 8192, R, C); const int Rb = Epi::PERM ? ((R & ~31) + perm32(R & 31)) : R;
        voffA[i] = (unsigned)R * g.a_rs + (unsigned)(C >> 4) * g.a_cs + (unsigned)(C & 15) * 2u; voffB[i] = (unsigned)Rb * g.b_rs + (unsigned)C * 2u; }
    const size_t kstepA = g.a_ks, kstepB = (size_t)(BK * 2);
    const size_t hstepA = (size_t)HALF * g.a_rs, hstepB = (size_t)HALF * g.b_rs, tstepA = 2 * hstepA, tstepB = 2 * hstepB;
    const unsigned ldsw = (unsigned)wid * 1024u;
    const int aoff = lds_byte(wr * 64 + fr, fq * 8), boff = lds_byte(wc * 32 + fr, fq * 8);
#define PG8_SA(b, h) (((b) * 2 + (h)) * HTB)
#define PG8_SB(b, h) ((4 + (b) * 2 + (h)) * HTB)
#define PG8_STAGE(bufoff, gbase, voff) do { _Pragma("unroll") for (int _i = 0; _i < 2; ++_i) \
        __builtin_amdgcn_global_load_lds((const unsigned*)((const char*)(gbase) + (voff)[_i]), (LAS unsigned*)(lds + (bufoff) + ldsw + _i * 8192), 16, 0, 0); } while (0)
#define PG8_LDA(dst, b, h) do { _Pragma("unroll") for (int m = 0; m < 4; ++m) _Pragma("unroll") for (int k = 0; k < 2; ++k) dst[m][k] = *(const LAS bf16x8*)(lds + PG8_SA(b, h) + aoff + m * 2048 + k * 1024); } while (0)
#define PG8_LDB(dst, b, h) do { _Pragma("unroll") for (int n = 0; n < 2; ++n) _Pragma("unroll") for (int k = 0; k < 2; ++k) dst[n][k] = *(const LAS bf16x8*)(lds + PG8_SB(b, h) + boff + n * 2048 + k * 1024); } while (0)
#define PG8_MMA(ai, bj, At, Bt) do { __builtin_amdgcn_s_setprio(1); _Pragma("unroll") for (int m = 0; m < 4; ++m) _Pragma("unroll") for (int n = 0; n < 2; ++n) _Pragma("unroll") for (int k = 0; k < 2; ++k) \
        acc[ai][bj][m][n] = __builtin_amdgcn_mfma_f32_16x16x32_bf16(Bt[n][k], At[m][k], acc[ai][bj][m][n], 0, 0, 0); __builtin_amdgcn_s_setprio(0); } while (0)
#define PG8_WAIT_V(n) asm volatile("s_waitcnt vmcnt(" #n ")" ::: "memory")
#define PG8_WAIT_L(n) asm volatile("s_waitcnt lgkmcnt(" #n ")" ::: "memory")
#define PG8_BAR __builtin_amdgcn_s_barrier()
#define PG8_SCHED __builtin_amdgcn_sched_barrier(0)
    Unit cur, nxt; int ui = 0;
    if (!S.next(0, cur)) return;
    f32x4 acc[2][2][4][2];
#pragma unroll
    for (int a = 0; a < 2; ++a)
#pragma unroll
        for (int b = 0; b < 2; ++b)
#pragma unroll
            for (int m = 0; m < 4; ++m)
#pragma unroll
                for (int n = 0; n < 2; ++n) acc[a][b][m][n] = (f32x4){0.f, 0.f, 0.f, 0.f};
    bf16x8 At[4][2], B0[2][2], B1[2][2];
    const char* cA = g.A + (size_t)cur.pm * tstepA + cur.aofs; const char* cB = g.B + (size_t)cur.pn * tstepB + cur.bofs;
    PG8_STAGE(PG8_SB(0, 0), cB, voffB); PG8_STAGE(PG8_SB(0, 1), cB + hstepB, voffB); PG8_STAGE(PG8_SA(0, 0), cA, voffA); PG8_STAGE(PG8_SA(0, 1), cA + hstepA, voffA);
    if (wr == 1) PG8_BAR;
    PG8_WAIT_V(2); PG8_BAR;
    PG8_STAGE(PG8_SB(1, 0), cB + kstepB, voffB); PG8_STAGE(PG8_SA(1, 0), cA + kstepA, voffA); PG8_STAGE(PG8_SB(1, 1), cB + hstepB + kstepB, voffB);
    PG8_WAIT_V(6); PG8_BAR;
    for (;;) {
        const bool has_next = S.next(ui + 1, nxt);
        const char* nA = has_next ? g.A + (size_t)nxt.pm * tstepA + nxt.aofs : cA; const char* nB = has_next ? g.B + (size_t)nxt.pn * tstepB + nxt.bofs : cB;
        for (int t = 0; t < nt; t += 2) {
            if constexpr (Epi::MID_T > 0) { if (t == Epi::MID_T) E.mid(acc, cur, wr, wc, fr, fq); }
            const bool last = (t == nt - 2);
            const char* a1 = cA + (size_t)(t + 1) * kstepA;
            const char* a2 = last ? nA : cA + (size_t)(t + 2) * kstepA; const char* b2 = last ? nB : cB + (size_t)(t + 2) * kstepB;
            const char* a3 = a2 + kstepA; const char* b3 = b2 + kstepB;
            PG8_LDB(B0, 0, 0); PG8_LDB(B1, 0, 1); PG8_SCHED; PG8_LDA(At, 0, 0); PG8_STAGE(PG8_SA(1, 1), a1 + hstepA, voffA);
            PG8_WAIT_V(8); PG8_WAIT_L(0); PG8_BAR; PG8_MMA(0, 0, At, B0); PG8_MMA(0, 1, At, B1); PG8_BAR; PG8_SCHED;
            PG8_LDA(At, 0, 1); PG8_STAGE(PG8_SB(0, 0), b2, voffB); PG8_STAGE(PG8_SB(0, 1), b2 + hstepB, voffB); PG8_STAGE(PG8_SA(0, 0), a2, voffA);
            PG8_WAIT_V(8); PG8_WAIT_L(0); PG8_BAR; PG8_MMA(1, 0, At, B0); PG8_MMA(1, 1, At, B1); PG8_BAR; PG8_SCHED;
            PG8_LDB(B0, 1, 0); PG8_LDB(B1, 1, 1); PG8_SCHED; PG8_LDA(At, 1, 0); PG8_STAGE(PG8_SA(0, 1), a2 + hstepA, voffA);
            PG8_WAIT_V(8); PG8_WAIT_L(0); PG8_BAR; PG8_MMA(0, 0, At, B0); PG8_MMA(0, 1, At, B1); PG8_BAR; PG8_SCHED;
            PG8_LDA(At, 1, 1); PG8_STAGE(PG8_SB(1, 0), b3, voffB); PG8_STAGE(PG8_SB(1, 1), b3 + hstepB, voffB); PG8_STAGE(PG8_SA(1, 0), a3, voffA);
            PG8_WAIT_V(8); PG8_WAIT_L(0); PG8_BAR; PG8_MMA(1, 0, At, B0); PG8_MMA(1, 1, At, B1); PG8_BAR; PG8_SCHED;
        }
        if constexpr (ALIGN_EPI) { if (wr == 0) PG8_BAR; }
        if constexpr (!Epi::AFTER_DRAIN) E(acc, cur, wr, wc, fr, fq);
        if (!has_next) break;
#pragma unroll
        for (int a = 0; a < 2; ++a)
#pragma unroll
            for (int b = 0; b < 2; ++b)
#pragma unroll
                for (int m = 0; m < 4; ++m)
#pragma unroll
                    for (int n = 0; n < 2; ++n) acc[a][b][m][n] = (f32x4){0.f, 0.f, 0.f, 0.f};
        cur = nxt; cA = nA; cB = nB; ++ui;
        if constexpr (ALIGN_EPI) { if (wr == 1) PG8_BAR; }
    }
    PG8_WAIT_V(0);
    if constexpr (!ALIGN_EPI) { if (wr == 0) PG8_BAR; }
    PG8_BAR;
    if constexpr (Epi::AFTER_DRAIN) E.fused(acc, cur, wr, wc, fr, fq, lds);
#undef PG8_SA
#undef PG8_SB
#undef PG8_STAGE
#undef PG8_LDA
#undef PG8_LDB
#undef PG8_MMA
#undef PG8_WAIT_V
#undef PG8_WAIT_L
#undef PG8_BAR
#undef PG8_SCHED
}
}

constexpr size_t MiB = 1u << 20;
constexpr size_t WS_CTL = 0, CTL_ZERO_BYTES = 1 * MiB;
constexpr size_t WS_SSQ_A = 256 * 1024, WS_SSQ_S = 320 * 1024, WS_SSQ_X = 384 * 1024, WS_SSQ_T = 448 * 1024  ;
constexpr size_t WS_WIN = 2 * MiB;
constexpr size_t WS_WGLU = 12 * MiB;
constexpr size_t WS_WOUT = 14 * MiB;
constexpr size_t WS_WGU = 22 * MiB;
constexpr size_t WS_WDN = 66 * MiB;
constexpr size_t WS_BG = 88 * MiB;
constexpr size_t WS_PG = 100 * MiB;
constexpr size_t WS_L16 = 108 * MiB;
constexpr size_t WS_SSCR = 109 * MiB;
constexpr size_t WS_XN = 141 * MiB;
constexpr size_t WS_Q = 205 * MiB;
constexpr size_t WS_K = 237 * MiB;
constexpr size_t WS_V = 245 * MiB;
constexpr size_t WS_AG = 253 * MiB;
constexpr size_t WS_YG = 301 * MiB;
constexpr size_t WS_MIX = 333 * MiB;
constexpr size_t WS_H = 205 * MiB;
constexpr size_t WS_END = 397 * MiB;
static_assert(WS_H + (size_t)M * FF * 2 <= WS_END, "ws map");

constexpr int RING_BYTES = 131072;
constexpr int LDS_BYTES = 147456;
constexpr int NWAVES = 8;
constexpr int LDSCTL_OFF = RING_BYTES, MISC_OFF = LDSCTL_OFF + 320;

struct Frame {
    LAS unsigned char* lds;
    int wave, vcu, G;
    const float* const* in; float* out; unsigned char* ws;
};

__device__ __forceinline__ float wave_sum(float v) {
#pragma unroll
    for (int o = 1; o < 64; o <<= 1) v += __shfl_xor(v, o);
    return v;
}
__device__ __forceinline__ unsigned f2bf(float f) { unsigned u = __builtin_bit_cast(unsigned, f); return (u + 0x7fffu + ((u >> 16) & 1u)) >> 16; }
__device__ __forceinline__ unsigned pk2(float lo, float hi) { return f2bf(lo) | (f2bf(hi) << 16); }

struct TItem { const float* W; bf16_t* WT; const float* gain; int K, N, rmul, radd, item; };
__device__ __forceinline__ void titem_load(const TItem& t, float (&v)[32], int lane) {
    const int nblk = t.N / 32, kb = t.item / nblk, nb = t.item % nblk, k0 = 64 * kb, n0 = 32 * nb;
    const float* p = t.W + (size_t)(k0 + (lane >> 5)) * t.N + n0 + (lane & 31);
#pragma unroll
    for (int i = 0; i < 32; ++i) v[i] = p[(size_t)(2 * i) * t.N];
}
__device__ __forceinline__ void titem_store(const TItem& t, const float (&v)[32], LAS float* scr, int lane) {
    const int nblk = t.N / 32, kb = t.item / nblk, nb = t.item % nblk, k0 = 64 * kb, n0 = 32 * nb;
#pragma unroll
    for (int i = 0; i < 32; ++i) scr[(2 * i + (lane >> 5)) * 33 + (lane & 31)] = v[i];
    asm volatile("s_waitcnt lgkmcnt(0)" ::: "memory");
    const int c = lane & 7;
    float gv[8];
#pragma unroll
    for (int i = 0; i < 8; ++i) gv[i] = t.gain ? t.gain[k0 + 8 * c + i] : 1.0f;
#pragma unroll
    for (int j = 0; j < 4; ++j) { const int n = (lane >> 3) + 8 * j; const LAS float* s = scr + (8 * c) * 33 + n; const int nn = n0 + n; const int row = (nn >> 7) * t.rmul + t.radd + (nn & 127);
        u32x4 o; o.x = pk2(s[0 * 33] * gv[0], s[1 * 33] * gv[1]); o.y = pk2(s[2 * 33] * gv[2], s[3 * 33] * gv[3]); o.z = pk2(s[4 * 33] * gv[4], s[5 * 33] * gv[5]); o.w = pk2(s[6 * 33] * gv[6], s[7 * 33] * gv[7]);
        *(u32x4*)(t.WT + (size_t)row * t.K + k0 + 8 * c) = o; }
    asm volatile("s_waitcnt lgkmcnt(0)" ::: "memory");
}
__device__ __forceinline__ void rms_row_load(const float* xrow, f32x4 (&v)[8], int lane) {
    const f32x4* xr = (const f32x4*)xrow + lane;
#pragma unroll
    for (int j = 0; j < 8; ++j) v[j] = xr[64 * j];
}
__device__ __forceinline__ void rms_row_store(const f32x4 (&v)[8], const float* gain, bf16_t* orow, int lane) {
    const f32x4* gr = (const f32x4*)gain + lane; float s = 0.f;
#pragma unroll
    for (int j = 0; j < 8; ++j) s += (v[j].x * v[j].x + v[j].y * v[j].y) + (v[j].z * v[j].z + v[j].w * v[j].w);
    const float rstd = 1.0f / sqrtf(wave_sum(s) * (1.0f / D_MODEL) + EPS);
    u32x2* o8 = (u32x2*)orow + lane;
#pragma unroll
    for (int j = 0; j < 8; ++j) { const f32x4 gg = gr[64 * j]; u32x2 w; w.x = pk2(v[j].x * rstd * gg.x, v[j].y * rstd * gg.y); w.y = pk2(v[j].z * rstd * gg.z, v[j].w * rstd * gg.w); o8[64 * j] = w; }
}
__device__ __forceinline__ void p0_ssm_tables(Frame& F, int g, int qr) {
    LAS float* LP = (LAS float*)F.lds; LAS float* BB = LP + 17 * 64 * 2; LAS float* CC = BB + 64 * 16 * 2; LAS float* KT = CC + 16 * 64 * 2;
    const float* a_re = F.in[7]; const float* a_im = F.in[8]; const float* log_dt = F.in[9]; const float* b_re = F.in[10]; const float* b_im = F.in[11]; const float* c_re = F.in[12]; const float* c_im = F.in[13];
    const int tid = F.wave * 64 + lane_id();
    if (tid < 64) {
        const int n = tid;
        const double dt = exp((double)log_dt[g]);
        const double are = (double)a_re[g * 64 + n], aim = (double)a_im[g * 64 + n];
        const double mag = exp(are * dt), ang = aim * dt;
        const double lre = mag * cos(ang), lim = mag * sin(ang);
        const double nr = lre - 1.0, ni = lim, den = are * are + aim * aim;
        const double fre = (nr * are + ni * aim) / den, fim = (ni * are - nr * aim) / den;
        double pr = 1.0, pi = 0.0;
        for (int t = 0; t <= 16; ++t) { LP[(t * 64 + n) * 2] = (float)pr; LP[(t * 64 + n) * 2 + 1] = (float)pi; const double nre = pr * lre - pi * lim, nim = pr * lim + pi * lre; pr = nre; pi = nim; }
        if (qr == 0) { float* l16 = (float*)(F.ws + WS_L16) + (g * 64 + n) * 2; l16[0] = LP[(16 * 64 + n) * 2]; l16[1] = LP[(16 * 64 + n) * 2 + 1]; }
        for (int p = 0; p < 16; ++p) { const double br = (double)b_re[(g * 64 + n) * 16 + p], bi = (double)b_im[(g * 64 + n) * 16 + p];
            BB[(n * 16 + p) * 2] = (float)(fre * br - fim * bi); BB[(n * 16 + p) * 2 + 1] = (float)(fre * bi + fim * br); }
    }
    for (int e = tid; e < 1024; e += 512) { CC[e * 2] = c_re[g * 1024 + e]; CC[e * 2 + 1] = c_im[g * 1024 + e]; }
    __syncthreads();
    {
        const int p = (tid >> 4) & 15, q = tid & 15, th = tid >> 8; float ka[8];
#pragma unroll
        for (int j = 0; j < 8; ++j) ka[j] = 0.f;
        for (int n = 0; n < 64; ++n) {
            const f32x2 c = *(const LAS f32x2*)(CC + (p * 64 + n) * 2), bb = *(const LAS f32x2*)(BB + (n * 16 + q) * 2);
            const float cbr = c.x * bb.x - c.y * bb.y, cbi = c.x * bb.y + c.y * bb.x;
#pragma unroll
            for (int j = 0; j < 8; ++j) { const f32x2 l = *(const LAS f32x2*)(LP + ((8 * th + j) * 64 + n) * 2); ka[j] += cbr * l.x - cbi * l.y; }
        }
#pragma unroll
        for (int j = 0; j < 8; ++j) KT[((8 * th + j) * 16 + p) * 16 + q] = ka[j];
    }
    __syncthreads();
    bf16_t* Bg = (bf16_t*)(F.ws + WS_BG) + (size_t)g * 256 * SSM_KA;
    for (int ch = tid; ch < 64 * 48; ch += 512) {
        const int rl = ch / 48, c8 = ch % 48, t = 4 * qr + (rl >> 4), p = rl & 15; float v[8];
        if (c8 < 32) { const int s = c8 >> 1, q0 = (c8 & 1) * 8;
#pragma unroll
            for (int i = 0; i < 8; ++i) v[i] = (s <= t) ? KT[((t - s) * 16 + p) * 16 + q0 + i] : 0.f;
        } else { const int n0 = (c8 - 32) * 4;
#pragma unroll
            for (int i = 0; i < 4; ++i) { const int n = n0 + i; const float cr = CC[(p * 64 + n) * 2], ci = CC[(p * 64 + n) * 2 + 1], lr = LP[((t + 1) * 64 + n) * 2], li = LP[((t + 1) * 64 + n) * 2 + 1];
                v[2 * i] = cr * lr - ci * li; v[2 * i + 1] = -(cr * li + ci * lr); }
        }
        u32x4 o; o.x = pk2(v[0], v[1]); o.y = pk2(v[2], v[3]); o.z = pk2(v[4], v[5]); o.w = pk2(v[6], v[7]);
        *(u32x4*)(Bg + (size_t)(t * 16 + p) * SSM_KA + c8 * 8) = o;
    }
    bf16_t* Pg = (bf16_t*)(F.ws + WS_PG) + (size_t)g * 256 * 256;
    for (int ch = tid; ch < 32 * 32; ch += 512) {
        const int rl = ch >> 5, c8 = ch & 31, n = 16 * qr + (rl >> 1), ri = rl & 1, s = c8 >> 1, q0 = (c8 & 1) * 8; float v[8];
        const float lr = LP[((15 - s) * 64 + n) * 2], li = LP[((15 - s) * 64 + n) * 2 + 1];
#pragma unroll
        for (int i = 0; i < 8; ++i) { const float br = BB[(n * 16 + q0 + i) * 2], bi = BB[(n * 16 + q0 + i) * 2 + 1]; v[i] = ri ? (lr * bi + li * br) : (lr * br - li * bi); }
        u32x4 o; o.x = pk2(v[0], v[1]); o.y = pk2(v[2], v[3]); o.z = pk2(v[4], v[5]); o.w = pk2(v[6], v[7]);
        *(u32x4*)(Pg + (size_t)(2 * n + ri) * 256 + c8 * 8) = o;
        *(u32x4*)(Pg + (size_t)(128 + 32 * qr + rl) * 256 + c8 * 8) = (u32x4){0u, 0u, 0u, 0u};
    }
    __syncthreads();
}
__device__ __forceinline__ void p0_prologue(Frame& F) {
    for (int it = F.vcu; it < 256; it += F.G) p0_ssm_tables(F, it >> 2, it & 3);
    LAS float* scr = (LAS float*)(F.lds + F.wave * 16384);
    const int lane = lane_id();
    const int gw = F.vcu * NWAVES + F.wave, NGW = F.G * NWAVES;
    constexpr int I_IN = (D_MODEL / 64) * (IN_W / 32);
    {
        TItem t{F.in[3], (bf16_t*)(F.ws + WS_WIN), nullptr, D_MODEL, IN_W, 128, 0, 0};
        float va[32], vb[32];
        int it = gw;
        if (it < I_IN) { t.item = it; titem_load(t, va, lane); }
        for (; it < I_IN; it += 2 * NGW) {
            TItem t2 = t; const bool h2 = it + NGW < I_IN;
            if (h2) { t2.item = it + NGW; titem_load(t2, vb, lane); }
            t.item = it; titem_store(t, va, scr, lane);
            if (h2) { if (it + 2 * NGW < I_IN) { t.item = it + 2 * NGW; titem_load(t, va, lane); } titem_store(t2, vb, scr, lane); }
        }
    }
    {
        bf16_t* xn = (bf16_t*)(F.ws + WS_XN); const float* x = F.in[0]; const float* g1 = F.in[2];
        f32x4 ra[8], rb[8];
        int m = gw;
        if (m < M) rms_row_load(x + (size_t)m * D_MODEL, ra, lane);
        for (; m < M; m += 2 * NGW) {
            const bool h2 = m + NGW < M;
            if (h2) rms_row_load(x + (size_t)(m + NGW) * D_MODEL, rb, lane);
            rms_row_store(ra, g1, xn + (size_t)m * D_MODEL, lane);
            if (h2) { if (m + 2 * NGW < M) rms_row_load(x + (size_t)(m + 2 * NGW) * D_MODEL, ra, lane); rms_row_store(rb, g1, xn + (size_t)(m + NGW) * D_MODEL, lane); }
        }
    }
}
__device__ __forceinline__ bool late_item(Frame& F, int r, TItem& t) {
    constexpr int I_GLU = (SSM_W / 64) * (SSM_W / 32), I_OUT = (2048 / 64) * (D_MODEL / 32), I_G = (D_MODEL / 64) * (FF / 32), I_D = (FF / 64) * (D_MODEL / 32);
    if (r >= I_GLU + I_OUT + 2 * I_G + I_D) return false;
    if (r < I_GLU) { t = TItem{F.in[15], (bf16_t*)(F.ws + WS_WGLU), nullptr, SSM_W, SSM_W, 128, 0, r}; return true; } r -= I_GLU;
    if (r < I_OUT) {
        const int kb = r / (D_MODEL / 32); t = TItem{F.in[18], (bf16_t*)(F.ws + WS_WOUT), (kb < 16) ? F.in[16] : (F.in[17] - 1024), 2048, D_MODEL, 128, 0, r}; return true; } r -= I_OUT;
    if (r < I_G) { t = TItem{F.in[20], (bf16_t*)(F.ws + WS_WGU), F.in[19], D_MODEL, FF, 256, 0, r}; return true; } r -= I_G;
    if (r < I_G) { t = TItem{F.in[21], (bf16_t*)(F.ws + WS_WGU), F.in[19], D_MODEL, FF, 256, 128, r}; return true; } r -= I_G;
    t = TItem{F.in[22], (bf16_t*)(F.ws + WS_WDN), nullptr, FF, D_MODEL, 128, 0, r}; return true;
}
__device__ __forceinline__ void convert_late_weights(Frame& F, int w, int nw) {
    LAS float* scr = (LAS float*)(F.lds + F.wave * 16384);
    const int lane = lane_id();
    TItem ta, tb; float va[32], vb[32];
    int it = w;
    bool ha = late_item(F, it, ta);
    if (ha) titem_load(ta, va, lane);
    while (ha) {
        const bool hb = late_item(F, it + nw, tb);
        if (hb) titem_load(tb, vb, lane);
        titem_store(ta, va, scr, lane);
        it += 2 * nw;
        ha = hb && late_item(F, it, ta);
        if (hb) { if (ha) titem_load(ta, va, lane); titem_store(tb, vb, scr, lane); }
    }
}

using pg8::Unit;
struct EpiIn {
    static constexpr bool PERM = true, AFTER_DRAIN = false; static constexpr int MID_T = 0;
    bf16_t* Q; bf16_t* Kb; bf16_t* Vb; bf16_t* Ag;
    __device__ __forceinline__ void operator()(const f32x4 (&acc)[2][2][4][2], const Unit& u, int wr, int wc, int fr, int fq) const {
        asm volatile("" : "+v"(fr), "+v"(fq));
        const int row0 = u.pm * 256 + wr * 64 + fr, pn = u.pn;
#pragma unroll
        for (int ai = 0; ai < 2; ++ai)
#pragma unroll
            for (int m = 0; m < 4; ++m) { const int row = row0 + ai * 128 + m * 16;
#pragma unroll
                for (int bj = 0; bj < 2; ++bj) { const int col = bj * 128 + wc * 32 + 8 * fq; const f32x4 v0 = acc[ai][bj][m][0], v1 = acc[ai][bj][m][1];
                    u32x4 w; w.x = cvt_pk_bf16(v0[0], v0[1]); w.y = cvt_pk_bf16(v0[2], v0[3]); w.z = cvt_pk_bf16(v1[0], v1[1]); w.w = cvt_pk_bf16(v1[2], v1[3]);
                    bf16_t* dst;
                    if (pn < 4) dst = Q + (size_t)row * ATTN_W + pn * 256 + col;
                    else if (pn == 4) dst = Kb + (size_t)row * KV_W + col;
                    else if (pn == 5) dst = Vb + (size_t)row * KV_W + col;
                    else { const int c = (pn - 6) * 256 + col; dst = Ag + ((size_t)(c >> 4) * 1024 + (row >> 4)) * SSM_KA + (row & 15) * 16 + (c & 15); }
                    *(u32x4*)dst = w; } }
    }
};
struct EpiS {
    static constexpr bool PERM = false, AFTER_DRAIN = true; static constexpr int MID_T = 0;
    __device__ __forceinline__ void operator()(const f32x4 (&acc)[2][2][4][2], const Unit& u, int wr, int wc, int fr, int fq) const {}
    __device__ __forceinline__ void fused(const f32x4 (&acc)[2][2][4][2], const Unit& u, int wr, int wc, int fr, int fq, LAS unsigned char* lds) const {
        asm volatile("" : "+v"(fr), "+v"(fq));
#pragma unroll
        for (int ai = 0; ai < 2; ++ai)
#pragma unroll
            for (int m = 0; m < 4; ++m) { const int r = ai * 128 + wr * 64 + m * 16 + fr;
#pragma unroll
                for (int n = 0; n < 2; ++n) *(LAS f32x4*)(lds + r * 512 + (((wc * 32 + n * 16 + 4 * fq) * 4) ^ ((r & 7) << 4))) = acc[ai][0][m][n]; }
    }
};
struct EpiY {
    static constexpr bool PERM = true, AFTER_DRAIN = false; static constexpr int MID_T = 0;
    const bf16_t* Ag; const float* dd; bf16_t* Yg;
    __device__ __forceinline__ void operator()(const f32x4 (&acc)[2][2][4][2], const Unit& u, int wr, int wc, int fr, int fq) const {
        asm volatile("" : "+v"(fr), "+v"(fq));
        const int g = u.pm >> 2; const int p0 = (8 * fq) & 15;
        const f32x4 d0 = *(const f32x4*)(dd + g * 16 + p0), d1 = *(const f32x4*)(dd + g * 16 + p0 + 4);
        const size_t grow0 = (size_t)u.pm * 256 + wr * 64 + fr; const int col0 = wc * 32 + 8 * fq;
        u32x4 uu[2][4][2];
#pragma unroll
        for (int ai = 0; ai < 2; ++ai)
#pragma unroll
            for (int m = 0; m < 4; ++m)
#pragma unroll
                for (int bj = 0; bj < 2; ++bj) uu[ai][m][bj] = *(const u32x4*)(Ag + (grow0 + ai * 128 + m * 16) * SSM_KA + bj * 128 + col0);
#pragma unroll
        for (int ai = 0; ai < 2; ++ai)
#pragma unroll
            for (int m = 0; m < 4; ++m) { const size_t grow = grow0 + ai * 128 + m * 16;
#pragma unroll
                for (int bj = 0; bj < 2; ++bj) { const u32x4 w_ = uu[ai][m][bj]; const f32x4 v0 = acc[ai][bj][m][0], v1 = acc[ai][bj][m][1];
                    const float y0 = gelu_tanh(v0[0] + d0[0] * bf_lo(w_.x)), y1 = gelu_tanh(v0[1] + d0[1] * bf_hi(w_.x)), y2 = gelu_tanh(v0[2] + d0[2] * bf_lo(w_.y)), y3 = gelu_tanh(v0[3] + d0[3] * bf_hi(w_.y));
                    const float y4 = gelu_tanh(v1[0] + d1[0] * bf_lo(w_.z)), y5 = gelu_tanh(v1[1] + d1[1] * bf_hi(w_.z)), y6 = gelu_tanh(v1[2] + d1[2] * bf_lo(w_.w)), y7 = gelu_tanh(v1[3] + d1[3] * bf_hi(w_.w));
                    u32x4 w; w.x = cvt_pk_bf16(y0, y1); w.y = cvt_pk_bf16(y2, y3); w.z = cvt_pk_bf16(y4, y5); w.w = cvt_pk_bf16(y6, y7);
                    *(u32x4*)(Yg + grow * 256 + bj * 128 + col0) = w; } }
    }
};
struct EpiGlu {
    static constexpr bool PERM = true, AFTER_DRAIN = false; static constexpr int MID_T = 0;
    const bf16_t* Yg; bf16_t* mixed; float* ssq;
    __device__ __forceinline__ void operator()(const f32x4 (&acc)[2][2][4][2], const Unit& u, int wr, int wc, int fr, int fq) const {
        asm volatile("" : "+v"(fr), "+v"(fq));
        const int row0 = u.pm * 256 + wr * 64 + fr, c0 = u.pn * 256 + wc * 32 + 8 * fq;
        u32x4 yy[2][4][2];
#pragma unroll
        for (int ai = 0; ai < 2; ++ai)
#pragma unroll
            for (int m = 0; m < 4; ++m)
#pragma unroll
                for (int bj = 0; bj < 2; ++bj) { const int c = c0 + bj * 128; yy[ai][m][bj] = *(const u32x4*)(Yg + ((size_t)(c >> 4) * M + row0 + ai * 128 + m * 16) * 16 + (c & 15)); }
#pragma unroll
        for (int ai = 0; ai < 2; ++ai)
#pragma unroll
            for (int m = 0; m < 4; ++m) { const int row = row0 + ai * 128 + m * 16; float sq = 0.f;
#pragma unroll
                for (int bj = 0; bj < 2; ++bj) { const int c = c0 + bj * 128; const u32x4 y_ = yy[ai][m][bj]; const f32x4 v0 = acc[ai][bj][m][0], v1 = acc[ai][bj][m][1];
                    const float s0 = bf_lo(y_.x) * sigmoidf_fast(v0[0]), s1 = bf_hi(y_.x) * sigmoidf_fast(v0[1]), s2 = bf_lo(y_.y) * sigmoidf_fast(v0[2]), s3 = bf_hi(y_.y) * sigmoidf_fast(v0[3]);
                    const float s4 = bf_lo(y_.z) * sigmoidf_fast(v1[0]), s5 = bf_hi(y_.z) * sigmoidf_fast(v1[1]), s6 = bf_lo(y_.w) * sigmoidf_fast(v1[2]), s7 = bf_hi(y_.w) * sigmoidf_fast(v1[3]);
                    sq += (s0 * s0 + s1 * s1) + (s2 * s2 + s3 * s3) + (s4 * s4 + s5 * s5) + (s6 * s6 + s7 * s7);
                    u32x4 w; w.x = cvt_pk_bf16(s0, s1); w.y = cvt_pk_bf16(s2, s3); w.z = cvt_pk_bf16(s4, s5); w.w = cvt_pk_bf16(s6, s7);
                    *(u32x4*)(mixed + (size_t)row * 2048 + 1024 + c) = w; }
                sq += __shfl_xor(sq, 16); sq += __shfl_xor(sq, 32);
                if (fq == 0) atomicAdd(ssq + row, sq); }
    }
};
struct EpiOut {
    static constexpr bool PERM = true, AFTER_DRAIN = false; static constexpr int MID_T = 16;
    const float* x; bf16_t* x1b; const float* ssq_a; const float* ssq_s; float* ssq_x;
    __device__ __forceinline__ void mid(f32x4 (&acc)[2][2][4][2], const Unit& u, int wr, int wc, int fr, int fq) const {
        asm volatile("" : "+v"(fr), "+v"(fq));
#pragma unroll
        for (int ai = 0; ai < 2; ++ai)
#pragma unroll
            for (int m = 0; m < 4; ++m) { const int row = u.pm * 256 + ai * 128 + wr * 64 + m * 16 + fr;
                const float f = sqrtf((ssq_s[row] * (1.0f / 1024.0f) + EPS) / (ssq_a[row] * (1.0f / 1024.0f) + EPS));
#pragma unroll
                for (int bj = 0; bj < 2; ++bj)
#pragma unroll
                    for (int n = 0; n < 2; ++n) acc[ai][bj][m][n] *= f; }
    }
    __device__ __forceinline__ void operator()(const f32x4 (&acc)[2][2][4][2], const Unit& u, int wr, int wc, int fr, int fq) const {
        asm volatile("" : "+v"(fr), "+v"(fq));
        const int row0 = u.pm * 256 + wr * 64 + fr; const size_t cofs = (size_t)u.pn * 256 + wc * 32 + 8 * fq;
        float sv[2][4];
#pragma unroll
        for (int ai = 0; ai < 2; ++ai)
#pragma unroll
            for (int m = 0; m < 4; ++m) sv[ai][m] = ssq_s[row0 + ai * 128 + m * 16];
#pragma unroll
        for (int ai = 0; ai < 2; ++ai) {
            f32x4 xb[4][2][2];
#pragma unroll
            for (int m = 0; m < 4; ++m)
#pragma unroll
                for (int bj = 0; bj < 2; ++bj) { const float* p = x + (size_t)(row0 + ai * 128 + m * 16) * D_MODEL + cofs + bj * 128; xb[m][bj][0] = *(const f32x4*)p; xb[m][bj][1] = *(const f32x4*)(p + 4); }
#pragma unroll
            for (int m = 0; m < 4; ++m) { const int row = row0 + ai * 128 + m * 16; const float rstd = 1.0f / sqrtf(sv[ai][m] * (1.0f / 1024.0f) + EPS); float sq = 0.f;
#pragma unroll
                for (int bj = 0; bj < 2; ++bj) { const size_t off = (size_t)row * D_MODEL + cofs + bj * 128;
                    const f32x4 o0 = xb[m][bj][0] + acc[ai][bj][m][0] * rstd, o1 = xb[m][bj][1] + acc[ai][bj][m][1] * rstd;
                    sq += (o0[0] * o0[0] + o0[1] * o0[1]) + (o0[2] * o0[2] + o0[3] * o0[3]) + (o1[0] * o1[0] + o1[1] * o1[1]) + (o1[2] * o1[2] + o1[3] * o1[3]);
                    u32x4 w; w.x = cvt_pk_bf16(o0[0], o0[1]); w.y = cvt_pk_bf16(o0[2], o0[3]); w.z = cvt_pk_bf16(o1[0], o1[1]); w.w = cvt_pk_bf16(o1[2], o1[3]);
                    *(u32x4*)(x1b + off) = w; }
                sq += __shfl_xor(sq, 16); sq += __shfl_xor(sq, 32); if (fq == 0) atomicAdd(ssq_x + row, sq); }
        }
    }
};
struct EpiGU {
    static constexpr bool PERM = true, AFTER_DRAIN = false; static constexpr int MID_T = 0;
    const float* ssq_x; bf16_t* H;
    __device__ __forceinline__ void operator()(const f32x4 (&acc)[2][2][4][2], const Unit& u, int wr, int wc, int fr, int fq) const {
        asm volatile("" : "+v"(fr), "+v"(fq));
        const int row0 = u.pm * 256 + wr * 64 + fr;
        float sv[2][4];
#pragma unroll
        for (int ai = 0; ai < 2; ++ai)
#pragma unroll
            for (int m = 0; m < 4; ++m) sv[ai][m] = ssq_x[row0 + ai * 128 + m * 16];
#pragma unroll
        for (int ai = 0; ai < 2; ++ai)
#pragma unroll
            for (int m = 0; m < 4; ++m) { const int row = row0 + ai * 128 + m * 16; const float rstd = 1.0f / sqrtf(sv[ai][m] * (1.0f / 2048.0f) + EPS);
                float h[8];
#pragma unroll
                for (int n = 0; n < 2; ++n)
#pragma unroll
                    for (int i = 0; i < 4; ++i) { const float gv = acc[ai][0][m][n][i] * rstd, uv = acc[ai][1][m][n][i] * rstd; h[4 * n + i] = gv * sigmoidf_fast(gv) * uv; }
                u32x4 w; w.x = cvt_pk_bf16(h[0], h[1]); w.y = cvt_pk_bf16(h[2], h[3]); w.z = cvt_pk_bf16(h[4], h[5]); w.w = cvt_pk_bf16(h[6], h[7]);
                *(u32x4*)(H + (size_t)row * FF + u.pn * 128 + wc * 32 + 8 * fq) = w; }
    }
};
template <bool DRY> struct EpiDown {
    static constexpr bool PERM = true, AFTER_DRAIN = false; static constexpr int MID_T = 0;
    const bf16_t* x1b; float* out; float* trash;
    __device__ __forceinline__ void operator()(const f32x4 (&acc)[2][2][4][2], const Unit& u, int wr, int wc, int fr, int fq) const {
        asm volatile("" : "+v"(fr), "+v"(fq));
        const int row0 = u.pm * 256 + wr * 64 + fr; const size_t cofs = (size_t)u.pn * 256 + wc * 32 + 8 * fq;
        u32x4 xb[2][4][2];
#pragma unroll
        for (int ai = 0; ai < 2; ++ai)
#pragma unroll
            for (int m = 0; m < 4; ++m)
#pragma unroll
                for (int bj = 0; bj < 2; ++bj) xb[ai][m][bj] = *(const u32x4*)(x1b + (size_t)(row0 + ai * 128 + m * 16) * D_MODEL + cofs + bj * 128);
#pragma unroll
        for (int ai = 0; ai < 2; ++ai)
#pragma unroll
            for (int m = 0; m < 4; ++m) { const int row = row0 + ai * 128 + m * 16;
#pragma unroll
                for (int bj = 0; bj < 2; ++bj) { const size_t off = (size_t)row * D_MODEL + cofs + bj * 128; const u32x4 x_ = xb[ai][m][bj];
                    const f32x4 b0 = {bf_lo(x_.x), bf_hi(x_.x), bf_lo(x_.y), bf_hi(x_.y)}, b1 = {bf_lo(x_.z), bf_hi(x_.z), bf_lo(x_.w), bf_hi(x_.w)};
                    float* q = DRY ? trash + (off & ((8u << 20) - 1)) : out + off;
                    *(f32x4*)q = b0 + acc[ai][bj][m][0]; *(f32x4*)(q + 4) = b1 + acc[ai][bj][m][1]; } }
    }
};

constexpr int ATT_KROW = 144, ATT_VROW = 520, ATT_K_OFF = 0, ATT_V_OFF = 256 * ATT_KROW, ATT_B_OFF = ATT_V_OFF + 64 * ATT_VROW;
constexpr int ATT_TAB = 192;
static_assert(ATT_B_OFF + 4 * ATT_TAB * 4 <= RING_BYTES, "attention LDS");
template <int STG_REPS = 1, int TASK_REPS = 1>
__device__ __forceinline__ void attn_unit(Frame& F, int b, int qb, int kvh, float* ssq_real) {
    LAS unsigned char* lds = F.lds;
    const int lane = lane_id(), wave = F.wave, tid = wave * 64 + lane;
    const bf16_t* Q = (const bf16_t*)(F.ws + WS_Q); const bf16_t* Kb = (const bf16_t*)(F.ws + WS_K); const bf16_t* Vb = (const bf16_t*)(F.ws + WS_V);
    bf16_t* mixed = (bf16_t*)(F.ws + WS_MIX);
    const int T0 = b * SEQ + qb * 128;
    const int q = lane & 31, hh = lane >> 5;
    u32x4 qraw[2][4];
#pragma unroll
    for (int it = 0; it < 2; ++it) { const int task = wave + 8 * it; const bf16_t* qp = Q + (size_t)(T0 + 32 * (task & 3) + q) * ATTN_W + (kvh * 4 + (task >> 2)) * 64 + hh * 8;
#pragma unroll
        for (int ks = 0; ks < 4; ++ks) qraw[it][ks] = *(const u32x4*)(qp + 16 * ks); }
    for (int srep = 0; srep < STG_REPS; ++srep)
    {
        const int key = tid & 255; const bool valid = (qb > 0) || (key >= 128);
        const size_t tok = (size_t)(T0 - 128 + key);
        u32x4 c[8];
        const bf16_t* src = ((tid < 256) ? Kb : Vb) + tok * KV_W + kvh * 64;
#pragma unroll
        for (int i = 0; i < 8; ++i) c[i] = valid ? *(const u32x4*)(src + 8 * i) : (u32x4){0u, 0u, 0u, 0u};
        if (tid < 256) {
            float ss = 0.f;
#pragma unroll
            for (int i = 0; i < 8; ++i) { const float a0 = bf_lo(c[i].x), a1 = bf_hi(c[i].x), a2 = bf_lo(c[i].y), a3 = bf_hi(c[i].y), a4 = bf_lo(c[i].z), a5 = bf_hi(c[i].z), a6 = bf_lo(c[i].w), a7 = bf_hi(c[i].w);
                ss += (a0 * a0 + a1 * a1) + (a2 * a2 + a3 * a3) + (a4 * a4 + a5 * a5) + (a6 * a6 + a7 * a7); }
            const float rstd = 1.0f / sqrtf(ss * (1.0f / 64.0f) + EPS);
            const float* kg = F.in[5];
#pragma unroll
            for (int i = 0; i < 8; ++i) { const f32x4 g0 = *(const f32x4*)(kg + 8 * i), g1 = *(const f32x4*)(kg + 8 * i + 4);
                u32x4 w; w.x = cvt_pk_bf16(bf_lo(c[i].x) * rstd * g0[0], bf_hi(c[i].x) * rstd * g0[1]); w.y = cvt_pk_bf16(bf_lo(c[i].y) * rstd * g0[2], bf_hi(c[i].y) * rstd * g0[3]);
                w.z = cvt_pk_bf16(bf_lo(c[i].z) * rstd * g1[0], bf_hi(c[i].z) * rstd * g1[1]); w.w = cvt_pk_bf16(bf_lo(c[i].w) * rstd * g1[2], bf_hi(c[i].w) * rstd * g1[3]);
                *(LAS u32x4*)(lds + ATT_K_OFF + key * ATT_KROW + i * 16) = w; }
        } else {
#pragma unroll
            for (int i = 0; i < 8; ++i) { const unsigned w4[4] = {c[i].x, c[i].y, c[i].z, c[i].w};
#pragma unroll
                for (int j = 0; j < 4; ++j) { *(LAS unsigned short*)(lds + ATT_V_OFF + (8 * i + 2 * j) * ATT_VROW + key * 2) = (unsigned short)(w4[j] & 0xffffu);
                    *(LAS unsigned short*)(lds + ATT_V_OFF + (8 * i + 2 * j + 1) * ATT_VROW + key * 2) = (unsigned short)(w4[j] >> 16); } }
        }
        for (int e = tid; e < 4 * ATT_TAB; e += NWAVES * 64) { const int hl = e / ATT_TAB, dist = e % ATT_TAB - 32;
            ((LAS float*)(lds + ATT_B_OFF))[e] = ((unsigned)dist < 128u) ? F.in[1][(int)kBucket[dist & 127] * NQH + kvh * 4 + hl] * LOG2E : -INFINITY; }
    }
    bf16x8 qf2[2][4];
    { const float* qg = F.in[4]; f32x4 gq[4][2];
#pragma unroll
      for (int ks = 0; ks < 4; ++ks) { gq[ks][0] = *(const f32x4*)(qg + 16 * ks + 8 * hh); gq[ks][1] = *(const f32x4*)(qg + 16 * ks + 8 * hh + 4); }
#pragma unroll
      for (int it = 0; it < 2; ++it) { float ss = 0.f;
#pragma unroll
        for (int ks = 0; ks < 4; ++ks) { const u32x4 w_ = qraw[it][ks];
            const float a0 = bf_lo(w_.x), a1 = bf_hi(w_.x), a2 = bf_lo(w_.y), a3 = bf_hi(w_.y), a4 = bf_lo(w_.z), a5 = bf_hi(w_.z), a6 = bf_lo(w_.w), a7 = bf_hi(w_.w);
            ss += (a0 * a0 + a1 * a1) + (a2 * a2 + a3 * a3) + (a4 * a4 + a5 * a5) + (a6 * a6 + a7 * a7); }
        ss += __shfl_xor(ss, 32);
        const float sc = (1.0f / sqrtf(ss * (1.0f / 64.0f) + EPS)) * (0.125f * LOG2E);
#pragma unroll
        for (int ks = 0; ks < 4; ++ks) { const u32x4 w_ = qraw[it][ks]; const f32x4 g0 = gq[ks][0], g1 = gq[ks][1];
            u32x4 w; w.x = cvt_pk_bf16(bf_lo(w_.x) * sc * g0[0], bf_hi(w_.x) * sc * g0[1]); w.y = cvt_pk_bf16(bf_lo(w_.y) * sc * g0[2], bf_hi(w_.y) * sc * g0[3]);
            w.z = cvt_pk_bf16(bf_lo(w_.z) * sc * g1[0], bf_hi(w_.z) * sc * g1[1]); w.w = cvt_pk_bf16(bf_lo(w_.w) * sc * g1[2], bf_hi(w_.w) * sc * g1[3]);
            qf2[it][ks] = __builtin_bit_cast(bf16x8, w); } } }
    __syncthreads();
    for (int trep = 0; trep < TASK_REPS; ++trep)
#pragma unroll
    for (int it = 0; it < 2; ++it) {
        float* ssq_a = (trep == TASK_REPS - 1) ? ssq_real : (float*)(F.ws + WS_SSQ_T);
        const int task = wave + 8 * it, hl = task >> 2, grp = task & 3, hq = kvh * 4 + hl, qi = 32 * grp + q;
        const bf16x8 (&qf)[4] = qf2[it];
        const LAS float* tb = (const LAS float*)(lds + ATT_B_OFF) + hl * ATT_TAB + (q + 128 - 4 * hh + 32 - 155);
        const float sink2 = F.in[6][hq] * LOG2E;
        f32x16 s[5];
#pragma unroll
        for (int kt = 0; kt < 5; ++kt) {
            f32x16 a;
#pragma unroll
            for (int r = 0; r < 16; ++r) a[r] = tb[155 - 32 * kt - ((r & 3) + 8 * (r >> 2))];
#pragma unroll
            for (int ks = 0; ks < 4; ++ks) { const bf16x8 kf = *(const LAS bf16x8*)(lds + ATT_K_OFF + (32 * (grp + kt) + q) * ATT_KROW + (16 * ks + 8 * hh) * 2);
                a = __builtin_amdgcn_mfma_f32_32x32x16_bf16(kf, qf[ks], a, 0, 0, 0); }
            if (qb == 0 && grp + kt < 4) {
#pragma unroll
                for (int r = 0; r < 16; ++r) a[r] = -INFINITY; }
            s[kt] = a;
        }
        float mx = sink2;
#pragma unroll
        for (int kt = 0; kt < 5; ++kt)
#pragma unroll
            for (int r = 0; r < 16; ++r) mx = fmaxf(mx, s[kt][r]);
        mx = fmaxf(mx, __shfl_xor(mx, 32));
        float l = 0.f;
#pragma unroll
        for (int kt = 0; kt < 5; ++kt)
#pragma unroll
            for (int r = 0; r < 16; ++r) { const float p = fast_exp2(s[kt][r] - mx); s[kt][r] = p; l += p; }
        l += __shfl_xor(l, 32);
        l += fast_exp2(sink2 - mx);
        f32x16 o[2]; o[0] = (f32x16){}; o[1] = (f32x16){};
#pragma unroll
        for (int kt = 0; kt < 5; ++kt)
#pragma unroll
            for (int s2 = 0; s2 < 2; ++s2) {
                u32x4 pw; pw.x = cvt_pk_bf16(s[kt][8 * s2 + 0], s[kt][8 * s2 + 1]); pw.y = cvt_pk_bf16(s[kt][8 * s2 + 2], s[kt][8 * s2 + 3]); pw.z = cvt_pk_bf16(s[kt][8 * s2 + 4], s[kt][8 * s2 + 5]); pw.w = cvt_pk_bf16(s[kt][8 * s2 + 6], s[kt][8 * s2 + 7]);
                const bf16x8 pb = __builtin_bit_cast(bf16x8, pw);
#pragma unroll
                for (int d0 = 0; d0 < 2; ++d0) { const LAS unsigned char* vp = lds + ATT_V_OFF + (32 * d0 + q) * ATT_VROW + (32 * (grp + kt) + 16 * s2 + 4 * hh) * 2;
                    const u32x2 lo = *(const LAS u32x2*)vp, hi = *(const LAS u32x2*)(vp + 16);
                    const u32x4 vv = {lo.x, lo.y, hi.x, hi.y};
                    o[d0] = __builtin_amdgcn_mfma_f32_32x32x16_bf16(__builtin_bit_cast(bf16x8, vv), pb, o[d0], 0, 0, 0); }
            }
        const float inv = 1.0f / l; float sq = 0.f;
        bf16_t* op = mixed + (size_t)(T0 + qi) * 2048 + hq * 64 + 4 * hh;
#pragma unroll
        for (int d0 = 0; d0 < 2; ++d0)
#pragma unroll
            for (int r4 = 0; r4 < 4; ++r4) { const float v0 = o[d0][4 * r4] * inv, v1 = o[d0][4 * r4 + 1] * inv, v2 = o[d0][4 * r4 + 2] * inv, v3 = o[d0][4 * r4 + 3] * inv;
                sq += (v0 * v0 + v1 * v1) + (v2 * v2 + v3 * v3);
                u32x2 w; w.x = cvt_pk_bf16(v0, v1); w.y = cvt_pk_bf16(v2, v3); *(u32x2*)(op + 32 * d0 + 8 * r4) = w; }
        sq += __shfl_xor(sq, 32);
        if (hh == 0) atomicAdd(ssq_a + T0 + qi, sq);
    }
    __syncthreads();
}

template <int MODE = 7>
__device__ __forceinline__ void ssm_unit(Frame& F, int pm) {
    const int g = pm >> 2;
    bf16_t* Ag = (bf16_t*)(F.ws + WS_AG);
    if constexpr (MODE & 1) {
        int Kc = 256; asm volatile("" : "+s"(Kc));
        pg8::Gemm gm{(const char*)Ag, (const char*)(F.ws + WS_PG), Kc, SSM_KA * 2, 32, 128, 256 * 2};
        pg8::OneUnit S1{pm, g}; EpiS E{};
        pg8::gemm_phase<EpiS, pg8::OneUnit, false>(F.lds, F.wave, gm, S1, E);
    }
    asm volatile("s_waitcnt lgkmcnt(0)" ::: "memory");
    __syncthreads();
    if ((MODE & 2) && F.wave == 0) {
        const int n = lane_id();
        const f32x2 l16 = *((const f32x2*)(F.ws + WS_L16) + g * 64 + n);
        float hr = 0.f, hi = 0.f;
        unsigned* hp = (unsigned*)(Ag + (size_t)pm * 256 * SSM_KA + 256) + n;
        for (int c0 = 0; c0 < 256; c0 += 8) {
            f32x2 sv[8];
#pragma unroll
            for (int j = 0; j < 8; ++j) sv[j] = *(const LAS f32x2*)(F.lds + (c0 + j) * 512 + ((8 * n) ^ (j << 4)));
#pragma unroll
            for (int j = 0; j < 8; ++j) { hp[(size_t)(c0 + j) * (SSM_KA / 2)] = cvt_pk_bf16(hr, hi);
                const float nr = l16.x * hr - l16.y * hi + sv[j].x, ni = l16.x * hi + l16.y * hr + sv[j].y; hr = nr; hi = ni; }
        }
    }
    asm volatile("s_waitcnt vmcnt(0) lgkmcnt(0)" ::: "memory");
    __syncthreads();
    if constexpr (MODE & 4) {
        int Kc = SSM_KA; asm volatile("" : "+s"(Kc));
        pg8::Gemm gm{(const char*)Ag, (const char*)(F.ws + WS_BG), Kc, SSM_KA * 2, 32, 128, SSM_KA * 2};
        pg8::OneUnit S1{pm, g}; EpiY E{Ag, F.in[14], (bf16_t*)(F.ws + WS_YG)};
        pg8::gemm_phase<EpiY, pg8::OneUnit, false>(F.lds, F.wave, gm, S1, E);
    }
}


#define XB_TMO      128
#define XB_XCNT(j)  (256  + 64 * (j))
#define XB_XSUB(j)  (1280 + 64 * (j))
#define XB_XGEN(j)  (2304 + 64 * (j))
#define XB_TOP      3328
#define XB_TOPGEN   3392
#define XCD_BAR_WORDS 3456
#define XB_SPIN_CAP (1u << 22)
constexpr size_t WS_BAR = 16384;
__device__ __forceinline__ unsigned xb_ld(unsigned* p)              { return __hip_atomic_load(p, __ATOMIC_RELAXED, __HIP_MEMORY_SCOPE_AGENT); }
__device__ __forceinline__ unsigned xb_add(unsigned* p, unsigned v) { return __hip_atomic_fetch_add(p, v, __ATOMIC_RELAXED, __HIP_MEMORY_SCOPE_AGENT); }
__device__ __forceinline__ unsigned xb_xcc_id() { return (unsigned)__builtin_amdgcn_s_getreg((3 << 11) | 20) & 0xFu; }
#define XB_SPIN(cond, bar) do { unsigned _sp = 0; while (cond) { __builtin_amdgcn_s_sleep(1); \
    if ((++_sp & 255u) == 0u) { if (xb_ld(&(bar)[XB_TMO])) break; if (_sp > XB_SPIN_CAP) { atomicAdd(&(bar)[XB_TMO], 1u); break; } } } } while (0)
struct XcdBarrier { unsigned* bar; unsigned x; volatile LAS unsigned* st; };
__device__ __forceinline__ XcdBarrier xcd_barrier_post(unsigned* bar, volatile LAS unsigned* st) {
    XcdBarrier b; b.bar = bar; b.x = xb_xcc_id(); b.st = st;
    if (threadIdx.x == 0) (void)xb_add(&bar[XB_XCNT(b.x)], 1u);
    return b;
}
__device__ __forceinline__ void xcd_barrier_complete(unsigned* bar, unsigned x, unsigned& nloc, unsigned& nx) {
    const unsigned G = gridDim.x * gridDim.y * gridDim.z;
    unsigned sum, cnt, mine, sp = 0u;
    for (;;) {
        sum = 0u; cnt = 0u; mine = 0u;
#pragma unroll
        for (unsigned j = 0; j < 16; ++j) { const unsigned c = xb_ld(&bar[XB_XCNT(j)]); sum += c; cnt += (c > 0u) ? 1u : 0u; mine = (j == x) ? c : mine; }
        if (sum == G) break;
        __builtin_amdgcn_s_sleep(1);
        if ((++sp & 255u) == 0u) { if (xb_ld(&bar[XB_TMO])) break; if (sp > XB_SPIN_CAP) { atomicAdd(&bar[XB_TMO], 1u); break; } }
    }
    nloc = mine > 0u ? mine : 1u; nx = cnt > 0u ? cnt : 1u;
}
__device__ __forceinline__ void xcd_barrier(const XcdBarrier& b, int wave) {
    asm volatile("s_waitcnt vmcnt(0)" ::: "memory");
    __syncthreads();
    if (wave == 0 && lane_id() == 0) {
        unsigned* bar = b.bar;
        __builtin_amdgcn_s_waitcnt(0);
        unsigned nloc = b.st[0], nx = b.st[1];
        if (nloc == 0u) { xcd_barrier_complete(bar, b.x, nloc, nx); b.st[0] = nloc; b.st[1] = nx; }
        const unsigned old = xb_add(&bar[XB_XSUB(b.x)], 1u);
        const unsigned gen = old / nloc;
        if (old + 1u == (gen + 1u) * nloc) {
            __builtin_amdgcn_fence(__ATOMIC_RELEASE, "agent");
            asm volatile("s_waitcnt vmcnt(0)" ::: "memory");
            const unsigned og = xb_add(&bar[XB_TOP], 1u);
            const unsigned tg = og / nx;
            if (og + 1u == (tg + 1u) * nx) xb_add(&bar[XB_TOPGEN], 1u);
            else XB_SPIN(xb_ld(&bar[XB_TOPGEN]) == tg, bar);
            __builtin_amdgcn_fence(__ATOMIC_ACQUIRE, "agent");
            xb_add(&bar[XB_XGEN(b.x)], 1u);
            asm volatile("s_waitcnt vmcnt(0)" ::: "memory");
        } else {
            XB_SPIN(xb_ld(&bar[XB_XGEN(b.x)]) == gen, bar);
            __builtin_amdgcn_fence(__ATOMIC_ACQUIRE, "agent");
            asm volatile("s_waitcnt vmcnt(0)" ::: "memory");
        }
    }
    __syncthreads();
}

struct Args { const float* in[23]; float* out; unsigned char* ws; int ph_lo, ph_hi; };
__global__ void __launch_bounds__(NWAVES * 64, 2) hymba_fwd(Args args) {
    extern __shared__ __attribute__((aligned(16))) unsigned char lds_raw[];
    Frame F;
    F.lds = (LAS unsigned char*)lds_raw;
    F.wave = __builtin_amdgcn_readfirstlane((int)threadIdx.x >> 6);
    F.G = gridDim.x; { const int bx = blockIdx.x; F.vcu = (F.G % 8 == 0) ? (bx % 8) * (F.G / 8) + bx / 8 : bx; }
    F.in = args.in; F.out = args.out; F.ws = args.ws;
    const int lo = args.ph_lo, hi = args.ph_hi;
    for (int u = threadIdx.x; u < (LDS_BYTES - LDSCTL_OFF) / 4; u += NWAVES * 64) ((LAS unsigned*)(F.lds + LDSCTL_OFF))[u] = 0u;
    __syncthreads();
    XcdBarrier bar; bar.bar = (unsigned*)(F.ws + WS_BAR); bar.x = 0; bar.st = nullptr;
    if (MK_N_LAUNCHES == 1) bar = xcd_barrier_post((unsigned*)(F.ws + WS_BAR), (volatile LAS unsigned*)(F.lds + MISC_OFF) + 8);
#define IN(k) (lo <= (k) && (k) < hi)
#define GRID_BAR(k) do { if (IN(k) && IN((k) + 1)) xcd_barrier(bar, F.wave); } while (0)
    unsigned char* ws = F.ws;
    float* const ssq_trash = (float*)(ws + WS_SSQ_T);
#define PHASE0(DRY) { p0_prologue(F); }
#define PHASE1(DRY) {     \
        pg8::Gemm g{(const char*)(ws + WS_XN), (const char*)(ws + WS_WIN), D_MODEL, D_MODEL * 2, 32, 128, D_MODEL * 2}; \
        pg8::StaticOrder S; S.init(M, IN_W, F.G, (int)blockIdx.x); \
        EpiIn E{(bf16_t*)(ws + WS_Q), (bf16_t*)(ws + WS_K), (bf16_t*)(ws + WS_V), (bf16_t*)(ws + WS_AG)}; \
        pg8::gemm_phase<EpiIn, pg8::StaticOrder, true>(F.lds, F.wave, g, S, E); \
        { const int nwg_ = (M / 256) * (IN_W / 256), maxu_ = (nwg_ + F.G - 1) / F.G, nheavy_ = nwg_ - (maxu_ - 1) * F.G, nlight_ = F.G - nheavy_, c_ = (int)blockIdx.x;     \
          if (nlight_ == 0) convert_late_weights(F, c_ * NWAVES + F.wave, F.G * NWAVES); \
          else if (c_ >= nheavy_) convert_late_weights(F, (c_ - nheavy_) * NWAVES + F.wave, nlight_ * NWAVES); } }
#define PHASE2(DRY) { \
        float* const sa_ = (DRY) ? ssq_trash : (float*)(ws + WS_SSQ_A); \
        for (int u = F.vcu; u < BATCH * 32 * NKVH; u += F.G) attn_unit<(PROBE_REP == 25 ? 2 : 1), (PROBE_REP == 26 ? 2 : 1)>(F, u >> 7, (u >> 2) & 31, u & 3, sa_); \
        if (F.vcu < 256) ssm_unit(F, F.vcu);     }
#define PHASE3(DRY) {     \
        pg8::Gemm g{(const char*)(ws + WS_YG), (const char*)(ws + WS_WGLU), SSM_W, 32, (unsigned)(M * 32), (unsigned)(4 * M * 32), SSM_W * 2}; \
        pg8::StaticOrder S; S.init(M, SSM_W, F.G, (int)blockIdx.x); \
        EpiGlu E{(const bf16_t*)(ws + WS_YG), (bf16_t*)(ws + WS_MIX), (DRY) ? ssq_trash : (float*)(ws + WS_SSQ_S)}; \
        pg8::gemm_phase<EpiGlu, pg8::StaticOrder, true>(F.lds, F.wave, g, S, E); }
#define PHASE4(DRY) {     \
        pg8::Gemm g{(const char*)(ws + WS_MIX), (const char*)(ws + WS_WOUT), 2048, 2048 * 2, 32, 128, 2048 * 2}; \
        pg8::StaticOrder S; S.init(M, D_MODEL, F.G, (int)blockIdx.x); \
        EpiOut E{F.in[0], (bf16_t*)(ws + WS_XN), (const float*)(ws + WS_SSQ_A), (const float*)(ws + WS_SSQ_S), (DRY) ? ssq_trash : (float*)(ws + WS_SSQ_X)}; \
        pg8::gemm_phase<EpiOut, pg8::StaticOrder, true>(F.lds, F.wave, g, S, E); }
#define PHASE5(DRY) {     \
        pg8::Gemm g{(const char*)(ws + WS_XN), (const char*)(ws + WS_WGU), D_MODEL, D_MODEL * 2, 32, 128, D_MODEL * 2}; \
        pg8::StaticOrder S; S.init(M, 2 * FF, F.G, (int)blockIdx.x); \
        EpiGU E{(const float*)(ws + WS_SSQ_X), (bf16_t*)(ws + WS_H)}; \
        pg8::gemm_phase<EpiGU, pg8::StaticOrder, true>(F.lds, F.wave, g, S, E); }
#define PHASE6(DRY) {     \
        pg8::Gemm g{(const char*)(ws + WS_H), (const char*)(ws + WS_WDN), FF, FF * 2, 32, 128, FF * 2}; \
        pg8::StaticOrder S; S.init(M, D_MODEL, F.G, (int)blockIdx.x); \
        EpiDown<(DRY)> E{(const bf16_t*)(ws + WS_XN), F.out, (float*)(ws + WS_SSCR)}; \
        pg8::gemm_phase<EpiDown<(DRY)>, pg8::StaticOrder, true>(F.lds, F.wave, g, S, E); }
#define PHASE2A(DRY) { for (int u = F.vcu; u < BATCH * 32 * NKVH; u += F.G) attn_unit(F, u >> 7, (u >> 2) & 31, u & 3, ssq_trash); }
#define PHASE2S(DRY) { if (F.vcu < 256) ssm_unit(F, F.vcu); }
#define RUN_PHASE(k, BODY) do { if (PROBE_REP == (k) && IN(k)) { BODY(1); xcd_barrier(bar, F.wave); } if (IN(k)) { BODY(0); } } while (0)
    RUN_PHASE(0, PHASE0);
    GRID_BAR(0);
    if (args.ph_lo < 0) cg::this_grid().sync();
    RUN_PHASE(1, PHASE1);
    GRID_BAR(1);
    if (PROBE_REP == 22 && IN(2)) { if (F.vcu < 256) ssm_unit<1>(F, F.vcu); xcd_barrier(bar, F.wave); }
    if (PROBE_REP == 23 && IN(2)) { if (F.vcu < 256) ssm_unit<2>(F, F.vcu); xcd_barrier(bar, F.wave); }
    if (PROBE_REP == 24 && IN(2)) { if (F.vcu < 256) ssm_unit<4>(F, F.vcu); xcd_barrier(bar, F.wave); }
    if (PROBE_REP == 20 && IN(2)) { PHASE2A(1); xcd_barrier(bar, F.wave); }
    if (PROBE_REP == 21 && IN(2)) { PHASE2S(1); xcd_barrier(bar, F.wave); }
    RUN_PHASE(2, PHASE2);
    GRID_BAR(2);
    RUN_PHASE(3, PHASE3);
    GRID_BAR(3);
    RUN_PHASE(4, PHASE4);
    GRID_BAR(4);
    RUN_PHASE(5, PHASE5);
    GRID_BAR(5);
    RUN_PHASE(6, PHASE6);
#undef IN
#undef GRID_BAR
}

extern "C" void kernel_launch(void* const* d_in, const int* in_sizes, int n_in, void* d_out, int out_size, void* d_ws, size_t ws_size, hipStream_t stream) {
    static int grid = 0;
    if (grid == 0) {
        if (n_in != 23 || in_sizes[0] != M * D_MODEL || out_size != M * D_MODEL || ws_size < WS_END) { fprintf(stderr, "kernel_launch: unexpected sizes (n_in %d, out %d, ws %zu); nothing launched\n", n_in, out_size, ws_size); grid = -1; return; }
        int dev = 0, cus = 0, per_cu = 0;
        if (hipGetDevice(&dev) != hipSuccess || hipDeviceGetAttribute(&cus, hipDeviceAttributeMultiprocessorCount, dev) != hipSuccess) { grid = -1; return; }
        if (hipFuncSetAttribute((const void*)hymba_fwd, hipFuncAttributeMaxDynamicSharedMemorySize, LDS_BYTES) != hipSuccess) { fprintf(stderr, "kernel_launch: hipFuncSetAttribute failed\n"); grid = -1; return; }
        if (hipOccupancyMaxActiveBlocksPerMultiprocessor(&per_cu, (const void*)hymba_fwd, NWAVES * 64, LDS_BYTES) != hipSuccess || per_cu < 1) { fprintf(stderr, "kernel_launch: occupancy query failed (%d)\n", per_cu); (void)hipGetLastError(); grid = -1; return; }
        grid = cus;
        if (grid < 256) { fprintf(stderr, "kernel_launch: this kernel needs >= 256 CUs (got %d); nothing launched\n", grid); grid = -1; return; }
    }
    if (grid < 0) return;
    (void)hipMemsetAsync((char*)d_ws + WS_CTL, 0, CTL_ZERO_BYTES, stream);
    Args a{};
    for (int i = 0; i < 23; ++i) a.in[i] = (const float*)d_in[i];
    a.out = (float*)d_out; a.ws = (unsigned char*)d_ws;
    constexpr int NPH = 7;
    for (int li = 0; li < MK_N_LAUNCHES; ++li) {
        a.ph_lo = (MK_N_LAUNCHES == 1) ? 0 : li; a.ph_hi = (MK_N_LAUNCHES == 1) ? NPH : li + 1;
        void* kargs[] = {&a};
        const hipError_t e = hipLaunchCooperativeKernel((const void*)hymba_fwd, dim3(grid), dim3(NWAVES * 64), kargs, LDS_BYTES, stream);
        if (e != hipSuccess) { fprintf(stderr, "kernel_launch: cooperative launch failed: %s (grid %d)\n", hipGetErrorString(e), grid); break; }
    }
}
```

```cpp
#include <hip/hip_runtime.h>
#include <hip/hip_cooperative_groups.h>
#include <cstdio>
#include <cstdint>
namespace cg = cooperative_groups;

#ifndef PROBE_REP
#define PROBE_REP -1
#endif
#ifndef MK_N_LAUNCHES
#define MK_N_LAUNCHES 1
#endif

#define LAS __attribute__((address_space(3)))
typedef unsigned short bf16_t;
typedef short bf16x8 __attribute__((ext_vector_type(8)));
typedef float f32x4 __attribute__((ext_vector_type(4)));
typedef float f32x2 __attribute__((ext_vector_type(2)));
typedef float f32x16 __attribute__((ext_vector_type(16)));
typedef unsigned u32x4 __attribute__((ext_vector_type(4)));
typedef unsigned u32x2 __attribute__((ext_vector_type(2)));

constexpr int D_MODEL = 2048, BATCH = 4, SEQ = 4096, M = BATCH * SEQ;
constexpr int HD = 64, NQH = 16, NKVH = 4, ATTN_W = 1024, KV_W = 256;
constexpr int SSM_W = 1024, SSM_P = 16, SSM_G = 64, SSM_N = 64, IN_W = 2560, FF = 5632;
constexpr int CH_T = 16;
constexpr int SSM_KA = CH_T * SSM_P + 2 * SSM_N;
constexpr float EPS = 1e-6f;
constexpr float LOG2E = 1.4426950408889634f;

__device__ const unsigned char kBucket[128] = {0, 1, 2, 3, 4, 5, 6, 7, 8, 9, 10, 11, 12, 13, 14, 15, 16, 16, 16, 17, 17, 18, 18, 18, 19, 19, 19, 20, 20, 20, 20, 21, 21, 21, 21, 22, 22, 22, 22, 22, 23, 23, 23, 23, 23, 23, 24, 24, 24, 24, 24, 24, 25, 25, 25, 25, 25, 25, 25, 26, 26, 26, 26, 26, 26, 26, 26, 27, 27, 27, 27, 27, 27, 27, 27, 27, 27, 28, 28, 28, 28, 28, 28, 28, 28, 28, 28, 29, 29, 29, 29, 29, 29, 29, 29, 29, 29, 29, 29, 30, 30, 30, 30, 30, 30, 30, 30, 30, 30, 30, 30, 30, 30, 31, 31, 31, 31, 31, 31, 31, 31, 31, 31, 31, 31, 31, 31, 31};

__device__ __forceinline__ unsigned cvt_pk_bf16(float lo, float hi) { unsigned r; asm volatile("v_cvt_pk_bf16_f32 %0, %1, %2" : "=v"(r) : "v"(lo), "v"(hi)); return r; }
__device__ __forceinline__ float bf_lo(unsigned w) { return __builtin_bit_cast(float, w << 16); }
__device__ __forceinline__ float bf_hi(unsigned w) { return __builtin_bit_cast(float, w & 0xffff0000u); }
__device__ __forceinline__ float fast_rcp(float x) { return __builtin_amdgcn_rcpf(x); }
__device__ __forceinline__ float fast_exp2(float x) { return __builtin_amdgcn_exp2f(x); }
__device__ __forceinline__ float sigmoidf_fast(float x) { return fast_rcp(1.0f + fast_exp2(-LOG2E * x)); }
__device__ __forceinline__ float gelu_tanh(float x) {
    const float u2 = 1.5957691216057308f * (x + 0.044715f * x * x * x);
    return x * sigmoidf_fast(u2);
}

__device__ __forceinline__ int lane_id() { int l = __builtin_amdgcn_mbcnt_hi(~0u, __builtin_amdgcn_mbcnt_lo(~0u, 0u)); asm volatile("" : "+v"(l)); return l; }

namespace pg8 {
constexpr int BM = 256, BK = 64, HALF = 128, HTB = HALF * BK * 2  , STAGE_BYTES = 8 * HTB, NXCD = 8, WGM = 8;
__host__ __device__ __forceinline__ int lds_byte(int r, int c) { const int st = (r >> 4) * 2 + (c >> 5), rr = r & 15, cc = c & 31, ob = rr * 64 + cc * 2; return st * 1024 + (ob ^ (((ob >> 9) & 1) << 5)); }
__host__ __device__ __forceinline__ void stage_rc(int b, int& R, int& C) { const int st = b / 1024, sb = b % 1024, swz = sb ^ (((sb >> 9) & 1) << 5); R = (st >> 1) * 16 + swz / 64; C = (st & 1) * 32 + (swz % 64) / 2; }
__host__ __device__ __forceinline__ int perm32(int rho) { const int n = rho >> 4, i = rho & 15; return 8 * (i >> 2) + 4 * n + (i & 3); }

struct Unit { int pm, pn; unsigned aofs, bofs; int part; };
struct Gemm { const char* A; const char* B; int K; unsigned a_rs, a_cs, a_ks, b_rs; };

struct StaticOrder {
    int nM, nN, nwg, G, c;
    __device__ void init(int Mr, int N, int G_, int c_) { nM = Mr / BM; nN = N / BM; nwg = nM * nN; G = G_; c = c_; }
    __device__ bool next(int i, Unit& u) const {
        const long L = (long)i * G + c; if (L >= nwg) return false;
        int wgid = (int)L; { const int q = nwg / NXCD, r = nwg % NXCD, xcd = wgid % NXCD, off = wgid / NXCD; wgid = (xcd < r ? xcd * (q + 1) : r * (q + 1) + (xcd - r) * q) + off; }
        const int nig = WGM * nN, gid = wgid / nig, fm = gid * WGM, gsz = (nM - fm) < WGM ? (nM - fm) : WGM;
        u.pm = fm + ((wgid % nig) % gsz); u.pn = (wgid % nig) / gsz; u.aofs = 0; u.bofs = 0; u.part = 0; return true;
    }
};
struct TwoPartOrder {
    StaticOrder S; unsigned kofs;
    __device__ bool next(int i, Unit& u) const { if (!S.next(i >> 1, u)) return false; u.part = i & 1; u.aofs = u.bofs = (i & 1) ? kofs : 0u; return true; }
};
struct OneUnit {
    int pm, pn;
    __device__ bool next(int i, Unit& u) const { if (i) return false; u.pm = pm; u.pn = pn; u.aofs = 0; u.bofs = 0; u.part = 0; return true; }
};

template <class Epi, class Sched, bool ALIGN_EPI>
__device__ __forceinline__ void gemm_phase(LAS unsigned char* lds, const int wid  , const Gemm g, const Sched& S, const Epi& E) {
    const int lane = lane_id(), tid = wid * 64 + lane, wr = wid >> 2, wc = wid & 3, fr = lane & 15, fq = lane >> 4;
    const int nt = g.K / BK;
    unsigned voffA[2], voffB[2];
#pragma unroll
    for (int i = 0; i < 2; ++i) { int R, C; stage_rc(tid * 16 + i * 8192, R, C); const int Rb = Epi::PERM ? ((R & ~31) + perm32(R & 31)) : R;
        voffA[i] = (unsigned)R * g.a_rs + (unsigned)(C >> 4) * g.a_cs + (unsigned)(C & 15) * 2u; voffB[i] = (unsigned)Rb * g.b_rs + (unsigned)C * 2u; }
    const size_t kstepA = g.a_ks, kstepB = (size_t)(BK * 2);
    const size_t hstepA = (size_t)HALF * g.a_rs, hstepB = (size_t)HALF * g.b_rs, tstepA = 2 * hstepA, tstepB = 2 * hstepB;
    const unsigned ldsw = (unsigned)wid * 1024u;
    const int aoff = lds_byte(wr * 64 + fr, fq * 8), boff = lds_byte(wc * 32 + fr, fq * 8);
#define PG8_SA(b, h) (((b) * 2 + (h)) * HTB)
#define PG8_SB(b, h) ((4 + (b) * 2 + (h)) * HTB)
#define PG8_STAGE(bufoff, gbase, voff) do { _Pragma("unroll") for (int _i = 0; _i < 2; ++_i) \
        __builtin_amdgcn_global_load_lds((const unsigned*)((const char*)(gbase) + (voff)[_i]), (LAS unsigned*)(lds + (bufoff) + ldsw + _i * 8192), 16, 0, 0); } while (0)
#define PG8_LDA(dst, b, h) do { _Pragma("unroll") for (int m = 0; m < 4; ++m) _Pragma("unroll") for (int k = 0; k < 2; ++k) dst[m][k] = *(const LAS bf16x8*)(lds + PG8_SA(b, h) + aoff + m * 2048 + k * 1024); } while (0)
#define PG8_LDB(dst, b, h) do { _Pragma("unroll") for (int n = 0; n < 2; ++n) _Pragma("unroll") for (int k = 0; k < 2; ++k) dst[n][k] = *(const LAS bf16x8*)(lds + PG8_SB(b, h) + boff + n * 2048 + k * 1024); } while (0)
#define PG8_MMA(ai, bj, At, Bt) do { __builtin_amdgcn_s_setprio(1); _Pragma("unroll") for (int m = 0; m < 4; ++m) _Pragma("unroll") for (int n = 0; n < 2; ++n) _Pragma("unroll") for (int k = 0; k < 2; ++k) \
        acc[ai][bj][m][n] = __builtin_amdgcn_mfma_f32_16x16x32_bf16(Bt[n][k], At[m][k], acc[ai][bj][m][n], 0, 0, 0); __builtin_amdgcn_s_setprio(0); } while (0)
#define PG8_WAIT_V(n) asm volatile("s_waitcnt vmcnt(" #n ")" ::: "memory")
#define PG8_WAIT_L(n) asm volatile("s_waitcnt lgkmcnt(" #n ")" ::: "memory")
#define PG8_BAR __builtin_amdgcn_s_barrier()
#define PG8_SCHED __builtin_amdgcn_sched_barrier(0)
    Unit cur, nxt; int ui = 0;
    if (!S.next(0, cur)) return;
    f32x4 acc[2][2][4][2];
#pragma unroll
    for (int a = 0; a < 2; ++a)
#pragma unroll
        for (int b = 0; b < 2; ++b)
#pragma unroll
            for (int m = 0; m < 4; ++m)
#pragma unroll
                for (int n = 0; n < 2; ++n) acc[a][b][m][n] = (f32x4){0.f, 0.f, 0.f, 0.f};
    bf16x8 At[4][2], B0[2][2], B1[2][2];
    const char* cA = g.A + (size_t)cur.pm * tstepA + cur.aofs; const char* cB = g.B + (size_t)cur.pn * tstepB + cur.bofs;
    PG8_STAGE(PG8_SB(0, 0), cB, voffB); PG8_STAGE(PG8_SB(0, 1), cB + hstepB, voffB); PG8_STAGE(PG8_SA(0, 0), cA, voffA); PG8_STAGE(PG8_SA(0, 1), cA + hstepA, voffA);
    if (wr == 1) PG8_BAR;
    PG8_WAIT_V(2); PG8_BAR;
    PG8_STAGE(PG8_SB(1, 0), cB + kstepB, voffB); PG8_STAGE(PG8_SA(1, 0), cA + kstepA, voffA); PG8_STAGE(PG8_SB(1, 1), cB + hstepB + kstepB, voffB);
    PG8_WAIT_V(6); PG8_BAR;
    for (;;) {
        const bool has_next = S.next(ui + 1, nxt);
        const char* nA = has_next ? g.A + (size_t)nxt.pm * tstepA + nxt.aofs : cA; const char* nB = has_next ? g.B + (size_t)nxt.pn * tstepB + nxt.bofs : cB;
        for (int t = 0; t < nt; t += 2) {
            if constexpr (Epi::MID_T > 0) { if (t == Epi::MID_T) E.mid(acc, cur, wr, wc, fr, fq); }
            const bool last = (t == nt - 2);
            const char* a1 = cA + (size_t)(t + 1) * kstepA;
            const char* a2 = last ? nA : cA + (size_t)(t + 2) * kstepA; const char* b2 = last ? nB : cB + (size_t)(t + 2) * kstepB;
            const char* a3 = a2 + kstepA; const char* b3 = b2 + kstepB;
            PG8_LDB(B0, 0, 0); PG8_LDB(B1, 0, 1); PG8_SCHED; PG8_LDA(At, 0, 0); PG8_STAGE(PG8_SA(1, 1), a1 + hstepA, voffA);
            PG8_WAIT_V(8); PG8_WAIT_L(0); PG8_BAR; PG8_MMA(0, 0, At, B0); PG8_MMA(0, 1, At, B1); PG8_BAR; PG8_SCHED;
            PG8_LDA(At, 0, 1); PG8_STAGE(PG8_SB(0, 0), b2, voffB); PG8_STAGE(PG8_SB(0, 1), b2 + hstepB, voffB); PG8_STAGE(PG8_SA(0, 0), a2, voffA);
            PG8_WAIT_V(8); PG8_WAIT_L(0); PG8_BAR; PG8_MMA(1, 0, At, B0); PG8_MMA(1, 1, At, B1); PG8_BAR; PG8_SCHED;
            PG8_LDB(B0, 1, 0); PG8_LDB(B1, 1, 1); PG8_SCHED; PG8_LDA(At, 1, 0); PG8_STAGE(PG8_SA(0, 1), a2 + hstepA, voffA);
            PG8_WAIT_V(8); PG8_WAIT_L(0); PG8_BAR; PG8_MMA(0, 0, At, B0); PG8_MMA(0, 1, At, B1); PG8_BAR; PG8_SCHED;
            PG8_LDA(At, 1, 1); PG8_STAGE(PG8_SB(1, 0), b3, voffB); PG8_STAGE(PG8_SB(1, 1), b3 + hstepB, voffB); PG8_STAGE(PG8_SA(1, 0), a3, voffA);
            PG8_WAIT_V(8); PG8_WAIT_L(0); PG8_BAR; PG8_MMA(1, 0, At, B0); PG8_MMA(1, 1, At, B1); PG8_BAR; PG8_SCHED;
        }
        if constexpr (ALIGN_EPI) { if (wr == 0) PG8_BAR; }
        if constexpr (!Epi::AFTER_DRAIN) E(acc, cur, wr, wc, fr, fq);
        if (!has_next) break;
#pragma unroll
        for (int a = 0; a < 2; ++a)
#pragma unroll
            for (int b = 0; b < 2; ++b)
#pragma unroll
                for (int m = 0; m < 4; ++m)
#pragma unroll
                    for (int n = 0; n < 2; ++n) acc[a][b][m][n] = (f32x4){0.f, 0.f, 0.f, 0.f};
        cur = nxt; cA = nA; cB = nB; ++ui;
        if constexpr (ALIGN_EPI) { if (wr == 1) PG8_BAR; }
    }
    PG8_WAIT_V(0);
    if constexpr (!ALIGN_EPI) { if (wr == 0) PG8_BAR; }
    PG8_BAR;
    if constexpr (Epi::AFTER_DRAIN) E.fused(acc, cur, wr, wc, fr, fq, lds);
#undef PG8_SA
#undef PG8_SB
#undef PG8_STAGE
#undef PG8_LDA
#undef PG8_LDB
#undef PG8_MMA
#undef PG8_WAIT_V
#undef PG8_WAIT_L
#undef PG8_BAR
#undef PG8_SCHED
}
}

constexpr size_t MiB = 1u << 20;
constexpr size_t WS_CTL = 0, CTL_ZERO_BYTES = 1 * MiB;
constexpr size_t WS_SSQ_A = 256 * 1024, WS_SSQ_S = 320 * 1024, WS_SSQ_X = 384 * 1024, WS_SSQ_T = 448 * 1024  ;
constexpr size_t WS_IRSTD1 = 512 * 1024;
constexpr size_t WS_WIN = 2 * MiB;
constexpr size_t WS_WGLU = 12 * MiB;
constexpr size_t WS_WOUT = 14 * MiB;
constexpr size_t WS_WGU = 22 * MiB;
constexpr size_t WS_WDN = 66 * MiB;
constexpr size_t WS_BG = 88 * MiB;
constexpr size_t WS_PG = 100 * MiB;
constexpr size_t WS_L16 = 108 * MiB;
constexpr size_t WS_SSCR = 109 * MiB;
constexpr size_t WS_XN = 141 * MiB;
constexpr size_t WS_Q = 205 * MiB;
constexpr size_t WS_K = 237 * MiB;
constexpr size_t WS_V = 245 * MiB;
constexpr size_t WS_AG = 253 * MiB;
constexpr size_t WS_YG = 301 * MiB;
constexpr size_t WS_MIX = 333 * MiB;
constexpr size_t WS_H = 205 * MiB;
constexpr size_t WS_END = 397 * MiB;
static_assert(WS_H + (size_t)M * FF * 2 <= WS_END, "ws map");

constexpr int RING_BYTES = 131072;
constexpr int LDS_BYTES = 147456;
constexpr int NWAVES = 8;
constexpr int LDSCTL_OFF = RING_BYTES, MISC_OFF = LDSCTL_OFF + 320;

struct Frame {
    LAS unsigned char* lds;
    int wave, vcu, G;
    const float* const* in; float* out; unsigned char* ws;
};

__device__ __forceinline__ float wave_sum(float v) {
#pragma unroll
    for (int o = 1; o < 64; o <<= 1) v += __shfl_xor(v, o);
    return v;
}
__device__ __forceinline__ unsigned f2bf(float f) { unsigned u = __builtin_bit_cast(unsigned, f); return (u + 0x7fffu + ((u >> 16) & 1u)) >> 16; }
__device__ __forceinline__ unsigned pk2(float lo, float hi) { return f2bf(lo) | (f2bf(hi) << 16); }

struct TItem { const float* W; bf16_t* WT; const float* gain; int K, N, rmul, radd, item; };
__device__ __forceinline__ void titem_load(const TItem& t, float (&v)[32], int lane) {
    const int nblk = t.N / 32, kb = t.item / nblk, nb = t.item % nblk, k0 = 64 * kb, n0 = 32 * nb;
    const float* p = t.W + (size_t)(k0 + (lane >> 5)) * t.N + n0 + (lane & 31);
#pragma unroll
    for (int i = 0; i < 32; ++i) v[i] = p[(size_t)(2 * i) * t.N];
}
__device__ __forceinline__ void titem_store(const TItem& t, const float (&v)[32], LAS float* scr, int lane) {
    const int nblk = t.N / 32, kb = t.item / nblk, nb = t.item % nblk, k0 = 64 * kb, n0 = 32 * nb;
#pragma unroll
    for (int i = 0; i < 32; ++i) scr[(2 * i + (lane >> 5)) * 33 + (lane & 31)] = v[i];
    asm volatile("s_waitcnt lgkmcnt(0)" ::: "memory");
    const int c = lane & 7;
    float gv[8];
#pragma unroll
    for (int i = 0; i < 8; ++i) gv[i] = t.gain ? t.gain[k0 + 8 * c + i] : 1.0f;
#pragma unroll
    for (int j = 0; j < 4; ++j) { const int n = (lane >> 3) + 8 * j; const LAS float* s = scr + (8 * c) * 33 + n; const int nn = n0 + n; const int row = (nn >> 7) * t.rmul + t.radd + (nn & 127);
        u32x4 o; o.x = pk2(s[0 * 33] * gv[0], s[1 * 33] * gv[1]); o.y = pk2(s[2 * 33] * gv[2], s[3 * 33] * gv[3]); o.z = pk2(s[4 * 33] * gv[4], s[5 * 33] * gv[5]); o.w = pk2(s[6 * 33] * gv[6], s[7 * 33] * gv[7]);
        *(u32x4*)(t.WT + (size_t)row * t.K + k0 + 8 * c) = o; }
    asm volatile("s_waitcnt lgkmcnt(0)" ::: "memory");
}
__device__ __forceinline__ void rms_row_load(const float* xrow, f32x4 (&v)[8], int lane) {
    const f32x4* xr = (const f32x4*)xrow + lane;
#pragma unroll
    for (int j = 0; j < 8; ++j) v[j] = xr[64 * j];
}
__device__ __forceinline__ void rms_row_store(const f32x4 (&v)[8], float* irstd, bf16_t* orow, int lane) {
    float s = 0.f;
#pragma unroll
    for (int j = 0; j < 8; ++j) s += (v[j].x * v[j].x + v[j].y * v[j].y) + (v[j].z * v[j].z + v[j].w * v[j].w);
    const float ms = wave_sum(s) * (1.0f / D_MODEL) + EPS; const float rstd = 1.0f / sqrtf(ms);
    if (lane == 0) *irstd = sqrtf(ms);
    u32x2* o8 = (u32x2*)orow + lane;
#pragma unroll
    for (int j = 0; j < 8; ++j) { u32x2 w; w.x = pk2(v[j].x * rstd, v[j].y * rstd); w.y = pk2(v[j].z * rstd, v[j].w * rstd); o8[64 * j] = w; }
}
__device__ __forceinline__ void p0_ssm_tables(Frame& F, int g, int qr) {
    LAS float* LP = (LAS float*)F.lds; LAS float* BB = LP + 17 * 64 * 2; LAS float* CC = BB + 64 * 16 * 2; LAS float* KT = CC + 16 * 64 * 2;
    const float* a_re = F.in[7]; const float* a_im = F.in[8]; const float* log_dt = F.in[9]; const float* b_re = F.in[10]; const float* b_im = F.in[11]; const float* c_re = F.in[12]; const float* c_im = F.in[13];
    const int tid = F.wave * 64 + lane_id();
    if (tid < 64) {
        const int n = tid;
        const double dt = exp((double)log_dt[g]);
        const double are = (double)a_re[g * 64 + n], aim = (double)a_im[g * 64 + n];
        const double mag = exp(are * dt), ang = aim * dt;
        const double lre = mag * cos(ang), lim = mag * sin(ang);
        const double nr = lre - 1.0, ni = lim, den = are * are + aim * aim;
        const double fre = (nr * are + ni * aim) / den, fim = (ni * are - nr * aim) / den;
        double pr = 1.0, pi = 0.0;
        for (int t = 0; t <= 16; ++t) { LP[(t * 64 + n) * 2] = (float)pr; LP[(t * 64 + n) * 2 + 1] = (float)pi; const double nre = pr * lre - pi * lim, nim = pr * lim + pi * lre; pr = nre; pi = nim; }
        if (qr == 0) { float* l16 = (float*)(F.ws + WS_L16) + (g * 64 + n) * 2; l16[0] = LP[(16 * 64 + n) * 2]; l16[1] = LP[(16 * 64 + n) * 2 + 1]; }
        for (int p = 0; p < 16; ++p) { const double br = (double)b_re[(g * 64 + n) * 16 + p], bi = (double)b_im[(g * 64 + n) * 16 + p];
            BB[(n * 16 + p) * 2] = (float)(fre * br - fim * bi); BB[(n * 16 + p) * 2 + 1] = (float)(fre * bi + fim * br); }
    }
    for (int e = tid; e < 1024; e += 512) { CC[e * 2] = c_re[g * 1024 + e]; CC[e * 2 + 1] = c_im[g * 1024 + e]; }
    __syncthreads();
    {
        const int p = (tid >> 4) & 15, q = tid & 15, th = tid >> 8; float ka[8];
#pragma unroll
        for (int j = 0; j < 8; ++j) ka[j] = 0.f;
        for (int n = 0; n < 64; ++n) {
            const f32x2 c = *(const LAS f32x2*)(CC + (p * 64 + n) * 2), bb = *(const LAS f32x2*)(BB + (n * 16 + q) * 2);
            const float cbr = c.x * bb.x - c.y * bb.y, cbi = c.x * bb.y + c.y * bb.x;
#pragma unroll
            for (int j = 0; j < 8; ++j) { const f32x2 l = *(const LAS f32x2*)(LP + ((8 * th + j) * 64 + n) * 2); ka[j] += cbr * l.x - cbi * l.y; }
        }
#pragma unroll
        for (int j = 0; j < 8; ++j) KT[((8 * th + j) * 16 + p) * 16 + q] = ka[j];
    }
    __syncthreads();
    bf16_t* Bg = (bf16_t*)(F.ws + WS_BG) + (size_t)g * 256 * SSM_KA;
    for (int ch = tid; ch < 64 * 48; ch += 512) {
        const int rl = ch / 48, c8 = ch % 48, t = 4 * qr + (rl >> 4), p = rl & 15; float v[8];
        if (c8 < 32) { const int s = c8 >> 1, q0 = (c8 & 1) * 8;
#pragma unroll
            for (int i = 0; i < 8; ++i) v[i] = (s <= t) ? KT[((t - s) * 16 + p) * 16 + q0 + i] : 0.f;
        } else { const int n0 = (c8 - 32) * 4;
#pragma unroll
            for (int i = 0; i < 4; ++i) { const int n = n0 + i; const float cr = CC[(p * 64 + n) * 2], ci = CC[(p * 64 + n) * 2 + 1], lr = LP[((t + 1) * 64 + n) * 2], li = LP[((t + 1) * 64 + n) * 2 + 1];
                v[2 * i] = cr * lr - ci * li; v[2 * i + 1] = -(cr * li + ci * lr); }
        }
        u32x4 o; o.x = pk2(v[0], v[1]); o.y = pk2(v[2], v[3]); o.z = pk2(v[4], v[5]); o.w = pk2(v[6], v[7]);
        *(u32x4*)(Bg + (size_t)(t * 16 + p) * SSM_KA + c8 * 8) = o;
    }
    bf16_t* Pg = (bf16_t*)(F.ws + WS_PG) + (size_t)g * 256 * 256;
    for (int ch = tid; ch < 32 * 32; ch += 512) {
        const int rl = ch >> 5, c8 = ch & 31, n = 16 * qr + (rl >> 1), ri = rl & 1, s = c8 >> 1, q0 = (c8 & 1) * 8; float v[8];
        const float lr = LP[((15 - s) * 64 + n) * 2], li = LP[((15 - s) * 64 + n) * 2 + 1];
#pragma unroll
        for (int i = 0; i < 8; ++i) { const float br = BB[(n * 16 + q0 + i) * 2], bi = BB[(n * 16 + q0 + i) * 2 + 1]; v[i] = ri ? (lr * bi + li * br) : (lr * br - li * bi); }
        u32x4 o; o.x = pk2(v[0], v[1]); o.y = pk2(v[2], v[3]); o.z = pk2(v[4], v[5]); o.w = pk2(v[6], v[7]);
        *(u32x4*)(Pg + (size_t)(2 * n + ri) * 256 + c8 * 8) = o;
        *(u32x4*)(Pg + (size_t)(128 + 32 * qr + rl) * 256 + c8 * 8) = (u32x4){0u, 0u, 0u, 0u};
    }
    __syncthreads();
}
__device__ __forceinline__ void p0_prologue(Frame& F) {
    for (int it = F.vcu; it < 256; it += F.G) p0_ssm_tables(F, it >> 2, it & 3);
    LAS float* scr = (LAS float*)(F.lds + F.wave * 16384);
    const int lane = lane_id();
    const int gw = F.vcu * NWAVES + F.wave, NGW = F.G * NWAVES;
    constexpr int I_IN = (D_MODEL / 64) * (IN_W / 32);
    {
        TItem t{F.in[3], (bf16_t*)(F.ws + WS_WIN), F.in[2]  , D_MODEL, IN_W, 128, 0, 0};
        float va[32], vb[32];
        int it = gw;
        if (it < I_IN) { t.item = it; titem_load(t, va, lane); }
        for (; it < I_IN; it += 2 * NGW) {
            TItem t2 = t; const bool h2 = it + NGW < I_IN;
            if (h2) { t2.item = it + NGW; titem_load(t2, vb, lane); }
            t.item = it; titem_store(t, va, scr, lane);
            if (h2) { if (it + 2 * NGW < I_IN) { t.item = it + 2 * NGW; titem_load(t, va, lane); } titem_store(t2, vb, scr, lane); }
        }
    }
    {
        bf16_t* xn = (bf16_t*)(F.ws + WS_XN); const float* x = F.in[0]; float* ir = (float*)(F.ws + WS_IRSTD1);
        f32x4 ra[8], rb[8];
        int m = gw;
        if (m < M) rms_row_load(x + (size_t)m * D_MODEL, ra, lane);
        for (; m < M; m += 2 * NGW) {
            const bool h2 = m + NGW < M;
            if (h2) rms_row_load(x + (size_t)(m + NGW) * D_MODEL, rb, lane);
            rms_row_store(ra, ir + m, xn + (size_t)m * D_MODEL, lane);
            if (h2) { if (m + 2 * NGW < M) rms_row_load(x + (size_t)(m + 2 * NGW) * D_MODEL, ra, lane); rms_row_store(rb, ir + m + NGW, xn + (size_t)(m + NGW) * D_MODEL, lane); }
        }
    }
}
__device__ __forceinline__ bool late_item(Frame& F, int r, TItem& t) {
    constexpr int I_GLU = (SSM_W / 64) * (SSM_W / 32), I_OUT = (2048 / 64) * (D_MODEL / 32), I_G = (D_MODEL / 64) * (FF / 32), I_D = (FF / 64) * (D_MODEL / 32);
    if (r >= I_GLU + I_OUT + 2 * I_G + I_D) return false;
    if (r < I_GLU) { t = TItem{F.in[15], (bf16_t*)(F.ws + WS_WGLU), nullptr, SSM_W, SSM_W, 128, 0, r}; return true; } r -= I_GLU;
    if (r < I_OUT) {
        const int kb = r / (D_MODEL / 32); t = TItem{F.in[18], (bf16_t*)(F.ws + WS_WOUT), (kb < 16) ? F.in[16] : (F.in[17] - 1024), 2048, D_MODEL, 128, 0, r}; return true; } r -= I_OUT;
    if (r < I_G) { t = TItem{F.in[20], (bf16_t*)(F.ws + WS_WGU), F.in[19], D_MODEL, FF, 256, 0, r}; return true; } r -= I_G;
    if (r < I_G) { t = TItem{F.in[21], (bf16_t*)(F.ws + WS_WGU), F.in[19], D_MODEL, FF, 256, 128, r}; return true; } r -= I_G;
    t = TItem{F.in[22], (bf16_t*)(F.ws + WS_WDN), nullptr, FF, D_MODEL, 128, 0, r}; return true;
}
__device__ __forceinline__ void convert_late_weights(Frame& F, int w, int nw) {
    LAS float* scr = (LAS float*)(F.lds + F.wave * 16384);
    const int lane = lane_id();
    TItem ta, tb; float va[32], vb[32];
    int it = w;
    bool ha = late_item(F, it, ta);
    if (ha) titem_load(ta, va, lane);
    while (ha) {
        const bool hb = late_item(F, it + nw, tb);
        if (hb) titem_load(tb, vb, lane);
        titem_store(ta, va, scr, lane);
        it += 2 * nw;
        ha = hb && late_item(F, it, ta);
        if (hb) { if (ha) titem_load(ta, va, lane); titem_store(tb, vb, scr, lane); }
    }
}

using pg8::Unit;
struct EpiIn {
    static constexpr bool PERM = true, AFTER_DRAIN = false; static constexpr int MID_T = 0;
    bf16_t* Q; bf16_t* Kb; bf16_t* Vb; bf16_t* Ag;
    __device__ __forceinline__ void operator()(const f32x4 (&acc)[2][2][4][2], const Unit& u, int wr, int wc, int fr, int fq) const {
        asm volatile("" : "+v"(fr), "+v"(fq));
        const int row0 = u.pm * 256 + wr * 64 + fr, pn = u.pn;
#pragma unroll
        for (int ai = 0; ai < 2; ++ai)
#pragma unroll
            for (int m = 0; m < 4; ++m) { const int row = row0 + ai * 128 + m * 16;
#pragma unroll
                for (int bj = 0; bj < 2; ++bj) { const int col = bj * 128 + wc * 32 + 8 * fq; const f32x4 v0 = acc[ai][bj][m][0], v1 = acc[ai][bj][m][1];
                    u32x4 w; w.x = cvt_pk_bf16(v0[0], v0[1]); w.y = cvt_pk_bf16(v0[2], v0[3]); w.z = cvt_pk_bf16(v1[0], v1[1]); w.w = cvt_pk_bf16(v1[2], v1[3]);
                    bf16_t* dst;
                    if (pn < 4) dst = Q + (size_t)row * ATTN_W + pn * 256 + col;
                    else if (pn == 4) dst = Kb + (size_t)row * KV_W + col;
                    else if (pn == 5) dst = Vb + (size_t)row * KV_W + col;
                    else { const int c = (pn - 6) * 256 + col; dst = Ag + ((size_t)(c >> 4) * 1024 + (row >> 4)) * SSM_KA + (row & 15) * 16 + (c & 15); }
                    *(u32x4*)dst = w; } }
    }
};
struct EpiS {
    static constexpr bool PERM = false, AFTER_DRAIN = true; static constexpr int MID_T = 0;
    __device__ __forceinline__ void operator()(const f32x4 (&acc)[2][2][4][2], const Unit& u, int wr, int wc, int fr, int fq) const {}
    __device__ __forceinline__ void fused(const f32x4 (&acc)[2][2][4][2], const Unit& u, int wr, int wc, int fr, int fq, LAS unsigned char* lds) const {
        asm volatile("" : "+v"(fr), "+v"(fq));
#pragma unroll
        for (int ai = 0; ai < 2; ++ai)
#pragma unroll
            for (int m = 0; m < 4; ++m) { const int r = ai * 128 + wr * 64 + m * 16 + fr;
#pragma unroll
                for (int n = 0; n < 2; ++n) *(LAS f32x4*)(lds + r * 512 + (((wc * 32 + n * 16 + 4 * fq) * 4) ^ ((r & 7) << 4))) = acc[ai][0][m][n]; }
    }
};
struct EpiY {
    static constexpr bool PERM = true, AFTER_DRAIN = false; static constexpr int MID_T = 0;
    const bf16_t* Ag; const float* dd; bf16_t* Yg;
    __device__ __forceinline__ void operator()(const f32x4 (&acc)[2][2][4][2], const Unit& u, int wr, int wc, int fr, int fq) const {
        asm volatile("" : "+v"(fr), "+v"(fq));
        const int g = u.pm >> 2; const int p0 = (8 * fq) & 15;
        const f32x4 d0 = *(const f32x4*)(dd + g * 16 + p0), d1 = *(const f32x4*)(dd + g * 16 + p0 + 4);
        const size_t grow0 = (size_t)u.pm * 256 + wr * 64 + fr; const int col0 = wc * 32 + 8 * fq;
        u32x4 uu[2][4][2];
#pragma unroll
        for (int ai = 0; ai < 2; ++ai)
#pragma unroll
            for (int m = 0; m < 4; ++m)
#pragma unroll
                for (int bj = 0; bj < 2; ++bj) uu[ai][m][bj] = *(const u32x4*)(Ag + (grow0 + ai * 128 + m * 16) * SSM_KA + bj * 128 + col0);
#pragma unroll
        for (int ai = 0; ai < 2; ++ai)
#pragma unroll
            for (int m = 0; m < 4; ++m) { const size_t grow = grow0 + ai * 128 + m * 16;
#pragma unroll
                for (int bj = 0; bj < 2; ++bj) { const u32x4 w_ = uu[ai][m][bj]; const f32x4 v0 = acc[ai][bj][m][0], v1 = acc[ai][bj][m][1];
                    const float y0 = gelu_tanh(v0[0] + d0[0] * bf_lo(w_.x)), y1 = gelu_tanh(v0[1] + d0[1] * bf_hi(w_.x)), y2 = gelu_tanh(v0[2] + d0[2] * bf_lo(w_.y)), y3 = gelu_tanh(v0[3] + d0[3] * bf_hi(w_.y));
                    const float y4 = gelu_tanh(v1[0] + d1[0] * bf_lo(w_.z)), y5 = gelu_tanh(v1[1] + d1[1] * bf_hi(w_.z)), y6 = gelu_tanh(v1[2] + d1[2] * bf_lo(w_.w)), y7 = gelu_tanh(v1[3] + d1[3] * bf_hi(w_.w));
                    u32x4 w; w.x = cvt_pk_bf16(y0, y1); w.y = cvt_pk_bf16(y2, y3); w.z = cvt_pk_bf16(y4, y5); w.w = cvt_pk_bf16(y6, y7);
                    *(u32x4*)(Yg + grow * 256 + bj * 128 + col0) = w; } }
    }
};
struct EpiGlu {
    static constexpr bool PERM = true, AFTER_DRAIN = false; static constexpr int MID_T = 0;
    const bf16_t* Yg; bf16_t* mixed; float* ssq;
    __device__ __forceinline__ void operator()(const f32x4 (&acc)[2][2][4][2], const Unit& u, int wr, int wc, int fr, int fq) const {
        asm volatile("" : "+v"(fr), "+v"(fq));
        const int row0 = u.pm * 256 + wr * 64 + fr, c0 = u.pn * 256 + wc * 32 + 8 * fq;
        u32x4 yy[2][4][2];
#pragma unroll
        for (int ai = 0; ai < 2; ++ai)
#pragma unroll
            for (int m = 0; m < 4; ++m)
#pragma unroll
                for (int bj = 0; bj < 2; ++bj) { const int c = c0 + bj * 128; yy[ai][m][bj] = *(const u32x4*)(Yg + ((size_t)(c >> 4) * M + row0 + ai * 128 + m * 16) * 16 + (c & 15)); }
#pragma unroll
        for (int ai = 0; ai < 2; ++ai)
#pragma unroll
            for (int m = 0; m < 4; ++m) { const int row = row0 + ai * 128 + m * 16; float sq = 0.f;
#pragma unroll
                for (int bj = 0; bj < 2; ++bj) { const int c = c0 + bj * 128; const u32x4 y_ = yy[ai][m][bj]; const f32x4 v0 = acc[ai][bj][m][0], v1 = acc[ai][bj][m][1];
                    const float s0 = bf_lo(y_.x) * sigmoidf_fast(v0[0]), s1 = bf_hi(y_.x) * sigmoidf_fast(v0[1]), s2 = bf_lo(y_.y) * sigmoidf_fast(v0[2]), s3 = bf_hi(y_.y) * sigmoidf_fast(v0[3]);
                    const float s4 = bf_lo(y_.z) * sigmoidf_fast(v1[0]), s5 = bf_hi(y_.z) * sigmoidf_fast(v1[1]), s6 = bf_lo(y_.w) * sigmoidf_fast(v1[2]), s7 = bf_hi(y_.w) * sigmoidf_fast(v1[3]);
                    sq += (s0 * s0 + s1 * s1) + (s2 * s2 + s3 * s3) + (s4 * s4 + s5 * s5) + (s6 * s6 + s7 * s7);
                    u32x4 w; w.x = cvt_pk_bf16(s0, s1); w.y = cvt_pk_bf16(s2, s3); w.z = cvt_pk_bf16(s4, s5); w.w = cvt_pk_bf16(s6, s7);
                    *(u32x4*)(mixed + (size_t)row * 2048 + 1024 + c) = w; }
                sq += __shfl_xor(sq, 16); sq += __shfl_xor(sq, 32);
                if (fq == 0) atomicAdd(ssq + row, sq); }
    }
};
struct EpiOut {
    static constexpr bool PERM = true, AFTER_DRAIN = false; static constexpr int MID_T = 16;
    const bf16_t* xn; const float* irstd1; bf16_t* x1b; const float* ssq_a; const float* ssq_s; float* ssq_x;
    __device__ __forceinline__ void mid(f32x4 (&acc)[2][2][4][2], const Unit& u, int wr, int wc, int fr, int fq) const {
        asm volatile("" : "+v"(fr), "+v"(fq));
#pragma unroll
        for (int ai = 0; ai < 2; ++ai)
#pragma unroll
            for (int m = 0; m < 4; ++m) { const int row = u.pm * 256 + ai * 128 + wr * 64 + m * 16 + fr;
                const float f = sqrtf((ssq_s[row] * (1.0f / 1024.0f) + EPS) / (ssq_a[row] * (1.0f / 1024.0f) + EPS));
#pragma unroll
                for (int bj = 0; bj < 2; ++bj)
#pragma unroll
                    for (int n = 0; n < 2; ++n) acc[ai][bj][m][n] *= f; }
    }
    __device__ __forceinline__ void operator()(const f32x4 (&acc)[2][2][4][2], const Unit& u, int wr, int wc, int fr, int fq) const {
        asm volatile("" : "+v"(fr), "+v"(fq));
        const int row0 = u.pm * 256 + wr * 64 + fr; const size_t cofs = (size_t)u.pn * 256 + wc * 32 + 8 * fq;
#pragma unroll
        for (int ai = 0; ai < 2; ++ai) {
            float sv[4], iv[4]; u32x4 xb[4][2];
#pragma unroll
            for (int m = 0; m < 4; ++m) { const int row = row0 + ai * 128 + m * 16; sv[m] = ssq_s[row]; iv[m] = irstd1[row];
#pragma unroll
                for (int bj = 0; bj < 2; ++bj) xb[m][bj] = *(const u32x4*)(xn + (size_t)row * D_MODEL + cofs + bj * 128); }
#pragma unroll
            for (int m = 0; m < 4; ++m) { const int row = row0 + ai * 128 + m * 16; const float rstd = 1.0f / sqrtf(sv[m] * (1.0f / 1024.0f) + EPS), ir = iv[m]; float sq = 0.f;
#pragma unroll
                for (int bj = 0; bj < 2; ++bj) { const size_t off = (size_t)row * D_MODEL + cofs + bj * 128; const u32x4 x_ = xb[m][bj];
                    const f32x4 b0 = {bf_lo(x_.x), bf_hi(x_.x), bf_lo(x_.y), bf_hi(x_.y)}, b1 = {bf_lo(x_.z), bf_hi(x_.z), bf_lo(x_.w), bf_hi(x_.w)};
                    const f32x4 o0 = b0 * ir + acc[ai][bj][m][0] * rstd, o1 = b1 * ir + acc[ai][bj][m][1] * rstd;
                    sq += (o0[0] * o0[0] + o0[1] * o0[1]) + (o0[2] * o0[2] + o0[3] * o0[3]) + (o1[0] * o1[0] + o1[1] * o1[1]) + (o1[2] * o1[2] + o1[3] * o1[3]);
                    u32x4 w; w.x = cvt_pk_bf16(o0[0], o0[1]); w.y = cvt_pk_bf16(o0[2], o0[3]); w.z = cvt_pk_bf16(o1[0], o1[1]); w.w = cvt_pk_bf16(o1[2], o1[3]);
                    *(u32x4*)(x1b + off) = w; }
                sq += __shfl_xor(sq, 16); sq += __shfl_xor(sq, 32); if (fq == 0) atomicAdd(ssq_x + row, sq); }
        }
    }
};
struct EpiGU {
    static constexpr bool PERM = true, AFTER_DRAIN = false; static constexpr int MID_T = 0;
    const float* ssq_x; bf16_t* H;
    __device__ __forceinline__ void operator()(const f32x4 (&acc)[2][2][4][2], const Unit& u, int wr, int wc, int fr, int fq) const {
        asm volatile("" : "+v"(fr), "+v"(fq));
        const int row0 = u.pm * 256 + wr * 64 + fr;
        float sv[2][4];
#pragma unroll
        for (int ai = 0; ai < 2; ++ai)
#pragma unroll
            for (int m = 0; m < 4; ++m) sv[ai][m] = ssq_x[row0 + ai * 128 + m * 16];
#pragma unroll
        for (int ai = 0; ai < 2; ++ai)
#pragma unroll
            for (int m = 0; m < 4; ++m) { const int row = row0 + ai * 128 + m * 16; const float rstd = 1.0f / sqrtf(sv[ai][m] * (1.0f / 2048.0f) + EPS);
                float h[8];
#pragma unroll
                for (int n = 0; n < 2; ++n)
#pragma unroll
                    for (int i = 0; i < 4; ++i) { const float gv = acc[ai][0][m][n][i] * rstd, uv = acc[ai][1][m][n][i] * rstd; h[4 * n + i] = gv * sigmoidf_fast(gv) * uv; }
                u32x4 w; w.x = cvt_pk_bf16(h[0], h[1]); w.y = cvt_pk_bf16(h[2], h[3]); w.z = cvt_pk_bf16(h[4], h[5]); w.w = cvt_pk_bf16(h[6], h[7]);
                *(u32x4*)(H + (size_t)row * FF + u.pn * 128 + wc * 32 + 8 * fq) = w; }
    }
};
template <bool DRY> struct EpiDown {
    static constexpr bool PERM = true, AFTER_DRAIN = false; static constexpr int MID_T = 0;
    const bf16_t* x1b; float* out; float* trash;
    __device__ __forceinline__ void operator()(const f32x4 (&acc)[2][2][4][2], const Unit& u, int wr, int wc, int fr, int fq) const {
        asm volatile("" : "+v"(fr), "+v"(fq));
        const int row0 = u.pm * 256 + wr * 64 + fr; const size_t cofs = (size_t)u.pn * 256 + wc * 32 + 8 * fq;
        u32x4 xb[2][4][2];
#pragma unroll
        for (int ai = 0; ai < 2; ++ai)
#pragma unroll
            for (int m = 0; m < 4; ++m)
#pragma unroll
                for (int bj = 0; bj < 2; ++bj) xb[ai][m][bj] = *(const u32x4*)(x1b + (size_t)(row0 + ai * 128 + m * 16) * D_MODEL + cofs + bj * 128);
#pragma unroll
        for (int ai = 0; ai < 2; ++ai)
#pragma unroll
            for (int m = 0; m < 4; ++m) { const int row = row0 + ai * 128 + m * 16;
#pragma unroll
                for (int bj = 0; bj < 2; ++bj) { const size_t off = (size_t)row * D_MODEL + cofs + bj * 128; const u32x4 x_ = xb[ai][m][bj];
                    const f32x4 b0 = {bf_lo(x_.x), bf_hi(x_.x), bf_lo(x_.y), bf_hi(x_.y)}, b1 = {bf_lo(x_.z), bf_hi(x_.z), bf_lo(x_.w), bf_hi(x_.w)};
                    float* q = DRY ? trash + (off & ((8u << 20) - 1)) : out + off;
                    *(f32x4*)q = b0 + acc[ai][bj][m][0]; *(f32x4*)(q + 4) = b1 + acc[ai][bj][m][1]; } }
    }
};

constexpr int ATT_KROW = 144, ATT_VROW = 520, ATT_K_OFF = 0, ATT_V_OFF = 256 * ATT_KROW, ATT_B_OFF = ATT_V_OFF + 64 * ATT_VROW;
constexpr int ATT_TAB = 192;
static_assert(ATT_B_OFF + 4 * ATT_TAB * 4 <= RING_BYTES, "attention LDS");
template <int STG_REPS = 1, int TASK_REPS = 1>
__device__ __forceinline__ void attn_unit(Frame& F, int b, int qb, int kvh, float* ssq_real) {
    LAS unsigned char* lds = F.lds;
    const int lane = lane_id(), wave = F.wave, tid = wave * 64 + lane;
    const bf16_t* Q = (const bf16_t*)(F.ws + WS_Q); const bf16_t* Kb = (const bf16_t*)(F.ws + WS_K); const bf16_t* Vb = (const bf16_t*)(F.ws + WS_V);
    bf16_t* mixed = (bf16_t*)(F.ws + WS_MIX);
    const int T0 = b * SEQ + qb * 128;
    const int q = lane & 31, hh = lane >> 5;
    u32x4 qraw[2][4];
#pragma unroll
    for (int it = 0; it < 2; ++it) { const int task = wave + 8 * it; const bf16_t* qp = Q + (size_t)(T0 + 32 * (task & 3) + q) * ATTN_W + (kvh * 4 + (task >> 2)) * 64 + hh * 8;
#pragma unroll
        for (int ks = 0; ks < 4; ++ks) qraw[it][ks] = *(const u32x4*)(qp + 16 * ks); }
    for (int srep = 0; srep < STG_REPS; ++srep)
    {
        const int key = tid & 255; const bool valid = (qb > 0) || (key >= 128);
        const size_t tok = (size_t)(T0 - 128 + key);
        u32x4 c[8];
        const bf16_t* src = ((tid < 256) ? Kb : Vb) + tok * KV_W + kvh * 64;
#pragma unroll
        for (int i = 0; i < 8; ++i) c[i] = valid ? *(const u32x4*)(src + 8 * i) : (u32x4){0u, 0u, 0u, 0u};
        if (tid < 256) {
            float ss = 0.f;
#pragma unroll
            for (int i = 0; i < 8; ++i) { const float a0 = bf_lo(c[i].x), a1 = bf_hi(c[i].x), a2 = bf_lo(c[i].y), a3 = bf_hi(c[i].y), a4 = bf_lo(c[i].z), a5 = bf_hi(c[i].z), a6 = bf_lo(c[i].w), a7 = bf_hi(c[i].w);
                ss += (a0 * a0 + a1 * a1) + (a2 * a2 + a3 * a3) + (a4 * a4 + a5 * a5) + (a6 * a6 + a7 * a7); }
            const float rstd = 1.0f / sqrtf(ss * (1.0f / 64.0f) + EPS);
            const float* kg = F.in[5];
#pragma unroll
            for (int i = 0; i < 8; ++i) { const f32x4 g0 = *(const f32x4*)(kg + 8 * i), g1 = *(const f32x4*)(kg + 8 * i + 4);
                u32x4 w; w.x = cvt_pk_bf16(bf_lo(c[i].x) * rstd * g0[0], bf_hi(c[i].x) * rstd * g0[1]); w.y = cvt_pk_bf16(bf_lo(c[i].y) * rstd * g0[2], bf_hi(c[i].y) * rstd * g0[3]);
                w.z = cvt_pk_bf16(bf_lo(c[i].z) * rstd * g1[0], bf_hi(c[i].z) * rstd * g1[1]); w.w = cvt_pk_bf16(bf_lo(c[i].w) * rstd * g1[2], bf_hi(c[i].w) * rstd * g1[3]);
                *(LAS u32x4*)(lds + ATT_K_OFF + key * ATT_KROW + i * 16) = w; }
        } else {
#pragma unroll
            for (int i = 0; i < 8; ++i) { const unsigned w4[4] = {c[i].x, c[i].y, c[i].z, c[i].w};
#pragma unroll
                for (int j = 0; j < 4; ++j) { *(LAS unsigned short*)(lds + ATT_V_OFF + (8 * i + 2 * j) * ATT_VROW + key * 2) = (unsigned short)(w4[j] & 0xffffu);
                    *(LAS unsigned short*)(lds + ATT_V_OFF + (8 * i + 2 * j + 1) * ATT_VROW + key * 2) = (unsigned short)(w4[j] >> 16); } }
        }
        for (int e = tid; e < 4 * ATT_TAB; e += NWAVES * 64) { const int hl = e / ATT_TAB, dist = e % ATT_TAB - 32;
            ((LAS float*)(lds + ATT_B_OFF))[e] = ((unsigned)dist < 128u) ? F.in[1][(int)kBucket[dist & 127] * NQH + kvh * 4 + hl] * LOG2E : -INFINITY; }
    }
    bf16x8 qf2[2][4];
    { const float* qg = F.in[4]; f32x4 gq[4][2];
#pragma unroll
      for (int ks = 0; ks < 4; ++ks) { gq[ks][0] = *(const f32x4*)(qg + 16 * ks + 8 * hh); gq[ks][1] = *(const f32x4*)(qg + 16 * ks + 8 * hh + 4); }
#pragma unroll
      for (int it = 0; it < 2; ++it) { float ss = 0.f;
#pragma unroll
        for (int ks = 0; ks < 4; ++ks) { const u32x4 w_ = qraw[it][ks];
            const float a0 = bf_lo(w_.x), a1 = bf_hi(w_.x), a2 = bf_lo(w_.y), a3 = bf_hi(w_.y), a4 = bf_lo(w_.z), a5 = bf_hi(w_.z), a6 = bf_lo(w_.w), a7 = bf_hi(w_.w);
            ss += (a0 * a0 + a1 * a1) + (a2 * a2 + a3 * a3) + (a4 * a4 + a5 * a5) + (a6 * a6 + a7 * a7); }
        ss += __shfl_xor(ss, 32);
        const float sc = (1.0f / sqrtf(ss * (1.0f / 64.0f) + EPS)) * (0.125f * LOG2E);
#pragma unroll
        for (int ks = 0; ks < 4; ++ks) { const u32x4 w_ = qraw[it][ks]; const f32x4 g0 = gq[ks][0], g1 = gq[ks][1];
            u32x4 w; w.x = cvt_pk_bf16(bf_lo(w_.x) * sc * g0[0], bf_hi(w_.x) * sc * g0[1]); w.y = cvt_pk_bf16(bf_lo(w_.y) * sc * g0[2], bf_hi(w_.y) * sc * g0[3]);
            w.z = cvt_pk_bf16(bf_lo(w_.z) * sc * g1[0], bf_hi(w_.z) * sc * g1[1]); w.w = cvt_pk_bf16(bf_lo(w_.w) * sc * g1[2], bf_hi(w_.w) * sc * g1[3]);
            qf2[it][ks] = __builtin_bit_cast(bf16x8, w); } } }
    __syncthreads();
    for (int trep = 0; trep < TASK_REPS; ++trep)
#pragma unroll
    for (int it = 0; it < 2; ++it) {
        float* ssq_a = (trep == TASK_REPS - 1) ? ssq_real : (float*)(F.ws + WS_SSQ_T);
        const int task = wave + 8 * it, hl = task >> 2, grp = task & 3, hq = kvh * 4 + hl, qi = 32 * grp + q;
        const bf16x8 (&qf)[4] = qf2[it];
        const LAS float* tb = (const LAS float*)(lds + ATT_B_OFF) + hl * ATT_TAB + (q + 128 - 4 * hh + 32 - 155);
        const float sink2 = F.in[6][hq] * LOG2E;
        f32x16 s[5];
#pragma unroll
        for (int kt = 0; kt < 5; ++kt) {
            f32x16 a;
#pragma unroll
            for (int r = 0; r < 16; ++r) a[r] = tb[155 - 32 * kt - ((r & 3) + 8 * (r >> 2))];
#pragma unroll
            for (int ks = 0; ks < 4; ++ks) { const bf16x8 kf = *(const LAS bf16x8*)(lds + ATT_K_OFF + (32 * (grp + kt) + q) * ATT_KROW + (16 * ks + 8 * hh) * 2);
                a = __builtin_amdgcn_mfma_f32_32x32x16_bf16(kf, qf[ks], a, 0, 0, 0); }
            if (qb == 0 && grp + kt < 4) {
#pragma unroll
                for (int r = 0; r < 16; ++r) a[r] = -INFINITY; }
            s[kt] = a;
        }
        float mx = sink2;
#pragma unroll
        for (int kt = 0; kt < 5; ++kt)
#pragma unroll
            for (int r = 0; r < 16; ++r) mx = fmaxf(mx, s[kt][r]);
        mx = fmaxf(mx, __shfl_xor(mx, 32));
        float l = 0.f;
#pragma unroll
        for (int kt = 0; kt < 5; ++kt)
#pragma unroll
            for (int r = 0; r < 16; ++r) { const float p = fast_exp2(s[kt][r] - mx); s[kt][r] = p; l += p; }
        l += __shfl_xor(l, 32);
        l += fast_exp2(sink2 - mx);
        f32x16 o[2]; o[0] = (f32x16){}; o[1] = (f32x16){};
#pragma unroll
        for (int kt = 0; kt < 5; ++kt)
#pragma unroll
            for (int s2 = 0; s2 < 2; ++s2) {
                u32x4 pw; pw.x = cvt_pk_bf16(s[kt][8 * s2 + 0], s[kt][8 * s2 + 1]); pw.y = cvt_pk_bf16(s[kt][8 * s2 + 2], s[kt][8 * s2 + 3]); pw.z = cvt_pk_bf16(s[kt][8 * s2 + 4], s[kt][8 * s2 + 5]); pw.w = cvt_pk_bf16(s[kt][8 * s2 + 6], s[kt][8 * s2 + 7]);
                const bf16x8 pb = __builtin_bit_cast(bf16x8, pw);
#pragma unroll
                for (int d0 = 0; d0 < 2; ++d0) { const LAS unsigned char* vp = lds + ATT_V_OFF + (32 * d0 + q) * ATT_VROW + (32 * (grp + kt) + 16 * s2 + 4 * hh) * 2;
                    const u32x2 lo = *(const LAS u32x2*)vp, hi = *(const LAS u32x2*)(vp + 16);
                    const u32x4 vv = {lo.x, lo.y, hi.x, hi.y};
                    o[d0] = __builtin_amdgcn_mfma_f32_32x32x16_bf16(__builtin_bit_cast(bf16x8, vv), pb, o[d0], 0, 0, 0); }
            }
        const float inv = 1.0f / l; float sq = 0.f;
        bf16_t* op = mixed + (size_t)(T0 + qi) * 2048 + hq * 64 + 4 * hh;
#pragma unroll
        for (int d0 = 0; d0 < 2; ++d0)
#pragma unroll
            for (int r4 = 0; r4 < 4; ++r4) { const float v0 = o[d0][4 * r4] * inv, v1 = o[d0][4 * r4 + 1] * inv, v2 = o[d0][4 * r4 + 2] * inv, v3 = o[d0][4 * r4 + 3] * inv;
                sq += (v0 * v0 + v1 * v1) + (v2 * v2 + v3 * v3);
                u32x2 w; w.x = cvt_pk_bf16(v0, v1); w.y = cvt_pk_bf16(v2, v3); *(u32x2*)(op + 32 * d0 + 8 * r4) = w; }
        sq += __shfl_xor(sq, 32);
        if (hh == 0) atomicAdd(ssq_a + T0 + qi, sq);
    }
    __syncthreads();
}

template <int MODE = 7>
__device__ __forceinline__ void ssm_unit(Frame& F, int pm) {
    const int g = pm >> 2;
    bf16_t* Ag = (bf16_t*)(F.ws + WS_AG);
    if constexpr (MODE & 1) {
        int Kc = 256; asm volatile("" : "+s"(Kc));
        pg8::Gemm gm{(const char*)Ag, (const char*)(F.ws + WS_PG), Kc, SSM_KA * 2, 32, 128, 256 * 2};
        pg8::OneUnit S1{pm, g}; EpiS E{};
        pg8::gemm_phase<EpiS, pg8::OneUnit, false>(F.lds, F.wave, gm, S1, E);
    }
    asm volatile("s_waitcnt lgkmcnt(0)" ::: "memory");
    __syncthreads();
    if ((MODE & 2) && F.wave == 0) {
        const int n = lane_id();
        const f32x2 l16 = *((const f32x2*)(F.ws + WS_L16) + g * 64 + n);
        float hr = 0.f, hi = 0.f;
        unsigned* hp = (unsigned*)(Ag + (size_t)pm * 256 * SSM_KA + 256) + n;
        for (int c0 = 0; c0 < 256; c0 += 8) {
            f32x2 sv[8];
#pragma unroll
            for (int j = 0; j < 8; ++j) sv[j] = *(const LAS f32x2*)(F.lds + (c0 + j) * 512 + ((8 * n) ^ (j << 4)));
#pragma unroll
            for (int j = 0; j < 8; ++j) { hp[(size_t)(c0 + j) * (SSM_KA / 2)] = cvt_pk_bf16(hr, hi);
                const float nr = l16.x * hr - l16.y * hi + sv[j].x, ni = l16.x * hi + l16.y * hr + sv[j].y; hr = nr; hi = ni; }
        }
    }
    asm volatile("s_waitcnt vmcnt(0) lgkmcnt(0)" ::: "memory");
    __syncthreads();
    if constexpr (MODE & 4) {
        int Kc = SSM_KA; asm volatile("" : "+s"(Kc));
        pg8::Gemm gm{(const char*)Ag, (const char*)(F.ws + WS_BG), Kc, SSM_KA * 2, 32, 128, SSM_KA * 2};
        pg8::OneUnit S1{pm, g}; EpiY E{Ag, F.in[14], (bf16_t*)(F.ws + WS_YG)};
        pg8::gemm_phase<EpiY, pg8::OneUnit, false>(F.lds, F.wave, gm, S1, E);
    }
}


#define XB_TMO      128
#define XB_XCNT(j)  (256  + 64 * (j))
#define XB_XSUB(j)  (1280 + 64 * (j))
#define XB_XGEN(j)  (2304 + 64 * (j))
#define XB_TOP      3328
#define XB_TOPGEN   3392
#define XCD_BAR_WORDS 3456
#define XB_SPIN_CAP (1u << 22)
constexpr size_t WS_BAR = 16384;
__device__ __forceinline__ unsigned xb_ld(unsigned* p)              { return __hip_atomic_load(p, __ATOMIC_RELAXED, __HIP_MEMORY_SCOPE_AGENT); }
__device__ __forceinline__ unsigned xb_add(unsigned* p, unsigned v) { return __hip_atomic_fetch_add(p, v, __ATOMIC_RELAXED, __HIP_MEMORY_SCOPE_AGENT); }
__device__ __forceinline__ unsigned xb_xcc_id() { return (unsigned)__builtin_amdgcn_s_getreg((3 << 11) | 20) & 0xFu; }
#define XB_SPIN(cond, bar) do { unsigned _sp = 0; while (cond) { __builtin_amdgcn_s_sleep(1); \
    if ((++_sp & 255u) == 0u) { if (xb_ld(&(bar)[XB_TMO])) break; if (_sp > XB_SPIN_CAP) { atomicAdd(&(bar)[XB_TMO], 1u); break; } } } } while (0)
struct XcdBarrier { unsigned* bar; unsigned x; volatile LAS unsigned* st; };
__device__ __forceinline__ XcdBarrier xcd_barrier_post(unsigned* bar, volatile LAS unsigned* st) {
    XcdBarrier b; b.bar = bar; b.x = xb_xcc_id(); b.st = st;
    if (threadIdx.x == 0) (void)xb_add(&bar[XB_XCNT(b.x)], 1u);
    return b;
}
__device__ __forceinline__ void xcd_barrier_complete(unsigned* bar, unsigned x, unsigned& nloc, unsigned& nx) {
    const unsigned G = gridDim.x * gridDim.y * gridDim.z;
    unsigned sum, cnt, mine, sp = 0u;
    for (;;) {
        sum = 0u; cnt = 0u; mine = 0u;
#pragma unroll
        for (unsigned j = 0; j < 16; ++j) { const unsigned c = xb_ld(&bar[XB_XCNT(j)]); sum += c; cnt += (c > 0u) ? 1u : 0u; mine = (j == x) ? c : mine; }
        if (sum == G) break;
        __builtin_amdgcn_s_sleep(1);
        if ((++sp & 255u) == 0u) { if (xb_ld(&bar[XB_TMO])) break; if (sp > XB_SPIN_CAP) { atomicAdd(&bar[XB_TMO], 1u); break; } }
    }
    nloc = mine > 0u ? mine : 1u; nx = cnt > 0u ? cnt : 1u;
}
__device__ __forceinline__ void xcd_barrier(const XcdBarrier& b, int wave) {
    asm volatile("s_waitcnt vmcnt(0)" ::: "memory");
    __syncthreads();
    if (wave == 0 && lane_id() == 0) {
        unsigned* bar = b.bar;
        __builtin_amdgcn_s_waitcnt(0);
        unsigned nloc = b.st[0], nx = b.st[1];
        if (nloc == 0u) { xcd_barrier_complete(bar, b.x, nloc, nx); b.st[0] = nloc; b.st[1] = nx; }
        const unsigned old = xb_add(&bar[XB_XSUB(b.x)], 1u);
        const unsigned gen = old / nloc;
        if (old + 1u == (gen + 1u) * nloc) {
            __builtin_amdgcn_fence(__ATOMIC_RELEASE, "agent");
            asm volatile("s_waitcnt vmcnt(0)" ::: "memory");
            const unsigned og = xb_add(&bar[XB_TOP], 1u);
            const unsigned tg = og / nx;
            if (og + 1u == (tg + 1u) * nx) xb_add(&bar[XB_TOPGEN], 1u);
            else XB_SPIN(xb_ld(&bar[XB_TOPGEN]) == tg, bar);
            __builtin_amdgcn_fence(__ATOMIC_ACQUIRE, "agent");
            xb_add(&bar[XB_XGEN(b.x)], 1u);
            asm volatile("s_waitcnt vmcnt(0)" ::: "memory");
        } else {
            XB_SPIN(xb_ld(&bar[XB_XGEN(b.x)]) == gen, bar);
            __builtin_amdgcn_fence(__ATOMIC_ACQUIRE, "agent");
            asm volatile("s_waitcnt vmcnt(0)" ::: "memory");
        }
    }
    __syncthreads();
}

struct Args { const float* in[23]; float* out; unsigned char* ws; int ph_lo, ph_hi; };
__global__ void __launch_bounds__(NWAVES * 64, 2) hymba_fwd(Args args) {
    extern __shared__ __attribute__((aligned(16))) unsigned char lds_raw[];
    Frame F;
    F.lds = (LAS unsigned char*)lds_raw;
    F.wave = __builtin_amdgcn_readfirstlane((int)threadIdx.x >> 6);
    F.G = gridDim.x; { const int bx = blockIdx.x; F.vcu = (F.G % 8 == 0) ? (bx % 8) * (F.G / 8) + bx / 8 : bx; }
    F.in = args.in; F.out = args.out; F.ws = args.ws;
    const int lo = args.ph_lo, hi = args.ph_hi;
    for (int u = threadIdx.x; u < (LDS_BYTES - LDSCTL_OFF) / 4; u += NWAVES * 64) ((LAS unsigned*)(F.lds + LDSCTL_OFF))[u] = 0u;
    __syncthreads();
    XcdBarrier bar; bar.bar = (unsigned*)(F.ws + WS_BAR); bar.x = 0; bar.st = nullptr;
    if (MK_N_LAUNCHES == 1) bar = xcd_barrier_post((unsigned*)(F.ws + WS_BAR), (volatile LAS unsigned*)(F.lds + MISC_OFF) + 8);
#define IN(k) (lo <= (k) && (k) < hi)
#define GRID_BAR(k) do { if (IN(k) && IN((k) + 1)) xcd_barrier(bar, F.wave); } while (0)
    unsigned char* ws = F.ws;
    float* const ssq_trash = (float*)(ws + WS_SSQ_T);
#define PHASE0(DRY) { p0_prologue(F); }
#define PHASE1(DRY) {     \
        pg8::Gemm g{(const char*)(ws + WS_XN), (const char*)(ws + WS_WIN), D_MODEL, D_MODEL * 2, 32, 128, D_MODEL * 2}; \
        pg8::StaticOrder S; S.init(M, IN_W, F.G, (int)blockIdx.x); \
        EpiIn E{(bf16_t*)(ws + WS_Q), (bf16_t*)(ws + WS_K), (bf16_t*)(ws + WS_V), (bf16_t*)(ws + WS_AG)}; \
        pg8::gemm_phase<EpiIn, pg8::StaticOrder, true>(F.lds, F.wave, g, S, E); \
        { const int nwg_ = (M / 256) * (IN_W / 256), maxu_ = (nwg_ + F.G - 1) / F.G, nheavy_ = nwg_ - (maxu_ - 1) * F.G, nlight_ = F.G - nheavy_, c_ = (int)blockIdx.x;     \
          if (nlight_ == 0) convert_late_weights(F, c_ * NWAVES + F.wave, F.G * NWAVES); \
          else if (c_ >= nheavy_) convert_late_weights(F, (c_ - nheavy_) * NWAVES + F.wave, nlight_ * NWAVES); } }
#define PHASE2(DRY) { \
        float* const sa_ = (DRY) ? ssq_trash : (float*)(ws + WS_SSQ_A); \
        for (int u = F.vcu; u < BATCH * 32 * NKVH; u += F.G) attn_unit<(PROBE_REP == 25 ? 2 : 1), (PROBE_REP == 26 ? 2 : 1)>(F, u >> 7, (u >> 2) & 31, u & 3, sa_); \
        if (F.vcu < 256) ssm_unit(F, F.vcu);     }
#define PHASE3(DRY) {     \
        pg8::Gemm g{(const char*)(ws + WS_YG), (const char*)(ws + WS_WGLU), SSM_W, 32, (unsigned)(M * 32), (unsigned)(4 * M * 32), SSM_W * 2}; \
        pg8::StaticOrder S; S.init(M, SSM_W, F.G, (int)blockIdx.x); \
        EpiGlu E{(const bf16_t*)(ws + WS_YG), (bf16_t*)(ws + WS_MIX), (DRY) ? ssq_trash : (float*)(ws + WS_SSQ_S)}; \
        pg8::gemm_phase<EpiGlu, pg8::StaticOrder, true>(F.lds, F.wave, g, S, E); }
#define PHASE4(DRY) {     \
        pg8::Gemm g{(const char*)(ws + WS_MIX), (const char*)(ws + WS_WOUT), 2048, 2048 * 2, 32, 128, 2048 * 2}; \
        pg8::StaticOrder S; S.init(M, D_MODEL, F.G, (int)blockIdx.x); \
        EpiOut E{(const bf16_t*)(ws + WS_XN), (const float*)(ws + WS_IRSTD1), (bf16_t*)(ws + WS_XN), (const float*)(ws + WS_SSQ_A), (const float*)(ws + WS_SSQ_S), (DRY) ? ssq_trash : (float*)(ws + WS_SSQ_X)}; \
        pg8::gemm_phase<EpiOut, pg8::StaticOrder, true>(F.lds, F.wave, g, S, E); }
#define PHASE5(DRY) {     \
        pg8::Gemm g{(const char*)(ws + WS_XN), (const char*)(ws + WS_WGU), D_MODEL, D_MODEL * 2, 32, 128, D_MODEL * 2}; \
        pg8::StaticOrder S; S.init(M, 2 * FF, F.G, (int)blockIdx.x); \
        EpiGU E{(const float*)(ws + WS_SSQ_X), (bf16_t*)(ws + WS_H)}; \
        pg8::gemm_phase<EpiGU, pg8::StaticOrder, true>(F.lds, F.wave, g, S, E); }
#define PHASE6(DRY) {     \
        pg8::Gemm g{(const char*)(ws + WS_H), (const char*)(ws + WS_WDN), FF, FF * 2, 32, 128, FF * 2}; \
        pg8::StaticOrder S; S.init(M, D_MODEL, F.G, (int)blockIdx.x); \
        EpiDown<(DRY)> E{(const bf16_t*)(ws + WS_XN), F.out, (float*)(ws + WS_SSCR)}; \
        pg8::gemm_phase<EpiDown<(DRY)>, pg8::StaticOrder, true>(F.lds, F.wave, g, S, E); }
#define PHASE2A(DRY) { for (int u = F.vcu; u < BATCH * 32 * NKVH; u += F.G) attn_unit(F, u >> 7, (u >> 2) & 31, u & 3, ssq_trash); }
#define PHASE2S(DRY) { if (F.vcu < 256) ssm_unit(F, F.vcu); }
#define RUN_PHASE(k, BODY) do { if (PROBE_REP == (k) && IN(k)) { BODY(1); xcd_barrier(bar, F.wave); } if (IN(k)) { BODY(0); } } while (0)
    RUN_PHASE(0, PHASE0);
    GRID_BAR(0);
    if (args.ph_lo < 0) cg::this_grid().sync();
    RUN_PHASE(1, PHASE1);
    GRID_BAR(1);
    if (PROBE_REP == 22 && IN(2)) { if (F.vcu < 256) ssm_unit<1>(F, F.vcu); xcd_barrier(bar, F.wave); }
    if (PROBE_REP == 23 && IN(2)) { if (F.vcu < 256) ssm_unit<2>(F, F.vcu); xcd_barrier(bar, F.wave); }
    if (PROBE_REP == 24 && IN(2)) { if (F.vcu < 256) ssm_unit<4>(F, F.vcu); xcd_barrier(bar, F.wave); }
    if (PROBE_REP == 20 && IN(2)) { PHASE2A(1); xcd_barrier(bar, F.wave); }
    if (PROBE_REP == 21 && IN(2)) { PHASE2S(1); xcd_barrier(bar, F.wave); }
    RUN_PHASE(2, PHASE2);
    GRID_BAR(2);
    RUN_PHASE(3, PHASE3);
    GRID_BAR(3);
    RUN_PHASE(4, PHASE4);
    GRID_BAR(4);
    RUN_PHASE(5, PHASE5);
    GRID_BAR(5);
    RUN_PHASE(6, PHASE6);
#undef IN
#undef GRID_BAR
}

extern "C" void kernel_launch(void* const* d_in, const int* in_sizes, int n_in, void* d_out, int out_size, void* d_ws, size_t ws_size, hipStream_t stream) {
    static int grid = 0;
    if (grid == 0) {
        if (n_in != 23 || in_sizes[0] != M * D_MODEL || out_size != M * D_MODEL || ws_size < WS_END) { fprintf(stderr, "kernel_launch: unexpected sizes (n_in %d, out %d, ws %zu); nothing launched\n", n_in, out_size, ws_size); grid = -1; return; }
        int dev = 0, cus = 0, per_cu = 0;
        if (hipGetDevice(&dev) != hipSuccess || hipDeviceGetAttribute(&cus, hipDeviceAttributeMultiprocessorCount, dev) != hipSuccess) { grid = -1; return; }
        if (hipFuncSetAttribute((const void*)hymba_fwd, hipFuncAttributeMaxDynamicSharedMemorySize, LDS_BYTES) != hipSuccess) { fprintf(stderr, "kernel_launch: hipFuncSetAttribute failed\n"); grid = -1; return; }
        if (hipOccupancyMaxActiveBlocksPerMultiprocessor(&per_cu, (const void*)hymba_fwd, NWAVES * 64, LDS_BYTES) != hipSuccess || per_cu < 1) { fprintf(stderr, "kernel_launch: occupancy query failed (%d)\n", per_cu); (void)hipGetLastError(); grid = -1; return; }
        grid = cus;
        if (grid < 256) { fprintf(stderr, "kernel_launch: this kernel needs >= 256 CUs (got %d); nothing launched\n", grid); grid = -1; return; }
    }
    if (grid < 0) return;
    (void)hipMemsetAsync((char*)d_ws + WS_CTL, 0, CTL_ZERO_BYTES, stream);
    Args a{};
    for (int i = 0; i < 23; ++i) a.in[i] = (const float*)d_in[i];
    a.out = (float*)d_out; a.ws = (unsigned char*)d_ws;
    constexpr int NPH = 7;
    for (int li = 0; li < MK_N_LAUNCHES; ++li) {
        a.ph_lo = (MK_N_LAUNCHES == 1) ? 0 : li; a.ph_hi = (MK_N_LAUNCHES == 1) ? NPH : li + 1;
        void* kargs[] = {&a};
        const hipError_t e = hipLaunchCooperativeKernel((const void*)hymba_fwd, dim3(grid), dim3(NWAVES * 64), kargs, LDS_BYTES, stream);
        if (e != hipSuccess) { fprintf(stderr, "kernel_launch: cooperative launch failed: %s (grid %d)\n", hipGetErrorString(e), grid); break; }
    }
}
```

```cpp
#include <hip/hip_runtime.h>
#include <hip/hip_cooperative_groups.h>
#include <cstdio>
#include <cstdint>
namespace cg = cooperative_groups;

#ifndef PROBE_REP
#define PROBE_REP -1
#endif
#ifndef MK_N_LAUNCHES
#define MK_N_LAUNCHES 1
#endif

#define LAS __attribute__((address_space(3)))
typedef unsigned short bf16_t;
typedef short bf16x8 __attribute__((ext_vector_type(8)));
typedef float f32x4 __attribute__((ext_vector_type(4)));
typedef float f32x2 __attribute__((ext_vector_type(2)));
typedef float f32x16 __attribute__((ext_vector_type(16)));
typedef unsigned u32x4 __attribute__((ext_vector_type(4)));
typedef unsigned u32x2 __attribute__((ext_vector_type(2)));

constexpr int D_MODEL = 2048, BATCH = 4, SEQ = 4096, M = BATCH * SEQ;
constexpr int HD = 64, NQH = 16, NKVH = 4, ATTN_W = 1024, KV_W = 256;
constexpr int SSM_W = 1024, SSM_P = 16, SSM_G = 64, SSM_N = 64, IN_W = 2560, FF = 5632;
constexpr int CH_T = 16;
constexpr int SSM_KA = CH_T * SSM_P + 2 * SSM_N;
constexpr float EPS = 1e-6f;
constexpr float LOG2E = 1.4426950408889634f;

__device__ const unsigned char kBucket[128] = {0, 1, 2, 3, 4, 5, 6, 7, 8, 9, 10, 11, 12, 13, 14, 15, 16, 16, 16, 17, 17, 18, 18, 18, 19, 19, 19, 20, 20, 20, 20, 21, 21, 21, 21, 22, 22, 22, 22, 22, 23, 23, 23, 23, 23, 23, 24, 24, 24, 24, 24, 24, 25, 25, 25, 25, 25, 25, 25, 26, 26, 26, 26, 26, 26, 26, 26, 27, 27, 27, 27, 27, 27, 27, 27, 27, 27, 28, 28, 28, 28, 28, 28, 28, 28, 28, 28, 29, 29, 29, 29, 29, 29, 29, 29, 29, 29, 29, 29, 30, 30, 30, 30, 30, 30, 30, 30, 30, 30, 30, 30, 30, 30, 31, 31, 31, 31, 31, 31, 31, 31, 31, 31, 31, 31, 31, 31, 31};

__device__ __forceinline__ unsigned cvt_pk_bf16(float lo, float hi) { unsigned r; asm volatile("v_cvt_pk_bf16_f32 %0, %1, %2" : "=v"(r) : "v"(lo), "v"(hi)); return r; }
__device__ __forceinline__ float bf_lo(unsigned w) { return __builtin_bit_cast(float, w << 16); }
__device__ __forceinline__ float bf_hi(unsigned w) { return __builtin_bit_cast(float, w & 0xffff0000u); }
__device__ __forceinline__ float fast_rcp(float x) { return __builtin_amdgcn_rcpf(x); }
__device__ __forceinline__ float fast_exp2(float x) { return __builtin_amdgcn_exp2f(x); }
__device__ __forceinline__ float sigmoidf_fast(float x) { return fast_rcp(1.0f + fast_exp2(-LOG2E * x)); }
__device__ __forceinline__ float gelu_tanh(float x) {
    const float u2 = 1.5957691216057308f * (x + 0.044715f * x * x * x);
    return x * sigmoidf_fast(u2);
}

__device__ __forceinline__ int lane_id() { int l = __builtin_amdgcn_mbcnt_hi(~0u, __builtin_amdgcn_mbcnt_lo(~0u, 0u)); asm volatile("" : "+v"(l)); return l; }

namespace pg8 {
constexpr int BM = 256, BK = 64, HALF = 128, HTB = HALF * BK * 2  , STAGE_BYTES = 8 * HTB, NXCD = 8, WGM = 4;
__host__ __device__ __forceinline__ int lds_byte(int r, int c) { const int st = (r >> 4) * 2 + (c >> 5), rr = r & 15, cc = c & 31, ob = rr * 64 + cc * 2; return st * 1024 + (ob ^ (((ob >> 9) & 1) << 5)); }
__host__ __device__ __forceinline__ void stage_rc(int b, int& R, int& C) { const int st = b / 1024, sb = b % 1024, swz = sb ^ (((sb >> 9) & 1) << 5); R = (st >> 1) * 16 + swz / 64; C = (st & 1) * 32 + (swz % 64) / 2; }
__host__ __device__ __forceinline__ int perm32(int rho) { const int n = rho >> 4, i = rho & 15; return 8 * (i >> 2) + 4 * n + (i & 3); }

struct Unit { int pm, pn; unsigned aofs, bofs; int part; };
struct Gemm { const char* A; const char* B; int K; unsigned a_rs, a_cs, a_ks, b_rs; };

struct StaticOrder {
    int nM, nN, nwg, G, c;
    __device__ void init(int Mr, int N, int G_, int c_) { nM = Mr / BM; nN = N / BM; nwg = nM * nN; G = G_; c = c_; }
    __device__ bool next(int i, Unit& u) const {
        const long L = (long)i * G + c; if (L >= nwg) return false;
        int wgid = (int)L; { const int q = nwg / NXCD, r = nwg % NXCD, xcd = wgid % NXCD, off = wgid / NXCD; wgid = (xcd < r ? xcd * (q + 1) : r * (q + 1) + (xcd - r) * q) + off; }
        const int nig = WGM * nN, gid = wgid / nig, fm = gid * WGM, gsz = (nM - fm) < WGM ? (nM - fm) : WGM;
        u.pm = fm + ((wgid % nig) % gsz); u.pn = (wgid % nig) / gsz; u.aofs = 0; u.bofs = 0; u.part = 0; return true;
    }
};
struct TwoPartOrder {
    StaticOrder S; unsigned kofs;
    __device__ bool next(int i, Unit& u) const { if (!S.next(i >> 1, u)) return false; u.part = i & 1; u.aofs = u.bofs = (i & 1) ? kofs : 0u; return true; }
};
struct OneUnit {
    int pm, pn;
    __device__ bool next(int i, Unit& u) const { if (i) return false; u.pm = pm; u.pn = pn; u.aofs = 0; u.bofs = 0; u.part = 0; return true; }
};

template <class Epi, class Sched, bool ALIGN_EPI>
__device__ __forceinline__ void gemm_phase(LAS unsigned char* lds, const int wid  , const Gemm g, const Sched& S, const Epi& E) {
    const int lane = lane_id(), tid = wid * 64 + lane, wr = wid >> 2, wc = wid & 3, fr = lane & 15, fq = lane >> 4;
    const int nt = g.K / BK;
    unsigned voffA[2], voffB[2];
#pragma unroll
    for (int i = 0; i < 2; ++i) { int R, C; stage_rc(tid * 16 + i * 8192, R, C); const int Rb = Epi::PERM ? ((R & ~31) + perm32(R & 31)) : R;
        voffA[i] = (unsigned)R * g.a_rs + (unsigned)(C >> 4) * g.a_cs + (unsigned)(C & 15) * 2u; voffB[i] = (unsigned)Rb * g.b_rs + (unsigned)C * 2u; }
    const size_t kstepA = g.a_ks, kstepB = (size_t)(BK * 2);
    const size_t hstepA = (size_t)HALF * g.a_rs, hstepB = (size_t)HALF * g.b_rs, tstepA = 2 * hstepA, tstepB = 2 * hstepB;
    const unsigned ldsw = (unsigned)wid * 1024u;
    const int aoff = lds_byte(wr * 64 + fr, fq * 8), boff = lds_byte(wc * 32 + fr, fq * 8);
#define PG8_SA(b, h) (((b) * 2 + (h)) * HTB)
#define PG8_SB(b, h) ((4 + (b) * 2 + (h)) * HTB)
#define PG8_STAGE(bufoff, gbase, voff) do { _Pragma("unroll") for (int _i = 0; _i < 2; ++_i) \
        __builtin_amdgcn_global_load_lds((const unsigned*)((const char*)(gbase) + (voff)[_i]), (LAS unsigned*)(lds + (bufoff) + ldsw + _i * 8192), 16, 0, 0); } while (0)
#define PG8_LDA(dst, b, h) do { _Pragma("unroll") for (int m = 0; m < 4; ++m) _Pragma("unroll") for (int k = 0; k < 2; ++k) dst[m][k] = *(const LAS bf16x8*)(lds + PG8_SA(b, h) + aoff + m * 2048 + k * 1024); } while (0)
#define PG8_LDB(dst, b, h) do { _Pragma("unroll") for (int n = 0; n < 2; ++n) _Pragma("unroll") for (int k = 0; k < 2; ++k) dst[n][k] = *(const LAS bf16x8*)(lds + PG8_SB(b, h) + boff + n * 2048 + k * 1024); } while (0)
#define PG8_MMA(ai, bj, At, Bt) do { __builtin_amdgcn_s_setprio(1); _Pragma("unroll") for (int m = 0; m < 4; ++m) _Pragma("unroll") for (int n = 0; n < 2; ++n) _Pragma("unroll") for (int k = 0; k < 2; ++k) \
        acc[ai][bj][m][n] = __builtin_amdgcn_mfma_f32_16x16x32_bf16(Bt[n][k], At[m][k], acc[ai][bj][m][n], 0, 0, 0); __builtin_amdgcn_s_setprio(0); } while (0)
#define PG8_WAIT_V(n) asm volatile("s_waitcnt vmcnt(" #n ")" ::: "memory")
#define PG8_WAIT_L(n) asm volatile("s_waitcnt lgkmcnt(" #n ")" ::: "memory")
#define PG8_BAR __builtin_amdgcn_s_barrier()
#define PG8_SCHED __builtin_amdgcn_sched_barrier(0)
    Unit cur, nxt; int ui = 0;
    if (!S.next(0, cur)) return;
    f32x4 acc[2][2][4][2];
#pragma unroll
    for (int a = 0; a < 2; ++a)
#pragma unroll
        for (int b = 0; b < 2; ++b)
#pragma unroll
            for (int m = 0; m < 4; ++m)
#pragma unroll
                for (int n = 0; n < 2; ++n) acc[a][b][m][n] = (f32x4){0.f, 0.f, 0.f, 0.f};
    bf16x8 At[4][2], B0[2][2], B1[2][2];
    const char* cA = g.A + (size_t)cur.pm * tstepA + cur.aofs; const char* cB = g.B + (size_t)cur.pn * tstepB + cur.bofs;
    PG8_STAGE(PG8_SB(0, 0), cB, voffB); PG8_STAGE(PG8_SB(0, 1), cB + hstepB, voffB); PG8_STAGE(PG8_SA(0, 0), cA, voffA); PG8_STAGE(PG8_SA(0, 1), cA + hstepA, voffA);
    if (wr == 1) PG8_BAR;
    PG8_WAIT_V(2); PG8_BAR;
    PG8_STAGE(PG8_SB(1, 0), cB + kstepB, voffB); PG8_STAGE(PG8_SA(1, 0), cA + kstepA, voffA); PG8_STAGE(PG8_SB(1, 1), cB + hstepB + kstepB, voffB);
    PG8_WAIT_V(6); PG8_BAR;
    for (;;) {
        const bool has_next = S.next(ui + 1, nxt);
        const char* nA = has_next ? g.A + (size_t)nxt.pm * tstepA + nxt.aofs : cA; const char* nB = has_next ? g.B + (size_t)nxt.pn * tstepB + nxt.bofs : cB;
        for (int t = 0; t < nt; t += 2) {
            if constexpr (Epi::MID_T > 0) { if (t == Epi::MID_T) E.mid(acc, cur, wr, wc, fr, fq); }
            const bool last = (t == nt - 2);
            const char* a1 = cA + (size_t)(t + 1) * kstepA;
            const char* a2 = last ? nA : cA + (size_t)(t + 2) * kstepA; const char* b2 = last ? nB : cB + (size_t)(t + 2) * kstepB;
            const char* a3 = a2 + kstepA; const char* b3 = b2 + kstepB;
            PG8_LDB(B0, 0, 0); PG8_LDB(B1, 0, 1); PG8_SCHED; PG8_LDA(At, 0, 0); PG8_STAGE(PG8_SA(1, 1), a1 + hstepA, voffA);
            PG8_WAIT_V(8); PG8_WAIT_L(0); PG8_BAR; PG8_MMA(0, 0, At, B0); PG8_MMA(0, 1, At, B1); PG8_BAR; PG8_SCHED;
            PG8_LDA(At, 0, 1); PG8_STAGE(PG8_SB(0, 0), b2, voffB); PG8_STAGE(PG8_SB(0, 1), b2 + hstepB, voffB); PG8_STAGE(PG8_SA(0, 0), a2, voffA);
            PG8_WAIT_V(8); PG8_WAIT_L(0); PG8_BAR; PG8_MMA(1, 0, At, B0); PG8_MMA(1, 1, At, B1); PG8_BAR; PG8_SCHED;
            PG8_LDB(B0, 1, 0); PG8_LDB(B1, 1, 1); PG8_SCHED; PG8_LDA(At, 1, 0); PG8_STAGE(PG8_SA(0, 1), a2 + hstepA, voffA);
            PG8_WAIT_V(8); PG8_WAIT_L(0); PG8_BAR; PG8_MMA(0, 0, At, B0); PG8_MMA(0, 1, At, B1); PG8_BAR; PG8_SCHED;
            PG8_LDA(At, 1, 1); PG8_STAGE(PG8_SB(1, 0), b3, voffB); PG8_STAGE(PG8_SB(1, 1), b3 + hstepB, voffB); PG8_STAGE(PG8_SA(1, 0), a3, voffA);
            PG8_WAIT_V(8); PG8_WAIT_L(0); PG8_BAR; PG8_MMA(1, 0, At, B0); PG8_MMA(1, 1, At, B1); PG8_BAR; PG8_SCHED;
        }
        if constexpr (ALIGN_EPI) { if (wr == 0) PG8_BAR; }
        if constexpr (!Epi::AFTER_DRAIN) E(acc, cur, wr, wc, fr, fq);
        if (!has_next) break;
#pragma unroll
        for (int a = 0; a < 2; ++a)
#pragma unroll
            for (int b = 0; b < 2; ++b)
#pragma unroll
                for (int m = 0; m < 4; ++m)
#pragma unroll
                    for (int n = 0; n < 2; ++n) acc[a][b][m][n] = (f32x4){0.f, 0.f, 0.f, 0.f};
        cur = nxt; cA = nA; cB = nB; ++ui;
        if constexpr (ALIGN_EPI) { if (wr == 1) PG8_BAR; }
    }
    PG8_WAIT_V(0);
    if constexpr (!ALIGN_EPI) { if (wr == 0) PG8_BAR; }
    PG8_BAR;
    if constexpr (Epi::AFTER_DRAIN) E.fused(acc, cur, wr, wc, fr, fq, lds);
#undef PG8_SA
#undef PG8_SB
#undef PG8_STAGE
#undef PG8_LDA
#undef PG8_LDB
#undef PG8_MMA
#undef PG8_WAIT_V
#undef PG8_WAIT_L
#undef PG8_BAR
#undef PG8_SCHED
}
}

constexpr size_t MiB = 1u << 20;
constexpr size_t WS_CTL = 0, CTL_ZERO_BYTES = 1 * MiB;
constexpr size_t WS_SSQ_A = 256 * 1024, WS_SSQ_S = 320 * 1024, WS_SSQ_X = 384 * 1024, WS_SSQ_T = 448 * 1024  ;
constexpr size_t WS_IRSTD1 = 512 * 1024;
constexpr size_t WS_WIN = 2 * MiB;
constexpr size_t WS_WGLU = 12 * MiB;
constexpr size_t WS_WOUT = 14 * MiB;
constexpr size_t WS_WGU = 22 * MiB;
constexpr size_t WS_WDN = 66 * MiB;
constexpr size_t WS_BG = 88 * MiB;
constexpr size_t WS_PG = 100 * MiB;
constexpr size_t WS_L16 = 108 * MiB;
constexpr size_t WS_SSCR = 109 * MiB;
constexpr size_t WS_XN = 141 * MiB;
constexpr size_t WS_Q = 205 * MiB;
constexpr size_t WS_K = 237 * MiB;
constexpr size_t WS_V = 245 * MiB;
constexpr size_t WS_AG = 253 * MiB;
constexpr size_t WS_YG = 301 * MiB;
constexpr size_t WS_MIX = 333 * MiB;
constexpr size_t WS_H = 205 * MiB;
constexpr size_t WS_END = 397 * MiB;
static_assert(WS_H + (size_t)M * FF * 2 <= WS_END, "ws map");

constexpr int RING_BYTES = 131072;
constexpr int LDS_BYTES = 147456;
constexpr int NWAVES = 8;
constexpr int LDSCTL_OFF = RING_BYTES, MISC_OFF = LDSCTL_OFF + 320;

struct Frame {
    LAS unsigned char* lds;
    int wave, vcu, G;
    const float* const* in; float* out; unsigned char* ws;
};

__device__ __forceinline__ float wave_sum(float v) {
#pragma unroll
    for (int o = 1; o < 64; o <<= 1) v += __shfl_xor(v, o);
    return v;
}
__device__ __forceinline__ unsigned f2bf(float f) { unsigned u = __builtin_bit_cast(unsigned, f); return (u + 0x7fffu + ((u >> 16) & 1u)) >> 16; }
__device__ __forceinline__ unsigned pk2(float lo, float hi) { return f2bf(lo) | (f2bf(hi) << 16); }

struct TItem { const float* W; bf16_t* WT; const float* gain; int K, N, rmul, radd, item; };
__device__ __forceinline__ void titem_load(const TItem& t, float (&v)[32], int lane) {
    const int nblk = t.N / 32, kb = t.item / nblk, nb = t.item % nblk, k0 = 64 * kb, n0 = 32 * nb;
    const float* p = t.W + (size_t)(k0 + (lane >> 5)) * t.N + n0 + (lane & 31);
#pragma unroll
    for (int i = 0; i < 32; ++i) v[i] = p[(size_t)(2 * i) * t.N];
}
__device__ __forceinline__ void titem_store(const TItem& t, const float (&v)[32], LAS float* scr, int lane) {
    const int nblk = t.N / 32, kb = t.item / nblk, nb = t.item % nblk, k0 = 64 * kb, n0 = 32 * nb;
#pragma unroll
    for (int i = 0; i < 32; ++i) scr[(2 * i + (lane >> 5)) * 33 + (lane & 31)] = v[i];
    asm volatile("s_waitcnt lgkmcnt(0)" ::: "memory");
    const int c = lane & 7;
    float gv[8];
#pragma unroll
    for (int i = 0; i < 8; ++i) gv[i] = t.gain ? t.gain[k0 + 8 * c + i] : 1.0f;
#pragma unroll
    for (int j = 0; j < 4; ++j) { const int n = (lane >> 3) + 8 * j; const LAS float* s = scr + (8 * c) * 33 + n; const int nn = n0 + n; const int row = (nn >> 7) * t.rmul + t.radd + (nn & 127);
        u32x4 o; o.x = pk2(s[0 * 33] * gv[0], s[1 * 33] * gv[1]); o.y = pk2(s[2 * 33] * gv[2], s[3 * 33] * gv[3]); o.z = pk2(s[4 * 33] * gv[4], s[5 * 33] * gv[5]); o.w = pk2(s[6 * 33] * gv[6], s[7 * 33] * gv[7]);
        *(u32x4*)(t.WT + (size_t)row * t.K + k0 + 8 * c) = o; }
    asm volatile("s_waitcnt lgkmcnt(0)" ::: "memory");
}
__device__ __forceinline__ void rms_row_load(const float* xrow, f32x4 (&v)[8], int lane) {
    const f32x4* xr = (const f32x4*)xrow + lane;
#pragma unroll
    for (int j = 0; j < 8; ++j) v[j] = xr[64 * j];
}
__device__ __forceinline__ void rms_row_store(const f32x4 (&v)[8], float* irstd, bf16_t* orow, int lane) {
    float s = 0.f;
#pragma unroll
    for (int j = 0; j < 8; ++j) s += (v[j].x * v[j].x + v[j].y * v[j].y) + (v[j].z * v[j].z + v[j].w * v[j].w);
    const float ms = wave_sum(s) * (1.0f / D_MODEL) + EPS; const float rstd = 1.0f / sqrtf(ms);
    if (lane == 0) *irstd = sqrtf(ms);
    u32x2* o8 = (u32x2*)orow + lane;
#pragma unroll
    for (int j = 0; j < 8; ++j) { u32x2 w; w.x = pk2(v[j].x * rstd, v[j].y * rstd); w.y = pk2(v[j].z * rstd, v[j].w * rstd); o8[64 * j] = w; }
}
__device__ __forceinline__ void p0_ssm_tables(Frame& F, int g, int qr) {
    LAS float* LP = (LAS float*)F.lds; LAS float* BB = LP + 17 * 64 * 2; LAS float* CC = BB + 64 * 16 * 2; LAS float* KT = CC + 16 * 64 * 2;
    const float* a_re = F.in[7]; const float* a_im = F.in[8]; const float* log_dt = F.in[9]; const float* b_re = F.in[10]; const float* b_im = F.in[11]; const float* c_re = F.in[12]; const float* c_im = F.in[13];
    const int tid = F.wave * 64 + lane_id();
    if (tid < 64) {
        const int n = tid;
        const double dt = exp((double)log_dt[g]);
        const double are = (double)a_re[g * 64 + n], aim = (double)a_im[g * 64 + n];
        const double mag = exp(are * dt), ang = aim * dt;
        const double lre = mag * cos(ang), lim = mag * sin(ang);
        const double nr = lre - 1.0, ni = lim, den = are * are + aim * aim;
        const double fre = (nr * are + ni * aim) / den, fim = (ni * are - nr * aim) / den;
        double pr = 1.0, pi = 0.0;
        for (int t = 0; t <= 16; ++t) { LP[(t * 64 + n) * 2] = (float)pr; LP[(t * 64 + n) * 2 + 1] = (float)pi; const double nre = pr * lre - pi * lim, nim = pr * lim + pi * lre; pr = nre; pi = nim; }
        if (qr == 0) { float* l16 = (float*)(F.ws + WS_L16) + (g * 64 + n) * 2; l16[0] = LP[(16 * 64 + n) * 2]; l16[1] = LP[(16 * 64 + n) * 2 + 1]; }
        for (int p = 0; p < 16; ++p) { const double br = (double)b_re[(g * 64 + n) * 16 + p], bi = (double)b_im[(g * 64 + n) * 16 + p];
            BB[(n * 16 + p) * 2] = (float)(fre * br - fim * bi); BB[(n * 16 + p) * 2 + 1] = (float)(fre * bi + fim * br); }
    }
    for (int e = tid; e < 1024; e += 512) { CC[e * 2] = c_re[g * 1024 + e]; CC[e * 2 + 1] = c_im[g * 1024 + e]; }
    __syncthreads();
    {
        const int p = (tid >> 4) & 15, q = tid & 15, th = tid >> 8; float ka[8];
#pragma unroll
        for (int j = 0; j < 8; ++j) ka[j] = 0.f;
        for (int n = 0; n < 64; ++n) {
            const f32x2 c = *(const LAS f32x2*)(CC + (p * 64 + n) * 2), bb = *(const LAS f32x2*)(BB + (n * 16 + q) * 2);
            const float cbr = c.x * bb.x - c.y * bb.y, cbi = c.x * bb.y + c.y * bb.x;
#pragma unroll
            for (int j = 0; j < 8; ++j) { const f32x2 l = *(const LAS f32x2*)(LP + ((8 * th + j) * 64 + n) * 2); ka[j] += cbr * l.x - cbi * l.y; }
        }
#pragma unroll
        for (int j = 0; j < 8; ++j) KT[((8 * th + j) * 16 + p) * 16 + q] = ka[j];
    }
    __syncthreads();
    bf16_t* Bg = (bf16_t*)(F.ws + WS_BG) + (size_t)g * 256 * SSM_KA;
    for (int ch = tid; ch < 64 * 48; ch += 512) {
        const int rl = ch / 48, c8 = ch % 48, t = 4 * qr + (rl >> 4), p = rl & 15; float v[8];
        if (c8 < 32) { const int s = c8 >> 1, q0 = (c8 & 1) * 8;
#pragma unroll
            for (int i = 0; i < 8; ++i) v[i] = (s <= t) ? KT[((t - s) * 16 + p) * 16 + q0 + i] : 0.f;
        } else { const int n0 = (c8 - 32) * 4;
#pragma unroll
            for (int i = 0; i < 4; ++i) { const int n = n0 + i; const float cr = CC[(p * 64 + n) * 2], ci = CC[(p * 64 + n) * 2 + 1], lr = LP[((t + 1) * 64 + n) * 2], li = LP[((t + 1) * 64 + n) * 2 + 1];
                v[2 * i] = cr * lr - ci * li; v[2 * i + 1] = -(cr * li + ci * lr); }
        }
        u32x4 o; o.x = pk2(v[0], v[1]); o.y = pk2(v[2], v[3]); o.z = pk2(v[4], v[5]); o.w = pk2(v[6], v[7]);
        *(u32x4*)(Bg + (size_t)(t * 16 + p) * SSM_KA + c8 * 8) = o;
    }
    bf16_t* Pg = (bf16_t*)(F.ws + WS_PG) + (size_t)g * 256 * 256;
    for (int ch = tid; ch < 32 * 32; ch += 512) {
        const int rl = ch >> 5, c8 = ch & 31, n = 16 * qr + (rl >> 1), ri = rl & 1, s = c8 >> 1, q0 = (c8 & 1) * 8; float v[8];
        const float lr = LP[((15 - s) * 64 + n) * 2], li = LP[((15 - s) * 64 + n) * 2 + 1];
#pragma unroll
        for (int i = 0; i < 8; ++i) { const float br = BB[(n * 16 + q0 + i) * 2], bi = BB[(n * 16 + q0 + i) * 2 + 1]; v[i] = ri ? (lr * bi + li * br) : (lr * br - li * bi); }
        u32x4 o; o.x = pk2(v[0], v[1]); o.y = pk2(v[2], v[3]); o.z = pk2(v[4], v[5]); o.w = pk2(v[6], v[7]);
        *(u32x4*)(Pg + (size_t)(2 * n + ri) * 256 + c8 * 8) = o;
        *(u32x4*)(Pg + (size_t)(128 + 32 * qr + rl) * 256 + c8 * 8) = (u32x4){0u, 0u, 0u, 0u};
    }
    __syncthreads();
}
__device__ __forceinline__ void p0_prologue(Frame& F) {
    for (int it = F.vcu; it < 256; it += F.G) p0_ssm_tables(F, it >> 2, it & 3);
    LAS float* scr = (LAS float*)(F.lds + F.wave * 16384);
    const int lane = lane_id();
    const int gw = F.vcu * NWAVES + F.wave, NGW = F.G * NWAVES;
    constexpr int I_IN = (D_MODEL / 64) * (IN_W / 32);
    {
        TItem t{F.in[3], (bf16_t*)(F.ws + WS_WIN), F.in[2]  , D_MODEL, IN_W, 128, 0, 0};
        float va[32], vb[32];
        int it = gw;
        if (it < I_IN) { t.item = it; titem_load(t, va, lane); }
        for (; it < I_IN; it += 2 * NGW) {
            TItem t2 = t; const bool h2 = it + NGW < I_IN;
            if (h2) { t2.item = it + NGW; titem_load(t2, vb, lane); }
            t.item = it; titem_store(t, va, scr, lane);
            if (h2) { if (it + 2 * NGW < I_IN) { t.item = it + 2 * NGW; titem_load(t, va, lane); } titem_store(t2, vb, scr, lane); }
        }
    }
    {
        bf16_t* xn = (bf16_t*)(F.ws + WS_XN); const float* x = F.in[0]; float* ir = (float*)(F.ws + WS_IRSTD1);
        f32x4 ra[8], rb[8];
        int m = gw;
        if (m < M) rms_row_load(x + (size_t)m * D_MODEL, ra, lane);
        for (; m < M; m += 2 * NGW) {
            const bool h2 = m + NGW < M;
            if (h2) rms_row_load(x + (size_t)(m + NGW) * D_MODEL, rb, lane);
            rms_row_store(ra, ir + m, xn + (size_t)m * D_MODEL, lane);
            if (h2) { if (m + 2 * NGW < M) rms_row_load(x + (size_t)(m + 2 * NGW) * D_MODEL, ra, lane); rms_row_store(rb, ir + m + NGW, xn + (size_t)(m + NGW) * D_MODEL, lane); }
        }
    }
}
__device__ __forceinline__ bool late_item(Frame& F, int r, TItem& t) {
    constexpr int I_GLU = (SSM_W / 64) * (SSM_W / 32), I_OUT = (2048 / 64) * (D_MODEL / 32), I_G = (D_MODEL / 64) * (FF / 32), I_D = (FF / 64) * (D_MODEL / 32);
    if (r >= I_GLU + I_OUT + 2 * I_G + I_D) return false;
    if (r < I_GLU) { t = TItem{F.in[15], (bf16_t*)(F.ws + WS_WGLU), nullptr, SSM_W, SSM_W, 128, 0, r}; return true; } r -= I_GLU;
    if (r < I_OUT) {
        const int kb = r / (D_MODEL / 32); t = TItem{F.in[18], (bf16_t*)(F.ws + WS_WOUT), (kb < 16) ? F.in[16] : (F.in[17] - 1024), 2048, D_MODEL, 128, 0, r}; return true; } r -= I_OUT;
    if (r < I_G) { t = TItem{F.in[20], (bf16_t*)(F.ws + WS_WGU), F.in[19], D_MODEL, FF, 256, 0, r}; return true; } r -= I_G;
    if (r < I_G) { t = TItem{F.in[21], (bf16_t*)(F.ws + WS_WGU), F.in[19], D_MODEL, FF, 256, 128, r}; return true; } r -= I_G;
    t = TItem{F.in[22], (bf16_t*)(F.ws + WS_WDN), nullptr, FF, D_MODEL, 128, 0, r}; return true;
}
__device__ __forceinline__ void convert_late_weights(Frame& F, int w, int nw) {
    LAS float* scr = (LAS float*)(F.lds + F.wave * 16384);
    const int lane = lane_id();
    TItem ta, tb; float va[32], vb[32];
    int it = w;
    bool ha = late_item(F, it, ta);
    if (ha) titem_load(ta, va, lane);
    while (ha) {
        const bool hb = late_item(F, it + nw, tb);
        if (hb) titem_load(tb, vb, lane);
        titem_store(ta, va, scr, lane);
        it += 2 * nw;
        ha = hb && late_item(F, it, ta);
        if (hb) { if (ha) titem_load(ta, va, lane); titem_store(tb, vb, scr, lane); }
    }
}

using pg8::Unit;
struct EpiIn {
    static constexpr bool PERM = true, AFTER_DRAIN = false; static constexpr int MID_T = 0;
    bf16_t* Q; bf16_t* Kb; bf16_t* Vb; bf16_t* Ag;
    __device__ __forceinline__ void operator()(const f32x4 (&acc)[2][2][4][2], const Unit& u, int wr, int wc, int fr, int fq) const {
        asm volatile("" : "+v"(fr), "+v"(fq));
        const int row0 = u.pm * 256 + wr * 64 + fr, pn = u.pn;
#pragma unroll
        for (int ai = 0; ai < 2; ++ai)
#pragma unroll
            for (int m = 0; m < 4; ++m) { const int row = row0 + ai * 128 + m * 16;
#pragma unroll
                for (int bj = 0; bj < 2; ++bj) { const int col = bj * 128 + wc * 32 + 8 * fq; const f32x4 v0 = acc[ai][bj][m][0], v1 = acc[ai][bj][m][1];
                    u32x4 w; w.x = cvt_pk_bf16(v0[0], v0[1]); w.y = cvt_pk_bf16(v0[2], v0[3]); w.z = cvt_pk_bf16(v1[0], v1[1]); w.w = cvt_pk_bf16(v1[2], v1[3]);
                    bf16_t* dst;
                    if (pn < 4) dst = Q + (size_t)row * ATTN_W + pn * 256 + col;
                    else if (pn == 4) dst = Kb + (size_t)row * KV_W + col;
                    else if (pn == 5) dst = Vb + (size_t)row * KV_W + col;
                    else { const int c = (pn - 6) * 256 + col; dst = Ag + ((size_t)(c >> 4) * 1024 + (row >> 4)) * SSM_KA + (row & 15) * 16 + (c & 15); }
                    *(u32x4*)dst = w; } }
    }
};
struct EpiS {
    static constexpr bool PERM = false, AFTER_DRAIN = true; static constexpr int MID_T = 0;
    __device__ __forceinline__ void operator()(const f32x4 (&acc)[2][2][4][2], const Unit& u, int wr, int wc, int fr, int fq) const {}
    __device__ __forceinline__ void fused(const f32x4 (&acc)[2][2][4][2], const Unit& u, int wr, int wc, int fr, int fq, LAS unsigned char* lds) const {
        asm volatile("" : "+v"(fr), "+v"(fq));
#pragma unroll
        for (int ai = 0; ai < 2; ++ai)
#pragma unroll
            for (int m = 0; m < 4; ++m) { const int r = ai * 128 + wr * 64 + m * 16 + fr;
#pragma unroll
                for (int n = 0; n < 2; ++n) *(LAS f32x4*)(lds + r * 512 + (((wc * 32 + n * 16 + 4 * fq) * 4) ^ ((r & 7) << 4))) = acc[ai][0][m][n]; }
    }
};
struct EpiY {
    static constexpr bool PERM = true, AFTER_DRAIN = false; static constexpr int MID_T = 0;
    const bf16_t* Ag; const float* dd; bf16_t* Yg;
    __device__ __forceinline__ void operator()(const f32x4 (&acc)[2][2][4][2], const Unit& u, int wr, int wc, int fr, int fq) const {
        asm volatile("" : "+v"(fr), "+v"(fq));
        const int g = u.pm >> 2; const int p0 = (8 * fq) & 15;
        const f32x4 d0 = *(const f32x4*)(dd + g * 16 + p0), d1 = *(const f32x4*)(dd + g * 16 + p0 + 4);
        const size_t grow0 = (size_t)u.pm * 256 + wr * 64 + fr; const int col0 = wc * 32 + 8 * fq;
        u32x4 uu[2][4][2];
#pragma unroll
        for (int ai = 0; ai < 2; ++ai)
#pragma unroll
            for (int m = 0; m < 4; ++m)
#pragma unroll
                for (int bj = 0; bj < 2; ++bj) uu[ai][m][bj] = *(const u32x4*)(Ag + (grow0 + ai * 128 + m * 16) * SSM_KA + bj * 128 + col0);
#pragma unroll
        for (int ai = 0; ai < 2; ++ai)
#pragma unroll
            for (int m = 0; m < 4; ++m) { const size_t grow = grow0 + ai * 128 + m * 16;
#pragma unroll
                for (int bj = 0; bj < 2; ++bj) { const u32x4 w_ = uu[ai][m][bj]; const f32x4 v0 = acc[ai][bj][m][0], v1 = acc[ai][bj][m][1];
                    const float y0 = gelu_tanh(v0[0] + d0[0] * bf_lo(w_.x)), y1 = gelu_tanh(v0[1] + d0[1] * bf_hi(w_.x)), y2 = gelu_tanh(v0[2] + d0[2] * bf_lo(w_.y)), y3 = gelu_tanh(v0[3] + d0[3] * bf_hi(w_.y));
                    const float y4 = gelu_tanh(v1[0] + d1[0] * bf_lo(w_.z)), y5 = gelu_tanh(v1[1] + d1[1] * bf_hi(w_.z)), y6 = gelu_tanh(v1[2] + d1[2] * bf_lo(w_.w)), y7 = gelu_tanh(v1[3] + d1[3] * bf_hi(w_.w));
                    u32x4 w; w.x = cvt_pk_bf16(y0, y1); w.y = cvt_pk_bf16(y2, y3); w.z = cvt_pk_bf16(y4, y5); w.w = cvt_pk_bf16(y6, y7);
                    *(u32x4*)(Yg + grow * 256 + bj * 128 + col0) = w; } }
    }
};
struct EpiGlu {
    static constexpr bool PERM = true, AFTER_DRAIN = false; static constexpr int MID_T = 0;
    const bf16_t* Yg; bf16_t* mixed; float* ssq;
    __device__ __forceinline__ void operator()(const f32x4 (&acc)[2][2][4][2], const Unit& u, int wr, int wc, int fr, int fq) const {
        asm volatile("" : "+v"(fr), "+v"(fq));
        const int row0 = u.pm * 256 + wr * 64 + fr, c0 = u.pn * 256 + wc * 32 + 8 * fq;
        u32x4 yy[2][4][2];
#pragma unroll
        for (int ai = 0; ai < 2; ++ai)
#pragma unroll
            for (int m = 0; m < 4; ++m)
#pragma unroll
                for (int bj = 0; bj < 2; ++bj) { const int c = c0 + bj * 128; yy[ai][m][bj] = *(const u32x4*)(Yg + ((size_t)(c >> 4) * M + row0 + ai * 128 + m * 16) * 16 + (c & 15)); }
#pragma unroll
        for (int ai = 0; ai < 2; ++ai)
#pragma unroll
            for (int m = 0; m < 4; ++m) { const int row = row0 + ai * 128 + m * 16; float sq = 0.f;
#pragma unroll
                for (int bj = 0; bj < 2; ++bj) { const int c = c0 + bj * 128; const u32x4 y_ = yy[ai][m][bj]; const f32x4 v0 = acc[ai][bj][m][0], v1 = acc[ai][bj][m][1];
                    const float s0 = bf_lo(y_.x) * sigmoidf_fast(v0[0]), s1 = bf_hi(y_.x) * sigmoidf_fast(v0[1]), s2 = bf_lo(y_.y) * sigmoidf_fast(v0[2]), s3 = bf_hi(y_.y) * sigmoidf_fast(v0[3]);
                    const float s4 = bf_lo(y_.z) * sigmoidf_fast(v1[0]), s5 = bf_hi(y_.z) * sigmoidf_fast(v1[1]), s6 = bf_lo(y_.w) * sigmoidf_fast(v1[2]), s7 = bf_hi(y_.w) * sigmoidf_fast(v1[3]);
                    sq += (s0 * s0 + s1 * s1) + (s2 * s2 + s3 * s3) + (s4 * s4 + s5 * s5) + (s6 * s6 + s7 * s7);
                    u32x4 w; w.x = cvt_pk_bf16(s0, s1); w.y = cvt_pk_bf16(s2, s3); w.z = cvt_pk_bf16(s4, s5); w.w = cvt_pk_bf16(s6, s7);
                    *(u32x4*)(mixed + (size_t)row * 2048 + 1024 + c) = w; }
                sq += __shfl_xor(sq, 16); sq += __shfl_xor(sq, 32);
                if (fq == 0) atomicAdd(ssq + row, sq); }
    }
};
struct EpiOut {
    static constexpr bool PERM = true, AFTER_DRAIN = false; static constexpr int MID_T = 16;
    const bf16_t* xn; const float* irstd1; bf16_t* x1b; const float* ssq_a; const float* ssq_s; float* ssq_x;
    __device__ __forceinline__ void mid(f32x4 (&acc)[2][2][4][2], const Unit& u, int wr, int wc, int fr, int fq) const {
        asm volatile("" : "+v"(fr), "+v"(fq));
#pragma unroll
        for (int ai = 0; ai < 2; ++ai)
#pragma unroll
            for (int m = 0; m < 4; ++m) { const int row = u.pm * 256 + ai * 128 + wr * 64 + m * 16 + fr;
                const float f = sqrtf((ssq_s[row] * (1.0f / 1024.0f) + EPS) / (ssq_a[row] * (1.0f / 1024.0f) + EPS));
#pragma unroll
                for (int bj = 0; bj < 2; ++bj)
#pragma unroll
                    for (int n = 0; n < 2; ++n) acc[ai][bj][m][n] *= f; }
    }
    __device__ __forceinline__ void operator()(const f32x4 (&acc)[2][2][4][2], const Unit& u, int wr, int wc, int fr, int fq) const {
        asm volatile("" : "+v"(fr), "+v"(fq));
        const int row0 = u.pm * 256 + wr * 64 + fr; const size_t cofs = (size_t)u.pn * 256 + wc * 32 + 8 * fq;
#pragma unroll
        for (int ai = 0; ai < 2; ++ai) {
            float sv[4], iv[4]; u32x4 xb[4][2];
#pragma unroll
            for (int m = 0; m < 4; ++m) { const int row = row0 + ai * 128 + m * 16; sv[m] = ssq_s[row]; iv[m] = irstd1[row];
#pragma unroll
                for (int bj = 0; bj < 2; ++bj) xb[m][bj] = *(const u32x4*)(xn + (size_t)row * D_MODEL + cofs + bj * 128); }
#pragma unroll
            for (int m = 0; m < 4; ++m) { const int row = row0 + ai * 128 + m * 16; const float rstd = 1.0f / sqrtf(sv[m] * (1.0f / 1024.0f) + EPS), ir = iv[m]; float sq = 0.f;
#pragma unroll
                for (int bj = 0; bj < 2; ++bj) { const size_t off = (size_t)row * D_MODEL + cofs + bj * 128; const u32x4 x_ = xb[m][bj];
                    const f32x4 b0 = {bf_lo(x_.x), bf_hi(x_.x), bf_lo(x_.y), bf_hi(x_.y)}, b1 = {bf_lo(x_.z), bf_hi(x_.z), bf_lo(x_.w), bf_hi(x_.w)};
                    const f32x4 o0 = b0 * ir + acc[ai][bj][m][0] * rstd, o1 = b1 * ir + acc[ai][bj][m][1] * rstd;
                    sq += (o0[0] * o0[0] + o0[1] * o0[1]) + (o0[2] * o0[2] + o0[3] * o0[3]) + (o1[0] * o1[0] + o1[1] * o1[1]) + (o1[2] * o1[2] + o1[3] * o1[3]);
                    u32x4 w; w.x = cvt_pk_bf16(o0[0], o0[1]); w.y = cvt_pk_bf16(o0[2], o0[3]); w.z = cvt_pk_bf16(o1[0], o1[1]); w.w = cvt_pk_bf16(o1[2], o1[3]);
                    *(u32x4*)(x1b + off) = w; }
                sq += __shfl_xor(sq, 16); sq += __shfl_xor(sq, 32); if (fq == 0) atomicAdd(ssq_x + row, sq); }
        }
    }
};
struct EpiGU {
    static constexpr bool PERM = true, AFTER_DRAIN = false; static constexpr int MID_T = 0;
    const float* ssq_x; bf16_t* H;
    __device__ __forceinline__ void operator()(const f32x4 (&acc)[2][2][4][2], const Unit& u, int wr, int wc, int fr, int fq) const {
        asm volatile("" : "+v"(fr), "+v"(fq));
        const int row0 = u.pm * 256 + wr * 64 + fr;
        float sv[2][4];
#pragma unroll
        for (int ai = 0; ai < 2; ++ai)
#pragma unroll
            for (int m = 0; m < 4; ++m) sv[ai][m] = ssq_x[row0 + ai * 128 + m * 16];
#pragma unroll
        for (int ai = 0; ai < 2; ++ai)
#pragma unroll
            for (int m = 0; m < 4; ++m) { const int row = row0 + ai * 128 + m * 16; const float rstd = 1.0f / sqrtf(sv[ai][m] * (1.0f / 2048.0f) + EPS);
                float h[8];
#pragma unroll
                for (int n = 0; n < 2; ++n)
#pragma unroll
                    for (int i = 0; i < 4; ++i) { const float gv = acc[ai][0][m][n][i] * rstd, uv = acc[ai][1][m][n][i] * rstd; h[4 * n + i] = gv * sigmoidf_fast(gv) * uv; }
                u32x4 w; w.x = cvt_pk_bf16(h[0], h[1]); w.y = cvt_pk_bf16(h[2], h[3]); w.z = cvt_pk_bf16(h[4], h[5]); w.w = cvt_pk_bf16(h[6], h[7]);
                *(u32x4*)(H + (size_t)row * FF + u.pn * 128 + wc * 32 + 8 * fq) = w; }
    }
};
template <bool DRY> struct EpiDown {
    static constexpr bool PERM = true, AFTER_DRAIN = false; static constexpr int MID_T = 0;
    const bf16_t* x1b; float* out; float* trash;
    __device__ __forceinline__ void operator()(const f32x4 (&acc)[2][2][4][2], const Unit& u, int wr, int wc, int fr, int fq) const {
        asm volatile("" : "+v"(fr), "+v"(fq));
        const int row0 = u.pm * 256 + wr * 64 + fr; const size_t cofs = (size_t)u.pn * 256 + wc * 32 + 8 * fq;
        u32x4 xb[2][4][2];
#pragma unroll
        for (int ai = 0; ai < 2; ++ai)
#pragma unroll
            for (int m = 0; m < 4; ++m)
#pragma unroll
                for (int bj = 0; bj < 2; ++bj) xb[ai][m][bj] = *(const u32x4*)(x1b + (size_t)(row0 + ai * 128 + m * 16) * D_MODEL + cofs + bj * 128);
#pragma unroll
        for (int ai = 0; ai < 2; ++ai)
#pragma unroll
            for (int m = 0; m < 4; ++m) { const int row = row0 + ai * 128 + m * 16;
#pragma unroll
                for (int bj = 0; bj < 2; ++bj) { const size_t off = (size_t)row * D_MODEL + cofs + bj * 128; const u32x4 x_ = xb[ai][m][bj];
                    const f32x4 b0 = {bf_lo(x_.x), bf_hi(x_.x), bf_lo(x_.y), bf_hi(x_.y)}, b1 = {bf_lo(x_.z), bf_hi(x_.z), bf_lo(x_.w), bf_hi(x_.w)};
                    float* q = DRY ? trash + (off & ((8u << 20) - 1)) : out + off;
                    *(f32x4*)q = b0 + acc[ai][bj][m][0]; *(f32x4*)(q + 4) = b1 + acc[ai][bj][m][1]; } }
    }
};

constexpr int ATT_KROW = 144, ATT_VROW = 520, ATT_K_OFF = 0, ATT_V_OFF = 256 * ATT_KROW, ATT_B_OFF = ATT_V_OFF + 64 * ATT_VROW;
constexpr int ATT_TAB = 192;
static_assert(ATT_B_OFF + 4 * ATT_TAB * 4 <= RING_BYTES, "attention LDS");
template <int STG_REPS = 1, int TASK_REPS = 1>
__device__ __forceinline__ void attn_unit(Frame& F, int b, int qb, int kvh, float* ssq_real) {
    LAS unsigned char* lds = F.lds;
    const int lane = lane_id(), wave = F.wave, tid = wave * 64 + lane;
    const bf16_t* Q = (const bf16_t*)(F.ws + WS_Q); const bf16_t* Kb = (const bf16_t*)(F.ws + WS_K); const bf16_t* Vb = (const bf16_t*)(F.ws + WS_V);
    bf16_t* mixed = (bf16_t*)(F.ws + WS_MIX);
    const int T0 = b * SEQ + qb * 128;
    const int q = lane & 31, hh = lane >> 5;
    u32x4 qraw[2][4];
#pragma unroll
    for (int it = 0; it < 2; ++it) { const int task = wave + 8 * it; const bf16_t* qp = Q + (size_t)(T0 + 32 * (task & 3) + q) * ATTN_W + (kvh * 4 + (task >> 2)) * 64 + hh * 8;
#pragma unroll
        for (int ks = 0; ks < 4; ++ks) qraw[it][ks] = *(const u32x4*)(qp + 16 * ks); }
    for (int srep = 0; srep < STG_REPS; ++srep)
    {
        const int key = tid & 255; const bool valid = (qb > 0) || (key >= 128);
        const size_t tok = (size_t)(T0 - 128 + key);
        u32x4 c[8];
        const bf16_t* src = ((tid < 256) ? Kb : Vb) + tok * KV_W + kvh * 64;
#pragma unroll
        for (int i = 0; i < 8; ++i) c[i] = valid ? *(const u32x4*)(src + 8 * i) : (u32x4){0u, 0u, 0u, 0u};
        if (tid < 256) {
            float ss = 0.f;
#pragma unroll
            for (int i = 0; i < 8; ++i) { const float a0 = bf_lo(c[i].x), a1 = bf_hi(c[i].x), a2 = bf_lo(c[i].y), a3 = bf_hi(c[i].y), a4 = bf_lo(c[i].z), a5 = bf_hi(c[i].z), a6 = bf_lo(c[i].w), a7 = bf_hi(c[i].w);
                ss += (a0 * a0 + a1 * a1) + (a2 * a2 + a3 * a3) + (a4 * a4 + a5 * a5) + (a6 * a6 + a7 * a7); }
            const float rstd = 1.0f / sqrtf(ss * (1.0f / 64.0f) + EPS);
            const float* kg = F.in[5];
#pragma unroll
            for (int i = 0; i < 8; ++i) { const f32x4 g0 = *(const f32x4*)(kg + 8 * i), g1 = *(const f32x4*)(kg + 8 * i + 4);
                u32x4 w; w.x = cvt_pk_bf16(bf_lo(c[i].x) * rstd * g0[0], bf_hi(c[i].x) * rstd * g0[1]); w.y = cvt_pk_bf16(bf_lo(c[i].y) * rstd * g0[2], bf_hi(c[i].y) * rstd * g0[3]);
                w.z = cvt_pk_bf16(bf_lo(c[i].z) * rstd * g1[0], bf_hi(c[i].z) * rstd * g1[1]); w.w = cvt_pk_bf16(bf_lo(c[i].w) * rstd * g1[2], bf_hi(c[i].w) * rstd * g1[3]);
                *(LAS u32x4*)(lds + ATT_K_OFF + key * ATT_KROW + i * 16) = w; }
        } else {
#pragma unroll
            for (int i = 0; i < 8; ++i) { const unsigned w4[4] = {c[i].x, c[i].y, c[i].z, c[i].w};
#pragma unroll
                for (int j = 0; j < 4; ++j) { *(LAS unsigned short*)(lds + ATT_V_OFF + (8 * i + 2 * j) * ATT_VROW + key * 2) = (unsigned short)(w4[j] & 0xffffu);
                    *(LAS unsigned short*)(lds + ATT_V_OFF + (8 * i + 2 * j + 1) * ATT_VROW + key * 2) = (unsigned short)(w4[j] >> 16); } }
        }
        for (int e = tid; e < 4 * ATT_TAB; e += NWAVES * 64) { const int hl = e / ATT_TAB, dist = e % ATT_TAB - 32;
            ((LAS float*)(lds + ATT_B_OFF))[e] = ((unsigned)dist < 128u) ? F.in[1][(int)kBucket[dist & 127] * NQH + kvh * 4 + hl] * LOG2E : -INFINITY; }
    }
    bf16x8 qf2[2][4];
    { const float* qg = F.in[4]; f32x4 gq[4][2];
#pragma unroll
      for (int ks = 0; ks < 4; ++ks) { gq[ks][0] = *(const f32x4*)(qg + 16 * ks + 8 * hh); gq[ks][1] = *(const f32x4*)(qg + 16 * ks + 8 * hh + 4); }
#pragma unroll
      for (int it = 0; it < 2; ++it) { float ss = 0.f;
#pragma unroll
        for (int ks = 0; ks < 4; ++ks) { const u32x4 w_ = qraw[it][ks];
            const float a0 = bf_lo(w_.x), a1 = bf_hi(w_.x), a2 = bf_lo(w_.y), a3 = bf_hi(w_.y), a4 = bf_lo(w_.z), a5 = bf_hi(w_.z), a6 = bf_lo(w_.w), a7 = bf_hi(w_.w);
            ss += (a0 * a0 + a1 * a1) + (a2 * a2 + a3 * a3) + (a4 * a4 + a5 * a5) + (a6 * a6 + a7 * a7); }
        ss += __shfl_xor(ss, 32);
        const float sc = (1.0f / sqrtf(ss * (1.0f / 64.0f) + EPS)) * (0.125f * LOG2E);
#pragma unroll
        for (int ks = 0; ks < 4; ++ks) { const u32x4 w_ = qraw[it][ks]; const f32x4 g0 = gq[ks][0], g1 = gq[ks][1];
            u32x4 w; w.x = cvt_pk_bf16(bf_lo(w_.x) * sc * g0[0], bf_hi(w_.x) * sc * g0[1]); w.y = cvt_pk_bf16(bf_lo(w_.y) * sc * g0[2], bf_hi(w_.y) * sc * g0[3]);
            w.z = cvt_pk_bf16(bf_lo(w_.z) * sc * g1[0], bf_hi(w_.z) * sc * g1[1]); w.w = cvt_pk_bf16(bf_lo(w_.w) * sc * g1[2], bf_hi(w_.w) * sc * g1[3]);
            qf2[it][ks] = __builtin_bit_cast(bf16x8, w); } } }
    __syncthreads();
    for (int trep = 0; trep < TASK_REPS; ++trep)
#pragma unroll
    for (int it = 0; it < 2; ++it) {
        float* ssq_a = (trep == TASK_REPS - 1) ? ssq_real : (float*)(F.ws + WS_SSQ_T);
        const int task = wave + 8 * it, hl = task >> 2, grp = task & 3, hq = kvh * 4 + hl, qi = 32 * grp + q;
        const bf16x8 (&qf)[4] = qf2[it];
        const LAS float* tb = (const LAS float*)(lds + ATT_B_OFF) + hl * ATT_TAB + (q + 128 - 4 * hh + 32 - 155);
        const float sink2 = F.in[6][hq] * LOG2E;
        f32x16 s[5];
#pragma unroll
        for (int kt = 0; kt < 5; ++kt) {
            f32x16 a;
#pragma unroll
            for (int r = 0; r < 16; ++r) a[r] = tb[155 - 32 * kt - ((r & 3) + 8 * (r >> 2))];
#pragma unroll
            for (int ks = 0; ks < 4; ++ks) { const bf16x8 kf = *(const LAS bf16x8*)(lds + ATT_K_OFF + (32 * (grp + kt) + q) * ATT_KROW + (16 * ks + 8 * hh) * 2);
                a = __builtin_amdgcn_mfma_f32_32x32x16_bf16(kf, qf[ks], a, 0, 0, 0); }
            if (qb == 0 && grp + kt < 4) {
#pragma unroll
                for (int r = 0; r < 16; ++r) a[r] = -INFINITY; }
            s[kt] = a;
        }
        float mx = sink2;
#pragma unroll
        for (int kt = 0; kt < 5; ++kt)
#pragma unroll
            for (int r = 0; r < 16; ++r) mx = fmaxf(mx, s[kt][r]);
        mx = fmaxf(mx, __shfl_xor(mx, 32));
        float l = 0.f;
#pragma unroll
        for (int kt = 0; kt < 5; ++kt)
#pragma unroll
            for (int r = 0; r < 16; ++r) { const float p = fast_exp2(s[kt][r] - mx); s[kt][r] = p; l += p; }
        l += __shfl_xor(l, 32);
        l += fast_exp2(sink2 - mx);
        f32x16 o[2]; o[0] = (f32x16){}; o[1] = (f32x16){};
#pragma unroll
        for (int kt = 0; kt < 5; ++kt)
#pragma unroll
            for (int s2 = 0; s2 < 2; ++s2) {
                u32x4 pw; pw.x = cvt_pk_bf16(s[kt][8 * s2 + 0], s[kt][8 * s2 + 1]); pw.y = cvt_pk_bf16(s[kt][8 * s2 + 2], s[kt][8 * s2 + 3]); pw.z = cvt_pk_bf16(s[kt][8 * s2 + 4], s[kt][8 * s2 + 5]); pw.w = cvt_pk_bf16(s[kt][8 * s2 + 6], s[kt][8 * s2 + 7]);
                const bf16x8 pb = __builtin_bit_cast(bf16x8, pw);
#pragma unroll
                for (int d0 = 0; d0 < 2; ++d0) { const LAS unsigned char* vp = lds + ATT_V_OFF + (32 * d0 + q) * ATT_VROW + (32 * (grp + kt) + 16 * s2 + 4 * hh) * 2;
                    const u32x2 lo = *(const LAS u32x2*)vp, hi = *(const LAS u32x2*)(vp + 16);
                    const u32x4 vv = {lo.x, lo.y, hi.x, hi.y};
                    o[d0] = __builtin_amdgcn_mfma_f32_32x32x16_bf16(__builtin_bit_cast(bf16x8, vv), pb, o[d0], 0, 0, 0); }
            }
        const float inv = 1.0f / l; float sq = 0.f;
        bf16_t* op = mixed + (size_t)(T0 + qi) * 2048 + hq * 64 + 4 * hh;
#pragma unroll
        for (int d0 = 0; d0 < 2; ++d0)
#pragma unroll
            for (int r4 = 0; r4 < 4; ++r4) { const float v0 = o[d0][4 * r4] * inv, v1 = o[d0][4 * r4 + 1] * inv, v2 = o[d0][4 * r4 + 2] * inv, v3 = o[d0][4 * r4 + 3] * inv;
                sq += (v0 * v0 + v1 * v1) + (v2 * v2 + v3 * v3);
                u32x2 w; w.x = cvt_pk_bf16(v0, v1); w.y = cvt_pk_bf16(v2, v3); *(u32x2*)(op + 32 * d0 + 8 * r4) = w; }
        sq += __shfl_xor(sq, 32);
        if (hh == 0) atomicAdd(ssq_a + T0 + qi, sq);
    }
    __syncthreads();
}

template <int MODE = 7>
__device__ __forceinline__ void ssm_unit(Frame& F, int pm) {
    const int g = pm >> 2;
    bf16_t* Ag = (bf16_t*)(F.ws + WS_AG);
    if constexpr (MODE & 1) {
        int Kc = 256; asm volatile("" : "+s"(Kc));
        pg8::Gemm gm{(const char*)Ag, (const char*)(F.ws + WS_PG), Kc, SSM_KA * 2, 32, 128, 256 * 2};
        pg8::OneUnit S1{pm, g}; EpiS E{};
        pg8::gemm_phase<EpiS, pg8::OneUnit, false>(F.lds, F.wave, gm, S1, E);
    }
    asm volatile("s_waitcnt lgkmcnt(0)" ::: "memory");
    __syncthreads();
    if ((MODE & 2) && F.wave == 0) {
        const int n = lane_id();
        const f32x2 l16 = *((const f32x2*)(F.ws + WS_L16) + g * 64 + n);
        float hr = 0.f, hi = 0.f;
        unsigned* hp = (unsigned*)(Ag + (size_t)pm * 256 * SSM_KA + 256) + n;
        for (int c0 = 0; c0 < 256; c0 += 8) {
            f32x2 sv[8];
#pragma unroll
            for (int j = 0; j < 8; ++j) sv[j] = *(const LAS f32x2*)(F.lds + (c0 + j) * 512 + ((8 * n) ^ (j << 4)));
#pragma unroll
            for (int j = 0; j < 8; ++j) { hp[(size_t)(c0 + j) * (SSM_KA / 2)] = cvt_pk_bf16(hr, hi);
                const float nr = l16.x * hr - l16.y * hi + sv[j].x, ni = l16.x * hi + l16.y * hr + sv[j].y; hr = nr; hi = ni; }
        }
    }
    asm volatile("s_waitcnt vmcnt(0) lgkmcnt(0)" ::: "memory");
    __syncthreads();
    if constexpr (MODE & 4) {
        int Kc = SSM_KA; asm volatile("" : "+s"(Kc));
        pg8::Gemm gm{(const char*)Ag, (const char*)(F.ws + WS_BG), Kc, SSM_KA * 2, 32, 128, SSM_KA * 2};
        pg8::OneUnit S1{pm, g}; EpiY E{Ag, F.in[14], (bf16_t*)(F.ws + WS_YG)};
        pg8::gemm_phase<EpiY, pg8::OneUnit, false>(F.lds, F.wave, gm, S1, E);
    }
}


#define XB_TMO      128
#define XB_XCNT(j)  (256  + 64 * (j))
#define XB_XSUB(j)  (1280 + 64 * (j))
#define XB_XGEN(j)  (2304 + 64 * (j))
#define XB_TOP      3328
#define XB_TOPGEN   3392
#define XCD_BAR_WORDS 3456
#define XB_SPIN_CAP (1u << 22)
constexpr size_t WS_BAR = 16384;
__device__ __forceinline__ unsigned xb_ld(unsigned* p)              { return __hip_atomic_load(p, __ATOMIC_RELAXED, __HIP_MEMORY_SCOPE_AGENT); }
__device__ __forceinline__ unsigned xb_add(unsigned* p, unsigned v) { return __hip_atomic_fetch_add(p, v, __ATOMIC_RELAXED, __HIP_MEMORY_SCOPE_AGENT); }
__device__ __forceinline__ unsigned xb_xcc_id() { return (unsigned)__builtin_amdgcn_s_getreg((3 << 11) | 20) & 0xFu; }
#define XB_SPIN(cond, bar) do { unsigned _sp = 0; while (cond) { __builtin_amdgcn_s_sleep(1); \
    if ((++_sp & 255u) == 0u) { if (xb_ld(&(bar)[XB_TMO])) break; if (_sp > XB_SPIN_CAP) { atomicAdd(&(bar)[XB_TMO], 1u); break; } } } } while (0)
struct XcdBarrier { unsigned* bar; unsigned x; volatile LAS unsigned* st; };
__device__ __forceinline__ XcdBarrier xcd_barrier_post(unsigned* bar, volatile LAS unsigned* st) {
    XcdBarrier b; b.bar = bar; b.x = xb_xcc_id(); b.st = st;
    if (threadIdx.x == 0) (void)xb_add(&bar[XB_XCNT(b.x)], 1u);
    return b;
}
__device__ __forceinline__ void xcd_barrier_complete(unsigned* bar, unsigned x, unsigned& nloc, unsigned& nx) {
    const unsigned G = gridDim.x * gridDim.y * gridDim.z;
    unsigned sum, cnt, mine, sp = 0u;
    for (;;) {
        sum = 0u; cnt = 0u; mine = 0u;
#pragma unroll
        for (unsigned j = 0; j < 16; ++j) { const unsigned c = xb_ld(&bar[XB_XCNT(j)]); sum += c; cnt += (c > 0u) ? 1u : 0u; mine = (j == x) ? c : mine; }
        if (sum == G) break;
        __builtin_amdgcn_s_sleep(1);
        if ((++sp & 255u) == 0u) { if (xb_ld(&bar[XB_TMO])) break; if (sp > XB_SPIN_CAP) { atomicAdd(&bar[XB_TMO], 1u); break; } }
    }
    nloc = mine > 0u ? mine : 1u; nx = cnt > 0u ? cnt : 1u;
}
__device__ __forceinline__ void xcd_barrier(const XcdBarrier& b, int wave) {
    asm volatile("s_waitcnt vmcnt(0)" ::: "memory");
    __syncthreads();
    if (wave == 0 && lane_id() == 0) {
        unsigned* bar = b.bar;
        __builtin_amdgcn_s_waitcnt(0);
        unsigned nloc = b.st[0], nx = b.st[1];
        if (nloc == 0u) { xcd_barrier_complete(bar, b.x, nloc, nx); b.st[0] = nloc; b.st[1] = nx; }
        const unsigned old = xb_add(&bar[XB_XSUB(b.x)], 1u);
        const unsigned gen = old / nloc;
        if (old + 1u == (gen + 1u) * nloc) {
            __builtin_amdgcn_fence(__ATOMIC_RELEASE, "agent");
            asm volatile("s_waitcnt vmcnt(0)" ::: "memory");
            const unsigned og = xb_add(&bar[XB_TOP], 1u);
            const unsigned tg = og / nx;
            if (og + 1u == (tg + 1u) * nx) xb_add(&bar[XB_TOPGEN], 1u);
            else XB_SPIN(xb_ld(&bar[XB_TOPGEN]) == tg, bar);
            __builtin_amdgcn_fence(__ATOMIC_ACQUIRE, "agent");
            xb_add(&bar[XB_XGEN(b.x)], 1u);
            asm volatile("s_waitcnt vmcnt(0)" ::: "memory");
        } else {
            XB_SPIN(xb_ld(&bar[XB_XGEN(b.x)]) == gen, bar);
            __builtin_amdgcn_fence(__ATOMIC_ACQUIRE, "agent");
            asm volatile("s_waitcnt vmcnt(0)" ::: "memory");
        }
    }
    __syncthreads();
}

struct Args { const float* in[23]; float* out; unsigned char* ws; int ph_lo, ph_hi; };
__global__ void __launch_bounds__(NWAVES * 64, 2) hymba_fwd(Args args) {
    extern __shared__ __attribute__((aligned(16))) unsigned char lds_raw[];
    Frame F;
    F.lds = (LAS unsigned char*)lds_raw;
    F.wave = __builtin_amdgcn_readfirstlane((int)threadIdx.x >> 6);
    F.G = gridDim.x; { const int bx = blockIdx.x; F.vcu = (F.G % 8 == 0) ? (bx % 8) * (F.G / 8) + bx / 8 : bx; }
    F.in = args.in; F.out = args.out; F.ws = args.ws;
    const int lo = args.ph_lo, hi = args.ph_hi;
    for (int u = threadIdx.x; u < (LDS_BYTES - LDSCTL_OFF) / 4; u += NWAVES * 64) ((LAS unsigned*)(F.lds + LDSCTL_OFF))[u] = 0u;
    __syncthreads();
    XcdBarrier bar; bar.bar = (unsigned*)(F.ws + WS_BAR); bar.x = 0; bar.st = nullptr;
    if (MK_N_LAUNCHES == 1) bar = xcd_barrier_post((unsigned*)(F.ws + WS_BAR), (volatile LAS unsigned*)(F.lds + MISC_OFF) + 8);
#define IN(k) (lo <= (k) && (k) < hi)
#define GRID_BAR(k) do { if (IN(k) && IN((k) + 1)) xcd_barrier(bar, F.wave); } while (0)
    unsigned char* ws = F.ws;
    float* const ssq_trash = (float*)(ws + WS_SSQ_T);
#define PHASE0(DRY) { p0_prologue(F); }
#define PHASE1(DRY) {     \
        pg8::Gemm g{(const char*)(ws + WS_XN), (const char*)(ws + WS_WIN), D_MODEL, D_MODEL * 2, 32, 128, D_MODEL * 2}; \
        pg8::StaticOrder S; S.init(M, IN_W, F.G, (int)blockIdx.x); \
        EpiIn E{(bf16_t*)(ws + WS_Q), (bf16_t*)(ws + WS_K), (bf16_t*)(ws + WS_V), (bf16_t*)(ws + WS_AG)}; \
        pg8::gemm_phase<EpiIn, pg8::StaticOrder, true>(F.lds, F.wave, g, S, E); \
        { const int nwg_ = (M / 256) * (IN_W / 256), maxu_ = (nwg_ + F.G - 1) / F.G, nheavy_ = nwg_ - (maxu_ - 1) * F.G, nlight_ = F.G - nheavy_, c_ = (int)blockIdx.x;     \
          if (nlight_ == 0) convert_late_weights(F, c_ * NWAVES + F.wave, F.G * NWAVES); \
          else if (c_ >= nheavy_) convert_late_weights(F, (c_ - nheavy_) * NWAVES + F.wave, nlight_ * NWAVES); } }
#define PHASE2(DRY) { \
        float* const sa_ = (DRY) ? ssq_trash : (float*)(ws + WS_SSQ_A); \
        for (int u = F.vcu; u < BATCH * 32 * NKVH; u += F.G) attn_unit<(PROBE_REP == 25 ? 2 : 1), (PROBE_REP == 26 ? 2 : 1)>(F, u >> 7, (u >> 2) & 31, u & 3, sa_); \
        if (F.vcu < 256) ssm_unit(F, F.vcu);     }
#define PHASE3(DRY) {     \
        pg8::Gemm g{(const char*)(ws + WS_YG), (const char*)(ws + WS_WGLU), SSM_W, 32, (unsigned)(M * 32), (unsigned)(4 * M * 32), SSM_W * 2}; \
        pg8::StaticOrder S; S.init(M, SSM_W, F.G, (int)blockIdx.x); \
        EpiGlu E{(const bf16_t*)(ws + WS_YG), (bf16_t*)(ws + WS_MIX), (DRY) ? ssq_trash : (float*)(ws + WS_SSQ_S)}; \
        pg8::gemm_phase<EpiGlu, pg8::StaticOrder, true>(F.lds, F.wave, g, S, E); }
#define PHASE4(DRY) {     \
        pg8::Gemm g{(const char*)(ws + WS_MIX), (const char*)(ws + WS_WOUT), 2048, 2048 * 2, 32, 128, 2048 * 2}; \
        pg8::StaticOrder S; S.init(M, D_MODEL, F.G, (int)blockIdx.x); \
        EpiOut E{(const bf16_t*)(ws + WS_XN), (const float*)(ws + WS_IRSTD1), (bf16_t*)(ws + WS_XN), (const float*)(ws + WS_SSQ_A), (const float*)(ws + WS_SSQ_S), (DRY) ? ssq_trash : (float*)(ws + WS_SSQ_X)}; \
        pg8::gemm_phase<EpiOut, pg8::StaticOrder, true>(F.lds, F.wave, g, S, E); }
#define PHASE5(DRY) {     \
        pg8::Gemm g{(const char*)(ws + WS_XN), (const char*)(ws + WS_WGU), D_MODEL, D_MODEL * 2, 32, 128, D_MODEL * 2}; \
        pg8::StaticOrder S; S.init(M, 2 * FF, F.G, (int)blockIdx.x); \
        EpiGU E{(const float*)(ws + WS_SSQ_X), (bf16_t*)(ws + WS_H)}; \
        pg8::gemm_phase<EpiGU, pg8::StaticOrder, true>(F.lds, F.wave, g, S, E); }
#define PHASE6(DRY) {     \
        pg8::Gemm g{(const char*)(ws + WS_H), (const char*)(ws + WS_WDN), FF, FF * 2, 32, 128, FF * 2}; \
        pg8::StaticOrder S; S.init(M, D_MODEL, F.G, (int)blockIdx.x); \
        EpiDown<(DRY)> E{(const bf16_t*)(ws + WS_XN), F.out, (float*)(ws + WS_SSCR)}; \
        pg8::gemm_phase<EpiDown<(DRY)>, pg8::StaticOrder, true>(F.lds, F.wave, g, S, E); }
#define PHASE2A(DRY) { for (int u = F.vcu; u < BATCH * 32 * NKVH; u += F.G) attn_unit(F, u >> 7, (u >> 2) & 31, u & 3, ssq_trash); }
#define PHASE2S(DRY) { if (F.vcu < 256) ssm_unit(F, F.vcu); }
#define RUN_PHASE(k, BODY) do { if (PROBE_REP == (k) && IN(k)) { BODY(1); xcd_barrier(bar, F.wave); } if (IN(k)) { BODY(0); } } while (0)
    RUN_PHASE(0, PHASE0);
    GRID_BAR(0);
    if (args.ph_lo < 0) cg::this_grid().sync();
    RUN_PHASE(1, PHASE1);
    GRID_BAR(1);
    if (PROBE_REP == 22 && IN(2)) { if (F.vcu < 256) ssm_unit<1>(F, F.vcu); xcd_barrier(bar, F.wave); }
    if (PROBE_REP == 23 && IN(2)) { if (F.vcu < 256) ssm_unit<2>(F, F.vcu); xcd_barrier(bar, F.wave); }
    if (PROBE_REP == 24 && IN(2)) { if (F.vcu < 256) ssm_unit<4>(F, F.vcu); xcd_barrier(bar, F.wave); }
    if (PROBE_REP == 20 && IN(2)) { PHASE2A(1); xcd_barrier(bar, F.wave); }
    if (PROBE_REP == 21 && IN(2)) { PHASE2S(1); xcd_barrier(bar, F.wave); }
    RUN_PHASE(2, PHASE2);
    GRID_BAR(2);
    RUN_PHASE(3, PHASE3);
    GRID_BAR(3);
    RUN_PHASE(4, PHASE4);
    GRID_BAR(4);
    RUN_PHASE(5, PHASE5);
    GRID_BAR(5);
    RUN_PHASE(6, PHASE6);
#undef IN
#undef GRID_BAR
}

extern "C" void kernel_launch(void* const* d_in, const int* in_sizes, int n_in, void* d_out, int out_size, void* d_ws, size_t ws_size, hipStream_t stream) {
    static int grid = 0;
    if (grid == 0) {
        if (n_in != 23 || in_sizes[0] != M * D_MODEL || out_size != M * D_MODEL || ws_size < WS_END) { fprintf(stderr, "kernel_launch: unexpected sizes (n_in %d, out %d, ws %zu); nothing launched\n", n_in, out_size, ws_size); grid = -1; return; }
        int dev = 0, cus = 0, per_cu = 0;
        if (hipGetDevice(&dev) != hipSuccess || hipDeviceGetAttribute(&cus, hipDeviceAttributeMultiprocessorCount, dev) != hipSuccess) { grid = -1; return; }
        if (hipFuncSetAttribute((const void*)hymba_fwd, hipFuncAttributeMaxDynamicSharedMemorySize, LDS_BYTES) != hipSuccess) { fprintf(stderr, "kernel_launch: hipFuncSetAttribute failed\n"); grid = -1; return; }
        if (hipOccupancyMaxActiveBlocksPerMultiprocessor(&per_cu, (const void*)hymba_fwd, NWAVES * 64, LDS_BYTES) != hipSuccess || per_cu < 1) { fprintf(stderr, "kernel_launch: occupancy query failed (%d)\n", per_cu); (void)hipGetLastError(); grid = -1; return; }
        grid = cus;
        if (grid < 256) { fprintf(stderr, "kernel_launch: this kernel needs >= 256 CUs (got %d); nothing launched\n", grid); grid = -1; return; }
    }
    if (grid < 0) return;
    (void)hipMemsetAsync((char*)d_ws + WS_CTL, 0, CTL_ZERO_BYTES, stream);
    Args a{};
    for (int i = 0; i < 23; ++i) a.in[i] = (const float*)d_in[i];
    a.out = (float*)d_out; a.ws = (unsigned char*)d_ws;
    constexpr int NPH = 7;
    for (int li = 0; li < MK_N_LAUNCHES; ++li) {
        a.ph_lo = (MK_N_LAUNCHES == 1) ? 0 : li; a.ph_hi = (MK_N_LAUNCHES == 1) ? NPH : li + 1;
        void* kargs[] = {&a};
        const hipError_t e = hipLaunchCooperativeKernel((const void*)hymba_fwd, dim3(grid), dim3(NWAVES * 64), kargs, LDS_BYTES, stream);
        if (e != hipSuccess) { fprintf(stderr, "kernel_launch: cooperative launch failed: %s (grid %d)\n", hipGetErrorString(e), grid); break; }
    }
}
```

```cpp
#include <hip/hip_runtime.h>
#include <hip/hip_cooperative_groups.h>
#include <cstdio>
#include <cstdint>
namespace cg = cooperative_groups;

#ifndef PROBE_REP
#define PROBE_REP -1
#endif
#ifndef WGM_P1
#define WGM_P1 4
#define WGM_P3 4
#define WGM_P4 4
#define WGM_P5 4
#define WGM_P6 4
#endif
#ifndef MK_N_LAUNCHES
#define MK_N_LAUNCHES 1
#endif

#define LAS __attribute__((address_space(3)))
typedef unsigned short bf16_t;
typedef short bf16x8 __attribute__((ext_vector_type(8)));
typedef float f32x4 __attribute__((ext_vector_type(4)));
typedef float f32x2 __attribute__((ext_vector_type(2)));
typedef float f32x16 __attribute__((ext_vector_type(16)));
typedef unsigned u32x4 __attribute__((ext_vector_type(4)));
typedef unsigned u32x2 __attribute__((ext_vector_type(2)));

constexpr int D_MODEL = 2048, BATCH = 4, SEQ = 4096, M = BATCH * SEQ;
constexpr int HD = 64, NQH = 16, NKVH = 4, ATTN_W = 1024, KV_W = 256;
constexpr int SSM_W = 1024, SSM_P = 16, SSM_G = 64, SSM_N = 64, IN_W = 2560, FF = 5632;
constexpr int CH_T = 16;
constexpr int SSM_KA = CH_T * SSM_P + 2 * SSM_N;
constexpr float EPS = 1e-6f;
constexpr float LOG2E = 1.4426950408889634f;

__device__ const unsigned char kBucket[128] = {0, 1, 2, 3, 4, 5, 6, 7, 8, 9, 10, 11, 12, 13, 14, 15, 16, 16, 16, 17, 17, 18, 18, 18, 19, 19, 19, 20, 20, 20, 20, 21, 21, 21, 21, 22, 22, 22, 22, 22, 23, 23, 23, 23, 23, 23, 24, 24, 24, 24, 24, 24, 25, 25, 25, 25, 25, 25, 25, 26, 26, 26, 26, 26, 26, 26, 26, 27, 27, 27, 27, 27, 27, 27, 27, 27, 27, 28, 28, 28, 28, 28, 28, 28, 28, 28, 28, 29, 29, 29, 29, 29, 29, 29, 29, 29, 29, 29, 29, 30, 30, 30, 30, 30, 30, 30, 30, 30, 30, 30, 30, 30, 30, 31, 31, 31, 31, 31, 31, 31, 31, 31, 31, 31, 31, 31, 31, 31};

__device__ __forceinline__ unsigned cvt_pk_bf16(float lo, float hi) { unsigned r; asm volatile("v_cvt_pk_bf16_f32 %0, %1, %2" : "=v"(r) : "v"(lo), "v"(hi)); return r; }
__device__ __forceinline__ float bf_lo(unsigned w) { return __builtin_bit_cast(float, w << 16); }
__device__ __forceinline__ float bf_hi(unsigned w) { return __builtin_bit_cast(float, w & 0xffff0000u); }
__device__ __forceinline__ float fast_rcp(float x) { return __builtin_amdgcn_rcpf(x); }
__device__ __forceinline__ float fast_exp2(float x) { return __builtin_amdgcn_exp2f(x); }
__device__ __forceinline__ float sigmoidf_fast(float x) { return fast_rcp(1.0f + fast_exp2(-LOG2E * x)); }
__device__ __forceinline__ float gelu_tanh(float x) {
    const float u2 = 1.5957691216057308f * (x + 0.044715f * x * x * x);
    return x * sigmoidf_fast(u2);
}

__device__ __forceinline__ int lane_id() { int l = __builtin_amdgcn_mbcnt_hi(~0u, __builtin_amdgcn_mbcnt_lo(~0u, 0u)); asm volatile("" : "+v"(l)); return l; }

namespace pg8 {
constexpr int BM = 256, BK = 64, HALF = 128, HTB = HALF * BK * 2  , STAGE_BYTES = 8 * HTB, NXCD = 8, WGM = 4;
__host__ __device__ __forceinline__ int lds_byte(int r, int c) { const int st = (r >> 4) * 2 + (c >> 5), rr = r & 15, cc = c & 31, ob = rr * 64 + cc * 2; return st * 1024 + (ob ^ (((ob >> 9) & 1) << 5)); }
__host__ __device__ __forceinline__ void stage_rc(int b, int& R, int& C) { const int st = b / 1024, sb = b % 1024, swz = sb ^ (((sb >> 9) & 1) << 5); R = (st >> 1) * 16 + swz / 64; C = (st & 1) * 32 + (swz % 64) / 2; }
__host__ __device__ __forceinline__ int perm32(int rho) { const int n = rho >> 4, i = rho & 15; return 8 * (i >> 2) + 4 * n + (i & 3); }

struct Unit { int pm, pn; unsigned aofs, bofs; int part; };
struct Gemm { const char* A; const char* B; int K; unsigned a_rs, a_cs, a_ks, b_rs; };

struct StaticOrder {
    int nM, nN, nwg, G, c, wgm;
    __device__ void init(int Mr, int N, int G_, int c_, int wgm_ = WGM) { nM = Mr / BM; nN = N / BM; nwg = nM * nN; G = G_; c = c_; wgm = wgm_; }
    __device__ bool next(int i, Unit& u) const {
        const long L = (long)i * G + c; if (L >= nwg) return false;
        int wgid = (int)L; { const int q = nwg / NXCD, r = nwg % NXCD, xcd = wgid % NXCD, off = wgid / NXCD; wgid = (xcd < r ? xcd * (q + 1) : r * (q + 1) + (xcd - r) * q) + off; }
        const int nig = wgm * nN, gid = wgid / nig, fm = gid * wgm, gsz = (nM - fm) < wgm ? (nM - fm) : wgm;
        u.pm = fm + ((wgid % nig) % gsz); u.pn = (wgid % nig) / gsz; u.aofs = 0; u.bofs = 0; u.part = 0; return true;
    }
};
struct TwoPartOrder {
    StaticOrder S; unsigned kofs;
    __device__ bool next(int i, Unit& u) const { if (!S.next(i >> 1, u)) return false; u.part = i & 1; u.aofs = u.bofs = (i & 1) ? kofs : 0u; return true; }
};
struct OneUnit {
    int pm, pn;
    __device__ bool next(int i, Unit& u) const { if (i) return false; u.pm = pm; u.pn = pn; u.aofs = 0; u.bofs = 0; u.part = 0; return true; }
};

template <class Epi, class Sched, bool ALIGN_EPI>
__device__ __forceinline__ void gemm_phase(LAS unsigned char* lds, const int wid  , const Gemm g, const Sched& S, const Epi& E) {
    const int lane = lane_id(), tid = wid * 64 + lane, wr = wid >> 2, wc = wid & 3, fr = lane & 15, fq = lane >> 4;
    const int nt = g.K / BK;
    unsigned voffA[2], voffB[2];
#pragma unroll
    for (int i = 0; i < 2; ++i) { int R, C; stage_rc(tid * 16 + i * 8192, R, C); const int Rb = Epi::PERM ? ((R & ~31) + perm32(R & 31)) : R;
        voffA[i] = (unsigned)R * g.a_rs + (unsigned)(C >> 4) * g.a_cs + (unsigned)(C & 15) * 2u; voffB[i] = (unsigned)Rb * g.b_rs + (unsigned)C * 2u; }
    const size_t kstepA = g.a_ks, kstepB = (size_t)(BK * 2);
    const size_t hstepA = (size_t)HALF * g.a_rs, hstepB = (size_t)HALF * g.b_rs, tstepA = 2 * hstepA, tstepB = 2 * hstepB;
    const unsigned ldsw = (unsigned)wid * 1024u;
    const int aoff = lds_byte(wr * 64 + fr, fq * 8), boff = lds_byte(wc * 32 + fr, fq * 8);
#define PG8_SA(b, h) (((b) * 2 + (h)) * HTB)
#define PG8_SB(b, h) ((4 + (b) * 2 + (h)) * HTB)
#define PG8_STAGE(bufoff, gbase, voff) do { _Pragma("unroll") for (int _i = 0; _i < 2; ++_i) \
        __builtin_amdgcn_global_load_lds((const unsigned*)((const char*)(gbase) + (voff)[_i]), (LAS unsigned*)(lds + (bufoff) + ldsw + _i * 8192), 16, 0, 0); } while (0)
#define PG8_LDA(dst, b, h) do { _Pragma("unroll") for (int m = 0; m < 4; ++m) _Pragma("unroll") for (int k = 0; k < 2; ++k) dst[m][k] = *(const LAS bf16x8*)(lds + PG8_SA(b, h) + aoff + m * 2048 + k * 1024); } while (0)
#define PG8_LDB(dst, b, h) do { _Pragma("unroll") for (int n = 0; n < 2; ++n) _Pragma("unroll") for (int k = 0; k < 2; ++k) dst[n][k] = *(const LAS bf16x8*)(lds + PG8_SB(b, h) + boff + n * 2048 + k * 1024); } while (0)
#define PG8_MMA(ai, bj, At, Bt) do { __builtin_amdgcn_s_setprio(1); _Pragma("unroll") for (int m = 0; m < 4; ++m) _Pragma("unroll") for (int n = 0; n < 2; ++n) _Pragma("unroll") for (int k = 0; k < 2; ++k) \
        acc[ai][bj][m][n] = __builtin_amdgcn_mfma_f32_16x16x32_bf16(Bt[n][k], At[m][k], acc[ai][bj][m][n], 0, 0, 0); __builtin_amdgcn_s_setprio(0); } while (0)
#define PG8_WAIT_V(n) asm volatile("s_waitcnt vmcnt(" #n ")" ::: "memory")
#define PG8_WAIT_L(n) asm volatile("s_waitcnt lgkmcnt(" #n ")" ::: "memory")
#define PG8_BAR __builtin_amdgcn_s_barrier()
#define PG8_SCHED __builtin_amdgcn_sched_barrier(0)
    Unit cur, nxt; int ui = 0;
    if (!S.next(0, cur)) return;
    f32x4 acc[2][2][4][2];
#pragma unroll
    for (int a = 0; a < 2; ++a)
#pragma unroll
        for (int b = 0; b < 2; ++b)
#pragma unroll
            for (int m = 0; m < 4; ++m)
#pragma unroll
                for (int n = 0; n < 2; ++n) acc[a][b][m][n] = (f32x4){0.f, 0.f, 0.f, 0.f};
    bf16x8 At[4][2], B0[2][2], B1[2][2];
    const char* cA = g.A + (size_t)cur.pm * tstepA + cur.aofs; const char* cB = g.B + (size_t)cur.pn * tstepB + cur.bofs;
    PG8_STAGE(PG8_SB(0, 0), cB, voffB); PG8_STAGE(PG8_SB(0, 1), cB + hstepB, voffB); PG8_STAGE(PG8_SA(0, 0), cA, voffA); PG8_STAGE(PG8_SA(0, 1), cA + hstepA, voffA);
    if (wr == 1) PG8_BAR;
    PG8_WAIT_V(2); PG8_BAR;
    PG8_STAGE(PG8_SB(1, 0), cB + kstepB, voffB); PG8_STAGE(PG8_SA(1, 0), cA + kstepA, voffA); PG8_STAGE(PG8_SB(1, 1), cB + hstepB + kstepB, voffB);
    PG8_WAIT_V(6); PG8_BAR;
    for (;;) {
        const bool has_next = S.next(ui + 1, nxt);
        const char* nA = has_next ? g.A + (size_t)nxt.pm * tstepA + nxt.aofs : cA; const char* nB = has_next ? g.B + (size_t)nxt.pn * tstepB + nxt.bofs : cB;
        for (int t = 0; t < nt; t += 2) {
            if constexpr (Epi::MID_T > 0) { if (t == Epi::MID_T) E.mid(acc, cur, wr, wc, fr, fq); }
            const bool last = (t == nt - 2);
            const char* a1 = cA + (size_t)(t + 1) * kstepA;
            const char* a2 = last ? nA : cA + (size_t)(t + 2) * kstepA; const char* b2 = last ? nB : cB + (size_t)(t + 2) * kstepB;
            const char* a3 = a2 + kstepA; const char* b3 = b2 + kstepB;
            PG8_LDB(B0, 0, 0); PG8_LDB(B1, 0, 1); PG8_SCHED; PG8_LDA(At, 0, 0); PG8_STAGE(PG8_SA(1, 1), a1 + hstepA, voffA);
            PG8_WAIT_V(8); PG8_WAIT_L(0); PG8_BAR; PG8_MMA(0, 0, At, B0); PG8_MMA(0, 1, At, B1); PG8_BAR; PG8_SCHED;
            PG8_LDA(At, 0, 1); PG8_STAGE(PG8_SB(0, 0), b2, voffB); PG8_STAGE(PG8_SB(0, 1), b2 + hstepB, voffB); PG8_STAGE(PG8_SA(0, 0), a2, voffA);
            PG8_WAIT_V(8); PG8_WAIT_L(0); PG8_BAR; PG8_MMA(1, 0, At, B0); PG8_MMA(1, 1, At, B1); PG8_BAR; PG8_SCHED;
            PG8_LDB(B0, 1, 0); PG8_LDB(B1, 1, 1); PG8_SCHED; PG8_LDA(At, 1, 0); PG8_STAGE(PG8_SA(0, 1), a2 + hstepA, voffA);
            PG8_WAIT_V(8); PG8_WAIT_L(0); PG8_BAR; PG8_MMA(0, 0, At, B0); PG8_MMA(0, 1, At, B1); PG8_BAR; PG8_SCHED;
            PG8_LDA(At, 1, 1); PG8_STAGE(PG8_SB(1, 0), b3, voffB); PG8_STAGE(PG8_SB(1, 1), b3 + hstepB, voffB); PG8_STAGE(PG8_SA(1, 0), a3, voffA);
            PG8_WAIT_V(8); PG8_WAIT_L(0); PG8_BAR; PG8_MMA(1, 0, At, B0); PG8_MMA(1, 1, At, B1); PG8_BAR; PG8_SCHED;
        }
        if constexpr (ALIGN_EPI) { if (wr == 0) PG8_BAR; }
        if constexpr (!Epi::AFTER_DRAIN) E(acc, cur, wr, wc, fr, fq);
        if (!has_next) break;
#pragma unroll
        for (int a = 0; a < 2; ++a)
#pragma unroll
            for (int b = 0; b < 2; ++b)
#pragma unroll
                for (int m = 0; m < 4; ++m)
#pragma unroll
                    for (int n = 0; n < 2; ++n) acc[a][b][m][n] = (f32x4){0.f, 0.f, 0.f, 0.f};
        cur = nxt; cA = nA; cB = nB; ++ui;
        if constexpr (ALIGN_EPI) { if (wr == 1) PG8_BAR; }
    }
    PG8_WAIT_V(0);
    if constexpr (!ALIGN_EPI) { if (wr == 0) PG8_BAR; }
    PG8_BAR;
    if constexpr (Epi::AFTER_DRAIN) E.fused(acc, cur, wr, wc, fr, fq, lds);
#undef PG8_SA
#undef PG8_SB
#undef PG8_STAGE
#undef PG8_LDA
#undef PG8_LDB
#undef PG8_MMA
#undef PG8_WAIT_V
#undef PG8_WAIT_L
#undef PG8_BAR
#undef PG8_SCHED
}
}

constexpr size_t MiB = 1u << 20;
constexpr size_t WS_CTL = 0, CTL_ZERO_BYTES = 1 * MiB;
constexpr size_t WS_SSQ_A = 256 * 1024, WS_SSQ_S = 320 * 1024, WS_SSQ_X = 384 * 1024, WS_SSQ_T = 448 * 1024  ;
constexpr size_t WS_IRSTD1 = 512 * 1024;
constexpr size_t WS_WIN = 2 * MiB;
constexpr size_t WS_WGLU = 12 * MiB;
constexpr size_t WS_WOUT = 14 * MiB;
constexpr size_t WS_WGU = 22 * MiB;
constexpr size_t WS_WDN = 66 * MiB;
constexpr size_t WS_BG = 88 * MiB;
constexpr size_t WS_PG = 100 * MiB;
constexpr size_t WS_L16 = 108 * MiB;
constexpr size_t WS_SSCR = 109 * MiB;
constexpr size_t WS_XN = 141 * MiB;
constexpr size_t WS_Q = 205 * MiB;
constexpr size_t WS_K = 237 * MiB;
constexpr size_t WS_V = 245 * MiB;
constexpr size_t WS_AG = 253 * MiB;
constexpr size_t WS_YG = 301 * MiB;
constexpr size_t WS_MIX = 333 * MiB;
constexpr size_t WS_H = 205 * MiB;
constexpr size_t WS_END = 397 * MiB;
static_assert(WS_H + (size_t)M * FF * 2 <= WS_END, "ws map");

constexpr int RING_BYTES = 131072;
constexpr int LDS_BYTES = 147456;
constexpr int NWAVES = 8;
constexpr int LDSCTL_OFF = RING_BYTES, MISC_OFF = LDSCTL_OFF + 320;

struct Frame {
    LAS unsigned char* lds;
    int wave, vcu, G;
    const float* const* in; float* out; unsigned char* ws;
};

__device__ __forceinline__ float wave_sum(float v) {
#pragma unroll
    for (int o = 1; o < 64; o <<= 1) v += __shfl_xor(v, o);
    return v;
}
__device__ __forceinline__ unsigned f2bf(float f) { unsigned u = __builtin_bit_cast(unsigned, f); return (u + 0x7fffu + ((u >> 16) & 1u)) >> 16; }
__device__ __forceinline__ unsigned pk2(float lo, float hi) { return f2bf(lo) | (f2bf(hi) << 16); }

struct TItem { const float* W; bf16_t* WT; const float* gain; int K, N, rmul, radd, item; };
__device__ __forceinline__ void titem_load(const TItem& t, float (&v)[32], int lane) {
    const int nblk = t.N / 32, kb = t.item / nblk, nb = t.item % nblk, k0 = 64 * kb, n0 = 32 * nb;
    const float* p = t.W + (size_t)(k0 + (lane >> 5)) * t.N + n0 + (lane & 31);
#pragma unroll
    for (int i = 0; i < 32; ++i) v[i] = p[(size_t)(2 * i) * t.N];
}
__device__ __forceinline__ void titem_store(const TItem& t, const float (&v)[32], LAS float* scr, int lane) {
    const int nblk = t.N / 32, kb = t.item / nblk, nb = t.item % nblk, k0 = 64 * kb, n0 = 32 * nb;
#pragma unroll
    for (int i = 0; i < 32; ++i) scr[(2 * i + (lane >> 5)) * 33 + (lane & 31)] = v[i];
    asm volatile("s_waitcnt lgkmcnt(0)" ::: "memory");
    const int c = lane & 7;
    float gv[8];
#pragma unroll
    for (int i = 0; i < 8; ++i) gv[i] = t.gain ? t.gain[k0 + 8 * c + i] : 1.0f;
#pragma unroll
    for (int j = 0; j < 4; ++j) { const int n = (lane >> 3) + 8 * j; const LAS float* s = scr + (8 * c) * 33 + n; const int nn = n0 + n; const int row = (nn >> 7) * t.rmul + t.radd + (nn & 127);
        u32x4 o; o.x = pk2(s[0 * 33] * gv[0], s[1 * 33] * gv[1]); o.y = pk2(s[2 * 33] * gv[2], s[3 * 33] * gv[3]); o.z = pk2(s[4 * 33] * gv[4], s[5 * 33] * gv[5]); o.w = pk2(s[6 * 33] * gv[6], s[7 * 33] * gv[7]);
        *(u32x4*)(t.WT + (size_t)row * t.K + k0 + 8 * c) = o; }
    asm volatile("s_waitcnt lgkmcnt(0)" ::: "memory");
}
__device__ __forceinline__ void rms_row_load(const float* xrow, f32x4 (&v)[8], int lane) {
    const f32x4* xr = (const f32x4*)xrow + lane;
#pragma unroll
    for (int j = 0; j < 8; ++j) v[j] = xr[64 * j];
}
__device__ __forceinline__ void rms_row_store(const f32x4 (&v)[8], float* irstd, bf16_t* orow, int lane) {
    float s = 0.f;
#pragma unroll
    for (int j = 0; j < 8; ++j) s += (v[j].x * v[j].x + v[j].y * v[j].y) + (v[j].z * v[j].z + v[j].w * v[j].w);
    const float ms = wave_sum(s) * (1.0f / D_MODEL) + EPS; const float rstd = 1.0f / sqrtf(ms);
    if (lane == 0) *irstd = sqrtf(ms);
    u32x2* o8 = (u32x2*)orow + lane;
#pragma unroll
    for (int j = 0; j < 8; ++j) { u32x2 w; w.x = pk2(v[j].x * rstd, v[j].y * rstd); w.y = pk2(v[j].z * rstd, v[j].w * rstd); o8[64 * j] = w; }
}
__device__ __forceinline__ void p0_ssm_tables(Frame& F, int g, int qr) {
    LAS float* LP = (LAS float*)F.lds; LAS float* BB = LP + 17 * 64 * 2; LAS float* CC = BB + 64 * 16 * 2; LAS float* KT = CC + 16 * 64 * 2;
    const float* a_re = F.in[7]; const float* a_im = F.in[8]; const float* log_dt = F.in[9]; const float* b_re = F.in[10]; const float* b_im = F.in[11]; const float* c_re = F.in[12]; const float* c_im = F.in[13];
    const int tid = F.wave * 64 + lane_id();
    if (tid < 64) {
        const int n = tid;
        const double dt = exp((double)log_dt[g]);
        const double are = (double)a_re[g * 64 + n], aim = (double)a_im[g * 64 + n];
        const double mag = exp(are * dt), ang = aim * dt;
        const double lre = mag * cos(ang), lim = mag * sin(ang);
        const double nr = lre - 1.0, ni = lim, den = are * are + aim * aim;
        const double fre = (nr * are + ni * aim) / den, fim = (ni * are - nr * aim) / den;
        double pr = 1.0, pi = 0.0;
        for (int t = 0; t <= 16; ++t) { LP[(t * 64 + n) * 2] = (float)pr; LP[(t * 64 + n) * 2 + 1] = (float)pi; const double nre = pr * lre - pi * lim, nim = pr * lim + pi * lre; pr = nre; pi = nim; }
        if (qr == 0) { float* l16 = (float*)(F.ws + WS_L16) + (g * 64 + n) * 2; l16[0] = LP[(16 * 64 + n) * 2]; l16[1] = LP[(16 * 64 + n) * 2 + 1]; }
        for (int p = 0; p < 16; ++p) { const double br = (double)b_re[(g * 64 + n) * 16 + p], bi = (double)b_im[(g * 64 + n) * 16 + p];
            BB[(n * 16 + p) * 2] = (float)(fre * br - fim * bi); BB[(n * 16 + p) * 2 + 1] = (float)(fre * bi + fim * br); }
    }
    for (int e = tid; e < 1024; e += 512) { CC[e * 2] = c_re[g * 1024 + e]; CC[e * 2 + 1] = c_im[g * 1024 + e]; }
    __syncthreads();
    {
        const int p = (tid >> 4) & 15, q = tid & 15, th = tid >> 8; float ka[8];
#pragma unroll
        for (int j = 0; j < 8; ++j) ka[j] = 0.f;
        for (int n = 0; n < 64; ++n) {
            const f32x2 c = *(const LAS f32x2*)(CC + (p * 64 + n) * 2), bb = *(const LAS f32x2*)(BB + (n * 16 + q) * 2);
            const float cbr = c.x * bb.x - c.y * bb.y, cbi = c.x * bb.y + c.y * bb.x;
#pragma unroll
            for (int j = 0; j < 8; ++j) { const f32x2 l = *(const LAS f32x2*)(LP + ((8 * th + j) * 64 + n) * 2); ka[j] += cbr * l.x - cbi * l.y; }
        }
#pragma unroll
        for (int j = 0; j < 8; ++j) KT[((8 * th + j) * 16 + p) * 16 + q] = ka[j];
    }
    __syncthreads();
    bf16_t* Bg = (bf16_t*)(F.ws + WS_BG) + (size_t)g * 256 * SSM_KA;
    for (int ch = tid; ch < 64 * 48; ch += 512) {
        const int rl = ch / 48, c8 = ch % 48, t = 4 * qr + (rl >> 4), p = rl & 15; float v[8];
        if (c8 < 32) { const int s = c8 >> 1, q0 = (c8 & 1) * 8;
#pragma unroll
            for (int i = 0; i < 8; ++i) v[i] = (s <= t) ? KT[((t - s) * 16 + p) * 16 + q0 + i] : 0.f;
        } else { const int n0 = (c8 - 32) * 4;
#pragma unroll
            for (int i = 0; i < 4; ++i) { const int n = n0 + i; const float cr = CC[(p * 64 + n) * 2], ci = CC[(p * 64 + n) * 2 + 1], lr = LP[((t + 1) * 64 + n) * 2], li = LP[((t + 1) * 64 + n) * 2 + 1];
                v[2 * i] = cr * lr - ci * li; v[2 * i + 1] = -(cr * li + ci * lr); }
        }
        u32x4 o; o.x = pk2(v[0], v[1]); o.y = pk2(v[2], v[3]); o.z = pk2(v[4], v[5]); o.w = pk2(v[6], v[7]);
        *(u32x4*)(Bg + (size_t)(t * 16 + p) * SSM_KA + c8 * 8) = o;
    }
    bf16_t* Pg = (bf16_t*)(F.ws + WS_PG) + (size_t)g * 256 * 256;
    for (int ch = tid; ch < 32 * 32; ch += 512) {
        const int rl = ch >> 5, c8 = ch & 31, n = 16 * qr + (rl >> 1), ri = rl & 1, s = c8 >> 1, q0 = (c8 & 1) * 8; float v[8];
        const float lr = LP[((15 - s) * 64 + n) * 2], li = LP[((15 - s) * 64 + n) * 2 + 1];
#pragma unroll
        for (int i = 0; i < 8; ++i) { const float br = BB[(n * 16 + q0 + i) * 2], bi = BB[(n * 16 + q0 + i) * 2 + 1]; v[i] = ri ? (lr * bi + li * br) : (lr * br - li * bi); }
        u32x4 o; o.x = pk2(v[0], v[1]); o.y = pk2(v[2], v[3]); o.z = pk2(v[4], v[5]); o.w = pk2(v[6], v[7]);
        *(u32x4*)(Pg + (size_t)(2 * n + ri) * 256 + c8 * 8) = o;
        *(u32x4*)(Pg + (size_t)(128 + 32 * qr + rl) * 256 + c8 * 8) = (u32x4){0u, 0u, 0u, 0u};
    }
    __syncthreads();
}
__device__ __forceinline__ void p0_prologue(Frame& F) {
    for (int it = F.vcu; it < 256; it += F.G) p0_ssm_tables(F, it >> 2, it & 3);
    LAS float* scr = (LAS float*)(F.lds + F.wave * 16384);
    const int lane = lane_id();
    const int gw = F.vcu * NWAVES + F.wave, NGW = F.G * NWAVES;
    constexpr int I_IN = (D_MODEL / 64) * (IN_W / 32);
    {
        TItem t{F.in[3], (bf16_t*)(F.ws + WS_WIN), F.in[2]  , D_MODEL, IN_W, 128, 0, 0};
        float va[32], vb[32];
        int it = gw;
        if (it < I_IN) { t.item = it; titem_load(t, va, lane); }
        for (; it < I_IN; it += 2 * NGW) {
            TItem t2 = t; const bool h2 = it + NGW < I_IN;
            if (h2) { t2.item = it + NGW; titem_load(t2, vb, lane); }
            t.item = it; titem_store(t, va, scr, lane);
            if (h2) { if (it + 2 * NGW < I_IN) { t.item = it + 2 * NGW; titem_load(t, va, lane); } titem_store(t2, vb, scr, lane); }
        }
    }
    {
        bf16_t* xn = (bf16_t*)(F.ws + WS_XN); const float* x = F.in[0]; float* ir = (float*)(F.ws + WS_IRSTD1);
        f32x4 ra[8], rb[8];
        int m = gw;
        if (m < M) rms_row_load(x + (size_t)m * D_MODEL, ra, lane);
        for (; m < M; m += 2 * NGW) {
            const bool h2 = m + NGW < M;
            if (h2) rms_row_load(x + (size_t)(m + NGW) * D_MODEL, rb, lane);
            rms_row_store(ra, ir + m, xn + (size_t)m * D_MODEL, lane);
            if (h2) { if (m + 2 * NGW < M) rms_row_load(x + (size_t)(m + 2 * NGW) * D_MODEL, ra, lane); rms_row_store(rb, ir + m + NGW, xn + (size_t)(m + NGW) * D_MODEL, lane); }
        }
    }
}
__device__ __forceinline__ bool late_item(Frame& F, int r, TItem& t) {
    constexpr int I_GLU = (SSM_W / 64) * (SSM_W / 32), I_OUT = (2048 / 64) * (D_MODEL / 32), I_G = (D_MODEL / 64) * (FF / 32), I_D = (FF / 64) * (D_MODEL / 32);
    if (r >= I_GLU + I_OUT + 2 * I_G + I_D) return false;
    if (r < I_GLU) { t = TItem{F.in[15], (bf16_t*)(F.ws + WS_WGLU), nullptr, SSM_W, SSM_W, 128, 0, r}; return true; } r -= I_GLU;
    if (r < I_OUT) {
        const int kb = r / (D_MODEL / 32); t = TItem{F.in[18], (bf16_t*)(F.ws + WS_WOUT), (kb < 16) ? F.in[16] : (F.in[17] - 1024), 2048, D_MODEL, 128, 0, r}; return true; } r -= I_OUT;
    if (r < I_G) { t = TItem{F.in[20], (bf16_t*)(F.ws + WS_WGU), F.in[19], D_MODEL, FF, 256, 0, r}; return true; } r -= I_G;
    if (r < I_G) { t = TItem{F.in[21], (bf16_t*)(F.ws + WS_WGU), F.in[19], D_MODEL, FF, 256, 128, r}; return true; } r -= I_G;
    t = TItem{F.in[22], (bf16_t*)(F.ws + WS_WDN), nullptr, FF, D_MODEL, 128, 0, r}; return true;
}
__device__ __forceinline__ void convert_late_weights(Frame& F, int w, int nw) {
    LAS float* scr = (LAS float*)(F.lds + F.wave * 16384);
    const int lane = lane_id();
    TItem ta, tb; float va[32], vb[32];
    int it = w;
    bool ha = late_item(F, it, ta);
    if (ha) titem_load(ta, va, lane);
    while (ha) {
        const bool hb = late_item(F, it + nw, tb);
        if (hb) titem_load(tb, vb, lane);
        titem_store(ta, va, scr, lane);
        it += 2 * nw;
        ha = hb && late_item(F, it, ta);
        if (hb) { if (ha) titem_load(ta, va, lane); titem_store(tb, vb, scr, lane); }
    }
}

using pg8::Unit;
struct EpiIn {
    static constexpr bool PERM = true, AFTER_DRAIN = false; static constexpr int MID_T = 0;
    bf16_t* Q; bf16_t* Kb; bf16_t* Vb; bf16_t* Ag;
    __device__ __forceinline__ void operator()(const f32x4 (&acc)[2][2][4][2], const Unit& u, int wr, int wc, int fr, int fq) const {
        asm volatile("" : "+v"(fr), "+v"(fq));
        const int row0 = u.pm * 256 + wr * 64 + fr, pn = u.pn;
#pragma unroll
        for (int ai = 0; ai < 2; ++ai)
#pragma unroll
            for (int m = 0; m < 4; ++m) { const int row = row0 + ai * 128 + m * 16;
#pragma unroll
                for (int bj = 0; bj < 2; ++bj) { const int col = bj * 128 + wc * 32 + 8 * fq; const f32x4 v0 = acc[ai][bj][m][0], v1 = acc[ai][bj][m][1];
                    u32x4 w; w.x = cvt_pk_bf16(v0[0], v0[1]); w.y = cvt_pk_bf16(v0[2], v0[3]); w.z = cvt_pk_bf16(v1[0], v1[1]); w.w = cvt_pk_bf16(v1[2], v1[3]);
                    bf16_t* dst;
                    if (pn < 4) dst = Q + (size_t)row * ATTN_W + pn * 256 + col;
                    else if (pn == 4) dst = Kb + (size_t)row * KV_W + col;
                    else if (pn == 5) dst = Vb + (size_t)row * KV_W + col;
                    else { const int c = (pn - 6) * 256 + col; dst = Ag + ((size_t)(c >> 4) * 1024 + (row >> 4)) * SSM_KA + (row & 15) * 16 + (c & 15); }
                    *(u32x4*)dst = w; } }
    }
};
struct EpiS {
    static constexpr bool PERM = false, AFTER_DRAIN = true; static constexpr int MID_T = 0;
    __device__ __forceinline__ void operator()(const f32x4 (&acc)[2][2][4][2], const Unit& u, int wr, int wc, int fr, int fq) const {}
    __device__ __forceinline__ void fused(const f32x4 (&acc)[2][2][4][2], const Unit& u, int wr, int wc, int fr, int fq, LAS unsigned char* lds) const {
        asm volatile("" : "+v"(fr), "+v"(fq));
#pragma unroll
        for (int ai = 0; ai < 2; ++ai)
#pragma unroll
            for (int m = 0; m < 4; ++m) { const int r = ai * 128 + wr * 64 + m * 16 + fr;
#pragma unroll
                for (int n = 0; n < 2; ++n) *(LAS f32x4*)(lds + r * 512 + (((wc * 32 + n * 16 + 4 * fq) * 4) ^ ((r & 7) << 4))) = acc[ai][0][m][n]; }
    }
};
struct EpiY {
    static constexpr bool PERM = true, AFTER_DRAIN = false; static constexpr int MID_T = 0;
    const bf16_t* Ag; const float* dd; bf16_t* Yg;
    __device__ __forceinline__ void operator()(const f32x4 (&acc)[2][2][4][2], const Unit& u, int wr, int wc, int fr, int fq) const {
        asm volatile("" : "+v"(fr), "+v"(fq));
        const int g = u.pm >> 2; const int p0 = (8 * fq) & 15;
        const f32x4 d0 = *(const f32x4*)(dd + g * 16 + p0), d1 = *(const f32x4*)(dd + g * 16 + p0 + 4);
        const size_t grow0 = (size_t)u.pm * 256 + wr * 64 + fr; const int col0 = wc * 32 + 8 * fq;
        u32x4 uu[2][4][2];
#pragma unroll
        for (int ai = 0; ai < 2; ++ai)
#pragma unroll
            for (int m = 0; m < 4; ++m)
#pragma unroll
                for (int bj = 0; bj < 2; ++bj) uu[ai][m][bj] = *(const u32x4*)(Ag + (grow0 + ai * 128 + m * 16) * SSM_KA + bj * 128 + col0);
#pragma unroll
        for (int ai = 0; ai < 2; ++ai)
#pragma unroll
            for (int m = 0; m < 4; ++m) { const size_t grow = grow0 + ai * 128 + m * 16;
#pragma unroll
                for (int bj = 0; bj < 2; ++bj) { const u32x4 w_ = uu[ai][m][bj]; const f32x4 v0 = acc[ai][bj][m][0], v1 = acc[ai][bj][m][1];
                    const float y0 = gelu_tanh(v0[0] + d0[0] * bf_lo(w_.x)), y1 = gelu_tanh(v0[1] + d0[1] * bf_hi(w_.x)), y2 = gelu_tanh(v0[2] + d0[2] * bf_lo(w_.y)), y3 = gelu_tanh(v0[3] + d0[3] * bf_hi(w_.y));
                    const float y4 = gelu_tanh(v1[0] + d1[0] * bf_lo(w_.z)), y5 = gelu_tanh(v1[1] + d1[1] * bf_hi(w_.z)), y6 = gelu_tanh(v1[2] + d1[2] * bf_lo(w_.w)), y7 = gelu_tanh(v1[3] + d1[3] * bf_hi(w_.w));
                    u32x4 w; w.x = cvt_pk_bf16(y0, y1); w.y = cvt_pk_bf16(y2, y3); w.z = cvt_pk_bf16(y4, y5); w.w = cvt_pk_bf16(y6, y7);
                    *(u32x4*)(Yg + grow * 256 + bj * 128 + col0) = w; } }
    }
};
struct EpiGlu {
    static constexpr bool PERM = true, AFTER_DRAIN = false; static constexpr int MID_T = 0;
    const bf16_t* Yg; bf16_t* mixed; float* ssq;
    __device__ __forceinline__ void operator()(const f32x4 (&acc)[2][2][4][2], const Unit& u, int wr, int wc, int fr, int fq) const {
        asm volatile("" : "+v"(fr), "+v"(fq));
        const int row0 = u.pm * 256 + wr * 64 + fr, c0 = u.pn * 256 + wc * 32 + 8 * fq;
        u32x4 yy[2][4][2];
#pragma unroll
        for (int ai = 0; ai < 2; ++ai)
#pragma unroll
            for (int m = 0; m < 4; ++m)
#pragma unroll
                for (int bj = 0; bj < 2; ++bj) { const int c = c0 + bj * 128; yy[ai][m][bj] = *(const u32x4*)(Yg + ((size_t)(c >> 4) * M + row0 + ai * 128 + m * 16) * 16 + (c & 15)); }
#pragma unroll
        for (int ai = 0; ai < 2; ++ai)
#pragma unroll
            for (int m = 0; m < 4; ++m) { const int row = row0 + ai * 128 + m * 16; float sq = 0.f;
#pragma unroll
                for (int bj = 0; bj < 2; ++bj) { const int c = c0 + bj * 128; const u32x4 y_ = yy[ai][m][bj]; const f32x4 v0 = acc[ai][bj][m][0], v1 = acc[ai][bj][m][1];
                    const float s0 = bf_lo(y_.x) * sigmoidf_fast(v0[0]), s1 = bf_hi(y_.x) * sigmoidf_fast(v0[1]), s2 = bf_lo(y_.y) * sigmoidf_fast(v0[2]), s3 = bf_hi(y_.y) * sigmoidf_fast(v0[3]);
                    const float s4 = bf_lo(y_.z) * sigmoidf_fast(v1[0]), s5 = bf_hi(y_.z) * sigmoidf_fast(v1[1]), s6 = bf_lo(y_.w) * sigmoidf_fast(v1[2]), s7 = bf_hi(y_.w) * sigmoidf_fast(v1[3]);
                    sq += (s0 * s0 + s1 * s1) + (s2 * s2 + s3 * s3) + (s4 * s4 + s5 * s5) + (s6 * s6 + s7 * s7);
                    u32x4 w; w.x = cvt_pk_bf16(s0, s1); w.y = cvt_pk_bf16(s2, s3); w.z = cvt_pk_bf16(s4, s5); w.w = cvt_pk_bf16(s6, s7);
                    *(u32x4*)(mixed + (size_t)row * 2048 + 1024 + c) = w; }
                sq += __shfl_xor(sq, 16); sq += __shfl_xor(sq, 32);
                if (fq == 0) atomicAdd(ssq + row, sq); }
    }
};
struct EpiOut {
    static constexpr bool PERM = true, AFTER_DRAIN = false; static constexpr int MID_T = 16;
    const bf16_t* xn; const float* irstd1; bf16_t* x1b; const float* ssq_a; const float* ssq_s; float* ssq_x;
    __device__ __forceinline__ void mid(f32x4 (&acc)[2][2][4][2], const Unit& u, int wr, int wc, int fr, int fq) const {
        asm volatile("" : "+v"(fr), "+v"(fq));
#pragma unroll
        for (int ai = 0; ai < 2; ++ai)
#pragma unroll
            for (int m = 0; m < 4; ++m) { const int row = u.pm * 256 + ai * 128 + wr * 64 + m * 16 + fr;
                const float f = sqrtf((ssq_s[row] * (1.0f / 1024.0f) + EPS) / (ssq_a[row] * (1.0f / 1024.0f) + EPS));
#pragma unroll
                for (int bj = 0; bj < 2; ++bj)
#pragma unroll
                    for (int n = 0; n < 2; ++n) acc[ai][bj][m][n] *= f; }
    }
    __device__ __forceinline__ void operator()(const f32x4 (&acc)[2][2][4][2], const Unit& u, int wr, int wc, int fr, int fq) const {
        asm volatile("" : "+v"(fr), "+v"(fq));
        const int row0 = u.pm * 256 + wr * 64 + fr; const size_t cofs = (size_t)u.pn * 256 + wc * 32 + 8 * fq;
#pragma unroll
        for (int ai = 0; ai < 2; ++ai) {
            float sv[4], iv[4]; u32x4 xb[4][2];
#pragma unroll
            for (int m = 0; m < 4; ++m) { const int row = row0 + ai * 128 + m * 16; sv[m] = ssq_s[row]; iv[m] = irstd1[row];
#pragma unroll
                for (int bj = 0; bj < 2; ++bj) xb[m][bj] = *(const u32x4*)(xn + (size_t)row * D_MODEL + cofs + bj * 128); }
#pragma unroll
            for (int m = 0; m < 4; ++m) { const int row = row0 + ai * 128 + m * 16; const float rstd = 1.0f / sqrtf(sv[m] * (1.0f / 1024.0f) + EPS), ir = iv[m]; float sq = 0.f;
#pragma unroll
                for (int bj = 0; bj < 2; ++bj) { const size_t off = (size_t)row * D_MODEL + cofs + bj * 128; const u32x4 x_ = xb[m][bj];
                    const f32x4 b0 = {bf_lo(x_.x), bf_hi(x_.x), bf_lo(x_.y), bf_hi(x_.y)}, b1 = {bf_lo(x_.z), bf_hi(x_.z), bf_lo(x_.w), bf_hi(x_.w)};
                    const f32x4 o0 = b0 * ir + acc[ai][bj][m][0] * rstd, o1 = b1 * ir + acc[ai][bj][m][1] * rstd;
                    sq += (o0[0] * o0[0] + o0[1] * o0[1]) + (o0[2] * o0[2] + o0[3] * o0[3]) + (o1[0] * o1[0] + o1[1] * o1[1]) + (o1[2] * o1[2] + o1[3] * o1[3]);
                    u32x4 w; w.x = cvt_pk_bf16(o0[0], o0[1]); w.y = cvt_pk_bf16(o0[2], o0[3]); w.z = cvt_pk_bf16(o1[0], o1[1]); w.w = cvt_pk_bf16(o1[2], o1[3]);
                    *(u32x4*)(x1b + off) = w; }
                sq += __shfl_xor(sq, 16); sq += __shfl_xor(sq, 32); if (fq == 0) atomicAdd(ssq_x + row, sq); }
        }
    }
};
struct EpiGU {
    static constexpr bool PERM = true, AFTER_DRAIN = false; static constexpr int MID_T = 0;
    const float* ssq_x; bf16_t* H;
    __device__ __forceinline__ void operator()(const f32x4 (&acc)[2][2][4][2], const Unit& u, int wr, int wc, int fr, int fq) const {
        asm volatile("" : "+v"(fr), "+v"(fq));
        const int row0 = u.pm * 256 + wr * 64 + fr;
        float sv[2][4];
#pragma unroll
        for (int ai = 0; ai < 2; ++ai)
#pragma unroll
            for (int m = 0; m < 4; ++m) sv[ai][m] = ssq_x[row0 + ai * 128 + m * 16];
#pragma unroll
        for (int ai = 0; ai < 2; ++ai)
#pragma unroll
            for (int m = 0; m < 4; ++m) { const int row = row0 + ai * 128 + m * 16; const float rstd = 1.0f / sqrtf(sv[ai][m] * (1.0f / 2048.0f) + EPS);
                float h[8];
#pragma unroll
                for (int n = 0; n < 2; ++n)
#pragma unroll
                    for (int i = 0; i < 4; ++i) { const float gv = acc[ai][0][m][n][i] * rstd, uv = acc[ai][1][m][n][i] * rstd; h[4 * n + i] = gv * sigmoidf_fast(gv) * uv; }
                u32x4 w; w.x = cvt_pk_bf16(h[0], h[1]); w.y = cvt_pk_bf16(h[2], h[3]); w.z = cvt_pk_bf16(h[4], h[5]); w.w = cvt_pk_bf16(h[6], h[7]);
                *(u32x4*)(H + (size_t)row * FF + u.pn * 128 + wc * 32 + 8 * fq) = w; }
    }
};
template <bool DRY> struct EpiDown {
    static constexpr bool PERM = true, AFTER_DRAIN = false; static constexpr int MID_T = 0;
    const bf16_t* x1b; float* out; float* trash;
    __device__ __forceinline__ void operator()(const f32x4 (&acc)[2][2][4][2], const Unit& u, int wr, int wc, int fr, int fq) const {
        asm volatile("" : "+v"(fr), "+v"(fq));
        const int row0 = u.pm * 256 + wr * 64 + fr; const size_t cofs = (size_t)u.pn * 256 + wc * 32 + 8 * fq;
        u32x4 xb[2][4][2];
#pragma unroll
        for (int ai = 0; ai < 2; ++ai)
#pragma unroll
            for (int m = 0; m < 4; ++m)
#pragma unroll
                for (int bj = 0; bj < 2; ++bj) xb[ai][m][bj] = *(const u32x4*)(x1b + (size_t)(row0 + ai * 128 + m * 16) * D_MODEL + cofs + bj * 128);
#pragma unroll
        for (int ai = 0; ai < 2; ++ai)
#pragma unroll
            for (int m = 0; m < 4; ++m) { const int row = row0 + ai * 128 + m * 16;
#pragma unroll
                for (int bj = 0; bj < 2; ++bj) { const size_t off = (size_t)row * D_MODEL + cofs + bj * 128; const u32x4 x_ = xb[ai][m][bj];
                    const f32x4 b0 = {bf_lo(x_.x), bf_hi(x_.x), bf_lo(x_.y), bf_hi(x_.y)}, b1 = {bf_lo(x_.z), bf_hi(x_.z), bf_lo(x_.w), bf_hi(x_.w)};
                    float* q = DRY ? trash + (off & ((8u << 20) - 1)) : out + off;
                    *(f32x4*)q = b0 + acc[ai][bj][m][0]; *(f32x4*)(q + 4) = b1 + acc[ai][bj][m][1]; } }
    }
};

constexpr int ATT_KROW = 144, ATT_VROW = 520, ATT_K_OFF = 0, ATT_V_OFF = 256 * ATT_KROW, ATT_B_OFF = ATT_V_OFF + 64 * ATT_VROW;
constexpr int ATT_TAB = 192;
static_assert(ATT_B_OFF + 4 * ATT_TAB * 4 <= RING_BYTES, "attention LDS");
template <int STG_REPS = 1, int TASK_REPS = 1>
__device__ __forceinline__ void attn_unit(Frame& F, int b, int qb, int kvh, float* ssq_real) {
    LAS unsigned char* lds = F.lds;
    const int lane = lane_id(), wave = F.wave, tid = wave * 64 + lane;
    const bf16_t* Q = (const bf16_t*)(F.ws + WS_Q); const bf16_t* Kb = (const bf16_t*)(F.ws + WS_K); const bf16_t* Vb = (const bf16_t*)(F.ws + WS_V);
    bf16_t* mixed = (bf16_t*)(F.ws + WS_MIX);
    const int T0 = b * SEQ + qb * 128;
    const int q = lane & 31, hh = lane >> 5;
    u32x4 qraw[2][4];
#pragma unroll
    for (int it = 0; it < 2; ++it) { const int task = wave + 8 * it; const bf16_t* qp = Q + (size_t)(T0 + 32 * (task & 3) + q) * ATTN_W + (kvh * 4 + (task >> 2)) * 64 + hh * 8;
#pragma unroll
        for (int ks = 0; ks < 4; ++ks) qraw[it][ks] = *(const u32x4*)(qp + 16 * ks); }
    for (int srep = 0; srep < STG_REPS; ++srep)
    {
        const int key = tid & 255; const bool valid = (qb > 0) || (key >= 128);
        const size_t tok = (size_t)(T0 - 128 + key);
        u32x4 c[8];
        const bf16_t* src = ((tid < 256) ? Kb : Vb) + tok * KV_W + kvh * 64;
#pragma unroll
        for (int i = 0; i < 8; ++i) c[i] = valid ? *(const u32x4*)(src + 8 * i) : (u32x4){0u, 0u, 0u, 0u};
        if (tid < 256) {
            float ss = 0.f;
#pragma unroll
            for (int i = 0; i < 8; ++i) { const float a0 = bf_lo(c[i].x), a1 = bf_hi(c[i].x), a2 = bf_lo(c[i].y), a3 = bf_hi(c[i].y), a4 = bf_lo(c[i].z), a5 = bf_hi(c[i].z), a6 = bf_lo(c[i].w), a7 = bf_hi(c[i].w);
                ss += (a0 * a0 + a1 * a1) + (a2 * a2 + a3 * a3) + (a4 * a4 + a5 * a5) + (a6 * a6 + a7 * a7); }
            const float rstd = 1.0f / sqrtf(ss * (1.0f / 64.0f) + EPS);
            const float* kg = F.in[5];
#pragma unroll
            for (int i = 0; i < 8; ++i) { const f32x4 g0 = *(const f32x4*)(kg + 8 * i), g1 = *(const f32x4*)(kg + 8 * i + 4);
                u32x4 w; w.x = cvt_pk_bf16(bf_lo(c[i].x) * rstd * g0[0], bf_hi(c[i].x) * rstd * g0[1]); w.y = cvt_pk_bf16(bf_lo(c[i].y) * rstd * g0[2], bf_hi(c[i].y) * rstd * g0[3]);
                w.z = cvt_pk_bf16(bf_lo(c[i].z) * rstd * g1[0], bf_hi(c[i].z) * rstd * g1[1]); w.w = cvt_pk_bf16(bf_lo(c[i].w) * rstd * g1[2], bf_hi(c[i].w) * rstd * g1[3]);
                *(LAS u32x4*)(lds + ATT_K_OFF + key * ATT_KROW + i * 16) = w; }
        } else {
#pragma unroll
            for (int i = 0; i < 8; ++i) { const unsigned w4[4] = {c[i].x, c[i].y, c[i].z, c[i].w};
#pragma unroll
                for (int j = 0; j < 4; ++j) { *(LAS unsigned short*)(lds + ATT_V_OFF + (8 * i + 2 * j) * ATT_VROW + key * 2) = (unsigned short)(w4[j] & 0xffffu);
                    *(LAS unsigned short*)(lds + ATT_V_OFF + (8 * i + 2 * j + 1) * ATT_VROW + key * 2) = (unsigned short)(w4[j] >> 16); } }
        }
        for (int e = tid; e < 4 * ATT_TAB; e += NWAVES * 64) { const int hl = e / ATT_TAB, dist = e % ATT_TAB - 32;
            ((LAS float*)(lds + ATT_B_OFF))[e] = ((unsigned)dist < 128u) ? F.in[1][(int)kBucket[dist & 127] * NQH + kvh * 4 + hl] * LOG2E : -INFINITY; }
    }
    bf16x8 qf2[2][4];
    { const float* qg = F.in[4]; f32x4 gq[4][2];
#pragma unroll
      for (int ks = 0; ks < 4; ++ks) { gq[ks][0] = *(const f32x4*)(qg + 16 * ks + 8 * hh); gq[ks][1] = *(const f32x4*)(qg + 16 * ks + 8 * hh + 4); }
#pragma unroll
      for (int it = 0; it < 2; ++it) { float ss = 0.f;
#pragma unroll
        for (int ks = 0; ks < 4; ++ks) { const u32x4 w_ = qraw[it][ks];
            const float a0 = bf_lo(w_.x), a1 = bf_hi(w_.x), a2 = bf_lo(w_.y), a3 = bf_hi(w_.y), a4 = bf_lo(w_.z), a5 = bf_hi(w_.z), a6 = bf_lo(w_.w), a7 = bf_hi(w_.w);
            ss += (a0 * a0 + a1 * a1) + (a2 * a2 + a3 * a3) + (a4 * a4 + a5 * a5) + (a6 * a6 + a7 * a7); }
        ss += __shfl_xor(ss, 32);
        const float sc = (1.0f / sqrtf(ss * (1.0f / 64.0f) + EPS)) * (0.125f * LOG2E);
#pragma unroll
        for (int ks = 0; ks < 4; ++ks) { const u32x4 w_ = qraw[it][ks]; const f32x4 g0 = gq[ks][0], g1 = gq[ks][1];
            u32x4 w; w.x = cvt_pk_bf16(bf_lo(w_.x) * sc * g0[0], bf_hi(w_.x) * sc * g0[1]); w.y = cvt_pk_bf16(bf_lo(w_.y) * sc * g0[2], bf_hi(w_.y) * sc * g0[3]);
            w.z = cvt_pk_bf16(bf_lo(w_.z) * sc * g1[0], bf_hi(w_.z) * sc * g1[1]); w.w = cvt_pk_bf16(bf_lo(w_.w) * sc * g1[2], bf_hi(w_.w) * sc * g1[3]);
            qf2[it][ks] = __builtin_bit_cast(bf16x8, w); } } }
    __syncthreads();
    for (int trep = 0; trep < TASK_REPS; ++trep)
#pragma unroll
    for (int it = 0; it < 2; ++it) {
        float* ssq_a = (trep == TASK_REPS - 1) ? ssq_real : (float*)(F.ws + WS_SSQ_T);
        const int task = wave + 8 * it, hl = task >> 2, grp = task & 3, hq = kvh * 4 + hl, qi = 32 * grp + q;
        const bf16x8 (&qf)[4] = qf2[it];
        const LAS float* tb = (const LAS float*)(lds + ATT_B_OFF) + hl * ATT_TAB + (q + 128 - 4 * hh + 32 - 155);
        const float sink2 = F.in[6][hq] * LOG2E;
        f32x16 s[5];
#pragma unroll
        for (int kt = 0; kt < 5; ++kt) {
            f32x16 a;
#pragma unroll
            for (int r = 0; r < 16; ++r) a[r] = tb[155 - 32 * kt - ((r & 3) + 8 * (r >> 2))];
#pragma unroll
            for (int ks = 0; ks < 4; ++ks) { const bf16x8 kf = *(const LAS bf16x8*)(lds + ATT_K_OFF + (32 * (grp + kt) + q) * ATT_KROW + (16 * ks + 8 * hh) * 2);
                a = __builtin_amdgcn_mfma_f32_32x32x16_bf16(kf, qf[ks], a, 0, 0, 0); }
            if (qb == 0 && grp + kt < 4) {
#pragma unroll
                for (int r = 0; r < 16; ++r) a[r] = -INFINITY; }
            s[kt] = a;
        }
        float mx = sink2;
#pragma unroll
        for (int kt = 0; kt < 5; ++kt)
#pragma unroll
            for (int r = 0; r < 16; ++r) mx = fmaxf(mx, s[kt][r]);
        mx = fmaxf(mx, __shfl_xor(mx, 32));
        float l = 0.f;
#pragma unroll
        for (int kt = 0; kt < 5; ++kt)
#pragma unroll
            for (int r = 0; r < 16; ++r) { const float p = fast_exp2(s[kt][r] - mx); s[kt][r] = p; l += p; }
        l += __shfl_xor(l, 32);
        l += fast_exp2(sink2 - mx);
        f32x16 o[2]; o[0] = (f32x16){}; o[1] = (f32x16){};
#pragma unroll
        for (int kt = 0; kt < 5; ++kt)
#pragma unroll
            for (int s2 = 0; s2 < 2; ++s2) {
                u32x4 pw; pw.x = cvt_pk_bf16(s[kt][8 * s2 + 0], s[kt][8 * s2 + 1]); pw.y = cvt_pk_bf16(s[kt][8 * s2 + 2], s[kt][8 * s2 + 3]); pw.z = cvt_pk_bf16(s[kt][8 * s2 + 4], s[kt][8 * s2 + 5]); pw.w = cvt_pk_bf16(s[kt][8 * s2 + 6], s[kt][8 * s2 + 7]);
                const bf16x8 pb = __builtin_bit_cast(bf16x8, pw);
#pragma unroll
                for (int d0 = 0; d0 < 2; ++d0) { const LAS unsigned char* vp = lds + ATT_V_OFF + (32 * d0 + q) * ATT_VROW + (32 * (grp + kt) + 16 * s2 + 4 * hh) * 2;
                    const u32x2 lo = *(const LAS u32x2*)vp, hi = *(const LAS u32x2*)(vp + 16);
                    const u32x4 vv = {lo.x, lo.y, hi.x, hi.y};
                    o[d0] = __builtin_amdgcn_mfma_f32_32x32x16_bf16(__builtin_bit_cast(bf16x8, vv), pb, o[d0], 0, 0, 0); }
            }
        const float inv = 1.0f / l; float sq = 0.f;
        bf16_t* op = mixed + (size_t)(T0 + qi) * 2048 + hq * 64 + 4 * hh;
#pragma unroll
        for (int d0 = 0; d0 < 2; ++d0)
#pragma unroll
            for (int r4 = 0; r4 < 4; ++r4) { const float v0 = o[d0][4 * r4] * inv, v1 = o[d0][4 * r4 + 1] * inv, v2 = o[d0][4 * r4 + 2] * inv, v3 = o[d0][4 * r4 + 3] * inv;
                sq += (v0 * v0 + v1 * v1) + (v2 * v2 + v3 * v3);
                u32x2 w; w.x = cvt_pk_bf16(v0, v1); w.y = cvt_pk_bf16(v2, v3); *(u32x2*)(op + 32 * d0 + 8 * r4) = w; }
        sq += __shfl_xor(sq, 32);
        if (hh == 0) atomicAdd(ssq_a + T0 + qi, sq);
    }
    __syncthreads();
}

template <int MODE = 7>
__device__ __forceinline__ void ssm_unit(Frame& F, int pm) {
    const int g = pm >> 2;
    bf16_t* Ag = (bf16_t*)(F.ws + WS_AG);
    if constexpr (MODE & 1) {
        int Kc = 256; asm volatile("" : "+s"(Kc));
        pg8::Gemm gm{(const char*)Ag, (const char*)(F.ws + WS_PG), Kc, SSM_KA * 2, 32, 128, 256 * 2};
        pg8::OneUnit S1{pm, g}; EpiS E{};
        pg8::gemm_phase<EpiS, pg8::OneUnit, false>(F.lds, F.wave, gm, S1, E);
    }
    asm volatile("s_waitcnt lgkmcnt(0)" ::: "memory");
    __syncthreads();
    if ((MODE & 2) && F.wave == 0) {
        const int n = lane_id();
        const f32x2 l16 = *((const f32x2*)(F.ws + WS_L16) + g * 64 + n);
        float hr = 0.f, hi = 0.f;
        unsigned* hp = (unsigned*)(Ag + (size_t)pm * 256 * SSM_KA + 256) + n;
        for (int c0 = 0; c0 < 256; c0 += 8) {
            f32x2 sv[8];
#pragma unroll
            for (int j = 0; j < 8; ++j) sv[j] = *(const LAS f32x2*)(F.lds + (c0 + j) * 512 + ((8 * n) ^ (j << 4)));
#pragma unroll
            for (int j = 0; j < 8; ++j) { hp[(size_t)(c0 + j) * (SSM_KA / 2)] = cvt_pk_bf16(hr, hi);
                const float nr = l16.x * hr - l16.y * hi + sv[j].x, ni = l16.x * hi + l16.y * hr + sv[j].y; hr = nr; hi = ni; }
        }
    }
    asm volatile("s_waitcnt vmcnt(0) lgkmcnt(0)" ::: "memory");
    __syncthreads();
    if constexpr (MODE & 4) {
        int Kc = SSM_KA; asm volatile("" : "+s"(Kc));
        pg8::Gemm gm{(const char*)Ag, (const char*)(F.ws + WS_BG), Kc, SSM_KA * 2, 32, 128, SSM_KA * 2};
        pg8::OneUnit S1{pm, g}; EpiY E{Ag, F.in[14], (bf16_t*)(F.ws + WS_YG)};
        pg8::gemm_phase<EpiY, pg8::OneUnit, false>(F.lds, F.wave, gm, S1, E);
    }
}


#define XB_TMO      128
#define XB_XCNT(j)  (256  + 64 * (j))
#define XB_XSUB(j)  (1280 + 64 * (j))
#define XB_XGEN(j)  (2304 + 64 * (j))
#define XB_TOP      3328
#define XB_TOPGEN   3392
#define XCD_BAR_WORDS 3456
#define XB_SPIN_CAP (1u << 22)
constexpr size_t WS_BAR = 16384;
__device__ __forceinline__ unsigned xb_ld(unsigned* p)              { return __hip_atomic_load(p, __ATOMIC_RELAXED, __HIP_MEMORY_SCOPE_AGENT); }
__device__ __forceinline__ unsigned xb_add(unsigned* p, unsigned v) { return __hip_atomic_fetch_add(p, v, __ATOMIC_RELAXED, __HIP_MEMORY_SCOPE_AGENT); }
__device__ __forceinline__ unsigned xb_xcc_id() { return (unsigned)__builtin_amdgcn_s_getreg((3 << 11) | 20) & 0xFu; }
#define XB_SPIN(cond, bar) do { unsigned _sp = 0; while (cond) { __builtin_amdgcn_s_sleep(1); \
    if ((++_sp & 255u) == 0u) { if (xb_ld(&(bar)[XB_TMO])) break; if (_sp > XB_SPIN_CAP) { atomicAdd(&(bar)[XB_TMO], 1u); break; } } } } while (0)
struct XcdBarrier { unsigned* bar; unsigned x; volatile LAS unsigned* st; };
__device__ __forceinline__ XcdBarrier xcd_barrier_post(unsigned* bar, volatile LAS unsigned* st) {
    XcdBarrier b; b.bar = bar; b.x = xb_xcc_id(); b.st = st;
    if (threadIdx.x == 0) (void)xb_add(&bar[XB_XCNT(b.x)], 1u);
    return b;
}
__device__ __forceinline__ void xcd_barrier_complete(unsigned* bar, unsigned x, unsigned& nloc, unsigned& nx) {
    const unsigned G = gridDim.x * gridDim.y * gridDim.z;
    unsigned sum, cnt, mine, sp = 0u;
    for (;;) {
        sum = 0u; cnt = 0u; mine = 0u;
#pragma unroll
        for (unsigned j = 0; j < 16; ++j) { const unsigned c = xb_ld(&bar[XB_XCNT(j)]); sum += c; cnt += (c > 0u) ? 1u : 0u; mine = (j == x) ? c : mine; }
        if (sum == G) break;
        __builtin_amdgcn_s_sleep(1);
        if ((++sp & 255u) == 0u) { if (xb_ld(&bar[XB_TMO])) break; if (sp > XB_SPIN_CAP) { atomicAdd(&bar[XB_TMO], 1u); break; } }
    }
    nloc = mine > 0u ? mine : 1u; nx = cnt > 0u ? cnt : 1u;
}
__device__ __forceinline__ void xcd_barrier(const XcdBarrier& b, int wave) {
    asm volatile("s_waitcnt vmcnt(0)" ::: "memory");
    __syncthreads();
    if (wave == 0 && lane_id() == 0) {
        unsigned* bar = b.bar;
        __builtin_amdgcn_s_waitcnt(0);
        unsigned nloc = b.st[0], nx = b.st[1];
        if (nloc == 0u) { xcd_barrier_complete(bar, b.x, nloc, nx); b.st[0] = nloc; b.st[1] = nx; }
        const unsigned old = xb_add(&bar[XB_XSUB(b.x)], 1u);
        const unsigned gen = old / nloc;
        if (old + 1u == (gen + 1u) * nloc) {
            __builtin_amdgcn_fence(__ATOMIC_RELEASE, "agent");
            asm volatile("s_waitcnt vmcnt(0)" ::: "memory");
            const unsigned og = xb_add(&bar[XB_TOP], 1u);
            const unsigned tg = og / nx;
            if (og + 1u == (tg + 1u) * nx) xb_add(&bar[XB_TOPGEN], 1u);
            else XB_SPIN(xb_ld(&bar[XB_TOPGEN]) == tg, bar);
            __builtin_amdgcn_fence(__ATOMIC_ACQUIRE, "agent");
            xb_add(&bar[XB_XGEN(b.x)], 1u);
            asm volatile("s_waitcnt vmcnt(0)" ::: "memory");
        } else {
            XB_SPIN(xb_ld(&bar[XB_XGEN(b.x)]) == gen, bar);
            __builtin_amdgcn_fence(__ATOMIC_ACQUIRE, "agent");
            asm volatile("s_waitcnt vmcnt(0)" ::: "memory");
        }
    }
    __syncthreads();
}

struct Args { const float* in[23]; float* out; unsigned char* ws; int ph_lo, ph_hi; };
__global__ void __launch_bounds__(NWAVES * 64, 2) hymba_fwd(Args args) {
    extern __shared__ __attribute__((aligned(16))) unsigned char lds_raw[];
    Frame F;
    F.lds = (LAS unsigned char*)lds_raw;
    F.wave = __builtin_amdgcn_readfirstlane((int)threadIdx.x >> 6);
    F.G = gridDim.x; { const int bx = blockIdx.x; F.vcu = (F.G % 8 == 0) ? (bx % 8) * (F.G / 8) + bx / 8 : bx; }
    F.in = args.in; F.out = args.out; F.ws = args.ws;
    const int lo = args.ph_lo, hi = args.ph_hi;
    for (int u = threadIdx.x; u < (LDS_BYTES - LDSCTL_OFF) / 4; u += NWAVES * 64) ((LAS unsigned*)(F.lds + LDSCTL_OFF))[u] = 0u;
    __syncthreads();
    XcdBarrier bar; bar.bar = (unsigned*)(F.ws + WS_BAR); bar.x = 0; bar.st = nullptr;
    if (MK_N_LAUNCHES == 1) bar = xcd_barrier_post((unsigned*)(F.ws + WS_BAR), (volatile LAS unsigned*)(F.lds + MISC_OFF) + 8);
#define IN(k) (lo <= (k) && (k) < hi)
#define GRID_BAR(k) do { if (IN(k) && IN((k) + 1)) xcd_barrier(bar, F.wave); } while (0)
    unsigned char* ws = F.ws;
    float* const ssq_trash = (float*)(ws + WS_SSQ_T);
#define PHASE0(DRY) { p0_prologue(F); }
#define PHASE1(DRY) {     \
        pg8::Gemm g{(const char*)(ws + WS_XN), (const char*)(ws + WS_WIN), D_MODEL, D_MODEL * 2, 32, 128, D_MODEL * 2}; \
        pg8::StaticOrder S; S.init(M, IN_W, F.G, (int)blockIdx.x, WGM_P1); \
        EpiIn E{(bf16_t*)(ws + WS_Q), (bf16_t*)(ws + WS_K), (bf16_t*)(ws + WS_V), (bf16_t*)(ws + WS_AG)}; \
        pg8::gemm_phase<EpiIn, pg8::StaticOrder, true>(F.lds, F.wave, g, S, E); \
        { const int nwg_ = (M / 256) * (IN_W / 256), maxu_ = (nwg_ + F.G - 1) / F.G, nheavy_ = nwg_ - (maxu_ - 1) * F.G, nlight_ = F.G - nheavy_, c_ = (int)blockIdx.x;     \
          if (nlight_ == 0) convert_late_weights(F, c_ * NWAVES + F.wave, F.G * NWAVES); \
          else if (c_ >= nheavy_) convert_late_weights(F, (c_ - nheavy_) * NWAVES + F.wave, nlight_ * NWAVES); } }
#define PHASE2(DRY) { \
        float* const sa_ = (DRY) ? ssq_trash : (float*)(ws + WS_SSQ_A); \
        for (int u = F.vcu; u < BATCH * 32 * NKVH; u += F.G) attn_unit<(PROBE_REP == 25 ? 2 : 1), (PROBE_REP == 26 ? 2 : 1)>(F, u >> 7, (u >> 2) & 31, u & 3, sa_); \
        if (F.vcu < 256) ssm_unit(F, F.vcu);     }
#define PHASE3(DRY) {     \
        pg8::Gemm g{(const char*)(ws + WS_YG), (const char*)(ws + WS_WGLU), SSM_W, 32, (unsigned)(M * 32), (unsigned)(4 * M * 32), SSM_W * 2}; \
        pg8::StaticOrder S; S.init(M, SSM_W, F.G, (int)blockIdx.x, WGM_P3); \
        EpiGlu E{(const bf16_t*)(ws + WS_YG), (bf16_t*)(ws + WS_MIX), (DRY) ? ssq_trash : (float*)(ws + WS_SSQ_S)}; \
        pg8::gemm_phase<EpiGlu, pg8::StaticOrder, true>(F.lds, F.wave, g, S, E); }
#define PHASE4(DRY) {     \
        pg8::Gemm g{(const char*)(ws + WS_MIX), (const char*)(ws + WS_WOUT), 2048, 2048 * 2, 32, 128, 2048 * 2}; \
        pg8::StaticOrder S; S.init(M, D_MODEL, F.G, (int)blockIdx.x, WGM_P4); \
        EpiOut E{(const bf16_t*)(ws + WS_XN), (const float*)(ws + WS_IRSTD1), (bf16_t*)(ws + WS_XN), (const float*)(ws + WS_SSQ_A), (const float*)(ws + WS_SSQ_S), (DRY) ? ssq_trash : (float*)(ws + WS_SSQ_X)}; \
        pg8::gemm_phase<EpiOut, pg8::StaticOrder, true>(F.lds, F.wave, g, S, E); }
#define PHASE5(DRY) {     \
        pg8::Gemm g{(const char*)(ws + WS_XN), (const char*)(ws + WS_WGU), D_MODEL, D_MODEL * 2, 32, 128, D_MODEL * 2}; \
        pg8::StaticOrder S; S.init(M, 2 * FF, F.G, (int)blockIdx.x, WGM_P5); \
        EpiGU E{(const float*)(ws + WS_SSQ_X), (bf16_t*)(ws + WS_H)}; \
        pg8::gemm_phase<EpiGU, pg8::StaticOrder, true>(F.lds, F.wave, g, S, E); }
#define PHASE6(DRY) {     \
        pg8::Gemm g{(const char*)(ws + WS_H), (const char*)(ws + WS_WDN), FF, FF * 2, 32, 128, FF * 2}; \
        pg8::StaticOrder S; S.init(M, D_MODEL, F.G, (int)blockIdx.x, WGM_P6); \
        EpiDown<(DRY)> E{(const bf16_t*)(ws + WS_XN), F.out, (float*)(ws + WS_SSCR)}; \
        pg8::gemm_phase<EpiDown<(DRY)>, pg8::StaticOrder, true>(F.lds, F.wave, g, S, E); }
#define PHASE2A(DRY) { for (int u = F.vcu; u < BATCH * 32 * NKVH; u += F.G) attn_unit(F, u >> 7, (u >> 2) & 31, u & 3, ssq_trash); }
#define PHASE2S(DRY) { if (F.vcu < 256) ssm_unit(F, F.vcu); }
#define RUN_PHASE(k, BODY) do { if (PROBE_REP == (k) && IN(k)) { BODY(1); xcd_barrier(bar, F.wave); } if (IN(k)) { BODY(0); } } while (0)
    RUN_PHASE(0, PHASE0);
    GRID_BAR(0);
    if (args.ph_lo < 0) cg::this_grid().sync();
    RUN_PHASE(1, PHASE1);
    GRID_BAR(1);
    if (PROBE_REP == 22 && IN(2)) { if (F.vcu < 256) ssm_unit<1>(F, F.vcu); xcd_barrier(bar, F.wave); }
    if (PROBE_REP == 23 && IN(2)) { if (F.vcu < 256) ssm_unit<2>(F, F.vcu); xcd_barrier(bar, F.wave); }
    if (PROBE_REP == 24 && IN(2)) { if (F.vcu < 256) ssm_unit<4>(F, F.vcu); xcd_barrier(bar, F.wave); }
    if (PROBE_REP == 20 && IN(2)) { PHASE2A(1); xcd_barrier(bar, F.wave); }
    if (PROBE_REP == 21 && IN(2)) { PHASE2S(1); xcd_barrier(bar, F.wave); }
    RUN_PHASE(2, PHASE2);
    GRID_BAR(2);
    RUN_PHASE(3, PHASE3);
    GRID_BAR(3);
    RUN_PHASE(4, PHASE4);
    GRID_BAR(4);
    RUN_PHASE(5, PHASE5);
    GRID_BAR(5);
    RUN_PHASE(6, PHASE6);
#undef IN
#undef GRID_BAR
}

extern "C" void kernel_launch(void* const* d_in, const int* in_sizes, int n_in, void* d_out, int out_size, void* d_ws, size_t ws_size, hipStream_t stream) {
    static int grid = 0;
    if (grid == 0) {
        if (n_in != 23 || in_sizes[0] != M * D_MODEL || out_size != M * D_MODEL || ws_size < WS_END) { fprintf(stderr, "kernel_launch: unexpected sizes (n_in %d, out %d, ws %zu); nothing launched\n", n_in, out_size, ws_size); grid = -1; return; }
        int dev = 0, cus = 0, per_cu = 0;
        if (hipGetDevice(&dev) != hipSuccess || hipDeviceGetAttribute(&cus, hipDeviceAttributeMultiprocessorCount, dev) != hipSuccess) { grid = -1; return; }
        if (hipFuncSetAttribute((const void*)hymba_fwd, hipFuncAttributeMaxDynamicSharedMemorySize, LDS_BYTES) != hipSuccess) { fprintf(stderr, "kernel_launch: hipFuncSetAttribute failed\n"); grid = -1; return; }
        if (hipOccupancyMaxActiveBlocksPerMultiprocessor(&per_cu, (const void*)hymba_fwd, NWAVES * 64, LDS_BYTES) != hipSuccess || per_cu < 1) { fprintf(stderr, "kernel_launch: occupancy query failed (%d)\n", per_cu); (void)hipGetLastError(); grid = -1; return; }
        grid = cus;
        if (grid < 256) { fprintf(stderr, "kernel_launch: this kernel needs >= 256 CUs (got %d); nothing launched\n", grid); grid = -1; return; }
    }
    if (grid < 0) return;
    (void)hipMemsetAsync((char*)d_ws + WS_CTL, 0, CTL_ZERO_BYTES, stream);
    Args a{};
    for (int i = 0; i < 23; ++i) a.in[i] = (const float*)d_in[i];
    a.out = (float*)d_out; a.ws = (unsigned char*)d_ws;
    constexpr int NPH = 7;
    for (int li = 0; li < MK_N_LAUNCHES; ++li) {
        a.ph_lo = (MK_N_LAUNCHES == 1) ? 0 : li; a.ph_hi = (MK_N_LAUNCHES == 1) ? NPH : li + 1;
        void* kargs[] = {&a};
        const hipError_t e = hipLaunchCooperativeKernel((const void*)hymba_fwd, dim3(grid), dim3(NWAVES * 64), kargs, LDS_BYTES, stream);
        if (e != hipSuccess) { fprintf(stderr, "kernel_launch: cooperative launch failed: %s (grid %d)\n", hipGetErrorString(e), grid); break; }
    }
}
```

```cpp
#include <hip/hip_runtime.h>
#include <hip/hip_cooperative_groups.h>
#include <cstdio>
#include <cstdint>
namespace cg = cooperative_groups;

#ifndef PROBE_REP
#define PROBE_REP -1
#endif
#ifndef WGM_P1
#define WGM_P1 4
#define WGM_P3 4
#define WGM_P4 4
#define WGM_P5 4
#define WGM_P6 4
#endif
#ifndef MK_N_LAUNCHES
#define MK_N_LAUNCHES 1
#endif

#define LAS __attribute__((address_space(3)))
typedef unsigned short bf16_t;
typedef short bf16x8 __attribute__((ext_vector_type(8)));
typedef float f32x4 __attribute__((ext_vector_type(4)));
typedef float f32x2 __attribute__((ext_vector_type(2)));
typedef float f32x16 __attribute__((ext_vector_type(16)));
typedef unsigned u32x4 __attribute__((ext_vector_type(4)));
typedef unsigned u32x2 __attribute__((ext_vector_type(2)));

constexpr int D_MODEL = 2048, BATCH = 4, SEQ = 4096, M = BATCH * SEQ;
constexpr int HD = 64, NQH = 16, NKVH = 4, ATTN_W = 1024, KV_W = 256;
constexpr int SSM_W = 1024, SSM_P = 16, SSM_G = 64, SSM_N = 64, IN_W = 2560, FF = 5632;
constexpr int CH_T = 16;
constexpr int SSM_KA = CH_T * SSM_P + 2 * SSM_N;
constexpr float EPS = 1e-6f;
constexpr float LOG2E = 1.4426950408889634f;

__device__ const unsigned char kBucket[128] = {0, 1, 2, 3, 4, 5, 6, 7, 8, 9, 10, 11, 12, 13, 14, 15, 16, 16, 16, 17, 17, 18, 18, 18, 19, 19, 19, 20, 20, 20, 20, 21, 21, 21, 21, 22, 22, 22, 22, 22, 23, 23, 23, 23, 23, 23, 24, 24, 24, 24, 24, 24, 25, 25, 25, 25, 25, 25, 25, 26, 26, 26, 26, 26, 26, 26, 26, 27, 27, 27, 27, 27, 27, 27, 27, 27, 27, 28, 28, 28, 28, 28, 28, 28, 28, 28, 28, 29, 29, 29, 29, 29, 29, 29, 29, 29, 29, 29, 29, 30, 30, 30, 30, 30, 30, 30, 30, 30, 30, 30, 30, 30, 30, 31, 31, 31, 31, 31, 31, 31, 31, 31, 31, 31, 31, 31, 31, 31};

__device__ __forceinline__ unsigned cvt_pk_bf16(float lo, float hi) { unsigned r; asm volatile("v_cvt_pk_bf16_f32 %0, %1, %2" : "=v"(r) : "v"(lo), "v"(hi)); return r; }
__device__ __forceinline__ float bf_lo(unsigned w) { return __builtin_bit_cast(float, w << 16); }
__device__ __forceinline__ float bf_hi(unsigned w) { return __builtin_bit_cast(float, w & 0xffff0000u); }
__device__ __forceinline__ float fast_rcp(float x) { return __builtin_amdgcn_rcpf(x); }
__device__ __forceinline__ float fast_exp2(float x) { return __builtin_amdgcn_exp2f(x); }
__device__ __forceinline__ float sigmoidf_fast(float x) { return fast_rcp(1.0f + fast_exp2(-LOG2E * x)); }
__device__ __forceinline__ float gelu_tanh(float x) {
    const float u2 = 1.5957691216057308f * (x + 0.044715f * x * x * x);
    return x * sigmoidf_fast(u2);
}

__device__ __forceinline__ int lane_id() { int l = __builtin_amdgcn_mbcnt_hi(~0u, __builtin_amdgcn_mbcnt_lo(~0u, 0u)); asm volatile("" : "+v"(l)); return l; }

namespace pg8 {
constexpr int BM = 256, BK = 64, HALF = 128, HTB = HALF * BK * 2  , STAGE_BYTES = 8 * HTB, NXCD = 8, WGM = 4;
__host__ __device__ __forceinline__ int lds_byte(int r, int c) { const int st = (r >> 4) * 2 + (c >> 5), rr = r & 15, cc = c & 31, ob = rr * 64 + cc * 2; return st * 1024 + (ob ^ (((ob >> 9) & 1) << 5)); }
__host__ __device__ __forceinline__ void stage_rc(int b, int& R, int& C) { const int st = b / 1024, sb = b % 1024, swz = sb ^ (((sb >> 9) & 1) << 5); R = (st >> 1) * 16 + swz / 64; C = (st & 1) * 32 + (swz % 64) / 2; }
__host__ __device__ __forceinline__ int perm32(int rho) { const int n = rho >> 4, i = rho & 15; return 8 * (i >> 2) + 4 * n + (i & 3); }

struct Unit { int pm, pn; unsigned aofs, bofs; int part; };
struct Gemm { const char* A; const char* B; int K; unsigned a_rs, a_cs, a_ks, b_rs; };

struct StaticOrder {
    int nM, nN, nwg, G, c, wgm;
    __device__ void init(int Mr, int N, int G_, int c_, int wgm_ = WGM) { nM = Mr / BM; nN = N / BM; nwg = nM * nN; G = G_; c = c_; wgm = wgm_; }
    __device__ bool next(int i, Unit& u) const {
        const long L = (long)i * G + c; if (L >= nwg) return false;
        int wgid = (int)L; { const int q = nwg / NXCD, r = nwg % NXCD, xcd = wgid % NXCD, off = wgid / NXCD; wgid = (xcd < r ? xcd * (q + 1) : r * (q + 1) + (xcd - r) * q) + off; }
        const int nig = wgm * nN, gid = wgid / nig, fm = gid * wgm, gsz = (nM - fm) < wgm ? (nM - fm) : wgm;
        u.pm = fm + ((wgid % nig) % gsz); u.pn = (wgid % nig) / gsz; u.aofs = 0; u.bofs = 0; u.part = 0; return true;
    }
};
struct TwoPartOrder {
    StaticOrder S; unsigned kofs;
    __device__ bool next(int i, Unit& u) const { if (!S.next(i >> 1, u)) return false; u.part = i & 1; u.aofs = u.bofs = (i & 1) ? kofs : 0u; return true; }
};
struct OneUnit {
    int pm, pn;
    __device__ bool next(int i, Unit& u) const { if (i) return false; u.pm = pm; u.pn = pn; u.aofs = 0; u.bofs = 0; u.part = 0; return true; }
};

template <class Epi, class Sched, bool ALIGN_EPI>
__device__ __forceinline__ void gemm_phase(LAS unsigned char* lds, const int wid  , const Gemm g, const Sched& S, const Epi& E) {
    const int lane = lane_id(), tid = wid * 64 + lane, wr = wid >> 2, wc = wid & 3, fr = lane & 15, fq = lane >> 4;
    const int nt = g.K / BK;
    unsigned voffA[2], voffB[2];
#pragma unroll
    for (int i = 0; i < 2; ++i) { int R, C; stage_rc(tid * 16 + i * 8192, R, C); const int Rb = Epi::PERM ? ((R & ~31) + perm32(R & 31)) : R;
        voffA[i] = (unsigned)R * g.a_rs + (unsigned)(C >> 4) * g.a_cs + (unsigned)(C & 15) * 2u; voffB[i] = (unsigned)Rb * g.b_rs + (unsigned)C * 2u; }
    const size_t kstepA = g.a_ks, kstepB = (size_t)(BK * 2);
    const size_t hstepA = (size_t)HALF * g.a_rs, hstepB = (size_t)HALF * g.b_rs, tstepA = 2 * hstepA, tstepB = 2 * hstepB;
    const unsigned ldsw = (unsigned)wid * 1024u;
    const int aoff = lds_byte(wr * 64 + fr, fq * 8), boff = lds_byte(wc * 32 + fr, fq * 8);
#define PG8_SA(b, h) (((b) * 2 + (h)) * HTB)
#define PG8_SB(b, h) ((4 + (b) * 2 + (h)) * HTB)
#define PG8_STAGE(bufoff, gbase, voff) do { _Pragma("unroll") for (int _i = 0; _i < 2; ++_i) \
        __builtin_amdgcn_global_load_lds((const unsigned*)((const char*)(gbase) + (voff)[_i]), (LAS unsigned*)(lds + (bufoff) + ldsw + _i * 8192), 16, 0, 0); } while (0)
#define PG8_LDA(dst, b, h) do { _Pragma("unroll") for (int m = 0; m < 4; ++m) _Pragma("unroll") for (int k = 0; k < 2; ++k) dst[m][k] = *(const LAS bf16x8*)(lds + PG8_SA(b, h) + aoff + m * 2048 + k * 1024); } while (0)
#define PG8_LDB(dst, b, h) do { _Pragma("unroll") for (int n = 0; n < 2; ++n) _Pragma("unroll") for (int k = 0; k < 2; ++k) dst[n][k] = *(const LAS bf16x8*)(lds + PG8_SB(b, h) + boff + n * 2048 + k * 1024); } while (0)
#define PG8_MMA(ai, bj, At, Bt) do { __builtin_amdgcn_s_setprio(1); _Pragma("unroll") for (int m = 0; m < 4; ++m) _Pragma("unroll") for (int n = 0; n < 2; ++n) _Pragma("unroll") for (int k = 0; k < 2; ++k) \
        acc[ai][bj][m][n] = __builtin_amdgcn_mfma_f32_16x16x32_bf16(Bt[n][k], At[m][k], acc[ai][bj][m][n], 0, 0, 0); __builtin_amdgcn_s_setprio(0); } while (0)
#define PG8_WAIT_V(n) asm volatile("s_waitcnt vmcnt(" #n ")" ::: "memory")
#define PG8_WAIT_L(n) asm volatile("s_waitcnt lgkmcnt(" #n ")" ::: "memory")
#define PG8_BAR __builtin_amdgcn_s_barrier()
#define PG8_SCHED __builtin_amdgcn_sched_barrier(0)
    Unit cur, nxt; int ui = 0;
    if (!S.next(0, cur)) return;
    f32x4 acc[2][2][4][2];
#pragma unroll
    for (int a = 0; a < 2; ++a)
#pragma unroll
        for (int b = 0; b < 2; ++b)
#pragma unroll
            for (int m = 0; m < 4; ++m)
#pragma unroll
                for (int n = 0; n < 2; ++n) acc[a][b][m][n] = (f32x4){0.f, 0.f, 0.f, 0.f};
    bf16x8 At[4][2], B0[2][2], B1[2][2];
    const char* cA = g.A + (size_t)cur.pm * tstepA + cur.aofs; const char* cB = g.B + (size_t)cur.pn * tstepB + cur.bofs;
    PG8_STAGE(PG8_SB(0, 0), cB, voffB); PG8_STAGE(PG8_SB(0, 1), cB + hstepB, voffB); PG8_STAGE(PG8_SA(0, 0), cA, voffA); PG8_STAGE(PG8_SA(0, 1), cA + hstepA, voffA);
    if (wr == 1) PG8_BAR;
    PG8_WAIT_V(2); PG8_BAR;
    PG8_STAGE(PG8_SB(1, 0), cB + kstepB, voffB); PG8_STAGE(PG8_SA(1, 0), cA + kstepA, voffA); PG8_STAGE(PG8_SB(1, 1), cB + hstepB + kstepB, voffB);
    PG8_WAIT_V(6); PG8_BAR;
    for (;;) {
        const bool has_next = S.next(ui + 1, nxt);
        const char* nA = has_next ? g.A + (size_t)nxt.pm * tstepA + nxt.aofs : cA; const char* nB = has_next ? g.B + (size_t)nxt.pn * tstepB + nxt.bofs : cB;
        for (int t = 0; t < nt; t += 2) {
            if constexpr (Epi::MID_T > 0) { if (t == Epi::MID_T) E.mid(acc, cur, wr, wc, fr, fq); }
            const bool last = (t == nt - 2);
            const char* a1 = cA + (size_t)(t + 1) * kstepA;
            const char* a2 = last ? nA : cA + (size_t)(t + 2) * kstepA; const char* b2 = last ? nB : cB + (size_t)(t + 2) * kstepB;
            const char* a3 = a2 + kstepA; const char* b3 = b2 + kstepB;
            PG8_LDB(B0, 0, 0); PG8_LDB(B1, 0, 1); PG8_SCHED; PG8_LDA(At, 0, 0); PG8_STAGE(PG8_SA(1, 1), a1 + hstepA, voffA);
            PG8_WAIT_V(8); PG8_WAIT_L(0); PG8_BAR; PG8_MMA(0, 0, At, B0); PG8_MMA(0, 1, At, B1); PG8_BAR; PG8_SCHED;
            PG8_LDA(At, 0, 1); PG8_STAGE(PG8_SB(0, 0), b2, voffB); PG8_STAGE(PG8_SB(0, 1), b2 + hstepB, voffB); PG8_STAGE(PG8_SA(0, 0), a2, voffA);
            PG8_WAIT_V(8); PG8_WAIT_L(0); PG8_BAR; PG8_MMA(1, 0, At, B0); PG8_MMA(1, 1, At, B1); PG8_BAR; PG8_SCHED;
            PG8_LDB(B0, 1, 0); PG8_LDB(B1, 1, 1); PG8_SCHED; PG8_LDA(At, 1, 0); PG8_STAGE(PG8_SA(0, 1), a2 + hstepA, voffA);
            PG8_WAIT_V(8); PG8_WAIT_L(0); PG8_BAR; PG8_MMA(0, 0, At, B0); PG8_MMA(0, 1, At, B1); PG8_BAR; PG8_SCHED;
            PG8_LDA(At, 1, 1); PG8_STAGE(PG8_SB(1, 0), b3, voffB); PG8_STAGE(PG8_SB(1, 1), b3 + hstepB, voffB); PG8_STAGE(PG8_SA(1, 0), a3, voffA);
            PG8_WAIT_V(8); PG8_WAIT_L(0); PG8_BAR; PG8_MMA(1, 0, At, B0); PG8_MMA(1, 1, At, B1); PG8_BAR; PG8_SCHED;
        }
        if constexpr (ALIGN_EPI) { if (wr == 0) PG8_BAR; }
        if constexpr (!Epi::AFTER_DRAIN) E(acc, cur, wr, wc, fr, fq);
        if (!has_next) break;
#pragma unroll
        for (int a = 0; a < 2; ++a)
#pragma unroll
            for (int b = 0; b < 2; ++b)
#pragma unroll
                for (int m = 0; m < 4; ++m)
#pragma unroll
                    for (int n = 0; n < 2; ++n) acc[a][b][m][n] = (f32x4){0.f, 0.f, 0.f, 0.f};
        cur = nxt; cA = nA; cB = nB; ++ui;
        if constexpr (ALIGN_EPI) { if (wr == 1) PG8_BAR; }
    }
    PG8_WAIT_V(0);
    if constexpr (!ALIGN_EPI) { if (wr == 0) PG8_BAR; }
    PG8_BAR;
    if constexpr (Epi::AFTER_DRAIN) E.fused(acc, cur, wr, wc, fr, fq, lds);
#undef PG8_SA
#undef PG8_SB
#undef PG8_STAGE
#undef PG8_LDA
#undef PG8_LDB
#undef PG8_MMA
#undef PG8_WAIT_V
#undef PG8_WAIT_L
#undef PG8_BAR
#undef PG8_SCHED
}
}

constexpr size_t MiB = 1u << 20;
constexpr size_t WS_CTL = 0, CTL_ZERO_BYTES = 1 * MiB;
constexpr size_t WS_SSQ_A = 256 * 1024, WS_SSQ_S = 320 * 1024, WS_SSQ_X = 384 * 1024, WS_SSQ_T = 448 * 1024  ;
constexpr size_t WS_IRSTD1 = 512 * 1024;
constexpr size_t WS_WIN = 2 * MiB;
constexpr size_t WS_WGLU = 12 * MiB;
constexpr size_t WS_WOUT = 14 * MiB;
constexpr size_t WS_WGU = 22 * MiB;
constexpr size_t WS_WDN = 66 * MiB;
constexpr size_t WS_BG = 88 * MiB;
constexpr size_t WS_PG = 100 * MiB;
constexpr size_t WS_L16 = 108 * MiB;
constexpr size_t WS_SSCR = 109 * MiB;
constexpr size_t WS_XN = 141 * MiB;
constexpr size_t WS_Q = 205 * MiB;
constexpr size_t WS_K = 237 * MiB;
constexpr size_t WS_V = 245 * MiB;
constexpr size_t WS_AG = 253 * MiB;
constexpr size_t WS_YG = 301 * MiB;
constexpr size_t WS_MIX = 333 * MiB;
constexpr size_t WS_H = 205 * MiB;
constexpr size_t WS_END = 397 * MiB;
static_assert(WS_H + (size_t)M * FF * 2 <= WS_END, "ws map");

constexpr int RING_BYTES = 131072;
constexpr int LDS_BYTES = 147456;
constexpr int NWAVES = 8;
constexpr int LDSCTL_OFF = RING_BYTES, MISC_OFF = LDSCTL_OFF + 320;

struct Frame {
    LAS unsigned char* lds;
    int wave, vcu, G;
    const float* const* in; float* out; unsigned char* ws;
};

__device__ __forceinline__ float wave_sum(float v) {
#pragma unroll
    for (int o = 1; o < 64; o <<= 1) v += __shfl_xor(v, o);
    return v;
}
__device__ __forceinline__ unsigned f2bf(float f) { unsigned u = __builtin_bit_cast(unsigned, f); return (u + 0x7fffu + ((u >> 16) & 1u)) >> 16; }
__device__ __forceinline__ unsigned pk2(float lo, float hi) { return f2bf(lo) | (f2bf(hi) << 16); }

struct TItem { const float* W; bf16_t* WT; const float* gain; int K, N, rmul, radd, item; };
__device__ __forceinline__ void titem_load(const TItem& t, float (&v)[32], int lane) {
    const int nblk = t.N / 32, kb = t.item / nblk, nb = t.item % nblk, k0 = 64 * kb, n0 = 32 * nb;
    const float* p = t.W + (size_t)(k0 + (lane >> 5)) * t.N + n0 + (lane & 31);
#pragma unroll
    for (int i = 0; i < 32; ++i) v[i] = __builtin_nontemporal_load(p + (size_t)(2 * i) * t.N);
}
__device__ __forceinline__ void titem_store(const TItem& t, const float (&v)[32], LAS float* scr, int lane) {
    const int nblk = t.N / 32, kb = t.item / nblk, nb = t.item % nblk, k0 = 64 * kb, n0 = 32 * nb;
#pragma unroll
    for (int i = 0; i < 32; ++i) scr[(2 * i + (lane >> 5)) * 33 + (lane & 31)] = v[i];
    asm volatile("s_waitcnt lgkmcnt(0)" ::: "memory");
    const int c = lane & 7;
    float gv[8];
#pragma unroll
    for (int i = 0; i < 8; ++i) gv[i] = t.gain ? t.gain[k0 + 8 * c + i] : 1.0f;
#pragma unroll
    for (int j = 0; j < 4; ++j) { const int n = (lane >> 3) + 8 * j; const LAS float* s = scr + (8 * c) * 33 + n; const int nn = n0 + n; const int row = (nn >> 7) * t.rmul + t.radd + (nn & 127);
        u32x4 o; o.x = pk2(s[0 * 33] * gv[0], s[1 * 33] * gv[1]); o.y = pk2(s[2 * 33] * gv[2], s[3 * 33] * gv[3]); o.z = pk2(s[4 * 33] * gv[4], s[5 * 33] * gv[5]); o.w = pk2(s[6 * 33] * gv[6], s[7 * 33] * gv[7]);
        *(u32x4*)(t.WT + (size_t)row * t.K + k0 + 8 * c) = o; }
    asm volatile("s_waitcnt lgkmcnt(0)" ::: "memory");
}
__device__ __forceinline__ void rms_row_load(const float* xrow, f32x4 (&v)[8], int lane) {
    const f32x4* xr = (const f32x4*)xrow + lane;
#pragma unroll
    for (int j = 0; j < 8; ++j) v[j] = __builtin_nontemporal_load(xr + 64 * j);
}
__device__ __forceinline__ void rms_row_store(const f32x4 (&v)[8], float* irstd, bf16_t* orow, int lane) {
    float s = 0.f;
#pragma unroll
    for (int j = 0; j < 8; ++j) s += (v[j].x * v[j].x + v[j].y * v[j].y) + (v[j].z * v[j].z + v[j].w * v[j].w);
    const float ms = wave_sum(s) * (1.0f / D_MODEL) + EPS; const float rstd = 1.0f / sqrtf(ms);
    if (lane == 0) *irstd = sqrtf(ms);
    u32x2* o8 = (u32x2*)orow + lane;
#pragma unroll
    for (int j = 0; j < 8; ++j) { u32x2 w; w.x = pk2(v[j].x * rstd, v[j].y * rstd); w.y = pk2(v[j].z * rstd, v[j].w * rstd); o8[64 * j] = w; }
}
__device__ __forceinline__ void p0_ssm_tables(Frame& F, int g, int qr) {
    LAS float* LP = (LAS float*)F.lds; LAS float* BB = LP + 17 * 64 * 2; LAS float* CC = BB + 64 * 16 * 2; LAS float* KT = CC + 16 * 64 * 2;
    const float* a_re = F.in[7]; const float* a_im = F.in[8]; const float* log_dt = F.in[9]; const float* b_re = F.in[10]; const float* b_im = F.in[11]; const float* c_re = F.in[12]; const float* c_im = F.in[13];
    const int tid = F.wave * 64 + lane_id();
    if (tid < 64) {
        const int n = tid;
        const double dt = exp((double)log_dt[g]);
        const double are = (double)a_re[g * 64 + n], aim = (double)a_im[g * 64 + n];
        const double mag = exp(are * dt), ang = aim * dt;
        const double lre = mag * cos(ang), lim = mag * sin(ang);
        const double nr = lre - 1.0, ni = lim, den = are * are + aim * aim;
        const double fre = (nr * are + ni * aim) / den, fim = (ni * are - nr * aim) / den;
        double pr = 1.0, pi = 0.0;
        for (int t = 0; t <= 16; ++t) { LP[(t * 64 + n) * 2] = (float)pr; LP[(t * 64 + n) * 2 + 1] = (float)pi; const double nre = pr * lre - pi * lim, nim = pr * lim + pi * lre; pr = nre; pi = nim; }
        if (qr == 0) { float* l16 = (float*)(F.ws + WS_L16) + (g * 64 + n) * 2; l16[0] = LP[(16 * 64 + n) * 2]; l16[1] = LP[(16 * 64 + n) * 2 + 1]; }
        for (int p = 0; p < 16; ++p) { const double br = (double)b_re[(g * 64 + n) * 16 + p], bi = (double)b_im[(g * 64 + n) * 16 + p];
            BB[(n * 16 + p) * 2] = (float)(fre * br - fim * bi); BB[(n * 16 + p) * 2 + 1] = (float)(fre * bi + fim * br); }
    }
    for (int e = tid; e < 1024; e += 512) { CC[e * 2] = c_re[g * 1024 + e]; CC[e * 2 + 1] = c_im[g * 1024 + e]; }
    __syncthreads();
    {
        const int p = (tid >> 4) & 15, q = tid & 15, th = tid >> 8; float ka[8];
#pragma unroll
        for (int j = 0; j < 8; ++j) ka[j] = 0.f;
        for (int n = 0; n < 64; ++n) {
            const f32x2 c = *(const LAS f32x2*)(CC + (p * 64 + n) * 2), bb = *(const LAS f32x2*)(BB + (n * 16 + q) * 2);
            const float cbr = c.x * bb.x - c.y * bb.y, cbi = c.x * bb.y + c.y * bb.x;
#pragma unroll
            for (int j = 0; j < 8; ++j) { const f32x2 l = *(const LAS f32x2*)(LP + ((8 * th + j) * 64 + n) * 2); ka[j] += cbr * l.x - cbi * l.y; }
        }
#pragma unroll
        for (int j = 0; j < 8; ++j) KT[((8 * th + j) * 16 + p) * 16 + q] = ka[j];
    }
    __syncthreads();
    bf16_t* Bg = (bf16_t*)(F.ws + WS_BG) + (size_t)g * 256 * SSM_KA;
    for (int ch = tid; ch < 64 * 48; ch += 512) {
        const int rl = ch / 48, c8 = ch % 48, t = 4 * qr + (rl >> 4), p = rl & 15; float v[8];
        if (c8 < 32) { const int s = c8 >> 1, q0 = (c8 & 1) * 8;
#pragma unroll
            for (int i = 0; i < 8; ++i) v[i] = (s <= t) ? KT[((t - s) * 16 + p) * 16 + q0 + i] : 0.f;
        } else { const int n0 = (c8 - 32) * 4;
#pragma unroll
            for (int i = 0; i < 4; ++i) { const int n = n0 + i; const float cr = CC[(p * 64 + n) * 2], ci = CC[(p * 64 + n) * 2 + 1], lr = LP[((t + 1) * 64 + n) * 2], li = LP[((t + 1) * 64 + n) * 2 + 1];
                v[2 * i] = cr * lr - ci * li; v[2 * i + 1] = -(cr * li + ci * lr); }
        }
        u32x4 o; o.x = pk2(v[0], v[1]); o.y = pk2(v[2], v[3]); o.z = pk2(v[4], v[5]); o.w = pk2(v[6], v[7]);
        *(u32x4*)(Bg + (size_t)(t * 16 + p) * SSM_KA + c8 * 8) = o;
    }
    bf16_t* Pg = (bf16_t*)(F.ws + WS_PG) + (size_t)g * 256 * 256;
    for (int ch = tid; ch < 32 * 32; ch += 512) {
        const int rl = ch >> 5, c8 = ch & 31, n = 16 * qr + (rl >> 1), ri = rl & 1, s = c8 >> 1, q0 = (c8 & 1) * 8; float v[8];
        const float lr = LP[((15 - s) * 64 + n) * 2], li = LP[((15 - s) * 64 + n) * 2 + 1];
#pragma unroll
        for (int i = 0; i < 8; ++i) { const float br = BB[(n * 16 + q0 + i) * 2], bi = BB[(n * 16 + q0 + i) * 2 + 1]; v[i] = ri ? (lr * bi + li * br) : (lr * br - li * bi); }
        u32x4 o; o.x = pk2(v[0], v[1]); o.y = pk2(v[2], v[3]); o.z = pk2(v[4], v[5]); o.w = pk2(v[6], v[7]);
        *(u32x4*)(Pg + (size_t)(2 * n + ri) * 256 + c8 * 8) = o;
        *(u32x4*)(Pg + (size_t)(128 + 32 * qr + rl) * 256 + c8 * 8) = (u32x4){0u, 0u, 0u, 0u};
    }
    __syncthreads();
}
__device__ __forceinline__ void p0_prologue(Frame& F) {
    for (int it = F.vcu; it < 256; it += F.G) p0_ssm_tables(F, it >> 2, it & 3);
    LAS float* scr = (LAS float*)(F.lds + F.wave * 16384);
    const int lane = lane_id();
    const int gw = F.vcu * NWAVES + F.wave, NGW = F.G * NWAVES;
    constexpr int I_IN = (D_MODEL / 64) * (IN_W / 32);
    {
        TItem t{F.in[3], (bf16_t*)(F.ws + WS_WIN), F.in[2]  , D_MODEL, IN_W, 128, 0, 0};
        float va[32], vb[32];
        int it = gw;
        if (it < I_IN) { t.item = it; titem_load(t, va, lane); }
        for (; it < I_IN; it += 2 * NGW) {
            TItem t2 = t; const bool h2 = it + NGW < I_IN;
            if (h2) { t2.item = it + NGW; titem_load(t2, vb, lane); }
            t.item = it; titem_store(t, va, scr, lane);
            if (h2) { if (it + 2 * NGW < I_IN) { t.item = it + 2 * NGW; titem_load(t, va, lane); } titem_store(t2, vb, scr, lane); }
        }
    }
    {
        bf16_t* xn = (bf16_t*)(F.ws + WS_XN); const float* x = F.in[0]; float* ir = (float*)(F.ws + WS_IRSTD1);
        f32x4 ra[8], rb[8];
        int m = gw;
        if (m < M) rms_row_load(x + (size_t)m * D_MODEL, ra, lane);
        for (; m < M; m += 2 * NGW) {
            const bool h2 = m + NGW < M;
            if (h2) rms_row_load(x + (size_t)(m + NGW) * D_MODEL, rb, lane);
            rms_row_store(ra, ir + m, xn + (size_t)m * D_MODEL, lane);
            if (h2) { if (m + 2 * NGW < M) rms_row_load(x + (size_t)(m + 2 * NGW) * D_MODEL, ra, lane); rms_row_store(rb, ir + m + NGW, xn + (size_t)(m + NGW) * D_MODEL, lane); }
        }
    }
}
__device__ __forceinline__ bool late_item(Frame& F, int r, TItem& t) {
    constexpr int I_GLU = (SSM_W / 64) * (SSM_W / 32), I_OUT = (2048 / 64) * (D_MODEL / 32), I_G = (D_MODEL / 64) * (FF / 32), I_D = (FF / 64) * (D_MODEL / 32);
    if (r >= I_GLU + I_OUT + 2 * I_G + I_D) return false;
    if (r < I_GLU) { t = TItem{F.in[15], (bf16_t*)(F.ws + WS_WGLU), nullptr, SSM_W, SSM_W, 128, 0, r}; return true; } r -= I_GLU;
    if (r < I_OUT) {
        const int kb = r / (D_MODEL / 32); t = TItem{F.in[18], (bf16_t*)(F.ws + WS_WOUT), (kb < 16) ? F.in[16] : (F.in[17] - 1024), 2048, D_MODEL, 128, 0, r}; return true; } r -= I_OUT;
    if (r < I_G) { t = TItem{F.in[20], (bf16_t*)(F.ws + WS_WGU), F.in[19], D_MODEL, FF, 256, 0, r}; return true; } r -= I_G;
    if (r < I_G) { t = TItem{F.in[21], (bf16_t*)(F.ws + WS_WGU), F.in[19], D_MODEL, FF, 256, 128, r}; return true; } r -= I_G;
    t = TItem{F.in[22], (bf16_t*)(F.ws + WS_WDN), nullptr, FF, D_MODEL, 128, 0, r}; return true;
}
__device__ __forceinline__ void convert_late_weights(Frame& F, int w, int nw) {
    LAS float* scr = (LAS float*)(F.lds + F.wave * 16384);
    const int lane = lane_id();
    TItem ta, tb; float va[32], vb[32];
    int it = w;
    bool ha = late_item(F, it, ta);
    if (ha) titem_load(ta, va, lane);
    while (ha) {
        const bool hb = late_item(F, it + nw, tb);
        if (hb) titem_load(tb, vb, lane);
        titem_store(ta, va, scr, lane);
        it += 2 * nw;
        ha = hb && late_item(F, it, ta);
        if (hb) { if (ha) titem_load(ta, va, lane); titem_store(tb, vb, scr, lane); }
    }
}

using pg8::Unit;
struct EpiIn {
    static constexpr bool PERM = true, AFTER_DRAIN = false; static constexpr int MID_T = 0;
    bf16_t* Q; bf16_t* Kb; bf16_t* Vb; bf16_t* Ag;
    __device__ __forceinline__ void operator()(const f32x4 (&acc)[2][2][4][2], const Unit& u, int wr, int wc, int fr, int fq) const {
        asm volatile("" : "+v"(fr), "+v"(fq));
        const int row0 = u.pm * 256 + wr * 64 + fr, pn = u.pn;
#pragma unroll
        for (int ai = 0; ai < 2; ++ai)
#pragma unroll
            for (int m = 0; m < 4; ++m) { const int row = row0 + ai * 128 + m * 16;
#pragma unroll
                for (int bj = 0; bj < 2; ++bj) { const int col = bj * 128 + wc * 32 + 8 * fq; const f32x4 v0 = acc[ai][bj][m][0], v1 = acc[ai][bj][m][1];
                    u32x4 w; w.x = cvt_pk_bf16(v0[0], v0[1]); w.y = cvt_pk_bf16(v0[2], v0[3]); w.z = cvt_pk_bf16(v1[0], v1[1]); w.w = cvt_pk_bf16(v1[2], v1[3]);
                    bf16_t* dst;
                    if (pn < 4) dst = Q + (size_t)row * ATTN_W + pn * 256 + col;
                    else if (pn == 4) dst = Kb + (size_t)row * KV_W + col;
                    else if (pn == 5) dst = Vb + (size_t)row * KV_W + col;
                    else { const int c = (pn - 6) * 256 + col; dst = Ag + ((size_t)(c >> 4) * 1024 + (row >> 4)) * SSM_KA + (row & 15) * 16 + (c & 15); }
                    *(u32x4*)dst = w; } }
    }
};
struct EpiS {
    static constexpr bool PERM = false, AFTER_DRAIN = true; static constexpr int MID_T = 0;
    __device__ __forceinline__ void operator()(const f32x4 (&acc)[2][2][4][2], const Unit& u, int wr, int wc, int fr, int fq) const {}
    __device__ __forceinline__ void fused(const f32x4 (&acc)[2][2][4][2], const Unit& u, int wr, int wc, int fr, int fq, LAS unsigned char* lds) const {
        asm volatile("" : "+v"(fr), "+v"(fq));
#pragma unroll
        for (int ai = 0; ai < 2; ++ai)
#pragma unroll
            for (int m = 0; m < 4; ++m) { const int r = ai * 128 + wr * 64 + m * 16 + fr;
#pragma unroll
                for (int n = 0; n < 2; ++n) *(LAS f32x4*)(lds + r * 512 + (((wc * 32 + n * 16 + 4 * fq) * 4) ^ ((r & 7) << 4))) = acc[ai][0][m][n]; }
    }
};
struct EpiY {
    static constexpr bool PERM = true, AFTER_DRAIN = false; static constexpr int MID_T = 0;
    const bf16_t* Ag; const float* dd; bf16_t* Yg;
    __device__ __forceinline__ void operator()(const f32x4 (&acc)[2][2][4][2], const Unit& u, int wr, int wc, int fr, int fq) const {
        asm volatile("" : "+v"(fr), "+v"(fq));
        const int g = u.pm >> 2; const int p0 = (8 * fq) & 15;
        const f32x4 d0 = *(const f32x4*)(dd + g * 16 + p0), d1 = *(const f32x4*)(dd + g * 16 + p0 + 4);
        const size_t grow0 = (size_t)u.pm * 256 + wr * 64 + fr; const int col0 = wc * 32 + 8 * fq;
        u32x4 uu[2][4][2];
#pragma unroll
        for (int ai = 0; ai < 2; ++ai)
#pragma unroll
            for (int m = 0; m < 4; ++m)
#pragma unroll
                for (int bj = 0; bj < 2; ++bj) uu[ai][m][bj] = *(const u32x4*)(Ag + (grow0 + ai * 128 + m * 16) * SSM_KA + bj * 128 + col0);
#pragma unroll
        for (int ai = 0; ai < 2; ++ai)
#pragma unroll
            for (int m = 0; m < 4; ++m) { const size_t grow = grow0 + ai * 128 + m * 16;
#pragma unroll
                for (int bj = 0; bj < 2; ++bj) { const u32x4 w_ = uu[ai][m][bj]; const f32x4 v0 = acc[ai][bj][m][0], v1 = acc[ai][bj][m][1];
                    const float y0 = gelu_tanh(v0[0] + d0[0] * bf_lo(w_.x)), y1 = gelu_tanh(v0[1] + d0[1] * bf_hi(w_.x)), y2 = gelu_tanh(v0[2] + d0[2] * bf_lo(w_.y)), y3 = gelu_tanh(v0[3] + d0[3] * bf_hi(w_.y));
                    const float y4 = gelu_tanh(v1[0] + d1[0] * bf_lo(w_.z)), y5 = gelu_tanh(v1[1] + d1[1] * bf_hi(w_.z)), y6 = gelu_tanh(v1[2] + d1[2] * bf_lo(w_.w)), y7 = gelu_tanh(v1[3] + d1[3] * bf_hi(w_.w));
                    u32x4 w; w.x = cvt_pk_bf16(y0, y1); w.y = cvt_pk_bf16(y2, y3); w.z = cvt_pk_bf16(y4, y5); w.w = cvt_pk_bf16(y6, y7);
                    *(u32x4*)(Yg + grow * 256 + bj * 128 + col0) = w; } }
    }
};
struct EpiGlu {
    static constexpr bool PERM = true, AFTER_DRAIN = false; static constexpr int MID_T = 0;
    const bf16_t* Yg; bf16_t* mixed; float* ssq;
    __device__ __forceinline__ void operator()(const f32x4 (&acc)[2][2][4][2], const Unit& u, int wr, int wc, int fr, int fq) const {
        asm volatile("" : "+v"(fr), "+v"(fq));
        const int row0 = u.pm * 256 + wr * 64 + fr, c0 = u.pn * 256 + wc * 32 + 8 * fq;
        u32x4 yy[2][4][2];
#pragma unroll
        for (int ai = 0; ai < 2; ++ai)
#pragma unroll
            for (int m = 0; m < 4; ++m)
#pragma unroll
                for (int bj = 0; bj < 2; ++bj) { const int c = c0 + bj * 128; yy[ai][m][bj] = *(const u32x4*)(Yg + ((size_t)(c >> 4) * M + row0 + ai * 128 + m * 16) * 16 + (c & 15)); }
#pragma unroll
        for (int ai = 0; ai < 2; ++ai)
#pragma unroll
            for (int m = 0; m < 4; ++m) { const int row = row0 + ai * 128 + m * 16; float sq = 0.f;
#pragma unroll
                for (int bj = 0; bj < 2; ++bj) { const int c = c0 + bj * 128; const u32x4 y_ = yy[ai][m][bj]; const f32x4 v0 = acc[ai][bj][m][0], v1 = acc[ai][bj][m][1];
                    const float s0 = bf_lo(y_.x) * sigmoidf_fast(v0[0]), s1 = bf_hi(y_.x) * sigmoidf_fast(v0[1]), s2 = bf_lo(y_.y) * sigmoidf_fast(v0[2]), s3 = bf_hi(y_.y) * sigmoidf_fast(v0[3]);
                    const float s4 = bf_lo(y_.z) * sigmoidf_fast(v1[0]), s5 = bf_hi(y_.z) * sigmoidf_fast(v1[1]), s6 = bf_lo(y_.w) * sigmoidf_fast(v1[2]), s7 = bf_hi(y_.w) * sigmoidf_fast(v1[3]);
                    sq += (s0 * s0 + s1 * s1) + (s2 * s2 + s3 * s3) + (s4 * s4 + s5 * s5) + (s6 * s6 + s7 * s7);
                    u32x4 w; w.x = cvt_pk_bf16(s0, s1); w.y = cvt_pk_bf16(s2, s3); w.z = cvt_pk_bf16(s4, s5); w.w = cvt_pk_bf16(s6, s7);
                    *(u32x4*)(mixed + (size_t)row * 2048 + 1024 + c) = w; }
                sq += __shfl_xor(sq, 16); sq += __shfl_xor(sq, 32);
                if (fq == 0) atomicAdd(ssq + row, sq); }
    }
};
struct EpiOut {
    static constexpr bool PERM = true, AFTER_DRAIN = false; static constexpr int MID_T = 16;
    const bf16_t* xn; const float* irstd1; bf16_t* x1b; const float* ssq_a; const float* ssq_s; float* ssq_x;
    __device__ __forceinline__ void mid(f32x4 (&acc)[2][2][4][2], const Unit& u, int wr, int wc, int fr, int fq) const {
        asm volatile("" : "+v"(fr), "+v"(fq));
#pragma unroll
        for (int ai = 0; ai < 2; ++ai)
#pragma unroll
            for (int m = 0; m < 4; ++m) { const int row = u.pm * 256 + ai * 128 + wr * 64 + m * 16 + fr;
                const float f = sqrtf((ssq_s[row] * (1.0f / 1024.0f) + EPS) / (ssq_a[row] * (1.0f / 1024.0f) + EPS));
#pragma unroll
                for (int bj = 0; bj < 2; ++bj)
#pragma unroll
                    for (int n = 0; n < 2; ++n) acc[ai][bj][m][n] *= f; }
    }
    __device__ __forceinline__ void operator()(const f32x4 (&acc)[2][2][4][2], const Unit& u, int wr, int wc, int fr, int fq) const {
        asm volatile("" : "+v"(fr), "+v"(fq));
        const int row0 = u.pm * 256 + wr * 64 + fr; const size_t cofs = (size_t)u.pn * 256 + wc * 32 + 8 * fq;
#pragma unroll
        for (int ai = 0; ai < 2; ++ai) {
            float sv[4], iv[4]; u32x4 xb[4][2];
#pragma unroll
            for (int m = 0; m < 4; ++m) { const int row = row0 + ai * 128 + m * 16; sv[m] = ssq_s[row]; iv[m] = irstd1[row];
#pragma unroll
                for (int bj = 0; bj < 2; ++bj) xb[m][bj] = *(const u32x4*)(xn + (size_t)row * D_MODEL + cofs + bj * 128); }
#pragma unroll
            for (int m = 0; m < 4; ++m) { const int row = row0 + ai * 128 + m * 16; const float rstd = 1.0f / sqrtf(sv[m] * (1.0f / 1024.0f) + EPS), ir = iv[m]; float sq = 0.f;
#pragma unroll
                for (int bj = 0; bj < 2; ++bj) { const size_t off = (size_t)row * D_MODEL + cofs + bj * 128; const u32x4 x_ = xb[m][bj];
                    const f32x4 b0 = {bf_lo(x_.x), bf_hi(x_.x), bf_lo(x_.y), bf_hi(x_.y)}, b1 = {bf_lo(x_.z), bf_hi(x_.z), bf_lo(x_.w), bf_hi(x_.w)};
                    const f32x4 o0 = b0 * ir + acc[ai][bj][m][0] * rstd, o1 = b1 * ir + acc[ai][bj][m][1] * rstd;
                    sq += (o0[0] * o0[0] + o0[1] * o0[1]) + (o0[2] * o0[2] + o0[3] * o0[3]) + (o1[0] * o1[0] + o1[1] * o1[1]) + (o1[2] * o1[2] + o1[3] * o1[3]);
                    u32x4 w; w.x = cvt_pk_bf16(o0[0], o0[1]); w.y = cvt_pk_bf16(o0[2], o0[3]); w.z = cvt_pk_bf16(o1[0], o1[1]); w.w = cvt_pk_bf16(o1[2], o1[3]);
                    *(u32x4*)(x1b + off) = w; }
                sq += __shfl_xor(sq, 16); sq += __shfl_xor(sq, 32); if (fq == 0) atomicAdd(ssq_x + row, sq); }
        }
    }
};
struct EpiGU {
    static constexpr bool PERM = true, AFTER_DRAIN = false; static constexpr int MID_T = 0;
    const float* ssq_x; bf16_t* H;
    __device__ __forceinline__ void operator()(const f32x4 (&acc)[2][2][4][2], const Unit& u, int wr, int wc, int fr, int fq) const {
        asm volatile("" : "+v"(fr), "+v"(fq));
        const int row0 = u.pm * 256 + wr * 64 + fr;
        float sv[2][4];
#pragma unroll
        for (int ai = 0; ai < 2; ++ai)
#pragma unroll
            for (int m = 0; m < 4; ++m) sv[ai][m] = ssq_x[row0 + ai * 128 + m * 16];
#pragma unroll
        for (int ai = 0; ai < 2; ++ai)
#pragma unroll
            for (int m = 0; m < 4; ++m) { const int row = row0 + ai * 128 + m * 16; const float rstd = 1.0f / sqrtf(sv[ai][m] * (1.0f / 2048.0f) + EPS);
                float h[8];
#pragma unroll
                for (int n = 0; n < 2; ++n)
#pragma unroll
                    for (int i = 0; i < 4; ++i) { const float gv = acc[ai][0][m][n][i] * rstd, uv = acc[ai][1][m][n][i] * rstd; h[4 * n + i] = gv * sigmoidf_fast(gv) * uv; }
                u32x4 w; w.x = cvt_pk_bf16(h[0], h[1]); w.y = cvt_pk_bf16(h[2], h[3]); w.z = cvt_pk_bf16(h[4], h[5]); w.w = cvt_pk_bf16(h[6], h[7]);
                *(u32x4*)(H + (size_t)row * FF + u.pn * 128 + wc * 32 + 8 * fq) = w; }
    }
};
template <bool DRY> struct EpiDown {
    static constexpr bool PERM = true, AFTER_DRAIN = false; static constexpr int MID_T = 0;
    const bf16_t* x1b; float* out; float* trash;
    __device__ __forceinline__ void operator()(const f32x4 (&acc)[2][2][4][2], const Unit& u, int wr, int wc, int fr, int fq) const {
        asm volatile("" : "+v"(fr), "+v"(fq));
        const int row0 = u.pm * 256 + wr * 64 + fr; const size_t cofs = (size_t)u.pn * 256 + wc * 32 + 8 * fq;
        u32x4 xb[2][4][2];
#pragma unroll
        for (int ai = 0; ai < 2; ++ai)
#pragma unroll
            for (int m = 0; m < 4; ++m)
#pragma unroll
                for (int bj = 0; bj < 2; ++bj) xb[ai][m][bj] = *(const u32x4*)(x1b + (size_t)(row0 + ai * 128 + m * 16) * D_MODEL + cofs + bj * 128);
#pragma unroll
        for (int ai = 0; ai < 2; ++ai)
#pragma unroll
            for (int m = 0; m < 4; ++m) { const int row = row0 + ai * 128 + m * 16;
#pragma unroll
                for (int bj = 0; bj < 2; ++bj) { const size_t off = (size_t)row * D_MODEL + cofs + bj * 128; const u32x4 x_ = xb[ai][m][bj];
                    const f32x4 b0 = {bf_lo(x_.x), bf_hi(x_.x), bf_lo(x_.y), bf_hi(x_.y)}, b1 = {bf_lo(x_.z), bf_hi(x_.z), bf_lo(x_.w), bf_hi(x_.w)};
                    float* q = DRY ? trash + (off & ((8u << 20) - 1)) : out + off;
                    *(f32x4*)q = b0 + acc[ai][bj][m][0]; *(f32x4*)(q + 4) = b1 + acc[ai][bj][m][1]; } }
    }
};

constexpr int ATT_KROW = 144, ATT_VROW = 520, ATT_K_OFF = 0, ATT_V_OFF = 256 * ATT_KROW, ATT_B_OFF = ATT_V_OFF + 64 * ATT_VROW;
constexpr int ATT_TAB = 192;
static_assert(ATT_B_OFF + 4 * ATT_TAB * 4 <= RING_BYTES, "attention LDS");
template <int STG_REPS = 1, int TASK_REPS = 1>
__device__ __forceinline__ void attn_unit(Frame& F, int b, int qb, int kvh, float* ssq_real) {
    LAS unsigned char* lds = F.lds;
    const int lane = lane_id(), wave = F.wave, tid = wave * 64 + lane;
    const bf16_t* Q = (const bf16_t*)(F.ws + WS_Q); const bf16_t* Kb = (const bf16_t*)(F.ws + WS_K); const bf16_t* Vb = (const bf16_t*)(F.ws + WS_V);
    bf16_t* mixed = (bf16_t*)(F.ws + WS_MIX);
    const int T0 = b * SEQ + qb * 128;
    const int q = lane & 31, hh = lane >> 5;
    u32x4 qraw[2][4];
#pragma unroll
    for (int it = 0; it < 2; ++it) { const int task = wave + 8 * it; const bf16_t* qp = Q + (size_t)(T0 + 32 * (task & 3) + q) * ATTN_W + (kvh * 4 + (task >> 2)) * 64 + hh * 8;
#pragma unroll
        for (int ks = 0; ks < 4; ++ks) qraw[it][ks] = *(const u32x4*)(qp + 16 * ks); }
    for (int srep = 0; srep < STG_REPS; ++srep)
    {
        const int key = tid & 255; const bool valid = (qb > 0) || (key >= 128);
        const size_t tok = (size_t)(T0 - 128 + key);
        u32x4 c[8];
        const bf16_t* src = ((tid < 256) ? Kb : Vb) + tok * KV_W + kvh * 64;
#pragma unroll
        for (int i = 0; i < 8; ++i) c[i] = valid ? *(const u32x4*)(src + 8 * i) : (u32x4){0u, 0u, 0u, 0u};
        if (tid < 256) {
            float ss = 0.f;
#pragma unroll
            for (int i = 0; i < 8; ++i) { const float a0 = bf_lo(c[i].x), a1 = bf_hi(c[i].x), a2 = bf_lo(c[i].y), a3 = bf_hi(c[i].y), a4 = bf_lo(c[i].z), a5 = bf_hi(c[i].z), a6 = bf_lo(c[i].w), a7 = bf_hi(c[i].w);
                ss += (a0 * a0 + a1 * a1) + (a2 * a2 + a3 * a3) + (a4 * a4 + a5 * a5) + (a6 * a6 + a7 * a7); }
            const float rstd = 1.0f / sqrtf(ss * (1.0f / 64.0f) + EPS);
            const float* kg = F.in[5];
#pragma unroll
            for (int i = 0; i < 8; ++i) { const f32x4 g0 = *(const f32x4*)(kg + 8 * i), g1 = *(const f32x4*)(kg + 8 * i + 4);
                u32x4 w; w.x = cvt_pk_bf16(bf_lo(c[i].x) * rstd * g0[0], bf_hi(c[i].x) * rstd * g0[1]); w.y = cvt_pk_bf16(bf_lo(c[i].y) * rstd * g0[2], bf_hi(c[i].y) * rstd * g0[3]);
                w.z = cvt_pk_bf16(bf_lo(c[i].z) * rstd * g1[0], bf_hi(c[i].z) * rstd * g1[1]); w.w = cvt_pk_bf16(bf_lo(c[i].w) * rstd * g1[2], bf_hi(c[i].w) * rstd * g1[3]);
                *(LAS u32x4*)(lds + ATT_K_OFF + key * ATT_KROW + i * 16) = w; }
        } else {
#pragma unroll
            for (int i = 0; i < 8; ++i) { const unsigned w4[4] = {c[i].x, c[i].y, c[i].z, c[i].w};
#pragma unroll
                for (int j = 0; j < 4; ++j) { *(LAS unsigned short*)(lds + ATT_V_OFF + (8 * i + 2 * j) * ATT_VROW + key * 2) = (unsigned short)(w4[j] & 0xffffu);
                    *(LAS unsigned short*)(lds + ATT_V_OFF + (8 * i + 2 * j + 1) * ATT_VROW + key * 2) = (unsigned short)(w4[j] >> 16); } }
        }
        for (int e = tid; e < 4 * ATT_TAB; e += NWAVES * 64) { const int hl = e / ATT_TAB, dist = e % ATT_TAB - 32;
            ((LAS float*)(lds + ATT_B_OFF))[e] = ((unsigned)dist < 128u) ? F.in[1][(int)kBucket[dist & 127] * NQH + kvh * 4 + hl] * LOG2E : -INFINITY; }
    }
    bf16x8 qf2[2][4];
    { const float* qg = F.in[4]; f32x4 gq[4][2];
#pragma unroll
      for (int ks = 0; ks < 4; ++ks) { gq[ks][0] = *(const f32x4*)(qg + 16 * ks + 8 * hh); gq[ks][1] = *(const f32x4*)(qg + 16 * ks + 8 * hh + 4); }
#pragma unroll
      for (int it = 0; it < 2; ++it) { float ss = 0.f;
#pragma unroll
        for (int ks = 0; ks < 4; ++ks) { const u32x4 w_ = qraw[it][ks];
            const float a0 = bf_lo(w_.x), a1 = bf_hi(w_.x), a2 = bf_lo(w_.y), a3 = bf_hi(w_.y), a4 = bf_lo(w_.z), a5 = bf_hi(w_.z), a6 = bf_lo(w_.w), a7 = bf_hi(w_.w);
            ss += (a0 * a0 + a1 * a1) + (a2 * a2 + a3 * a3) + (a4 * a4 + a5 * a5) + (a6 * a6 + a7 * a7); }
        ss += __shfl_xor(ss, 32);
        const float sc = (1.0f / sqrtf(ss * (1.0f / 64.0f) + EPS)) * (0.125f * LOG2E);
#pragma unroll
        for (int ks = 0; ks < 4; ++ks) { const u32x4 w_ = qraw[it][ks]; const f32x4 g0 = gq[ks][0], g1 = gq[ks][1];
            u32x4 w; w.x = cvt_pk_bf16(bf_lo(w_.x) * sc * g0[0], bf_hi(w_.x) * sc * g0[1]); w.y = cvt_pk_bf16(bf_lo(w_.y) * sc * g0[2], bf_hi(w_.y) * sc * g0[3]);
            w.z = cvt_pk_bf16(bf_lo(w_.z) * sc * g1[0], bf_hi(w_.z) * sc * g1[1]); w.w = cvt_pk_bf16(bf_lo(w_.w) * sc * g1[2], bf_hi(w_.w) * sc * g1[3]);
            qf2[it][ks] = __builtin_bit_cast(bf16x8, w); } } }
    __syncthreads();
    for (int trep = 0; trep < TASK_REPS; ++trep)
#pragma unroll
    for (int it = 0; it < 2; ++it) {
        float* ssq_a = (trep == TASK_REPS - 1) ? ssq_real : (float*)(F.ws + WS_SSQ_T);
        const int task = wave + 8 * it, hl = task >> 2, grp = task & 3, hq = kvh * 4 + hl, qi = 32 * grp + q;
        const bf16x8 (&qf)[4] = qf2[it];
        const LAS float* tb = (const LAS float*)(lds + ATT_B_OFF) + hl * ATT_TAB + (q + 128 - 4 * hh + 32 - 155);
        const float sink2 = F.in[6][hq] * LOG2E;
        f32x16 s[5];
#pragma unroll
        for (int kt = 0; kt < 5; ++kt) {
            f32x16 a;
#pragma unroll
            for (int r = 0; r < 16; ++r) a[r] = tb[155 - 32 * kt - ((r & 3) + 8 * (r >> 2))];
#pragma unroll
            for (int ks = 0; ks < 4; ++ks) { const bf16x8 kf = *(const LAS bf16x8*)(lds + ATT_K_OFF + (32 * (grp + kt) + q) * ATT_KROW + (16 * ks + 8 * hh) * 2);
                a = __builtin_amdgcn_mfma_f32_32x32x16_bf16(kf, qf[ks], a, 0, 0, 0); }
            if (qb == 0 && grp + kt < 4) {
#pragma unroll
                for (int r = 0; r < 16; ++r) a[r] = -INFINITY; }
            s[kt] = a;
        }
        float mx = sink2;
#pragma unroll
        for (int kt = 0; kt < 5; ++kt)
#pragma unroll
            for (int r = 0; r < 16; ++r) mx = fmaxf(mx, s[kt][r]);
        mx = fmaxf(mx, __shfl_xor(mx, 32));
        float l = 0.f;
#pragma unroll
        for (int kt = 0; kt < 5; ++kt)
#pragma unroll
            for (int r = 0; r < 16; ++r) { const float p = fast_exp2(s[kt][r] - mx); s[kt][r] = p; l += p; }
        l += __shfl_xor(l, 32);
        l += fast_exp2(sink2 - mx);
        f32x16 o[2]; o[0] = (f32x16){}; o[1] = (f32x16){};
#pragma unroll
        for (int kt = 0; kt < 5; ++kt)
#pragma unroll
            for (int s2 = 0; s2 < 2; ++s2) {
                u32x4 pw; pw.x = cvt_pk_bf16(s[kt][8 * s2 + 0], s[kt][8 * s2 + 1]); pw.y = cvt_pk_bf16(s[kt][8 * s2 + 2], s[kt][8 * s2 + 3]); pw.z = cvt_pk_bf16(s[kt][8 * s2 + 4], s[kt][8 * s2 + 5]); pw.w = cvt_pk_bf16(s[kt][8 * s2 + 6], s[kt][8 * s2 + 7]);
                const bf16x8 pb = __builtin_bit_cast(bf16x8, pw);
#pragma unroll
                for (int d0 = 0; d0 < 2; ++d0) { const LAS unsigned char* vp = lds + ATT_V_OFF + (32 * d0 + q) * ATT_VROW + (32 * (grp + kt) + 16 * s2 + 4 * hh) * 2;
                    const u32x2 lo = *(const LAS u32x2*)vp, hi = *(const LAS u32x2*)(vp + 16);
                    const u32x4 vv = {lo.x, lo.y, hi.x, hi.y};
                    o[d0] = __builtin_amdgcn_mfma_f32_32x32x16_bf16(__builtin_bit_cast(bf16x8, vv), pb, o[d0], 0, 0, 0); }
            }
        const float inv = 1.0f / l; float sq = 0.f;
        bf16_t* op = mixed + (size_t)(T0 + qi) * 2048 + hq * 64 + 4 * hh;
#pragma unroll
        for (int d0 = 0; d0 < 2; ++d0)
#pragma unroll
            for (int r4 = 0; r4 < 4; ++r4) { const float v0 = o[d0][4 * r4] * inv, v1 = o[d0][4 * r4 + 1] * inv, v2 = o[d0][4 * r4 + 2] * inv, v3 = o[d0][4 * r4 + 3] * inv;
                sq += (v0 * v0 + v1 * v1) + (v2 * v2 + v3 * v3);
                u32x2 w; w.x = cvt_pk_bf16(v0, v1); w.y = cvt_pk_bf16(v2, v3); *(u32x2*)(op + 32 * d0 + 8 * r4) = w; }
        sq += __shfl_xor(sq, 32);
        if (hh == 0) atomicAdd(ssq_a + T0 + qi, sq);
    }
    __syncthreads();
}

template <int MODE = 7>
__device__ __forceinline__ void ssm_unit(Frame& F, int pm) {
    const int g = pm >> 2;
    bf16_t* Ag = (bf16_t*)(F.ws + WS_AG);
    if constexpr (MODE & 1) {
        int Kc = 256; asm volatile("" : "+s"(Kc));
        pg8::Gemm gm{(const char*)Ag, (const char*)(F.ws + WS_PG), Kc, SSM_KA * 2, 32, 128, 256 * 2};
        pg8::OneUnit S1{pm, g}; EpiS E{};
        pg8::gemm_phase<EpiS, pg8::OneUnit, false>(F.lds, F.wave, gm, S1, E);
    }
    asm volatile("s_waitcnt lgkmcnt(0)" ::: "memory");
    __syncthreads();
    if ((MODE & 2) && F.wave == 0) {
        const int n = lane_id();
        const f32x2 l16 = *((const f32x2*)(F.ws + WS_L16) + g * 64 + n);
        float hr = 0.f, hi = 0.f;
        unsigned* hp = (unsigned*)(Ag + (size_t)pm * 256 * SSM_KA + 256) + n;
        for (int c0 = 0; c0 < 256; c0 += 8) {
            f32x2 sv[8];
#pragma unroll
            for (int j = 0; j < 8; ++j) sv[j] = *(const LAS f32x2*)(F.lds + (c0 + j) * 512 + ((8 * n) ^ (j << 4)));
#pragma unroll
            for (int j = 0; j < 8; ++j) { hp[(size_t)(c0 + j) * (SSM_KA / 2)] = cvt_pk_bf16(hr, hi);
                const float nr = l16.x * hr - l16.y * hi + sv[j].x, ni = l16.x * hi + l16.y * hr + sv[j].y; hr = nr; hi = ni; }
        }
    }
    asm volatile("s_waitcnt vmcnt(0) lgkmcnt(0)" ::: "memory");
    __syncthreads();
    if constexpr (MODE & 4) {
        int Kc = SSM_KA; asm volatile("" : "+s"(Kc));
        pg8::Gemm gm{(const char*)Ag, (const char*)(F.ws + WS_BG), Kc, SSM_KA * 2, 32, 128, SSM_KA * 2};
        pg8::OneUnit S1{pm, g}; EpiY E{Ag, F.in[14], (bf16_t*)(F.ws + WS_YG)};
        pg8::gemm_phase<EpiY, pg8::OneUnit, false>(F.lds, F.wave, gm, S1, E);
    }
}


#define XB_TMO      128
#define XB_XCNT(j)  (256  + 64 * (j))
#define XB_XSUB(j)  (1280 + 64 * (j))
#define XB_XGEN(j)  (2304 + 64 * (j))
#define XB_TOP      3328
#define XB_TOPGEN   3392
#define XCD_BAR_WORDS 3456
#define XB_SPIN_CAP (1u << 22)
constexpr size_t WS_BAR = 16384;
__device__ __forceinline__ unsigned xb_ld(unsigned* p)              { return __hip_atomic_load(p, __ATOMIC_RELAXED, __HIP_MEMORY_SCOPE_AGENT); }
__device__ __forceinline__ unsigned xb_add(unsigned* p, unsigned v) { return __hip_atomic_fetch_add(p, v, __ATOMIC_RELAXED, __HIP_MEMORY_SCOPE_AGENT); }
__device__ __forceinline__ unsigned xb_xcc_id() { return (unsigned)__builtin_amdgcn_s_getreg((3 << 11) | 20) & 0xFu; }
#define XB_SPIN(cond, bar) do { unsigned _sp = 0; while (cond) { __builtin_amdgcn_s_sleep(1); \
    if ((++_sp & 255u) == 0u) { if (xb_ld(&(bar)[XB_TMO])) break; if (_sp > XB_SPIN_CAP) { atomicAdd(&(bar)[XB_TMO], 1u); break; } } } } while (0)
struct XcdBarrier { unsigned* bar; unsigned x; volatile LAS unsigned* st; };
__device__ __forceinline__ XcdBarrier xcd_barrier_post(unsigned* bar, volatile LAS unsigned* st) {
    XcdBarrier b; b.bar = bar; b.x = xb_xcc_id(); b.st = st;
    if (threadIdx.x == 0) (void)xb_add(&bar[XB_XCNT(b.x)], 1u);
    return b;
}
__device__ __forceinline__ void xcd_barrier_complete(unsigned* bar, unsigned x, unsigned& nloc, unsigned& nx) {
    const unsigned G = gridDim.x * gridDim.y * gridDim.z;
    unsigned sum, cnt, mine, sp = 0u;
    for (;;) {
        sum = 0u; cnt = 0u; mine = 0u;
#pragma unroll
        for (unsigned j = 0; j < 16; ++j) { const unsigned c = xb_ld(&bar[XB_XCNT(j)]); sum += c; cnt += (c > 0u) ? 1u : 0u; mine = (j == x) ? c : mine; }
        if (sum == G) break;
        __builtin_amdgcn_s_sleep(1);
        if ((++sp & 255u) == 0u) { if (xb_ld(&bar[XB_TMO])) break; if (sp > XB_SPIN_CAP) { atomicAdd(&bar[XB_TMO], 1u); break; } }
    }
    nloc = mine > 0u ? mine : 1u; nx = cnt > 0u ? cnt : 1u;
}
__device__ __forceinline__ void xcd_barrier(const XcdBarrier& b, int wave) {
    asm volatile("s_waitcnt vmcnt(0)" ::: "memory");
    __syncthreads();
    if (wave == 0 && lane_id() == 0) {
        unsigned* bar = b.bar;
        __builtin_amdgcn_s_waitcnt(0);
        unsigned nloc = b.st[0], nx = b.st[1];
        if (nloc == 0u) { xcd_barrier_complete(bar, b.x, nloc, nx); b.st[0] = nloc; b.st[1] = nx; }
        const unsigned old = xb_add(&bar[XB_XSUB(b.x)], 1u);
        const unsigned gen = old / nloc;
        if (old + 1u == (gen + 1u) * nloc) {
            __builtin_amdgcn_fence(__ATOMIC_RELEASE, "agent");
            asm volatile("s_waitcnt vmcnt(0)" ::: "memory");
            const unsigned og = xb_add(&bar[XB_TOP], 1u);
            const unsigned tg = og / nx;
            if (og + 1u == (tg + 1u) * nx) xb_add(&bar[XB_TOPGEN], 1u);
            else XB_SPIN(xb_ld(&bar[XB_TOPGEN]) == tg, bar);
            __builtin_amdgcn_fence(__ATOMIC_ACQUIRE, "agent");
            xb_add(&bar[XB_XGEN(b.x)], 1u);
            asm volatile("s_waitcnt vmcnt(0)" ::: "memory");
        } else {
            XB_SPIN(xb_ld(&bar[XB_XGEN(b.x)]) == gen, bar);
            __builtin_amdgcn_fence(__ATOMIC_ACQUIRE, "agent");
            asm volatile("s_waitcnt vmcnt(0)" ::: "memory");
        }
    }
    __syncthreads();
}

struct Args { const float* in[23]; float* out; unsigned char* ws; int ph_lo, ph_hi; };
__global__ void __launch_bounds__(NWAVES * 64, 2) hymba_fwd(Args args) {
    extern __shared__ __attribute__((aligned(16))) unsigned char lds_raw[];
    Frame F;
    F.lds = (LAS unsigned char*)lds_raw;
    F.wave = __builtin_amdgcn_readfirstlane((int)threadIdx.x >> 6);
    F.G = gridDim.x; { const int bx = blockIdx.x; F.vcu = (F.G % 8 == 0) ? (bx % 8) * (F.G / 8) + bx / 8 : bx; }
    F.in = args.in; F.out = args.out; F.ws = args.ws;
    const int lo = args.ph_lo, hi = args.ph_hi;
    for (int u = threadIdx.x; u < (LDS_BYTES - LDSCTL_OFF) / 4; u += NWAVES * 64) ((LAS unsigned*)(F.lds + LDSCTL_OFF))[u] = 0u;
    __syncthreads();
    XcdBarrier bar; bar.bar = (unsigned*)(F.ws + WS_BAR); bar.x = 0; bar.st = nullptr;
    if (MK_N_LAUNCHES == 1) bar = xcd_barrier_post((unsigned*)(F.ws + WS_BAR), (volatile LAS unsigned*)(F.lds + MISC_OFF) + 8);
#define IN(k) (lo <= (k) && (k) < hi)
#define GRID_BAR(k) do { if (IN(k) && IN((k) + 1)) xcd_barrier(bar, F.wave); } while (0)
    unsigned char* ws = F.ws;
    float* const ssq_trash = (float*)(ws + WS_SSQ_T);
#define PHASE0(DRY) { p0_prologue(F); }
#define PHASE1(DRY) {     \
        pg8::Gemm g{(const char*)(ws + WS_XN), (const char*)(ws + WS_WIN), D_MODEL, D_MODEL * 2, 32, 128, D_MODEL * 2}; \
        pg8::StaticOrder S; S.init(M, IN_W, F.G, (int)blockIdx.x, WGM_P1); \
        EpiIn E{(bf16_t*)(ws + WS_Q), (bf16_t*)(ws + WS_K), (bf16_t*)(ws + WS_V), (bf16_t*)(ws + WS_AG)}; \
        pg8::gemm_phase<EpiIn, pg8::StaticOrder, true>(F.lds, F.wave, g, S, E); \
        { const int nwg_ = (M / 256) * (IN_W / 256), maxu_ = (nwg_ + F.G - 1) / F.G, nheavy_ = nwg_ - (maxu_ - 1) * F.G, nlight_ = F.G - nheavy_, c_ = (int)blockIdx.x;     \
          if (nlight_ == 0) convert_late_weights(F, c_ * NWAVES + F.wave, F.G * NWAVES); \
          else if (c_ >= nheavy_) convert_late_weights(F, (c_ - nheavy_) * NWAVES + F.wave, nlight_ * NWAVES); } }
#define PHASE2(DRY) { \
        float* const sa_ = (DRY) ? ssq_trash : (float*)(ws + WS_SSQ_A); \
        for (int u = F.vcu; u < BATCH * 32 * NKVH; u += F.G) attn_unit<(PROBE_REP == 25 ? 2 : 1), (PROBE_REP == 26 ? 2 : 1)>(F, u >> 7, (u >> 2) & 31, u & 3, sa_); \
        if (F.vcu < 256) ssm_unit(F, F.vcu);     }
#define PHASE3(DRY) {     \
        pg8::Gemm g{(const char*)(ws + WS_YG), (const char*)(ws + WS_WGLU), SSM_W, 32, (unsigned)(M * 32), (unsigned)(4 * M * 32), SSM_W * 2}; \
        pg8::StaticOrder S; S.init(M, SSM_W, F.G, (int)blockIdx.x, WGM_P3); \
        EpiGlu E{(const bf16_t*)(ws + WS_YG), (bf16_t*)(ws + WS_MIX), (DRY) ? ssq_trash : (float*)(ws + WS_SSQ_S)}; \
        pg8::gemm_phase<EpiGlu, pg8::StaticOrder, true>(F.lds, F.wave, g, S, E); }
#define PHASE4(DRY) {     \
        pg8::Gemm g{(const char*)(ws + WS_MIX), (const char*)(ws + WS_WOUT), 2048, 2048 * 2, 32, 128, 2048 * 2}; \
        pg8::StaticOrder S; S.init(M, D_MODEL, F.G, (int)blockIdx.x, WGM_P4); \
        EpiOut E{(const bf16_t*)(ws + WS_XN), (const float*)(ws + WS_IRSTD1), (bf16_t*)(ws + WS_XN), (const float*)(ws + WS_SSQ_A), (const float*)(ws + WS_SSQ_S), (DRY) ? ssq_trash : (float*)(ws + WS_SSQ_X)}; \
        pg8::gemm_phase<EpiOut, pg8::StaticOrder, true>(F.lds, F.wave, g, S, E); }
#define PHASE5(DRY) {     \
        pg8::Gemm g{(const char*)(ws + WS_XN), (const char*)(ws + WS_WGU), D_MODEL, D_MODEL * 2, 32, 128, D_MODEL * 2}; \
        pg8::StaticOrder S; S.init(M, 2 * FF, F.G, (int)blockIdx.x, WGM_P5); \
        EpiGU E{(const float*)(ws + WS_SSQ_X), (bf16_t*)(ws + WS_H)}; \
        pg8::gemm_phase<EpiGU, pg8::StaticOrder, true>(F.lds, F.wave, g, S, E); }
#define PHASE6(DRY) {     \
        pg8::Gemm g{(const char*)(ws + WS_H), (const char*)(ws + WS_WDN), FF, FF * 2, 32, 128, FF * 2}; \
        pg8::StaticOrder S; S.init(M, D_MODEL, F.G, (int)blockIdx.x, WGM_P6); \
        EpiDown<(DRY)> E{(const bf16_t*)(ws + WS_XN), F.out, (float*)(ws + WS_SSCR)}; \
        pg8::gemm_phase<EpiDown<(DRY)>, pg8::StaticOrder, true>(F.lds, F.wave, g, S, E); }
#define PHASE2A(DRY) { for (int u = F.vcu; u < BATCH * 32 * NKVH; u += F.G) attn_unit(F, u >> 7, (u >> 2) & 31, u & 3, ssq_trash); }
#define PHASE2S(DRY) { if (F.vcu < 256) ssm_unit(F, F.vcu); }
#define RUN_PHASE(k, BODY) do { if (PROBE_REP == (k) && IN(k)) { BODY(1); xcd_barrier(bar, F.wave); } if (IN(k)) { BODY(0); } } while (0)
    RUN_PHASE(0, PHASE0);
    GRID_BAR(0);
    if (args.ph_lo < 0) cg::this_grid().sync();
    RUN_PHASE(1, PHASE1);
    GRID_BAR(1);
    if (PROBE_REP == 22 && IN(2)) { if (F.vcu < 256) ssm_unit<1>(F, F.vcu); xcd_barrier(bar, F.wave); }
    if (PROBE_REP == 23 && IN(2)) { if (F.vcu < 256) ssm_unit<2>(F, F.vcu); xcd_barrier(bar, F.wave); }
    if (PROBE_REP == 24 && IN(2)) { if (F.vcu < 256) ssm_unit<4>(F, F.vcu); xcd_barrier(bar, F.wave); }
    if (PROBE_REP == 20 && IN(2)) { PHASE2A(1); xcd_barrier(bar, F.wave); }
    if (PROBE_REP == 21 && IN(2)) { PHASE2S(1); xcd_barrier(bar, F.wave); }
    RUN_PHASE(2, PHASE2);
    GRID_BAR(2);
    RUN_PHASE(3, PHASE3);
    GRID_BAR(3);
    RUN_PHASE(4, PHASE4);
    GRID_BAR(4);
    RUN_PHASE(5, PHASE5);
    GRID_BAR(5);
    RUN_PHASE(6, PHASE6);
#undef IN
#undef GRID_BAR
}

extern "C" void kernel_launch(void* const* d_in, const int* in_sizes, int n_in, void* d_out, int out_size, void* d_ws, size_t ws_size, hipStream_t stream) {
    static int grid = 0;
    if (grid == 0) {
        if (n_in != 23 || in_sizes[0] != M * D_MODEL || out_size != M * D_MODEL || ws_size < WS_END) { fprintf(stderr, "kernel_launch: unexpected sizes (n_in %d, out %d, ws %zu); nothing launched\n", n_in, out_size, ws_size); grid = -1; return; }
        int dev = 0, cus = 0, per_cu = 0;
        if (hipGetDevice(&dev) != hipSuccess || hipDeviceGetAttribute(&cus, hipDeviceAttributeMultiprocessorCount, dev) != hipSuccess) { grid = -1; return; }
        if (hipFuncSetAttribute((const void*)hymba_fwd, hipFuncAttributeMaxDynamicSharedMemorySize, LDS_BYTES) != hipSuccess) { fprintf(stderr, "kernel_launch: hipFuncSetAttribute failed\n"); grid = -1; return; }
        if (hipOccupancyMaxActiveBlocksPerMultiprocessor(&per_cu, (const void*)hymba_fwd, NWAVES * 64, LDS_BYTES) != hipSuccess || per_cu < 1) { fprintf(stderr, "kernel_launch: occupancy query failed (%d)\n", per_cu); (void)hipGetLastError(); grid = -1; return; }
        grid = cus;
        if (grid < 256) { fprintf(stderr, "kernel_launch: this kernel needs >= 256 CUs (got %d); nothing launched\n", grid); grid = -1; return; }
    }
    if (grid < 0) return;
    (void)hipMemsetAsync((char*)d_ws + WS_CTL, 0, CTL_ZERO_BYTES, stream);
    Args a{};
    for (int i = 0; i < 23; ++i) a.in[i] = (const float*)d_in[i];
    a.out = (float*)d_out; a.ws = (unsigned char*)d_ws;
    constexpr int NPH = 7;
    for (int li = 0; li < MK_N_LAUNCHES; ++li) {
        a.ph_lo = (MK_N_LAUNCHES == 1) ? 0 : li; a.ph_hi = (MK_N_LAUNCHES == 1) ? NPH : li + 1;
        void* kargs[] = {&a};
        const hipError_t e = hipLaunchCooperativeKernel((const void*)hymba_fwd, dim3(grid), dim3(NWAVES * 64), kargs, LDS_BYTES, stream);
        if (e != hipSuccess) { fprintf(stderr, "kernel_launch: cooperative launch failed: %s (grid %d)\n", hipGetErrorString(e), grid); break; }
    }
}
```

```cpp
#include <hip/hip_runtime.h>
#include <hip/hip_cooperative_groups.h>
#include <cstdio>
#include <cstdint>
namespace cg = cooperative_groups;

#ifndef PROBE_REP
#define PROBE_REP -1
#endif
#ifndef WGM_P1
#define WGM_P1 4
#define WGM_P3 4
#define WGM_P4 4
#define WGM_P5 4
#define WGM_P6 4
#endif
#ifndef MK_N_LAUNCHES
#define MK_N_LAUNCHES 1
#endif

#define LAS __attribute__((address_space(3)))
typedef unsigned short bf16_t;
typedef short bf16x8 __attribute__((ext_vector_type(8)));
typedef float f32x4 __attribute__((ext_vector_type(4)));
typedef float f32x2 __attribute__((ext_vector_type(2)));
typedef float f32x16 __attribute__((ext_vector_type(16)));
typedef unsigned u32x4 __attribute__((ext_vector_type(4)));
typedef unsigned u32x2 __attribute__((ext_vector_type(2)));

constexpr int D_MODEL = 2048, BATCH = 4, SEQ = 4096, M = BATCH * SEQ;
constexpr int HD = 64, NQH = 16, NKVH = 4, ATTN_W = 1024, KV_W = 256;
constexpr int SSM_W = 1024, SSM_P = 16, SSM_G = 64, SSM_N = 64, IN_W = 2560, FF = 5632;
constexpr int CH_T = 16;
constexpr int SSM_KA = CH_T * SSM_P + 2 * SSM_N;
constexpr float EPS = 1e-6f;
constexpr float LOG2E = 1.4426950408889634f;

__device__ const unsigned char kBucket[128] = {0, 1, 2, 3, 4, 5, 6, 7, 8, 9, 10, 11, 12, 13, 14, 15, 16, 16, 16, 17, 17, 18, 18, 18, 19, 19, 19, 20, 20, 20, 20, 21, 21, 21, 21, 22, 22, 22, 22, 22, 23, 23, 23, 23, 23, 23, 24, 24, 24, 24, 24, 24, 25, 25, 25, 25, 25, 25, 25, 26, 26, 26, 26, 26, 26, 26, 26, 27, 27, 27, 27, 27, 27, 27, 27, 27, 27, 28, 28, 28, 28, 28, 28, 28, 28, 28, 28, 29, 29, 29, 29, 29, 29, 29, 29, 29, 29, 29, 29, 30, 30, 30, 30, 30, 30, 30, 30, 30, 30, 30, 30, 30, 30, 31, 31, 31, 31, 31, 31, 31, 31, 31, 31, 31, 31, 31, 31, 31};

__device__ __forceinline__ unsigned cvt_pk_bf16(float lo, float hi) { unsigned r; asm volatile("v_cvt_pk_bf16_f32 %0, %1, %2" : "=v"(r) : "v"(lo), "v"(hi)); return r; }
__device__ __forceinline__ float bf_lo(unsigned w) { return __builtin_bit_cast(float, w << 16); }
__device__ __forceinline__ float bf_hi(unsigned w) { return __builtin_bit_cast(float, w & 0xffff0000u); }
__device__ __forceinline__ float fast_rcp(float x) { return __builtin_amdgcn_rcpf(x); }
__device__ __forceinline__ float fast_exp2(float x) { return __builtin_amdgcn_exp2f(x); }
__device__ __forceinline__ float sigmoidf_fast(float x) { return fast_rcp(1.0f + fast_exp2(-LOG2E * x)); }
__device__ __forceinline__ float gelu_tanh(float x) {
    const float u2 = 1.5957691216057308f * (x + 0.044715f * x * x * x);
    return x * sigmoidf_fast(u2);
}

__device__ __forceinline__ int lane_id() { int l = __builtin_amdgcn_mbcnt_hi(~0u, __builtin_amdgcn_mbcnt_lo(~0u, 0u)); asm volatile("" : "+v"(l)); return l; }

namespace pg8 {
constexpr int BM = 256, BK = 64, HALF = 128, HTB = HALF * BK * 2  , STAGE_BYTES = 8 * HTB, NXCD = 8, WGM = 4;
__host__ __device__ __forceinline__ int lds_byte(int r, int c) { const int st = (r >> 4) * 2 + (c >> 5), rr = r & 15, cc = c & 31, ob = rr * 64 + cc * 2; return st * 1024 + (ob ^ (((ob >> 9) & 1) << 5)); }
__host__ __device__ __forceinline__ void stage_rc(int b, int& R, int& C) { const int st = b / 1024, sb = b % 1024, swz = sb ^ (((sb >> 9) & 1) << 5); R = (st >> 1) * 16 + swz / 64; C = (st & 1) * 32 + (swz % 64) / 2; }
__host__ __device__ __forceinline__ int perm32(int rho) { const int n = rho >> 4, i = rho & 15; return 8 * (i >> 2) + 4 * n + (i & 3); }

struct Unit { int pm, pn; unsigned aofs, bofs; int part; };
struct Gemm { const char* A; const char* B; int K; unsigned a_rs, a_cs, a_ks, b_rs; };

struct StaticOrder {
    int nM, nN, nwg, G, c, wgm;
    __device__ void init(int Mr, int N, int G_, int c_, int wgm_ = WGM) { nM = Mr / BM; nN = N / BM; nwg = nM * nN; G = G_; c = c_; wgm = wgm_; }
    __device__ bool next(int i, Unit& u) const {
        const long L = (long)i * G + c; if (L >= nwg) return false;
        int wgid = (int)L; { const int q = nwg / NXCD, r = nwg % NXCD, xcd = wgid % NXCD, off = wgid / NXCD; wgid = (xcd < r ? xcd * (q + 1) : r * (q + 1) + (xcd - r) * q) + off; }
        const int nig = wgm * nN, gid = wgid / nig, fm = gid * wgm, gsz = (nM - fm) < wgm ? (nM - fm) : wgm;
        u.pm = fm + ((wgid % nig) % gsz); u.pn = (wgid % nig) / gsz; u.aofs = 0; u.bofs = 0; u.part = 0; return true;
    }
};
struct TwoPartOrder {
    StaticOrder S; unsigned kofs;
    __device__ bool next(int i, Unit& u) const { if (!S.next(i >> 1, u)) return false; u.part = i & 1; u.aofs = u.bofs = (i & 1) ? kofs : 0u; return true; }
};
struct OneUnit {
    int pm, pn;
    __device__ bool next(int i, Unit& u) const { if (i) return false; u.pm = pm; u.pn = pn; u.aofs = 0; u.bofs = 0; u.part = 0; return true; }
};

template <class Epi, class Sched, bool ALIGN_EPI>
__device__ __forceinline__ void gemm_phase(LAS unsigned char* lds, const int wid  , const Gemm g, const Sched& S, const Epi& E) {
    const int lane = lane_id(), tid = wid * 64 + lane, wr = wid >> 2, wc = wid & 3, fr = lane & 15, fq = lane >> 4;
    const int nt = g.K / BK;
    unsigned voffA[2], voffB[2];
#pragma unroll
    for (int i = 0; i < 2; ++i) { int R, C; stage_rc(tid * 16 + i * 8192, R, C); const int Rb = Epi::PERM ? ((R & ~31) + perm32(R & 31)) : R;
        voffA[i] = (unsigned)R * g.a_rs + (unsigned)(C >> 4) * g.a_cs + (unsigned)(C & 15) * 2u; voffB[i] = (unsigned)Rb * g.b_rs + (unsigned)C * 2u; }
    const size_t kstepA = g.a_ks, kstepB = (size_t)(BK * 2);
    const size_t hstepA = (size_t)HALF * g.a_rs, hstepB = (size_t)HALF * g.b_rs, tstepA = 2 * hstepA, tstepB = 2 * hstepB;
    const unsigned ldsw = (unsigned)wid * 1024u;
    const int aoff = lds_byte(wr * 64 + fr, fq * 8), boff = lds_byte(wc * 32 + fr, fq * 8);
#define PG8_SA(b, h) (((b) * 2 + (h)) * HTB)
#define PG8_SB(b, h) ((4 + (b) * 2 + (h)) * HTB)
#define PG8_STAGE(bufoff, gbase, voff) do { _Pragma("unroll") for (int _i = 0; _i < 2; ++_i) \
        __builtin_amdgcn_global_load_lds((const unsigned*)((const char*)(gbase) + (voff)[_i]), (LAS unsigned*)(lds + (bufoff) + ldsw + _i * 8192), 16, 0, 0); } while (0)
#define PG8_LDA(dst, b, h) do { _Pragma("unroll") for (int m = 0; m < 4; ++m) _Pragma("unroll") for (int k = 0; k < 2; ++k) dst[m][k] = *(const LAS bf16x8*)(lds + PG8_SA(b, h) + aoff + m * 2048 + k * 1024); } while (0)
#define PG8_LDB(dst, b, h) do { _Pragma("unroll") for (int n = 0; n < 2; ++n) _Pragma("unroll") for (int k = 0; k < 2; ++k) dst[n][k] = *(const LAS bf16x8*)(lds + PG8_SB(b, h) + boff + n * 2048 + k * 1024); } while (0)
#define PG8_MMA(ai, bj, At, Bt) do { __builtin_amdgcn_s_setprio(1); _Pragma("unroll") for (int m = 0; m < 4; ++m) _Pragma("unroll") for (int n = 0; n < 2; ++n) _Pragma("unroll") for (int k = 0; k < 2; ++k) \
        acc[ai][bj][m][n] = __builtin_amdgcn_mfma_f32_16x16x32_bf16(Bt[n][k], At[m][k], acc[ai][bj][m][n], 0, 0, 0); __builtin_amdgcn_s_setprio(0); } while (0)
#define PG8_WAIT_V(n) asm volatile("s_waitcnt vmcnt(" #n ")" ::: "memory")
#define PG8_WAIT_L(n) asm volatile("s_waitcnt lgkmcnt(" #n ")" ::: "memory")
#define PG8_BAR __builtin_amdgcn_s_barrier()
#define PG8_SCHED __builtin_amdgcn_sched_barrier(0)
    Unit cur, nxt; int ui = 0;
    if (!S.next(0, cur)) return;
    f32x4 acc[2][2][4][2];
#pragma unroll
    for (int a = 0; a < 2; ++a)
#pragma unroll
        for (int b = 0; b < 2; ++b)
#pragma unroll
            for (int m = 0; m < 4; ++m)
#pragma unroll
                for (int n = 0; n < 2; ++n) acc[a][b][m][n] = (f32x4){0.f, 0.f, 0.f, 0.f};
    bf16x8 At[4][2], B0[2][2], B1[2][2];
    const char* cA = g.A + (size_t)cur.pm * tstepA + cur.aofs; const char* cB = g.B + (size_t)cur.pn * tstepB + cur.bofs;
    PG8_STAGE(PG8_SB(0, 0), cB, voffB); PG8_STAGE(PG8_SB(0, 1), cB + hstepB, voffB); PG8_STAGE(PG8_SA(0, 0), cA, voffA); PG8_STAGE(PG8_SA(0, 1), cA + hstepA, voffA);
    if (wr == 1) PG8_BAR;
    PG8_WAIT_V(2); PG8_BAR;
    PG8_STAGE(PG8_SB(1, 0), cB + kstepB, voffB); PG8_STAGE(PG8_SA(1, 0), cA + kstepA, voffA); PG8_STAGE(PG8_SB(1, 1), cB + hstepB + kstepB, voffB);
    PG8_WAIT_V(6); PG8_BAR;
    for (;;) {
        const bool has_next = S.next(ui + 1, nxt);
        const char* nA = has_next ? g.A + (size_t)nxt.pm * tstepA + nxt.aofs : cA; const char* nB = has_next ? g.B + (size_t)nxt.pn * tstepB + nxt.bofs : cB;
        for (int t = 0; t < nt; t += 2) {
            if constexpr (Epi::MID_T > 0) { if (t == Epi::MID_T) E.mid(acc, cur, wr, wc, fr, fq); }
            const bool last = (t == nt - 2);
            const char* a1 = cA + (size_t)(t + 1) * kstepA;
            const char* a2 = last ? nA : cA + (size_t)(t + 2) * kstepA; const char* b2 = last ? nB : cB + (size_t)(t + 2) * kstepB;
            const char* a3 = a2 + kstepA; const char* b3 = b2 + kstepB;
            PG8_LDB(B0, 0, 0); PG8_LDB(B1, 0, 1); PG8_SCHED; PG8_LDA(At, 0, 0); PG8_STAGE(PG8_SA(1, 1), a1 + hstepA, voffA);
            PG8_WAIT_V(8); PG8_WAIT_L(0); PG8_BAR; PG8_MMA(0, 0, At, B0); PG8_MMA(0, 1, At, B1); PG8_BAR; PG8_SCHED;
            PG8_LDA(At, 0, 1); PG8_STAGE(PG8_SB(0, 0), b2, voffB); PG8_STAGE(PG8_SB(0, 1), b2 + hstepB, voffB); PG8_STAGE(PG8_SA(0, 0), a2, voffA);
            PG8_WAIT_V(8); PG8_WAIT_L(0); PG8_BAR; PG8_MMA(1, 0, At, B0); PG8_MMA(1, 1, At, B1); PG8_BAR; PG8_SCHED;
            PG8_LDB(B0, 1, 0); PG8_LDB(B1, 1, 1); PG8_SCHED; PG8_LDA(At, 1, 0); PG8_STAGE(PG8_SA(0, 1), a2 + hstepA, voffA);
            PG8_WAIT_V(8); PG8_WAIT_L(0); PG8_BAR; PG8_MMA(0, 0, At, B0); PG8_MMA(0, 1, At, B1); PG8_BAR; PG8_SCHED;
            PG8_LDA(At, 1, 1); PG8_STAGE(PG8_SB(1, 0), b3, voffB); PG8_STAGE(PG8_SB(1, 1), b3 + hstepB, voffB); PG8_STAGE(PG8_SA(1, 0), a3, voffA);
            PG8_WAIT_V(8); PG8_WAIT_L(0); PG8_BAR; PG8_MMA(1, 0, At, B0); PG8_MMA(1, 1, At, B1); PG8_BAR; PG8_SCHED;
        }
        if constexpr (ALIGN_EPI) { if (wr == 0) PG8_BAR; }
        if constexpr (!Epi::AFTER_DRAIN) E(acc, cur, wr, wc, fr, fq);
        if (!has_next) break;
#pragma unroll
        for (int a = 0; a < 2; ++a)
#pragma unroll
            for (int b = 0; b < 2; ++b)
#pragma unroll
                for (int m = 0; m < 4; ++m)
#pragma unroll
                    for (int n = 0; n < 2; ++n) acc[a][b][m][n] = (f32x4){0.f, 0.f, 0.f, 0.f};
        cur = nxt; cA = nA; cB = nB; ++ui;
        if constexpr (ALIGN_EPI) { if (wr == 1) PG8_BAR; }
    }
    PG8_WAIT_V(0);
    if constexpr (!ALIGN_EPI) { if (wr == 0) PG8_BAR; }
    PG8_BAR;
    if constexpr (Epi::AFTER_DRAIN) E.fused(acc, cur, wr, wc, fr, fq, lds);
#undef PG8_SA
#undef PG8_SB
#undef PG8_STAGE
#undef PG8_LDA
#undef PG8_LDB
#undef PG8_MMA
#undef PG8_WAIT_V
#undef PG8_WAIT_L
#undef PG8_BAR
#undef PG8_SCHED
}
}

constexpr size_t MiB = 1u << 20;
constexpr size_t WS_CTL = 0, CTL_ZERO_BYTES = 1 * MiB;
constexpr size_t WS_SSQ_A = 256 * 1024, WS_SSQ_S = 320 * 1024, WS_SSQ_X = 384 * 1024, WS_SSQ_T = 448 * 1024  ;
constexpr size_t WS_IRSTD1 = 512 * 1024;
constexpr size_t WS_WIN = 2 * MiB;
constexpr size_t WS_WGLU = 12 * MiB;
constexpr size_t WS_WOUT = 14 * MiB;
constexpr size_t WS_WGU = 22 * MiB;
constexpr size_t WS_WDN = 66 * MiB;
constexpr size_t WS_BG = 88 * MiB;
constexpr size_t WS_PG = 100 * MiB;
constexpr size_t WS_L16 = 108 * MiB;
constexpr size_t WS_SSCR = 109 * MiB;
constexpr size_t WS_XN = 141 * MiB;
constexpr size_t WS_Q = 205 * MiB;
constexpr size_t WS_K = 237 * MiB;
constexpr size_t WS_V = 245 * MiB;
constexpr size_t WS_AG = 253 * MiB;
constexpr size_t WS_YG = 301 * MiB;
constexpr size_t WS_MIX = 333 * MiB;
constexpr size_t WS_H = 205 * MiB;
constexpr size_t WS_END = 397 * MiB;
static_assert(WS_H + (size_t)M * FF * 2 <= WS_END, "ws map");

constexpr int RING_BYTES = 131072;
constexpr int LDS_BYTES = 147456;
constexpr int NWAVES = 8;
constexpr int LDSCTL_OFF = RING_BYTES, MISC_OFF = LDSCTL_OFF + 320;

struct Frame {
    LAS unsigned char* lds;
    int wave, vcu, G;
    const float* const* in; float* out; unsigned char* ws;
};

__device__ __forceinline__ float wave_sum(float v) {
#pragma unroll
    for (int o = 1; o < 64; o <<= 1) v += __shfl_xor(v, o);
    return v;
}
__device__ __forceinline__ unsigned f2bf(float f) { unsigned u = __builtin_bit_cast(unsigned, f); return (u + 0x7fffu + ((u >> 16) & 1u)) >> 16; }
__device__ __forceinline__ unsigned pk2(float lo, float hi) { return f2bf(lo) | (f2bf(hi) << 16); }

struct TItem { const float* W; bf16_t* WT; const float* gain; int K, N, rmul, radd, item; };
__device__ __forceinline__ void titem_load(const TItem& t, float (&v)[32], int lane) {
    const int nblk = t.N / 32, kb = t.item / nblk, nb = t.item % nblk, k0 = 64 * kb, n0 = 32 * nb;
    const float* p = t.W + (size_t)(k0 + (lane >> 5)) * t.N + n0 + (lane & 31);
#pragma unroll
    for (int i = 0; i < 32; ++i) v[i] = __builtin_nontemporal_load(p + (size_t)(2 * i) * t.N);
}
__device__ __forceinline__ void titem_store(const TItem& t, const float (&v)[32], LAS float* scr, int lane) {
    const int nblk = t.N / 32, kb = t.item / nblk, nb = t.item % nblk, k0 = 64 * kb, n0 = 32 * nb;
#pragma unroll
    for (int i = 0; i < 32; ++i) scr[(2 * i + (lane >> 5)) * 33 + (lane & 31)] = v[i];
    asm volatile("s_waitcnt lgkmcnt(0)" ::: "memory");
    const int c = lane & 7;
    float gv[8];
#pragma unroll
    for (int i = 0; i < 8; ++i) gv[i] = t.gain ? t.gain[k0 + 8 * c + i] : 1.0f;
#pragma unroll
    for (int j = 0; j < 4; ++j) { const int n = (lane >> 3) + 8 * j; const LAS float* s = scr + (8 * c) * 33 + n; const int nn = n0 + n; const int row = (nn >> 7) * t.rmul + t.radd + (nn & 127);
        u32x4 o; o.x = pk2(s[0 * 33] * gv[0], s[1 * 33] * gv[1]); o.y = pk2(s[2 * 33] * gv[2], s[3 * 33] * gv[3]); o.z = pk2(s[4 * 33] * gv[4], s[5 * 33] * gv[5]); o.w = pk2(s[6 * 33] * gv[6], s[7 * 33] * gv[7]);
        *(u32x4*)(t.WT + (size_t)row * t.K + k0 + 8 * c) = o; }
    asm volatile("s_waitcnt lgkmcnt(0)" ::: "memory");
}
__device__ __forceinline__ void rms_row_load(const float* xrow, f32x4 (&v)[8], int lane) {
    const f32x4* xr = (const f32x4*)xrow + lane;
#pragma unroll
    for (int j = 0; j < 8; ++j) v[j] = __builtin_nontemporal_load(xr + 64 * j);
}
__device__ __forceinline__ void rms_row_store(const f32x4 (&v)[8], float* irstd, bf16_t* orow, int lane) {
    float s = 0.f;
#pragma unroll
    for (int j = 0; j < 8; ++j) s += (v[j].x * v[j].x + v[j].y * v[j].y) + (v[j].z * v[j].z + v[j].w * v[j].w);
    const float ms = wave_sum(s) * (1.0f / D_MODEL) + EPS; const float rstd = 1.0f / sqrtf(ms);
    if (lane == 0) *irstd = sqrtf(ms);
    u32x2* o8 = (u32x2*)orow + lane;
#pragma unroll
    for (int j = 0; j < 8; ++j) { u32x2 w; w.x = pk2(v[j].x * rstd, v[j].y * rstd); w.y = pk2(v[j].z * rstd, v[j].w * rstd); o8[64 * j] = w; }
}
__device__ __forceinline__ void p0_ssm_tables(Frame& F, int g, int qr) {
    LAS float* LP = (LAS float*)F.lds; LAS float* BB = LP + 17 * 64 * 2; LAS float* CC = BB + 64 * 16 * 2; LAS float* KT = CC + 16 * 64 * 2;
    const float* a_re = F.in[7]; const float* a_im = F.in[8]; const float* log_dt = F.in[9]; const float* b_re = F.in[10]; const float* b_im = F.in[11]; const float* c_re = F.in[12]; const float* c_im = F.in[13];
    const int tid = F.wave * 64 + lane_id();
    if (tid < 64) {
        const int n = tid;
        const double dt = exp((double)log_dt[g]);
        const double are = (double)a_re[g * 64 + n], aim = (double)a_im[g * 64 + n];
        const double mag = exp(are * dt), ang = aim * dt;
        const double lre = mag * cos(ang), lim = mag * sin(ang);
        const double nr = lre - 1.0, ni = lim, den = are * are + aim * aim;
        const double fre = (nr * are + ni * aim) / den, fim = (ni * are - nr * aim) / den;
        double pr = 1.0, pi = 0.0;
        for (int t = 0; t <= 16; ++t) { LP[(t * 64 + n) * 2] = (float)pr; LP[(t * 64 + n) * 2 + 1] = (float)pi; const double nre = pr * lre - pi * lim, nim = pr * lim + pi * lre; pr = nre; pi = nim; }
        if (qr == 0) { float* l16 = (float*)(F.ws + WS_L16) + (g * 64 + n) * 2; l16[0] = LP[(16 * 64 + n) * 2]; l16[1] = LP[(16 * 64 + n) * 2 + 1]; }
        for (int p = 0; p < 16; ++p) { const double br = (double)b_re[(g * 64 + n) * 16 + p], bi = (double)b_im[(g * 64 + n) * 16 + p];
            BB[(n * 16 + p) * 2] = (float)(fre * br - fim * bi); BB[(n * 16 + p) * 2 + 1] = (float)(fre * bi + fim * br); }
    }
    for (int e = tid; e < 1024; e += 512) { CC[e * 2] = c_re[g * 1024 + e]; CC[e * 2 + 1] = c_im[g * 1024 + e]; }
    __syncthreads();
    {
        const int p = (tid >> 4) & 15, q = tid & 15, th = tid >> 8; float ka[8];
#pragma unroll
        for (int j = 0; j < 8; ++j) ka[j] = 0.f;
        for (int n = 0; n < 64; ++n) {
            const f32x2 c = *(const LAS f32x2*)(CC + (p * 64 + n) * 2), bb = *(const LAS f32x2*)(BB + (n * 16 + q) * 2);
            const float cbr = c.x * bb.x - c.y * bb.y, cbi = c.x * bb.y + c.y * bb.x;
#pragma unroll
            for (int j = 0; j < 8; ++j) { const f32x2 l = *(const LAS f32x2*)(LP + ((8 * th + j) * 64 + n) * 2); ka[j] += cbr * l.x - cbi * l.y; }
        }
#pragma unroll
        for (int j = 0; j < 8; ++j) KT[((8 * th + j) * 16 + p) * 16 + q] = ka[j];
    }
    __syncthreads();
    bf16_t* Bg = (bf16_t*)(F.ws + WS_BG) + (size_t)g * 256 * SSM_KA;
    for (int ch = tid; ch < 64 * 48; ch += 512) {
        const int rl = ch / 48, c8 = ch % 48, t = 4 * qr + (rl >> 4), p = rl & 15; float v[8];
        if (c8 < 32) { const int s = c8 >> 1, q0 = (c8 & 1) * 8;
#pragma unroll
            for (int i = 0; i < 8; ++i) v[i] = (s <= t) ? KT[((t - s) * 16 + p) * 16 + q0 + i] : 0.f;
        } else { const int n0 = (c8 - 32) * 4;
#pragma unroll
            for (int i = 0; i < 4; ++i) { const int n = n0 + i; const float cr = CC[(p * 64 + n) * 2], ci = CC[(p * 64 + n) * 2 + 1], lr = LP[((t + 1) * 64 + n) * 2], li = LP[((t + 1) * 64 + n) * 2 + 1];
                v[2 * i] = cr * lr - ci * li; v[2 * i + 1] = -(cr * li + ci * lr); }
        }
        u32x4 o; o.x = pk2(v[0], v[1]); o.y = pk2(v[2], v[3]); o.z = pk2(v[4], v[5]); o.w = pk2(v[6], v[7]);
        *(u32x4*)(Bg + (size_t)(t * 16 + p) * SSM_KA + c8 * 8) = o;
    }
    bf16_t* Pg = (bf16_t*)(F.ws + WS_PG) + (size_t)g * 256 * 256;
    for (int ch = tid; ch < 32 * 32; ch += 512) {
        const int rl = ch >> 5, c8 = ch & 31, n = 16 * qr + (rl >> 1), ri = rl & 1, s = c8 >> 1, q0 = (c8 & 1) * 8; float v[8];
        const float lr = LP[((15 - s) * 64 + n) * 2], li = LP[((15 - s) * 64 + n) * 2 + 1];
#pragma unroll
        for (int i = 0; i < 8; ++i) { const float br = BB[(n * 16 + q0 + i) * 2], bi = BB[(n * 16 + q0 + i) * 2 + 1]; v[i] = ri ? (lr * bi + li * br) : (lr * br - li * bi); }
        u32x4 o; o.x = pk2(v[0], v[1]); o.y = pk2(v[2], v[3]); o.z = pk2(v[4], v[5]); o.w = pk2(v[6], v[7]);
        *(u32x4*)(Pg + (size_t)(2 * n + ri) * 256 + c8 * 8) = o;
        *(u32x4*)(Pg + (size_t)(128 + 32 * qr + rl) * 256 + c8 * 8) = (u32x4){0u, 0u, 0u, 0u};
    }
    __syncthreads();
}
__device__ __forceinline__ void p0_prologue(Frame& F) {
    for (int it = F.vcu; it < 256; it += F.G) p0_ssm_tables(F, it >> 2, it & 3);
    LAS float* scr = (LAS float*)(F.lds + F.wave * 16384);
    const int lane = lane_id();
    const int gw = F.vcu * NWAVES + F.wave, NGW = F.G * NWAVES;
    constexpr int I_IN = (D_MODEL / 64) * (IN_W / 32);
    {
        TItem t{F.in[3], (bf16_t*)(F.ws + WS_WIN), F.in[2]  , D_MODEL, IN_W, 128, 0, 0};
        float va[32], vb[32];
        int it = gw;
        if (it < I_IN) { t.item = it; titem_load(t, va, lane); }
        for (; it < I_IN; it += 2 * NGW) {
            TItem t2 = t; const bool h2 = it + NGW < I_IN;
            if (h2) { t2.item = it + NGW; titem_load(t2, vb, lane); }
            t.item = it; titem_store(t, va, scr, lane);
            if (h2) { if (it + 2 * NGW < I_IN) { t.item = it + 2 * NGW; titem_load(t, va, lane); } titem_store(t2, vb, scr, lane); }
        }
    }
    {
        bf16_t* xn = (bf16_t*)(F.ws + WS_XN); const float* x = F.in[0]; float* ir = (float*)(F.ws + WS_IRSTD1);
        f32x4 ra[8], rb[8];
        int m = gw;
        if (m < M) rms_row_load(x + (size_t)m * D_MODEL, ra, lane);
        for (; m < M; m += 2 * NGW) {
            const bool h2 = m + NGW < M;
            if (h2) rms_row_load(x + (size_t)(m + NGW) * D_MODEL, rb, lane);
            rms_row_store(ra, ir + m, xn + (size_t)m * D_MODEL, lane);
            if (h2) { if (m + 2 * NGW < M) rms_row_load(x + (size_t)(m + 2 * NGW) * D_MODEL, ra, lane); rms_row_store(rb, ir + m + NGW, xn + (size_t)(m + NGW) * D_MODEL, lane); }
        }
    }
}
__device__ __forceinline__ bool late_item(Frame& F, int r, TItem& t) {
    constexpr int I_GLU = (SSM_W / 64) * (SSM_W / 32), I_OUT = (2048 / 64) * (D_MODEL / 32), I_G = (D_MODEL / 64) * (FF / 32), I_D = (FF / 64) * (D_MODEL / 32);
    if (r >= I_GLU + I_OUT + 2 * I_G + I_D) return false;
    if (r < I_GLU) { t = TItem{F.in[15], (bf16_t*)(F.ws + WS_WGLU), nullptr, SSM_W, SSM_W, 128, 0, r}; return true; } r -= I_GLU;
    if (r < I_OUT) {
        const int kb = r / (D_MODEL / 32); t = TItem{F.in[18], (bf16_t*)(F.ws + WS_WOUT), (kb < 16) ? F.in[16] : (F.in[17] - 1024), 2048, D_MODEL, 128, 0, r}; return true; } r -= I_OUT;
    if (r < I_G) { t = TItem{F.in[20], (bf16_t*)(F.ws + WS_WGU), F.in[19], D_MODEL, FF, 256, 0, r}; return true; } r -= I_G;
    if (r < I_G) { t = TItem{F.in[21], (bf16_t*)(F.ws + WS_WGU), F.in[19], D_MODEL, FF, 256, 128, r}; return true; } r -= I_G;
    t = TItem{F.in[22], (bf16_t*)(F.ws + WS_WDN), nullptr, FF, D_MODEL, 128, 0, r}; return true;
}
__device__ __forceinline__ void convert_late_weights(Frame& F, int w, int nw) {
    LAS float* scr = (LAS float*)(F.lds + F.wave * 16384);
    const int lane = lane_id();
    TItem ta, tb; float va[32], vb[32];
    int it = w;
    bool ha = late_item(F, it, ta);
    if (ha) titem_load(ta, va, lane);
    while (ha) {
        const bool hb = late_item(F, it + nw, tb);
        if (hb) titem_load(tb, vb, lane);
        titem_store(ta, va, scr, lane);
        it += 2 * nw;
        ha = hb && late_item(F, it, ta);
        if (hb) { if (ha) titem_load(ta, va, lane); titem_store(tb, vb, scr, lane); }
    }
}

using pg8::Unit;
struct EpiIn {
    static constexpr bool PERM = true, AFTER_DRAIN = false; static constexpr int MID_T = 0;
    bf16_t* Q; bf16_t* Kb; bf16_t* Vb; bf16_t* Ag;
    __device__ __forceinline__ void operator()(const f32x4 (&acc)[2][2][4][2], const Unit& u, int wr, int wc, int fr, int fq) const {
        asm volatile("" : "+v"(fr), "+v"(fq));
        const int row0 = u.pm * 256 + wr * 64 + fr, pn = u.pn;
#pragma unroll
        for (int ai = 0; ai < 2; ++ai)
#pragma unroll
            for (int m = 0; m < 4; ++m) { const int row = row0 + ai * 128 + m * 16;
#pragma unroll
                for (int bj = 0; bj < 2; ++bj) { const int col = bj * 128 + wc * 32 + 8 * fq; const f32x4 v0 = acc[ai][bj][m][0], v1 = acc[ai][bj][m][1];
                    u32x4 w; w.x = cvt_pk_bf16(v0[0], v0[1]); w.y = cvt_pk_bf16(v0[2], v0[3]); w.z = cvt_pk_bf16(v1[0], v1[1]); w.w = cvt_pk_bf16(v1[2], v1[3]);
                    bf16_t* dst;
                    if (pn < 4) dst = Q + (size_t)row * ATTN_W + pn * 256 + col;
                    else if (pn == 4) dst = Kb + (size_t)row * KV_W + col;
                    else if (pn == 5) dst = Vb + (size_t)row * KV_W + col;
                    else { const int c = (pn - 6) * 256 + col; dst = Ag + ((size_t)(c >> 4) * 1024 + (row >> 4)) * SSM_KA + (row & 15) * 16 + (c & 15); }
                    *(u32x4*)dst = w; } }
    }
};
struct EpiS {
    static constexpr bool PERM = false, AFTER_DRAIN = true; static constexpr int MID_T = 0;
    __device__ __forceinline__ void operator()(const f32x4 (&acc)[2][2][4][2], const Unit& u, int wr, int wc, int fr, int fq) const {}
    __device__ __forceinline__ void fused(const f32x4 (&acc)[2][2][4][2], const Unit& u, int wr, int wc, int fr, int fq, LAS unsigned char* lds) const {
        asm volatile("" : "+v"(fr), "+v"(fq));
#pragma unroll
        for (int ai = 0; ai < 2; ++ai)
#pragma unroll
            for (int m = 0; m < 4; ++m) { const int r = ai * 128 + wr * 64 + m * 16 + fr;
#pragma unroll
                for (int n = 0; n < 2; ++n) *(LAS f32x4*)(lds + r * 512 + (((wc * 32 + n * 16 + 4 * fq) * 4) ^ ((r & 7) << 4))) = acc[ai][0][m][n]; }
    }
};
struct EpiY {
    static constexpr bool PERM = true, AFTER_DRAIN = false; static constexpr int MID_T = 0;
    const bf16_t* Ag; const float* dd; bf16_t* Yg;
    __device__ __forceinline__ void operator()(const f32x4 (&acc)[2][2][4][2], const Unit& u, int wr, int wc, int fr, int fq) const {
        asm volatile("" : "+v"(fr), "+v"(fq));
        const int g = u.pm >> 2; const int p0 = (8 * fq) & 15;
        const f32x4 d0 = *(const f32x4*)(dd + g * 16 + p0), d1 = *(const f32x4*)(dd + g * 16 + p0 + 4);
        const size_t grow0 = (size_t)u.pm * 256 + wr * 64 + fr; const int col0 = wc * 32 + 8 * fq;
        u32x4 uu[2][4][2];
#pragma unroll
        for (int ai = 0; ai < 2; ++ai)
#pragma unroll
            for (int m = 0; m < 4; ++m)
#pragma unroll
                for (int bj = 0; bj < 2; ++bj) uu[ai][m][bj] = __builtin_nontemporal_load((const u32x4*)(Ag + (grow0 + ai * 128 + m * 16) * SSM_KA + bj * 128 + col0));
#pragma unroll
        for (int ai = 0; ai < 2; ++ai)
#pragma unroll
            for (int m = 0; m < 4; ++m) { const size_t grow = grow0 + ai * 128 + m * 16;
#pragma unroll
                for (int bj = 0; bj < 2; ++bj) { const u32x4 w_ = uu[ai][m][bj]; const f32x4 v0 = acc[ai][bj][m][0], v1 = acc[ai][bj][m][1];
                    const float y0 = gelu_tanh(v0[0] + d0[0] * bf_lo(w_.x)), y1 = gelu_tanh(v0[1] + d0[1] * bf_hi(w_.x)), y2 = gelu_tanh(v0[2] + d0[2] * bf_lo(w_.y)), y3 = gelu_tanh(v0[3] + d0[3] * bf_hi(w_.y));
                    const float y4 = gelu_tanh(v1[0] + d1[0] * bf_lo(w_.z)), y5 = gelu_tanh(v1[1] + d1[1] * bf_hi(w_.z)), y6 = gelu_tanh(v1[2] + d1[2] * bf_lo(w_.w)), y7 = gelu_tanh(v1[3] + d1[3] * bf_hi(w_.w));
                    u32x4 w; w.x = cvt_pk_bf16(y0, y1); w.y = cvt_pk_bf16(y2, y3); w.z = cvt_pk_bf16(y4, y5); w.w = cvt_pk_bf16(y6, y7);
                    *(u32x4*)(Yg + grow * 256 + bj * 128 + col0) = w; } }
    }
};
struct EpiGlu {
    static constexpr bool PERM = true, AFTER_DRAIN = false; static constexpr int MID_T = 0;
    const bf16_t* Yg; bf16_t* mixed; float* ssq;
    __device__ __forceinline__ void operator()(const f32x4 (&acc)[2][2][4][2], const Unit& u, int wr, int wc, int fr, int fq) const {
        asm volatile("" : "+v"(fr), "+v"(fq));
        const int row0 = u.pm * 256 + wr * 64 + fr, c0 = u.pn * 256 + wc * 32 + 8 * fq;
        u32x4 yy[2][4][2];
#pragma unroll
        for (int ai = 0; ai < 2; ++ai)
#pragma unroll
            for (int m = 0; m < 4; ++m)
#pragma unroll
                for (int bj = 0; bj < 2; ++bj) { const int c = c0 + bj * 128; yy[ai][m][bj] = __builtin_nontemporal_load((const u32x4*)(Yg + ((size_t)(c >> 4) * M + row0 + ai * 128 + m * 16) * 16 + (c & 15))); }
#pragma unroll
        for (int ai = 0; ai < 2; ++ai)
#pragma unroll
            for (int m = 0; m < 4; ++m) { const int row = row0 + ai * 128 + m * 16; float sq = 0.f;
#pragma unroll
                for (int bj = 0; bj < 2; ++bj) { const int c = c0 + bj * 128; const u32x4 y_ = yy[ai][m][bj]; const f32x4 v0 = acc[ai][bj][m][0], v1 = acc[ai][bj][m][1];
                    const float s0 = bf_lo(y_.x) * sigmoidf_fast(v0[0]), s1 = bf_hi(y_.x) * sigmoidf_fast(v0[1]), s2 = bf_lo(y_.y) * sigmoidf_fast(v0[2]), s3 = bf_hi(y_.y) * sigmoidf_fast(v0[3]);
                    const float s4 = bf_lo(y_.z) * sigmoidf_fast(v1[0]), s5 = bf_hi(y_.z) * sigmoidf_fast(v1[1]), s6 = bf_lo(y_.w) * sigmoidf_fast(v1[2]), s7 = bf_hi(y_.w) * sigmoidf_fast(v1[3]);
                    sq += (s0 * s0 + s1 * s1) + (s2 * s2 + s3 * s3) + (s4 * s4 + s5 * s5) + (s6 * s6 + s7 * s7);
                    u32x4 w; w.x = cvt_pk_bf16(s0, s1); w.y = cvt_pk_bf16(s2, s3); w.z = cvt_pk_bf16(s4, s5); w.w = cvt_pk_bf16(s6, s7);
                    *(u32x4*)(mixed + (size_t)row * 2048 + 1024 + c) = w; }
                sq += __shfl_xor(sq, 16); sq += __shfl_xor(sq, 32);
                if (fq == 0) atomicAdd(ssq + row, sq); }
    }
};
struct EpiOut {
    static constexpr bool PERM = true, AFTER_DRAIN = false; static constexpr int MID_T = 16;
    const bf16_t* xn; const float* irstd1; bf16_t* x1b; const float* ssq_a; const float* ssq_s; float* ssq_x;
    __device__ __forceinline__ void mid(f32x4 (&acc)[2][2][4][2], const Unit& u, int wr, int wc, int fr, int fq) const {
        asm volatile("" : "+v"(fr), "+v"(fq));
#pragma unroll
        for (int ai = 0; ai < 2; ++ai)
#pragma unroll
            for (int m = 0; m < 4; ++m) { const int row = u.pm * 256 + ai * 128 + wr * 64 + m * 16 + fr;
                const float f = sqrtf((ssq_s[row] * (1.0f / 1024.0f) + EPS) / (ssq_a[row] * (1.0f / 1024.0f) + EPS));
#pragma unroll
                for (int bj = 0; bj < 2; ++bj)
#pragma unroll
                    for (int n = 0; n < 2; ++n) acc[ai][bj][m][n] *= f; }
    }
    __device__ __forceinline__ void operator()(const f32x4 (&acc)[2][2][4][2], const Unit& u, int wr, int wc, int fr, int fq) const {
        asm volatile("" : "+v"(fr), "+v"(fq));
        const int row0 = u.pm * 256 + wr * 64 + fr; const size_t cofs = (size_t)u.pn * 256 + wc * 32 + 8 * fq;
#pragma unroll
        for (int ai = 0; ai < 2; ++ai) {
            float sv[4], iv[4]; u32x4 xb[4][2];
#pragma unroll
            for (int m = 0; m < 4; ++m) { const int row = row0 + ai * 128 + m * 16; sv[m] = ssq_s[row]; iv[m] = irstd1[row];
#pragma unroll
                for (int bj = 0; bj < 2; ++bj) xb[m][bj] = *(const u32x4*)(xn + (size_t)row * D_MODEL + cofs + bj * 128); }
#pragma unroll
            for (int m = 0; m < 4; ++m) { const int row = row0 + ai * 128 + m * 16; const float rstd = 1.0f / sqrtf(sv[m] * (1.0f / 1024.0f) + EPS), ir = iv[m]; float sq = 0.f;
#pragma unroll
                for (int bj = 0; bj < 2; ++bj) { const size_t off = (size_t)row * D_MODEL + cofs + bj * 128; const u32x4 x_ = xb[m][bj];
                    const f32x4 b0 = {bf_lo(x_.x), bf_hi(x_.x), bf_lo(x_.y), bf_hi(x_.y)}, b1 = {bf_lo(x_.z), bf_hi(x_.z), bf_lo(x_.w), bf_hi(x_.w)};
                    const f32x4 o0 = b0 * ir + acc[ai][bj][m][0] * rstd, o1 = b1 * ir + acc[ai][bj][m][1] * rstd;
                    sq += (o0[0] * o0[0] + o0[1] * o0[1]) + (o0[2] * o0[2] + o0[3] * o0[3]) + (o1[0] * o1[0] + o1[1] * o1[1]) + (o1[2] * o1[2] + o1[3] * o1[3]);
                    u32x4 w; w.x = cvt_pk_bf16(o0[0], o0[1]); w.y = cvt_pk_bf16(o0[2], o0[3]); w.z = cvt_pk_bf16(o1[0], o1[1]); w.w = cvt_pk_bf16(o1[2], o1[3]);
                    *(u32x4*)(x1b + off) = w; }
                sq += __shfl_xor(sq, 16); sq += __shfl_xor(sq, 32); if (fq == 0) atomicAdd(ssq_x + row, sq); }
        }
    }
};
struct EpiGU {
    static constexpr bool PERM = true, AFTER_DRAIN = false; static constexpr int MID_T = 0;
    const float* ssq_x; bf16_t* H;
    __device__ __forceinline__ void operator()(const f32x4 (&acc)[2][2][4][2], const Unit& u, int wr, int wc, int fr, int fq) const {
        asm volatile("" : "+v"(fr), "+v"(fq));
        const int row0 = u.pm * 256 + wr * 64 + fr;
        float sv[2][4];
#pragma unroll
        for (int ai = 0; ai < 2; ++ai)
#pragma unroll
            for (int m = 0; m < 4; ++m) sv[ai][m] = ssq_x[row0 + ai * 128 + m * 16];
#pragma unroll
        for (int ai = 0; ai < 2; ++ai)
#pragma unroll
            for (int m = 0; m < 4; ++m) { const int row = row0 + ai * 128 + m * 16; const float rstd = 1.0f / sqrtf(sv[ai][m] * (1.0f / 2048.0f) + EPS);
                float h[8];
#pragma unroll
                for (int n = 0; n < 2; ++n)
#pragma unroll
                    for (int i = 0; i < 4; ++i) { const float gv = acc[ai][0][m][n][i] * rstd, uv = acc[ai][1][m][n][i] * rstd; h[4 * n + i] = gv * sigmoidf_fast(gv) * uv; }
                u32x4 w; w.x = cvt_pk_bf16(h[0], h[1]); w.y = cvt_pk_bf16(h[2], h[3]); w.z = cvt_pk_bf16(h[4], h[5]); w.w = cvt_pk_bf16(h[6], h[7]);
                *(u32x4*)(H + (size_t)row * FF + u.pn * 128 + wc * 32 + 8 * fq) = w; }
    }
};
template <bool DRY> struct EpiDown {
    static constexpr bool PERM = true, AFTER_DRAIN = false; static constexpr int MID_T = 0;
    const bf16_t* x1b; float* out; float* trash;
    __device__ __forceinline__ void operator()(const f32x4 (&acc)[2][2][4][2], const Unit& u, int wr, int wc, int fr, int fq) const {
        asm volatile("" : "+v"(fr), "+v"(fq));
        const int row0 = u.pm * 256 + wr * 64 + fr; const size_t cofs = (size_t)u.pn * 256 + wc * 32 + 8 * fq;
        u32x4 xb[2][4][2];
#pragma unroll
        for (int ai = 0; ai < 2; ++ai)
#pragma unroll
            for (int m = 0; m < 4; ++m)
#pragma unroll
                for (int bj = 0; bj < 2; ++bj) xb[ai][m][bj] = __builtin_nontemporal_load((const u32x4*)(x1b + (size_t)(row0 + ai * 128 + m * 16) * D_MODEL + cofs + bj * 128));
#pragma unroll
        for (int ai = 0; ai < 2; ++ai)
#pragma unroll
            for (int m = 0; m < 4; ++m) { const int row = row0 + ai * 128 + m * 16;
#pragma unroll
                for (int bj = 0; bj < 2; ++bj) { const size_t off = (size_t)row * D_MODEL + cofs + bj * 128; const u32x4 x_ = xb[ai][m][bj];
                    const f32x4 b0 = {bf_lo(x_.x), bf_hi(x_.x), bf_lo(x_.y), bf_hi(x_.y)}, b1 = {bf_lo(x_.z), bf_hi(x_.z), bf_lo(x_.w), bf_hi(x_.w)};
                    float* q = DRY ? trash + (off & ((8u << 20) - 1)) : out + off;
                    *(f32x4*)q = b0 + acc[ai][bj][m][0]; *(f32x4*)(q + 4) = b1 + acc[ai][bj][m][1]; } }
    }
};

constexpr int ATT_KROW = 144, ATT_VROW = 520, ATT_K_OFF = 0, ATT_V_OFF = 256 * ATT_KROW, ATT_B_OFF = ATT_V_OFF + 64 * ATT_VROW;
constexpr int ATT_TAB = 192;
static_assert(ATT_B_OFF + 4 * ATT_TAB * 4 <= RING_BYTES, "attention LDS");
template <int STG_REPS = 1, int TASK_REPS = 1>
__device__ __forceinline__ void attn_unit(Frame& F, int b, int qb, int kvh, float* ssq_real) {
    LAS unsigned char* lds = F.lds;
    const int lane = lane_id(), wave = F.wave, tid = wave * 64 + lane;
    const bf16_t* Q = (const bf16_t*)(F.ws + WS_Q); const bf16_t* Kb = (const bf16_t*)(F.ws + WS_K); const bf16_t* Vb = (const bf16_t*)(F.ws + WS_V);
    bf16_t* mixed = (bf16_t*)(F.ws + WS_MIX);
    const int T0 = b * SEQ + qb * 128;
    const int q = lane & 31, hh = lane >> 5;
    u32x4 qraw[2][4];
#pragma unroll
    for (int it = 0; it < 2; ++it) { const int task = wave + 8 * it; const bf16_t* qp = Q + (size_t)(T0 + 32 * (task & 3) + q) * ATTN_W + (kvh * 4 + (task >> 2)) * 64 + hh * 8;
#pragma unroll
        for (int ks = 0; ks < 4; ++ks) qraw[it][ks] = __builtin_nontemporal_load((const u32x4*)(qp + 16 * ks)); }
    for (int srep = 0; srep < STG_REPS; ++srep)
    {
        const int key = tid & 255; const bool valid = (qb > 0) || (key >= 128);
        const size_t tok = (size_t)(T0 - 128 + key);
        u32x4 c[8];
        const bf16_t* src = ((tid < 256) ? Kb : Vb) + tok * KV_W + kvh * 64;
#pragma unroll
        for (int i = 0; i < 8; ++i) c[i] = valid ? *(const u32x4*)(src + 8 * i) : (u32x4){0u, 0u, 0u, 0u};
        if (tid < 256) {
            float ss = 0.f;
#pragma unroll
            for (int i = 0; i < 8; ++i) { const float a0 = bf_lo(c[i].x), a1 = bf_hi(c[i].x), a2 = bf_lo(c[i].y), a3 = bf_hi(c[i].y), a4 = bf_lo(c[i].z), a5 = bf_hi(c[i].z), a6 = bf_lo(c[i].w), a7 = bf_hi(c[i].w);
                ss += (a0 * a0 + a1 * a1) + (a2 * a2 + a3 * a3) + (a4 * a4 + a5 * a5) + (a6 * a6 + a7 * a7); }
            const float rstd = 1.0f / sqrtf(ss * (1.0f / 64.0f) + EPS);
            const float* kg = F.in[5];
#pragma unroll
            for (int i = 0; i < 8; ++i) { const f32x4 g0 = *(const f32x4*)(kg + 8 * i), g1 = *(const f32x4*)(kg + 8 * i + 4);
                u32x4 w; w.x = cvt_pk_bf16(bf_lo(c[i].x) * rstd * g0[0], bf_hi(c[i].x) * rstd * g0[1]); w.y = cvt_pk_bf16(bf_lo(c[i].y) * rstd * g0[2], bf_hi(c[i].y) * rstd * g0[3]);
                w.z = cvt_pk_bf16(bf_lo(c[i].z) * rstd * g1[0], bf_hi(c[i].z) * rstd * g1[1]); w.w = cvt_pk_bf16(bf_lo(c[i].w) * rstd * g1[2], bf_hi(c[i].w) * rstd * g1[3]);
                *(LAS u32x4*)(lds + ATT_K_OFF + key * ATT_KROW + i * 16) = w; }
        } else {
#pragma unroll
            for (int i = 0; i < 8; ++i) { const unsigned w4[4] = {c[i].x, c[i].y, c[i].z, c[i].w};
#pragma unroll
                for (int j = 0; j < 4; ++j) { *(LAS unsigned short*)(lds + ATT_V_OFF + (8 * i + 2 * j) * ATT_VROW + key * 2) = (unsigned short)(w4[j] & 0xffffu);
                    *(LAS unsigned short*)(lds + ATT_V_OFF + (8 * i + 2 * j + 1) * ATT_VROW + key * 2) = (unsigned short)(w4[j] >> 16); } }
        }
        for (int e = tid; e < 4 * ATT_TAB; e += NWAVES * 64) { const int hl = e / ATT_TAB, dist = e % ATT_TAB - 32;
            ((LAS float*)(lds + ATT_B_OFF))[e] = ((unsigned)dist < 128u) ? F.in[1][(int)kBucket[dist & 127] * NQH + kvh * 4 + hl] * LOG2E : -INFINITY; }
    }
    bf16x8 qf2[2][4];
    { const float* qg = F.in[4]; f32x4 gq[4][2];
#pragma unroll
      for (int ks = 0; ks < 4; ++ks) { gq[ks][0] = *(const f32x4*)(qg + 16 * ks + 8 * hh); gq[ks][1] = *(const f32x4*)(qg + 16 * ks + 8 * hh + 4); }
#pragma unroll
      for (int it = 0; it < 2; ++it) { float ss = 0.f;
#pragma unroll
        for (int ks = 0; ks < 4; ++ks) { const u32x4 w_ = qraw[it][ks];
            const float a0 = bf_lo(w_.x), a1 = bf_hi(w_.x), a2 = bf_lo(w_.y), a3 = bf_hi(w_.y), a4 = bf_lo(w_.z), a5 = bf_hi(w_.z), a6 = bf_lo(w_.w), a7 = bf_hi(w_.w);
            ss += (a0 * a0 + a1 * a1) + (a2 * a2 + a3 * a3) + (a4 * a4 + a5 * a5) + (a6 * a6 + a7 * a7); }
        ss += __shfl_xor(ss, 32);
        const float sc = (1.0f / sqrtf(ss * (1.0f / 64.0f) + EPS)) * (0.125f * LOG2E);
#pragma unroll
        for (int ks = 0; ks < 4; ++ks) { const u32x4 w_ = qraw[it][ks]; const f32x4 g0 = gq[ks][0], g1 = gq[ks][1];
            u32x4 w; w.x = cvt_pk_bf16(bf_lo(w_.x) * sc * g0[0], bf_hi(w_.x) * sc * g0[1]); w.y = cvt_pk_bf16(bf_lo(w_.y) * sc * g0[2], bf_hi(w_.y) * sc * g0[3]);
            w.z = cvt_pk_bf16(bf_lo(w_.z) * sc * g1[0], bf_hi(w_.z) * sc * g1[1]); w.w = cvt_pk_bf16(bf_lo(w_.w) * sc * g1[2], bf_hi(w_.w) * sc * g1[3]);
            qf2[it][ks] = __builtin_bit_cast(bf16x8, w); } } }
    __syncthreads();
    for (int trep = 0; trep < TASK_REPS; ++trep)
#pragma unroll
    for (int it = 0; it < 2; ++it) {
        float* ssq_a = (trep == TASK_REPS - 1) ? ssq_real : (float*)(F.ws + WS_SSQ_T);
        const int task = wave + 8 * it, hl = task >> 2, grp = task & 3, hq = kvh * 4 + hl, qi = 32 * grp + q;
        const bf16x8 (&qf)[4] = qf2[it];
        const LAS float* tb = (const LAS float*)(lds + ATT_B_OFF) + hl * ATT_TAB + (q + 128 - 4 * hh + 32 - 155);
        const float sink2 = F.in[6][hq] * LOG2E;
        f32x16 s[5];
#pragma unroll
        for (int kt = 0; kt < 5; ++kt) {
            f32x16 a;
#pragma unroll
            for (int r = 0; r < 16; ++r) a[r] = tb[155 - 32 * kt - ((r & 3) + 8 * (r >> 2))];
#pragma unroll
            for (int ks = 0; ks < 4; ++ks) { const bf16x8 kf = *(const LAS bf16x8*)(lds + ATT_K_OFF + (32 * (grp + kt) + q) * ATT_KROW + (16 * ks + 8 * hh) * 2);
                a = __builtin_amdgcn_mfma_f32_32x32x16_bf16(kf, qf[ks], a, 0, 0, 0); }
            if (qb == 0 && grp + kt < 4) {
#pragma unroll
                for (int r = 0; r < 16; ++r) a[r] = -INFINITY; }
            s[kt] = a;
        }
        float mx = sink2;
#pragma unroll
        for (int kt = 0; kt < 5; ++kt)
#pragma unroll
            for (int r = 0; r < 16; ++r) mx = fmaxf(mx, s[kt][r]);
        mx = fmaxf(mx, __shfl_xor(mx, 32));
        float l = 0.f;
#pragma unroll
        for (int kt = 0; kt < 5; ++kt)
#pragma unroll
            for (int r = 0; r < 16; ++r) { const float p = fast_exp2(s[kt][r] - mx); s[kt][r] = p; l += p; }
        l += __shfl_xor(l, 32);
        l += fast_exp2(sink2 - mx);
        f32x16 o[2]; o[0] = (f32x16){}; o[1] = (f32x16){};
#pragma unroll
        for (int kt = 0; kt < 5; ++kt)
#pragma unroll
            for (int s2 = 0; s2 < 2; ++s2) {
                u32x4 pw; pw.x = cvt_pk_bf16(s[kt][8 * s2 + 0], s[kt][8 * s2 + 1]); pw.y = cvt_pk_bf16(s[kt][8 * s2 + 2], s[kt][8 * s2 + 3]); pw.z = cvt_pk_bf16(s[kt][8 * s2 + 4], s[kt][8 * s2 + 5]); pw.w = cvt_pk_bf16(s[kt][8 * s2 + 6], s[kt][8 * s2 + 7]);
                const bf16x8 pb = __builtin_bit_cast(bf16x8, pw);
#pragma unroll
                for (int d0 = 0; d0 < 2; ++d0) { const LAS unsigned char* vp = lds + ATT_V_OFF + (32 * d0 + q) * ATT_VROW + (32 * (grp + kt) + 16 * s2 + 4 * hh) * 2;
                    const u32x2 lo = *(const LAS u32x2*)vp, hi = *(const LAS u32x2*)(vp + 16);
                    const u32x4 vv = {lo.x, lo.y, hi.x, hi.y};
                    o[d0] = __builtin_amdgcn_mfma_f32_32x32x16_bf16(__builtin_bit_cast(bf16x8, vv), pb, o[d0], 0, 0, 0); }
            }
        const float inv = 1.0f / l; float sq = 0.f;
        bf16_t* op = mixed + (size_t)(T0 + qi) * 2048 + hq * 64 + 4 * hh;
#pragma unroll
        for (int d0 = 0; d0 < 2; ++d0)
#pragma unroll
            for (int r4 = 0; r4 < 4; ++r4) { const float v0 = o[d0][4 * r4] * inv, v1 = o[d0][4 * r4 + 1] * inv, v2 = o[d0][4 * r4 + 2] * inv, v3 = o[d0][4 * r4 + 3] * inv;
                sq += (v0 * v0 + v1 * v1) + (v2 * v2 + v3 * v3);
                u32x2 w; w.x = cvt_pk_bf16(v0, v1); w.y = cvt_pk_bf16(v2, v3); *(u32x2*)(op + 32 * d0 + 8 * r4) = w; }
        sq += __shfl_xor(sq, 32);
        if (hh == 0) atomicAdd(ssq_a + T0 + qi, sq);
    }
    __syncthreads();
}

template <int MODE = 7>
__device__ __forceinline__ void ssm_unit(Frame& F, int pm) {
    const int g = pm >> 2;
    bf16_t* Ag = (bf16_t*)(F.ws + WS_AG);
    if constexpr (MODE & 1) {
        int Kc = 256; asm volatile("" : "+s"(Kc));
        pg8::Gemm gm{(const char*)Ag, (const char*)(F.ws + WS_PG), Kc, SSM_KA * 2, 32, 128, 256 * 2};
        pg8::OneUnit S1{pm, g}; EpiS E{};
        pg8::gemm_phase<EpiS, pg8::OneUnit, false>(F.lds, F.wave, gm, S1, E);
    }
    asm volatile("s_waitcnt lgkmcnt(0)" ::: "memory");
    __syncthreads();
    if ((MODE & 2) && F.wave == 0) {
        const int n = lane_id();
        const f32x2 l16 = *((const f32x2*)(F.ws + WS_L16) + g * 64 + n);
        float hr = 0.f, hi = 0.f;
        unsigned* hp = (unsigned*)(Ag + (size_t)pm * 256 * SSM_KA + 256) + n;
        for (int c0 = 0; c0 < 256; c0 += 8) {
            f32x2 sv[8];
#pragma unroll
            for (int j = 0; j < 8; ++j) sv[j] = *(const LAS f32x2*)(F.lds + (c0 + j) * 512 + ((8 * n) ^ (j << 4)));
#pragma unroll
            for (int j = 0; j < 8; ++j) { hp[(size_t)(c0 + j) * (SSM_KA / 2)] = cvt_pk_bf16(hr, hi);
                const float nr = l16.x * hr - l16.y * hi + sv[j].x, ni = l16.x * hi + l16.y * hr + sv[j].y; hr = nr; hi = ni; }
        }
    }
    asm volatile("s_waitcnt vmcnt(0) lgkmcnt(0)" ::: "memory");
    __syncthreads();
    if constexpr (MODE & 4) {
        int Kc = SSM_KA; asm volatile("" : "+s"(Kc));
        pg8::Gemm gm{(const char*)Ag, (const char*)(F.ws + WS_BG), Kc, SSM_KA * 2, 32, 128, SSM_KA * 2};
        pg8::OneUnit S1{pm, g}; EpiY E{Ag, F.in[14], (bf16_t*)(F.ws + WS_YG)};
        pg8::gemm_phase<EpiY, pg8::OneUnit, false>(F.lds, F.wave, gm, S1, E);
    }
}


#define XB_TMO      128
#define XB_XCNT(j)  (256  + 64 * (j))
#define XB_XSUB(j)  (1280 + 64 * (j))
#define XB_XGEN(j)  (2304 + 64 * (j))
#define XB_TOP      3328
#define XB_TOPGEN   3392
#define XCD_BAR_WORDS 3456
#define XB_SPIN_CAP (1u << 22)
constexpr size_t WS_BAR = 16384;
__device__ __forceinline__ unsigned xb_ld(unsigned* p)              { return __hip_atomic_load(p, __ATOMIC_RELAXED, __HIP_MEMORY_SCOPE_AGENT); }
__device__ __forceinline__ unsigned xb_add(unsigned* p, unsigned v) { return __hip_atomic_fetch_add(p, v, __ATOMIC_RELAXED, __HIP_MEMORY_SCOPE_AGENT); }
__device__ __forceinline__ unsigned xb_xcc_id() { return (unsigned)__builtin_amdgcn_s_getreg((3 << 11) | 20) & 0xFu; }
#define XB_SPIN(cond, bar) do { unsigned _sp = 0; while (cond) { __builtin_amdgcn_s_sleep(1); \
    if ((++_sp & 255u) == 0u) { if (xb_ld(&(bar)[XB_TMO])) break; if (_sp > XB_SPIN_CAP) { atomicAdd(&(bar)[XB_TMO], 1u); break; } } } } while (0)
struct XcdBarrier { unsigned* bar; unsigned x; volatile LAS unsigned* st; };
__device__ __forceinline__ XcdBarrier xcd_barrier_post(unsigned* bar, volatile LAS unsigned* st) {
    XcdBarrier b; b.bar = bar; b.x = xb_xcc_id(); b.st = st;
    if (threadIdx.x == 0) (void)xb_add(&bar[XB_XCNT(b.x)], 1u);
    return b;
}
__device__ __forceinline__ void xcd_barrier_complete(unsigned* bar, unsigned x, unsigned& nloc, unsigned& nx) {
    const unsigned G = gridDim.x * gridDim.y * gridDim.z;
    unsigned sum, cnt, mine, sp = 0u;
    for (;;) {
        sum = 0u; cnt = 0u; mine = 0u;
#pragma unroll
        for (unsigned j = 0; j < 16; ++j) { const unsigned c = xb_ld(&bar[XB_XCNT(j)]); sum += c; cnt += (c > 0u) ? 1u : 0u; mine = (j == x) ? c : mine; }
        if (sum == G) break;
        __builtin_amdgcn_s_sleep(1);
        if ((++sp & 255u) == 0u) { if (xb_ld(&bar[XB_TMO])) break; if (sp > XB_SPIN_CAP) { atomicAdd(&bar[XB_TMO], 1u); break; } }
    }
    nloc = mine > 0u ? mine : 1u; nx = cnt > 0u ? cnt : 1u;
}
__device__ __forceinline__ void xcd_barrier(const XcdBarrier& b, int wave) {
    asm volatile("s_waitcnt vmcnt(0)" ::: "memory");
    __syncthreads();
    if (wave == 0 && lane_id() == 0) {
        unsigned* bar = b.bar;
        __builtin_amdgcn_s_waitcnt(0);
        unsigned nloc = b.st[0], nx = b.st[1];
        if (nloc == 0u) { xcd_barrier_complete(bar, b.x, nloc, nx); b.st[0] = nloc; b.st[1] = nx; }
        const unsigned old = xb_add(&bar[XB_XSUB(b.x)], 1u);
        const unsigned gen = old / nloc;
        if (old + 1u == (gen + 1u) * nloc) {
            __builtin_amdgcn_fence(__ATOMIC_RELEASE, "agent");
            asm volatile("s_waitcnt vmcnt(0)" ::: "memory");
            const unsigned og = xb_add(&bar[XB_TOP], 1u);
            const unsigned tg = og / nx;
            if (og + 1u == (tg + 1u) * nx) xb_add(&bar[XB_TOPGEN], 1u);
            else XB_SPIN(xb_ld(&bar[XB_TOPGEN]) == tg, bar);
            __builtin_amdgcn_fence(__ATOMIC_ACQUIRE, "agent");
            xb_add(&bar[XB_XGEN(b.x)], 1u);
            asm volatile("s_waitcnt vmcnt(0)" ::: "memory");
        } else {
            XB_SPIN(xb_ld(&bar[XB_XGEN(b.x)]) == gen, bar);
            __builtin_amdgcn_fence(__ATOMIC_ACQUIRE, "agent");
            asm volatile("s_waitcnt vmcnt(0)" ::: "memory");
        }
    }
    __syncthreads();
}

struct Args { const float* in[23]; float* out; unsigned char* ws; int ph_lo, ph_hi; };
__global__ void __launch_bounds__(NWAVES * 64, 2) hymba_fwd(Args args) {
    extern __shared__ __attribute__((aligned(16))) unsigned char lds_raw[];
    Frame F;
    F.lds = (LAS unsigned char*)lds_raw;
    F.wave = __builtin_amdgcn_readfirstlane((int)threadIdx.x >> 6);
    F.G = gridDim.x; { const int bx = blockIdx.x; F.vcu = (F.G % 8 == 0) ? (bx % 8) * (F.G / 8) + bx / 8 : bx; }
    F.in = args.in; F.out = args.out; F.ws = args.ws;
    const int lo = args.ph_lo, hi = args.ph_hi;
    for (int u = threadIdx.x; u < (LDS_BYTES - LDSCTL_OFF) / 4; u += NWAVES * 64) ((LAS unsigned*)(F.lds + LDSCTL_OFF))[u] = 0u;
    __syncthreads();
    XcdBarrier bar; bar.bar = (unsigned*)(F.ws + WS_BAR); bar.x = 0; bar.st = nullptr;
    if (MK_N_LAUNCHES == 1) bar = xcd_barrier_post((unsigned*)(F.ws + WS_BAR), (volatile LAS unsigned*)(F.lds + MISC_OFF) + 8);
#define IN(k) (lo <= (k) && (k) < hi)
#define GRID_BAR(k) do { if (IN(k) && IN((k) + 1)) xcd_barrier(bar, F.wave); } while (0)
    unsigned char* ws = F.ws;
    float* const ssq_trash = (float*)(ws + WS_SSQ_T);
#define PHASE0(DRY) { p0_prologue(F); }
#define PHASE1(DRY) {     \
        pg8::Gemm g{(const char*)(ws + WS_XN), (const char*)(ws + WS_WIN), D_MODEL, D_MODEL * 2, 32, 128, D_MODEL * 2}; \
        pg8::StaticOrder S; S.init(M, IN_W, F.G, (int)blockIdx.x, WGM_P1); \
        EpiIn E{(bf16_t*)(ws + WS_Q), (bf16_t*)(ws + WS_K), (bf16_t*)(ws + WS_V), (bf16_t*)(ws + WS_AG)}; \
        pg8::gemm_phase<EpiIn, pg8::StaticOrder, true>(F.lds, F.wave, g, S, E); \
        { const int nwg_ = (M / 256) * (IN_W / 256), maxu_ = (nwg_ + F.G - 1) / F.G, nheavy_ = nwg_ - (maxu_ - 1) * F.G, nlight_ = F.G - nheavy_, c_ = (int)blockIdx.x;     \
          if (nlight_ == 0) convert_late_weights(F, c_ * NWAVES + F.wave, F.G * NWAVES); \
          else if (c_ >= nheavy_) convert_late_weights(F, (c_ - nheavy_) * NWAVES + F.wave, nlight_ * NWAVES); } }
#define PHASE2(DRY) { \
        float* const sa_ = (DRY) ? ssq_trash : (float*)(ws + WS_SSQ_A); \
        for (int u = F.vcu; u < BATCH * 32 * NKVH; u += F.G) attn_unit<(PROBE_REP == 25 ? 2 : 1), (PROBE_REP == 26 ? 2 : 1)>(F, u >> 7, (u >> 2) & 31, u & 3, sa_); \
        if (F.vcu < 256) ssm_unit(F, F.vcu);     }
#define PHASE3(DRY) {     \
        pg8::Gemm g{(const char*)(ws + WS_YG), (const char*)(ws + WS_WGLU), SSM_W, 32, (unsigned)(M * 32), (unsigned)(4 * M * 32), SSM_W * 2}; \
        pg8::StaticOrder S; S.init(M, SSM_W, F.G, (int)blockIdx.x, WGM_P3); \
        EpiGlu E{(const bf16_t*)(ws + WS_YG), (bf16_t*)(ws + WS_MIX), (DRY) ? ssq_trash : (float*)(ws + WS_SSQ_S)}; \
        pg8::gemm_phase<EpiGlu, pg8::StaticOrder, true>(F.lds, F.wave, g, S, E); }
#define PHASE4(DRY) {     \
        pg8::Gemm g{(const char*)(ws + WS_MIX), (const char*)(ws + WS_WOUT), 2048, 2048 * 2, 32, 128, 2048 * 2}; \
        pg8::StaticOrder S; S.init(M, D_MODEL, F.G, (int)blockIdx.x, WGM_P4); \
        EpiOut E{(const bf16_t*)(ws + WS_XN), (const float*)(ws + WS_IRSTD1), (bf16_t*)(ws + WS_XN), (const float*)(ws + WS_SSQ_A), (const float*)(ws + WS_SSQ_S), (DRY) ? ssq_trash : (float*)(ws + WS_SSQ_X)}; \
        pg8::gemm_phase<EpiOut, pg8::StaticOrder, true>(F.lds, F.wave, g, S, E); }
#define PHASE5(DRY) {     \
        pg8::Gemm g{(const char*)(ws + WS_XN), (const char*)(ws + WS_WGU), D_MODEL, D_MODEL * 2, 32, 128, D_MODEL * 2}; \
        pg8::StaticOrder S; S.init(M, 2 * FF, F.G, (int)blockIdx.x, WGM_P5); \
        EpiGU E{(const float*)(ws + WS_SSQ_X), (bf16_t*)(ws + WS_H)}; \
        pg8::gemm_phase<EpiGU, pg8::StaticOrder, true>(F.lds, F.wave, g, S, E); }
#define PHASE6(DRY) {     \
        pg8::Gemm g{(const char*)(ws + WS_H), (const char*)(ws + WS_WDN), FF, FF * 2, 32, 128, FF * 2}; \
        pg8::StaticOrder S; S.init(M, D_MODEL, F.G, (int)blockIdx.x, WGM_P6); \
        EpiDown<(DRY)> E{(const bf16_t*)(ws + WS_XN), F.out, (float*)(ws + WS_SSCR)}; \
        pg8::gemm_phase<EpiDown<(DRY)>, pg8::StaticOrder, true>(F.lds, F.wave, g, S, E); }
#define PHASE2A(DRY) { for (int u = F.vcu; u < BATCH * 32 * NKVH; u += F.G) attn_unit(F, u >> 7, (u >> 2) & 31, u & 3, ssq_trash); }
#define PHASE2S(DRY) { if (F.vcu < 256) ssm_unit(F, F.vcu); }
#define RUN_PHASE(k, BODY) do { if (PROBE_REP == (k) && IN(k)) { BODY(1); xcd_barrier(bar, F.wave); } if (IN(k)) { BODY(0); } } while (0)
    RUN_PHASE(0, PHASE0);
    GRID_BAR(0);
    if (args.ph_lo < 0) cg::this_grid().sync();
    RUN_PHASE(1, PHASE1);
    GRID_BAR(1);
    if (PROBE_REP == 22 && IN(2)) { if (F.vcu < 256) ssm_unit<1>(F, F.vcu); xcd_barrier(bar, F.wave); }
    if (PROBE_REP == 23 && IN(2)) { if (F.vcu < 256) ssm_unit<2>(F, F.vcu); xcd_barrier(bar, F.wave); }
    if (PROBE_REP == 24 && IN(2)) { if (F.vcu < 256) ssm_unit<4>(F, F.vcu); xcd_barrier(bar, F.wave); }
    if (PROBE_REP == 20 && IN(2)) { PHASE2A(1); xcd_barrier(bar, F.wave); }
    if (PROBE_REP == 21 && IN(2)) { PHASE2S(1); xcd_barrier(bar, F.wave); }
    RUN_PHASE(2, PHASE2);
    GRID_BAR(2);
    RUN_PHASE(3, PHASE3);
    GRID_BAR(3);
    RUN_PHASE(4, PHASE4);
    GRID_BAR(4);
    RUN_PHASE(5, PHASE5);
    GRID_BAR(5);
    RUN_PHASE(6, PHASE6);
#undef IN
#undef GRID_BAR
}

extern "C" void kernel_launch(void* const* d_in, const int* in_sizes, int n_in, void* d_out, int out_size, void* d_ws, size_t ws_size, hipStream_t stream) {
    static int grid = 0;
    if (grid == 0) {
        if (n_in != 23 || in_sizes[0] != M * D_MODEL || out_size != M * D_MODEL || ws_size < WS_END) { fprintf(stderr, "kernel_launch: unexpected sizes (n_in %d, out %d, ws %zu); nothing launched\n", n_in, out_size, ws_size); grid = -1; return; }
        int dev = 0, cus = 0, per_cu = 0;
        if (hipGetDevice(&dev) != hipSuccess || hipDeviceGetAttribute(&cus, hipDeviceAttributeMultiprocessorCount, dev) != hipSuccess) { grid = -1; return; }
        if (hipFuncSetAttribute((const void*)hymba_fwd, hipFuncAttributeMaxDynamicSharedMemorySize, LDS_BYTES) != hipSuccess) { fprintf(stderr, "kernel_launch: hipFuncSetAttribute failed\n"); grid = -1; return; }
        if (hipOccupancyMaxActiveBlocksPerMultiprocessor(&per_cu, (const void*)hymba_fwd, NWAVES * 64, LDS_BYTES) != hipSuccess || per_cu < 1) { fprintf(stderr, "kernel_launch: occupancy query failed (%d)\n", per_cu); (void)hipGetLastError(); grid = -1; return; }
        grid = cus;
        if (grid < 256) { fprintf(stderr, "kernel_launch: this kernel needs >= 256 CUs (got %d); nothing launched\n", grid); grid = -1; return; }
    }
    if (grid < 0) return;
    (void)hipMemsetAsync((char*)d_ws + WS_CTL, 0, CTL_ZERO_BYTES, stream);
    Args a{};
    for (int i = 0; i < 23; ++i) a.in[i] = (const float*)d_in[i];
    a.out = (float*)d_out; a.ws = (unsigned char*)d_ws;
    constexpr int NPH = 7;
    for (int li = 0; li < MK_N_LAUNCHES; ++li) {
        a.ph_lo = (MK_N_LAUNCHES == 1) ? 0 : li; a.ph_hi = (MK_N_LAUNCHES == 1) ? NPH : li + 1;
        void* kargs[] = {&a};
        const hipError_t e = hipLaunchCooperativeKernel((const void*)hymba_fwd, dim3(grid), dim3(NWAVES * 64), kargs, LDS_BYTES, stream);
        if (e != hipSuccess) { fprintf(stderr, "kernel_launch: cooperative launch failed: %s (grid %d)\n", hipGetErrorString(e), grid); break; }
    }
}
```

```cpp
#include <hip/hip_runtime.h>
#include <hip/hip_cooperative_groups.h>
#include <cstdio>
#include <cstdint>
namespace cg = cooperative_groups;

#ifndef PROBE_REP
#define PROBE_REP -1
#endif
#ifndef WGM_P1
#define WGM_P1 4
#define WGM_P3 4
#define WGM_P4 4
#define WGM_P5 4
#define WGM_P6 4
#endif
#ifndef MK_N_LAUNCHES
#define MK_N_LAUNCHES 1
#endif

#define LAS __attribute__((address_space(3)))
typedef unsigned short bf16_t;
typedef short bf16x8 __attribute__((ext_vector_type(8)));
typedef float f32x4 __attribute__((ext_vector_type(4)));
typedef float f32x2 __attribute__((ext_vector_type(2)));
typedef float f32x16 __attribute__((ext_vector_type(16)));
typedef unsigned u32x4 __attribute__((ext_vector_type(4)));
typedef unsigned u32x2 __attribute__((ext_vector_type(2)));

constexpr int D_MODEL = 2048, BATCH = 4, SEQ = 4096, M = BATCH * SEQ;
constexpr int HD = 64, NQH = 16, NKVH = 4, ATTN_W = 1024, KV_W = 256;
constexpr int SSM_W = 1024, SSM_P = 16, SSM_G = 64, SSM_N = 64, IN_W = 2560, FF = 5632;
constexpr int CH_T = 16;
constexpr int SSM_KA = CH_T * SSM_P + 2 * SSM_N;
constexpr float EPS = 1e-6f;
constexpr float LOG2E = 1.4426950408889634f;

__device__ const unsigned char kBucket[128] = {0, 1, 2, 3, 4, 5, 6, 7, 8, 9, 10, 11, 12, 13, 14, 15, 16, 16, 16, 17, 17, 18, 18, 18, 19, 19, 19, 20, 20, 20, 20, 21, 21, 21, 21, 22, 22, 22, 22, 22, 23, 23, 23, 23, 23, 23, 24, 24, 24, 24, 24, 24, 25, 25, 25, 25, 25, 25, 25, 26, 26, 26, 26, 26, 26, 26, 26, 27, 27, 27, 27, 27, 27, 27, 27, 27, 27, 28, 28, 28, 28, 28, 28, 28, 28, 28, 28, 29, 29, 29, 29, 29, 29, 29, 29, 29, 29, 29, 29, 30, 30, 30, 30, 30, 30, 30, 30, 30, 30, 30, 30, 30, 30, 31, 31, 31, 31, 31, 31, 31, 31, 31, 31, 31, 31, 31, 31, 31};

__device__ __forceinline__ unsigned cvt_pk_bf16(float lo, float hi) { unsigned r; asm volatile("v_cvt_pk_bf16_f32 %0, %1, %2" : "=v"(r) : "v"(lo), "v"(hi)); return r; }
__device__ __forceinline__ float bf_lo(unsigned w) { return __builtin_bit_cast(float, w << 16); }
__device__ __forceinline__ float bf_hi(unsigned w) { return __builtin_bit_cast(float, w & 0xffff0000u); }
__device__ __forceinline__ float fast_rcp(float x) { return __builtin_amdgcn_rcpf(x); }
__device__ __forceinline__ float fast_exp2(float x) { return __builtin_amdgcn_exp2f(x); }
__device__ __forceinline__ float sigmoidf_fast(float x) { return fast_rcp(1.0f + fast_exp2(-LOG2E * x)); }
__device__ __forceinline__ float gelu_tanh(float x) {
    const float u2 = 1.5957691216057308f * (x + 0.044715f * x * x * x);
    return x * sigmoidf_fast(u2);
}

__device__ __forceinline__ int lane_id() { int l = __builtin_amdgcn_mbcnt_hi(~0u, __builtin_amdgcn_mbcnt_lo(~0u, 0u)); asm volatile("" : "+v"(l)); return l; }

namespace pg8 {
constexpr int BM = 256, BK = 64, HALF = 128, HTB = HALF * BK * 2  , STAGE_BYTES = 8 * HTB, NXCD = 8, WGM = 4;
__host__ __device__ __forceinline__ int lds_byte(int r, int c) { const int st = (r >> 4) * 2 + (c >> 5), rr = r & 15, cc = c & 31, ob = rr * 64 + cc * 2; return st * 1024 + (ob ^ (((ob >> 9) & 1) << 5)); }
__host__ __device__ __forceinline__ void stage_rc(int b, int& R, int& C) { const int st = b / 1024, sb = b % 1024, swz = sb ^ (((sb >> 9) & 1) << 5); R = (st >> 1) * 16 + swz / 64; C = (st & 1) * 32 + (swz % 64) / 2; }
__host__ __device__ __forceinline__ int perm32(int rho) { const int n = rho >> 4, i = rho & 15; return 8 * (i >> 2) + 4 * n + (i & 3); }

struct Unit { int pm, pn; unsigned aofs, bofs; int part; };
struct Gemm { const char* A; const char* B; int K; unsigned a_rs, a_cs, a_ks, b_rs; };

struct StaticOrder {
    int nM, nN, nwg, G, c, wgm;
    __device__ void init(int Mr, int N, int G_, int c_, int wgm_ = WGM) { nM = Mr / BM; nN = N / BM; nwg = nM * nN; G = G_; c = c_; wgm = wgm_; }
    __device__ bool next(int i, Unit& u) const {
        const long L = (long)i * G + c; if (L >= nwg) return false;
        int wgid = (int)L; { const int q = nwg / NXCD, r = nwg % NXCD, xcd = wgid % NXCD, off = wgid / NXCD; wgid = (xcd < r ? xcd * (q + 1) : r * (q + 1) + (xcd - r) * q) + off; }
        const int nig = wgm * nN, gid = wgid / nig, fm = gid * wgm, gsz = (nM - fm) < wgm ? (nM - fm) : wgm;
        u.pm = fm + ((wgid % nig) % gsz); u.pn = (wgid % nig) / gsz; u.aofs = 0; u.bofs = 0; u.part = 0; return true;
    }
};
struct TwoPartOrder {
    StaticOrder S; unsigned kofs;
    __device__ bool next(int i, Unit& u) const { if (!S.next(i >> 1, u)) return false; u.part = i & 1; u.aofs = u.bofs = (i & 1) ? kofs : 0u; return true; }
};
struct OneUnit {
    int pm, pn;
    __device__ bool next(int i, Unit& u) const { if (i) return false; u.pm = pm; u.pn = pn; u.aofs = 0; u.bofs = 0; u.part = 0; return true; }
};

template <class Epi, class Sched, bool ALIGN_EPI>
__device__ __forceinline__ void gemm_phase(LAS unsigned char* lds, const int wid  , const Gemm g, const Sched& S, const Epi& E) {
    const int lane = lane_id(), tid = wid * 64 + lane, wr = wid >> 2, wc = wid & 3, fr = lane & 15, fq = lane >> 4;
    const int nt = g.K / BK;
    unsigned voffA[2], voffB[2];
#pragma unroll
    for (int i = 0; i < 2; ++i) { int R, C; stage_rc(tid * 16 + i * 8192, R, C); const int Rb = Epi::PERM ? ((R & ~31) + perm32(R & 31)) : R;
        voffA[i] = (unsigned)R * g.a_rs + (unsigned)(C >> 4) * g.a_cs + (unsigned)(C & 15) * 2u; voffB[i] = (unsigned)Rb * g.b_rs + (unsigned)C * 2u; }
    const size_t kstepA = g.a_ks, kstepB = (size_t)(BK * 2);
    const size_t hstepA = (size_t)HALF * g.a_rs, hstepB = (size_t)HALF * g.b_rs, tstepA = 2 * hstepA, tstepB = 2 * hstepB;
    const unsigned ldsw = (unsigned)wid * 1024u;
    const int aoff = lds_byte(wr * 64 + fr, fq * 8), boff = lds_byte(wc * 32 + fr, fq * 8);
#define PG8_SA(b, h) (((b) * 2 + (h)) * HTB)
#define PG8_SB(b, h) ((4 + (b) * 2 + (h)) * HTB)
#define PG8_STAGE(bufoff, gbase, voff) do { _Pragma("unroll") for (int _i = 0; _i < 2; ++_i) \
        __builtin_amdgcn_global_load_lds((const unsigned*)((const char*)(gbase) + (voff)[_i]), (LAS unsigned*)(lds + (bufoff) + ldsw + _i * 8192), 16, 0, 0); } while (0)
#define PG8_LDA(dst, b, h) do { _Pragma("unroll") for (int m = 0; m < 4; ++m) _Pragma("unroll") for (int k = 0; k < 2; ++k) dst[m][k] = *(const LAS bf16x8*)(lds + PG8_SA(b, h) + aoff + m * 2048 + k * 1024); } while (0)
#define PG8_LDB(dst, b, h) do { _Pragma("unroll") for (int n = 0; n < 2; ++n) _Pragma("unroll") for (int k = 0; k < 2; ++k) dst[n][k] = *(const LAS bf16x8*)(lds + PG8_SB(b, h) + boff + n * 2048 + k * 1024); } while (0)
#define PG8_MMA(ai, bj, At, Bt) do { __builtin_amdgcn_s_setprio(1); _Pragma("unroll") for (int m = 0; m < 4; ++m) _Pragma("unroll") for (int n = 0; n < 2; ++n) _Pragma("unroll") for (int k = 0; k < 2; ++k) \
        acc[ai][bj][m][n] = __builtin_amdgcn_mfma_f32_16x16x32_bf16(Bt[n][k], At[m][k], acc[ai][bj][m][n], 0, 0, 0); __builtin_amdgcn_s_setprio(0); } while (0)
#define PG8_WAIT_V(n) asm volatile("s_waitcnt vmcnt(" #n ")" ::: "memory")
#define PG8_WAIT_L(n) asm volatile("s_waitcnt lgkmcnt(" #n ")" ::: "memory")
#define PG8_BAR __builtin_amdgcn_s_barrier()
#define PG8_SCHED __builtin_amdgcn_sched_barrier(0)
    Unit cur, nxt; int ui = 0;
    if (!S.next(0, cur)) return;
    f32x4 acc[2][2][4][2];
#pragma unroll
    for (int a = 0; a < 2; ++a)
#pragma unroll
        for (int b = 0; b < 2; ++b)
#pragma unroll
            for (int m = 0; m < 4; ++m)
#pragma unroll
                for (int n = 0; n < 2; ++n) acc[a][b][m][n] = (f32x4){0.f, 0.f, 0.f, 0.f};
    bf16x8 At[4][2], B0[2][2], B1[2][2];
    const char* cA = g.A + (size_t)cur.pm * tstepA + cur.aofs; const char* cB = g.B + (size_t)cur.pn * tstepB + cur.bofs;
    PG8_STAGE(PG8_SB(0, 0), cB, voffB); PG8_STAGE(PG8_SB(0, 1), cB + hstepB, voffB); PG8_STAGE(PG8_SA(0, 0), cA, voffA); PG8_STAGE(PG8_SA(0, 1), cA + hstepA, voffA);
    if (wr == 1) PG8_BAR;
    PG8_WAIT_V(2); PG8_BAR;
    PG8_STAGE(PG8_SB(1, 0), cB + kstepB, voffB); PG8_STAGE(PG8_SA(1, 0), cA + kstepA, voffA); PG8_STAGE(PG8_SB(1, 1), cB + hstepB + kstepB, voffB);
    PG8_WAIT_V(6); PG8_BAR;
    for (;;) {
        const bool has_next = S.next(ui + 1, nxt);
        const char* nA = has_next ? g.A + (size_t)nxt.pm * tstepA + nxt.aofs : cA; const char* nB = has_next ? g.B + (size_t)nxt.pn * tstepB + nxt.bofs : cB;
        for (int t = 0; t < nt; t += 2) {
            if constexpr (Epi::MID_T > 0) { if (t == Epi::MID_T) E.mid(acc, cur, wr, wc, fr, fq); }
            const bool last = (t == nt - 2);
            const char* a1 = cA + (size_t)(t + 1) * kstepA;
            const char* a2 = last ? nA : cA + (size_t)(t + 2) * kstepA; const char* b2 = last ? nB : cB + (size_t)(t + 2) * kstepB;
            const char* a3 = a2 + kstepA; const char* b3 = b2 + kstepB;
            PG8_LDB(B0, 0, 0); PG8_LDB(B1, 0, 1); PG8_SCHED; PG8_LDA(At, 0, 0); PG8_STAGE(PG8_SA(1, 1), a1 + hstepA, voffA);
            PG8_WAIT_V(8); PG8_WAIT_L(0); PG8_BAR; PG8_MMA(0, 0, At, B0); PG8_MMA(0, 1, At, B1); PG8_BAR; PG8_SCHED;
            PG8_LDA(At, 0, 1); PG8_STAGE(PG8_SB(0, 0), b2, voffB); PG8_STAGE(PG8_SB(0, 1), b2 + hstepB, voffB); PG8_STAGE(PG8_SA(0, 0), a2, voffA);
            PG8_WAIT_V(8); PG8_WAIT_L(0); PG8_BAR; PG8_MMA(1, 0, At, B0); PG8_MMA(1, 1, At, B1); PG8_BAR; PG8_SCHED;
            PG8_LDB(B0, 1, 0); PG8_LDB(B1, 1, 1); PG8_SCHED; PG8_LDA(At, 1, 0); PG8_STAGE(PG8_SA(0, 1), a2 + hstepA, voffA);
            PG8_WAIT_V(8); PG8_WAIT_L(0); PG8_BAR; PG8_MMA(0, 0, At, B0); PG8_MMA(0, 1, At, B1); PG8_BAR; PG8_SCHED;
            PG8_LDA(At, 1, 1); PG8_STAGE(PG8_SB(1, 0), b3, voffB); PG8_STAGE(PG8_SB(1, 1), b3 + hstepB, voffB); PG8_STAGE(PG8_SA(1, 0), a3, voffA);
            PG8_WAIT_V(8); PG8_WAIT_L(0); PG8_BAR; PG8_MMA(1, 0, At, B0); PG8_MMA(1, 1, At, B1); PG8_BAR; PG8_SCHED;
        }
        if constexpr (ALIGN_EPI) { if (wr == 0) PG8_BAR; }
        if constexpr (!Epi::AFTER_DRAIN) E(acc, cur, wr, wc, fr, fq);
        if (!has_next) break;
#pragma unroll
        for (int a = 0; a < 2; ++a)
#pragma unroll
            for (int b = 0; b < 2; ++b)
#pragma unroll
                for (int m = 0; m < 4; ++m)
#pragma unroll
                    for (int n = 0; n < 2; ++n) acc[a][b][m][n] = (f32x4){0.f, 0.f, 0.f, 0.f};
        cur = nxt; cA = nA; cB = nB; ++ui;
        if constexpr (ALIGN_EPI) { if (wr == 1) PG8_BAR; }
    }
    PG8_WAIT_V(0);
    if constexpr (!ALIGN_EPI) { if (wr == 0) PG8_BAR; }
    PG8_BAR;
    if constexpr (Epi::AFTER_DRAIN) E.fused(acc, cur, wr, wc, fr, fq, lds);
#undef PG8_SA
#undef PG8_SB
#undef PG8_STAGE
#undef PG8_LDA
#undef PG8_LDB
#undef PG8_MMA
#undef PG8_WAIT_V
#undef PG8_WAIT_L
#undef PG8_BAR
#undef PG8_SCHED
}
}

constexpr size_t MiB = 1u << 20;
constexpr size_t WS_CTL = 0, CTL_ZERO_BYTES = 1 * MiB;
constexpr size_t WS_SSQ_A = 256 * 1024, WS_SSQ_S = 320 * 1024, WS_SSQ_X = 384 * 1024, WS_SSQ_T = 448 * 1024  ;
constexpr size_t WS_IRSTD1 = 512 * 1024;
constexpr size_t WS_WIN = 2 * MiB;
constexpr size_t WS_WGLU = 12 * MiB;
constexpr size_t WS_WOUT = 14 * MiB;
constexpr size_t WS_WGU = 22 * MiB;
constexpr size_t WS_WDN = 66 * MiB;
constexpr size_t WS_BG = 88 * MiB;
constexpr size_t WS_PG = 100 * MiB;
constexpr size_t WS_L16 = 108 * MiB;
constexpr size_t WS_SSCR = 109 * MiB;
constexpr size_t WS_XN = 141 * MiB;
constexpr size_t WS_Q = 205 * MiB;
constexpr size_t WS_K = 237 * MiB;
constexpr size_t WS_V = 245 * MiB;
constexpr size_t WS_AG = 253 * MiB;
constexpr size_t WS_YG = 301 * MiB;
constexpr size_t WS_MIX = 333 * MiB;
constexpr size_t WS_H = 205 * MiB;
constexpr size_t WS_END = 397 * MiB;
static_assert(WS_H + (size_t)M * FF * 2 <= WS_END, "ws map");

constexpr int RING_BYTES = 131072;
constexpr int LDS_BYTES = 147456;
constexpr int NWAVES = 8;
constexpr int LDSCTL_OFF = RING_BYTES, MISC_OFF = LDSCTL_OFF + 320;

struct Frame {
    LAS unsigned char* lds;
    int wave, vcu, G;
    const float* const* in; float* out; unsigned char* ws;
};

__device__ __forceinline__ float wave_sum(float v) {
#pragma unroll
    for (int o = 1; o < 64; o <<= 1) v += __shfl_xor(v, o);
    return v;
}
__device__ __forceinline__ unsigned f2bf(float f) { unsigned u = __builtin_bit_cast(unsigned, f); return (u + 0x7fffu + ((u >> 16) & 1u)) >> 16; }
__device__ __forceinline__ unsigned pk2(float lo, float hi) { return f2bf(lo) | (f2bf(hi) << 16); }

struct TItem { const float* W; bf16_t* WT; const float* gain; int K, N, rmul, radd, item; };
__device__ __forceinline__ void titem_load(const TItem& t, float (&v)[32], int lane) {
    const int nblk = t.N / 32, kb = t.item / nblk, nb = t.item % nblk, k0 = 64 * kb, n0 = 32 * nb;
    const float* p = t.W + (size_t)(k0 + (lane >> 5)) * t.N + n0 + (lane & 31);
#pragma unroll
    for (int i = 0; i < 32; ++i) v[i] = __builtin_nontemporal_load(p + (size_t)(2 * i) * t.N);
}
__device__ __forceinline__ void titem_store(const TItem& t, const float (&v)[32], LAS float* scr, int lane) {
    const int nblk = t.N / 32, kb = t.item / nblk, nb = t.item % nblk, k0 = 64 * kb, n0 = 32 * nb;
#pragma unroll
    for (int i = 0; i < 32; ++i) scr[(2 * i + (lane >> 5)) * 33 + (lane & 31)] = v[i];
    asm volatile("s_waitcnt lgkmcnt(0)" ::: "memory");
    const int c = lane & 7;
    float gv[8];
#pragma unroll
    for (int i = 0; i < 8; ++i) gv[i] = t.gain ? t.gain[k0 + 8 * c + i] : 1.0f;
#pragma unroll
    for (int j = 0; j < 4; ++j) { const int n = (lane >> 3) + 8 * j; const LAS float* s = scr + (8 * c) * 33 + n; const int nn = n0 + n; const int row = (nn >> 7) * t.rmul + t.radd + (nn & 127);
        u32x4 o; o.x = pk2(s[0 * 33] * gv[0], s[1 * 33] * gv[1]); o.y = pk2(s[2 * 33] * gv[2], s[3 * 33] * gv[3]); o.z = pk2(s[4 * 33] * gv[4], s[5 * 33] * gv[5]); o.w = pk2(s[6 * 33] * gv[6], s[7 * 33] * gv[7]);
        __builtin_nontemporal_store(o, (u32x4*)(t.WT + (size_t)row * t.K + k0 + 8 * c)); }
    asm volatile("s_waitcnt lgkmcnt(0)" ::: "memory");
}
__device__ __forceinline__ void rms_row_load(const float* xrow, f32x4 (&v)[8], int lane) {
    const f32x4* xr = (const f32x4*)xrow + lane;
#pragma unroll
    for (int j = 0; j < 8; ++j) v[j] = __builtin_nontemporal_load(xr + 64 * j);
}
__device__ __forceinline__ void rms_row_store(const f32x4 (&v)[8], float* irstd, bf16_t* orow, int lane) {
    float s = 0.f;
#pragma unroll
    for (int j = 0; j < 8; ++j) s += (v[j].x * v[j].x + v[j].y * v[j].y) + (v[j].z * v[j].z + v[j].w * v[j].w);
    const float ms = wave_sum(s) * (1.0f / D_MODEL) + EPS; const float rstd = 1.0f / sqrtf(ms);
    if (lane == 0) *irstd = sqrtf(ms);
    u32x2* o8 = (u32x2*)orow + lane;
#pragma unroll
    for (int j = 0; j < 8; ++j) { u32x2 w; w.x = pk2(v[j].x * rstd, v[j].y * rstd); w.y = pk2(v[j].z * rstd, v[j].w * rstd); o8[64 * j] = w; }
}
__device__ __forceinline__ void p0_ssm_tables(Frame& F, int g, int qr) {
    LAS float* LP = (LAS float*)F.lds; LAS float* BB = LP + 17 * 64 * 2; LAS float* CC = BB + 64 * 16 * 2; LAS float* KT = CC + 16 * 64 * 2;
    const float* a_re = F.in[7]; const float* a_im = F.in[8]; const float* log_dt = F.in[9]; const float* b_re = F.in[10]; const float* b_im = F.in[11]; const float* c_re = F.in[12]; const float* c_im = F.in[13];
    const int tid = F.wave * 64 + lane_id();
    if (tid < 64) {
        const int n = tid;
        const double dt = exp((double)log_dt[g]);
        const double are = (double)a_re[g * 64 + n], aim = (double)a_im[g * 64 + n];
        const double mag = exp(are * dt), ang = aim * dt;
        const double lre = mag * cos(ang), lim = mag * sin(ang);
        const double nr = lre - 1.0, ni = lim, den = are * are + aim * aim;
        const double fre = (nr * are + ni * aim) / den, fim = (ni * are - nr * aim) / den;
        double pr = 1.0, pi = 0.0;
        for (int t = 0; t <= 16; ++t) { LP[(t * 64 + n) * 2] = (float)pr; LP[(t * 64 + n) * 2 + 1] = (float)pi; const double nre = pr * lre - pi * lim, nim = pr * lim + pi * lre; pr = nre; pi = nim; }
        if (qr == 0) { float* l16 = (float*)(F.ws + WS_L16) + (g * 64 + n) * 2; l16[0] = LP[(16 * 64 + n) * 2]; l16[1] = LP[(16 * 64 + n) * 2 + 1]; }
        for (int p = 0; p < 16; ++p) { const double br = (double)b_re[(g * 64 + n) * 16 + p], bi = (double)b_im[(g * 64 + n) * 16 + p];
            BB[(n * 16 + p) * 2] = (float)(fre * br - fim * bi); BB[(n * 16 + p) * 2 + 1] = (float)(fre * bi + fim * br); }
    }
    for (int e = tid; e < 1024; e += 512) { CC[e * 2] = c_re[g * 1024 + e]; CC[e * 2 + 1] = c_im[g * 1024 + e]; }
    __syncthreads();
    {
        const int p = (tid >> 4) & 15, q = tid & 15, th = tid >> 8; float ka[8];
#pragma unroll
        for (int j = 0; j < 8; ++j) ka[j] = 0.f;
        for (int n = 0; n < 64; ++n) {
            const f32x2 c = *(const LAS f32x2*)(CC + (p * 64 + n) * 2), bb = *(const LAS f32x2*)(BB + (n * 16 + q) * 2);
            const float cbr = c.x * bb.x - c.y * bb.y, cbi = c.x * bb.y + c.y * bb.x;
#pragma unroll
            for (int j = 0; j < 8; ++j) { const f32x2 l = *(const LAS f32x2*)(LP + ((8 * th + j) * 64 + n) * 2); ka[j] += cbr * l.x - cbi * l.y; }
        }
#pragma unroll
        for (int j = 0; j < 8; ++j) KT[((8 * th + j) * 16 + p) * 16 + q] = ka[j];
    }
    __syncthreads();
    bf16_t* Bg = (bf16_t*)(F.ws + WS_BG) + (size_t)g * 256 * SSM_KA;
    for (int ch = tid; ch < 64 * 48; ch += 512) {
        const int rl = ch / 48, c8 = ch % 48, t = 4 * qr + (rl >> 4), p = rl & 15; float v[8];
        if (c8 < 32) { const int s = c8 >> 1, q0 = (c8 & 1) * 8;
#pragma unroll
            for (int i = 0; i < 8; ++i) v[i] = (s <= t) ? KT[((t - s) * 16 + p) * 16 + q0 + i] : 0.f;
        } else { const int n0 = (c8 - 32) * 4;
#pragma unroll
            for (int i = 0; i < 4; ++i) { const int n = n0 + i; const float cr = CC[(p * 64 + n) * 2], ci = CC[(p * 64 + n) * 2 + 1], lr = LP[((t + 1) * 64 + n) * 2], li = LP[((t + 1) * 64 + n) * 2 + 1];
                v[2 * i] = cr * lr - ci * li; v[2 * i + 1] = -(cr * li + ci * lr); }
        }
        u32x4 o; o.x = pk2(v[0], v[1]); o.y = pk2(v[2], v[3]); o.z = pk2(v[4], v[5]); o.w = pk2(v[6], v[7]);
        *(u32x4*)(Bg + (size_t)(t * 16 + p) * SSM_KA + c8 * 8) = o;
    }
    bf16_t* Pg = (bf16_t*)(F.ws + WS_PG) + (size_t)g * 256 * 256;
    for (int ch = tid; ch < 32 * 32; ch += 512) {
        const int rl = ch >> 5, c8 = ch & 31, n = 16 * qr + (rl >> 1), ri = rl & 1, s = c8 >> 1, q0 = (c8 & 1) * 8; float v[8];
        const float lr = LP[((15 - s) * 64 + n) * 2], li = LP[((15 - s) * 64 + n) * 2 + 1];
#pragma unroll
        for (int i = 0; i < 8; ++i) { const float br = BB[(n * 16 + q0 + i) * 2], bi = BB[(n * 16 + q0 + i) * 2 + 1]; v[i] = ri ? (lr * bi + li * br) : (lr * br - li * bi); }
        u32x4 o; o.x = pk2(v[0], v[1]); o.y = pk2(v[2], v[3]); o.z = pk2(v[4], v[5]); o.w = pk2(v[6], v[7]);
        *(u32x4*)(Pg + (size_t)(2 * n + ri) * 256 + c8 * 8) = o;
        *(u32x4*)(Pg + (size_t)(128 + 32 * qr + rl) * 256 + c8 * 8) = (u32x4){0u, 0u, 0u, 0u};
    }
    __syncthreads();
}
__device__ __forceinline__ void p0_prologue(Frame& F) {
    for (int it = F.vcu; it < 256; it += F.G) p0_ssm_tables(F, it >> 2, it & 3);
    LAS float* scr = (LAS float*)(F.lds + F.wave * 16384);
    const int lane = lane_id();
    const int gw = F.vcu * NWAVES + F.wave, NGW = F.G * NWAVES;
    constexpr int I_IN = (D_MODEL / 64) * (IN_W / 32);
    {
        TItem t{F.in[3], (bf16_t*)(F.ws + WS_WIN), F.in[2]  , D_MODEL, IN_W, 128, 0, 0};
        float va[32], vb[32];
        int it = gw;
        if (it < I_IN) { t.item = it; titem_load(t, va, lane); }
        for (; it < I_IN; it += 2 * NGW) {
            TItem t2 = t; const bool h2 = it + NGW < I_IN;
            if (h2) { t2.item = it + NGW; titem_load(t2, vb, lane); }
            t.item = it; titem_store(t, va, scr, lane);
            if (h2) { if (it + 2 * NGW < I_IN) { t.item = it + 2 * NGW; titem_load(t, va, lane); } titem_store(t2, vb, scr, lane); }
        }
    }
    {
        bf16_t* xn = (bf16_t*)(F.ws + WS_XN); const float* x = F.in[0]; float* ir = (float*)(F.ws + WS_IRSTD1);
        f32x4 ra[8], rb[8];
        int m = gw;
        if (m < M) rms_row_load(x + (size_t)m * D_MODEL, ra, lane);
        for (; m < M; m += 2 * NGW) {
            const bool h2 = m + NGW < M;
            if (h2) rms_row_load(x + (size_t)(m + NGW) * D_MODEL, rb, lane);
            rms_row_store(ra, ir + m, xn + (size_t)m * D_MODEL, lane);
            if (h2) { if (m + 2 * NGW < M) rms_row_load(x + (size_t)(m + 2 * NGW) * D_MODEL, ra, lane); rms_row_store(rb, ir + m + NGW, xn + (size_t)(m + NGW) * D_MODEL, lane); }
        }
    }
}
__device__ __forceinline__ bool late_item(Frame& F, int r, TItem& t) {
    constexpr int I_GLU = (SSM_W / 64) * (SSM_W / 32), I_OUT = (2048 / 64) * (D_MODEL / 32), I_G = (D_MODEL / 64) * (FF / 32), I_D = (FF / 64) * (D_MODEL / 32);
    if (r >= I_GLU + I_OUT + 2 * I_G + I_D) return false;
    if (r < I_GLU) { t = TItem{F.in[15], (bf16_t*)(F.ws + WS_WGLU), nullptr, SSM_W, SSM_W, 128, 0, r}; return true; } r -= I_GLU;
    if (r < I_OUT) {
        const int kb = r / (D_MODEL / 32); t = TItem{F.in[18], (bf16_t*)(F.ws + WS_WOUT), (kb < 16) ? F.in[16] : (F.in[17] - 1024), 2048, D_MODEL, 128, 0, r}; return true; } r -= I_OUT;
    if (r < I_G) { t = TItem{F.in[20], (bf16_t*)(F.ws + WS_WGU), F.in[19], D_MODEL, FF, 256, 0, r}; return true; } r -= I_G;
    if (r < I_G) { t = TItem{F.in[21], (bf16_t*)(F.ws + WS_WGU), F.in[19], D_MODEL, FF, 256, 128, r}; return true; } r -= I_G;
    t = TItem{F.in[22], (bf16_t*)(F.ws + WS_WDN), nullptr, FF, D_MODEL, 128, 0, r}; return true;
}
__device__ __forceinline__ void convert_late_weights(Frame& F, int w, int nw) {
    LAS float* scr = (LAS float*)(F.lds + F.wave * 16384);
    const int lane = lane_id();
    TItem ta, tb; float va[32], vb[32];
    int it = w;
    bool ha = late_item(F, it, ta);
    if (ha) titem_load(ta, va, lane);
    while (ha) {
        const bool hb = late_item(F, it + nw, tb);
        if (hb) titem_load(tb, vb, lane);
        titem_store(ta, va, scr, lane);
        it += 2 * nw;
        ha = hb && late_item(F, it, ta);
        if (hb) { if (ha) titem_load(ta, va, lane); titem_store(tb, vb, scr, lane); }
    }
}

using pg8::Unit;
struct EpiIn {
    static constexpr bool PERM = true, AFTER_DRAIN = false; static constexpr int MID_T = 0;
    bf16_t* Q; bf16_t* Kb; bf16_t* Vb; bf16_t* Ag;
    __device__ __forceinline__ void operator()(const f32x4 (&acc)[2][2][4][2], const Unit& u, int wr, int wc, int fr, int fq) const {
        asm volatile("" : "+v"(fr), "+v"(fq));
        const int row0 = u.pm * 256 + wr * 64 + fr, pn = u.pn;
#pragma unroll
        for (int ai = 0; ai < 2; ++ai)
#pragma unroll
            for (int m = 0; m < 4; ++m) { const int row = row0 + ai * 128 + m * 16;
#pragma unroll
                for (int bj = 0; bj < 2; ++bj) { const int col = bj * 128 + wc * 32 + 8 * fq; const f32x4 v0 = acc[ai][bj][m][0], v1 = acc[ai][bj][m][1];
                    u32x4 w; w.x = cvt_pk_bf16(v0[0], v0[1]); w.y = cvt_pk_bf16(v0[2], v0[3]); w.z = cvt_pk_bf16(v1[0], v1[1]); w.w = cvt_pk_bf16(v1[2], v1[3]);
                    bf16_t* dst;
                    if (pn < 4) dst = Q + (size_t)row * ATTN_W + pn * 256 + col;
                    else if (pn == 4) dst = Kb + (size_t)row * KV_W + col;
                    else if (pn == 5) dst = Vb + (size_t)row * KV_W + col;
                    else { const int c = (pn - 6) * 256 + col; dst = Ag + ((size_t)(c >> 4) * 1024 + (row >> 4)) * SSM_KA + (row & 15) * 16 + (c & 15); }
                    *(u32x4*)dst = w; } }
    }
};
struct EpiS {
    static constexpr bool PERM = false, AFTER_DRAIN = true; static constexpr int MID_T = 0;
    __device__ __forceinline__ void operator()(const f32x4 (&acc)[2][2][4][2], const Unit& u, int wr, int wc, int fr, int fq) const {}
    __device__ __forceinline__ void fused(const f32x4 (&acc)[2][2][4][2], const Unit& u, int wr, int wc, int fr, int fq, LAS unsigned char* lds) const {
        asm volatile("" : "+v"(fr), "+v"(fq));
#pragma unroll
        for (int ai = 0; ai < 2; ++ai)
#pragma unroll
            for (int m = 0; m < 4; ++m) { const int r = ai * 128 + wr * 64 + m * 16 + fr;
#pragma unroll
                for (int n = 0; n < 2; ++n) *(LAS f32x4*)(lds + r * 512 + (((wc * 32 + n * 16 + 4 * fq) * 4) ^ ((r & 7) << 4))) = acc[ai][0][m][n]; }
    }
};
struct EpiY {
    static constexpr bool PERM = true, AFTER_DRAIN = false; static constexpr int MID_T = 0;
    const bf16_t* Ag; const float* dd; bf16_t* Yg;
    __device__ __forceinline__ void operator()(const f32x4 (&acc)[2][2][4][2], const Unit& u, int wr, int wc, int fr, int fq) const {
        asm volatile("" : "+v"(fr), "+v"(fq));
        const int g = u.pm >> 2; const int p0 = (8 * fq) & 15;
        const f32x4 d0 = *(const f32x4*)(dd + g * 16 + p0), d1 = *(const f32x4*)(dd + g * 16 + p0 + 4);
        const size_t grow0 = (size_t)u.pm * 256 + wr * 64 + fr; const int col0 = wc * 32 + 8 * fq;
        u32x4 uu[2][4][2];
#pragma unroll
        for (int ai = 0; ai < 2; ++ai)
#pragma unroll
            for (int m = 0; m < 4; ++m)
#pragma unroll
                for (int bj = 0; bj < 2; ++bj) uu[ai][m][bj] = __builtin_nontemporal_load((const u32x4*)(Ag + (grow0 + ai * 128 + m * 16) * SSM_KA + bj * 128 + col0));
#pragma unroll
        for (int ai = 0; ai < 2; ++ai)
#pragma unroll
            for (int m = 0; m < 4; ++m) { const size_t grow = grow0 + ai * 128 + m * 16;
#pragma unroll
                for (int bj = 0; bj < 2; ++bj) { const u32x4 w_ = uu[ai][m][bj]; const f32x4 v0 = acc[ai][bj][m][0], v1 = acc[ai][bj][m][1];
                    const float y0 = gelu_tanh(v0[0] + d0[0] * bf_lo(w_.x)), y1 = gelu_tanh(v0[1] + d0[1] * bf_hi(w_.x)), y2 = gelu_tanh(v0[2] + d0[2] * bf_lo(w_.y)), y3 = gelu_tanh(v0[3] + d0[3] * bf_hi(w_.y));
                    const float y4 = gelu_tanh(v1[0] + d1[0] * bf_lo(w_.z)), y5 = gelu_tanh(v1[1] + d1[1] * bf_hi(w_.z)), y6 = gelu_tanh(v1[2] + d1[2] * bf_lo(w_.w)), y7 = gelu_tanh(v1[3] + d1[3] * bf_hi(w_.w));
                    u32x4 w; w.x = cvt_pk_bf16(y0, y1); w.y = cvt_pk_bf16(y2, y3); w.z = cvt_pk_bf16(y4, y5); w.w = cvt_pk_bf16(y6, y7);
                    *(u32x4*)(Yg + grow * 256 + bj * 128 + col0) = w; } }
    }
};
struct EpiGlu {
    static constexpr bool PERM = true, AFTER_DRAIN = false; static constexpr int MID_T = 0;
    const bf16_t* Yg; bf16_t* mixed; float* ssq;
    __device__ __forceinline__ void operator()(const f32x4 (&acc)[2][2][4][2], const Unit& u, int wr, int wc, int fr, int fq) const {
        asm volatile("" : "+v"(fr), "+v"(fq));
        const int row0 = u.pm * 256 + wr * 64 + fr, c0 = u.pn * 256 + wc * 32 + 8 * fq;
        u32x4 yy[2][4][2];
#pragma unroll
        for (int ai = 0; ai < 2; ++ai)
#pragma unroll
            for (int m = 0; m < 4; ++m)
#pragma unroll
                for (int bj = 0; bj < 2; ++bj) { const int c = c0 + bj * 128; yy[ai][m][bj] = __builtin_nontemporal_load((const u32x4*)(Yg + ((size_t)(c >> 4) * M + row0 + ai * 128 + m * 16) * 16 + (c & 15))); }
#pragma unroll
        for (int ai = 0; ai < 2; ++ai)
#pragma unroll
            for (int m = 0; m < 4; ++m) { const int row = row0 + ai * 128 + m * 16; float sq = 0.f;
#pragma unroll
                for (int bj = 0; bj < 2; ++bj) { const int c = c0 + bj * 128; const u32x4 y_ = yy[ai][m][bj]; const f32x4 v0 = acc[ai][bj][m][0], v1 = acc[ai][bj][m][1];
                    const float s0 = bf_lo(y_.x) * sigmoidf_fast(v0[0]), s1 = bf_hi(y_.x) * sigmoidf_fast(v0[1]), s2 = bf_lo(y_.y) * sigmoidf_fast(v0[2]), s3 = bf_hi(y_.y) * sigmoidf_fast(v0[3]);
                    const float s4 = bf_lo(y_.z) * sigmoidf_fast(v1[0]), s5 = bf_hi(y_.z) * sigmoidf_fast(v1[1]), s6 = bf_lo(y_.w) * sigmoidf_fast(v1[2]), s7 = bf_hi(y_.w) * sigmoidf_fast(v1[3]);
                    sq += (s0 * s0 + s1 * s1) + (s2 * s2 + s3 * s3) + (s4 * s4 + s5 * s5) + (s6 * s6 + s7 * s7);
                    u32x4 w; w.x = cvt_pk_bf16(s0, s1); w.y = cvt_pk_bf16(s2, s3); w.z = cvt_pk_bf16(s4, s5); w.w = cvt_pk_bf16(s6, s7);
                    *(u32x4*)(mixed + (size_t)row * 2048 + 1024 + c) = w; }
                sq += __shfl_xor(sq, 16); sq += __shfl_xor(sq, 32);
                if (fq == 0) atomicAdd(ssq + row, sq); }
    }
};
struct EpiOut {
    static constexpr bool PERM = true, AFTER_DRAIN = false; static constexpr int MID_T = 16;
    const bf16_t* xn; const float* irstd1; bf16_t* x1b; const float* ssq_a; const float* ssq_s; float* ssq_x;
    __device__ __forceinline__ void mid(f32x4 (&acc)[2][2][4][2], const Unit& u, int wr, int wc, int fr, int fq) const {
        asm volatile("" : "+v"(fr), "+v"(fq));
#pragma unroll
        for (int ai = 0; ai < 2; ++ai)
#pragma unroll
            for (int m = 0; m < 4; ++m) { const int row = u.pm * 256 + ai * 128 + wr * 64 + m * 16 + fr;
                const float f = sqrtf((ssq_s[row] * (1.0f / 1024.0f) + EPS) / (ssq_a[row] * (1.0f / 1024.0f) + EPS));
#pragma unroll
                for (int bj = 0; bj < 2; ++bj)
#pragma unroll
                    for (int n = 0; n < 2; ++n) acc[ai][bj][m][n] *= f; }
    }
    __device__ __forceinline__ void operator()(const f32x4 (&acc)[2][2][4][2], const Unit& u, int wr, int wc, int fr, int fq) const {
        asm volatile("" : "+v"(fr), "+v"(fq));
        const int row0 = u.pm * 256 + wr * 64 + fr; const size_t cofs = (size_t)u.pn * 256 + wc * 32 + 8 * fq;
#pragma unroll
        for (int ai = 0; ai < 2; ++ai) {
            float sv[4], iv[4]; u32x4 xb[4][2];
#pragma unroll
            for (int m = 0; m < 4; ++m) { const int row = row0 + ai * 128 + m * 16; sv[m] = ssq_s[row]; iv[m] = irstd1[row];
#pragma unroll
                for (int bj = 0; bj < 2; ++bj) xb[m][bj] = *(const u32x4*)(xn + (size_t)row * D_MODEL + cofs + bj * 128); }
#pragma unroll
            for (int m = 0; m < 4; ++m) { const int row = row0 + ai * 128 + m * 16; const float rstd = 1.0f / sqrtf(sv[m] * (1.0f / 1024.0f) + EPS), ir = iv[m]; float sq = 0.f;
#pragma unroll
                for (int bj = 0; bj < 2; ++bj) { const size_t off = (size_t)row * D_MODEL + cofs + bj * 128; const u32x4 x_ = xb[m][bj];
                    const f32x4 b0 = {bf_lo(x_.x), bf_hi(x_.x), bf_lo(x_.y), bf_hi(x_.y)}, b1 = {bf_lo(x_.z), bf_hi(x_.z), bf_lo(x_.w), bf_hi(x_.w)};
                    const f32x4 o0 = b0 * ir + acc[ai][bj][m][0] * rstd, o1 = b1 * ir + acc[ai][bj][m][1] * rstd;
                    sq += (o0[0] * o0[0] + o0[1] * o0[1]) + (o0[2] * o0[2] + o0[3] * o0[3]) + (o1[0] * o1[0] + o1[1] * o1[1]) + (o1[2] * o1[2] + o1[3] * o1[3]);
                    u32x4 w; w.x = cvt_pk_bf16(o0[0], o0[1]); w.y = cvt_pk_bf16(o0[2], o0[3]); w.z = cvt_pk_bf16(o1[0], o1[1]); w.w = cvt_pk_bf16(o1[2], o1[3]);
                    *(u32x4*)(x1b + off) = w; }
                sq += __shfl_xor(sq, 16); sq += __shfl_xor(sq, 32); if (fq == 0) atomicAdd(ssq_x + row, sq); }
        }
    }
};
struct EpiGU {
    static constexpr bool PERM = true, AFTER_DRAIN = false; static constexpr int MID_T = 0;
    const float* ssq_x; bf16_t* H;
    __device__ __forceinline__ void operator()(const f32x4 (&acc)[2][2][4][2], const Unit& u, int wr, int wc, int fr, int fq) const {
        asm volatile("" : "+v"(fr), "+v"(fq));
        const int row0 = u.pm * 256 + wr * 64 + fr;
        float sv[2][4];
#pragma unroll
        for (int ai = 0; ai < 2; ++ai)
#pragma unroll
            for (int m = 0; m < 4; ++m) sv[ai][m] = ssq_x[row0 + ai * 128 + m * 16];
#pragma unroll
        for (int ai = 0; ai < 2; ++ai)
#pragma unroll
            for (int m = 0; m < 4; ++m) { const int row = row0 + ai * 128 + m * 16; const float rstd = 1.0f / sqrtf(sv[ai][m] * (1.0f / 2048.0f) + EPS);
                float h[8];
#pragma unroll
                for (int n = 0; n < 2; ++n)
#pragma unroll
                    for (int i = 0; i < 4; ++i) { const float gv = acc[ai][0][m][n][i] * rstd, uv = acc[ai][1][m][n][i] * rstd; h[4 * n + i] = gv * sigmoidf_fast(gv) * uv; }
                u32x4 w; w.x = cvt_pk_bf16(h[0], h[1]); w.y = cvt_pk_bf16(h[2], h[3]); w.z = cvt_pk_bf16(h[4], h[5]); w.w = cvt_pk_bf16(h[6], h[7]);
                *(u32x4*)(H + (size_t)row * FF + u.pn * 128 + wc * 32 + 8 * fq) = w; }
    }
};
template <bool DRY> struct EpiDown {
    static constexpr bool PERM = true, AFTER_DRAIN = false; static constexpr int MID_T = 0;
    const bf16_t* x1b; float* out; float* trash;
    __device__ __forceinline__ void operator()(const f32x4 (&acc)[2][2][4][2], const Unit& u, int wr, int wc, int fr, int fq) const {
        asm volatile("" : "+v"(fr), "+v"(fq));
        const int row0 = u.pm * 256 + wr * 64 + fr; const size_t cofs = (size_t)u.pn * 256 + wc * 32 + 8 * fq;
        u32x4 xb[2][4][2];
#pragma unroll
        for (int ai = 0; ai < 2; ++ai)
#pragma unroll
            for (int m = 0; m < 4; ++m)
#pragma unroll
                for (int bj = 0; bj < 2; ++bj) xb[ai][m][bj] = __builtin_nontemporal_load((const u32x4*)(x1b + (size_t)(row0 + ai * 128 + m * 16) * D_MODEL + cofs + bj * 128));
#pragma unroll
        for (int ai = 0; ai < 2; ++ai)
#pragma unroll
            for (int m = 0; m < 4; ++m) { const int row = row0 + ai * 128 + m * 16;
#pragma unroll
                for (int bj = 0; bj < 2; ++bj) { const size_t off = (size_t)row * D_MODEL + cofs + bj * 128; const u32x4 x_ = xb[ai][m][bj];
                    const f32x4 b0 = {bf_lo(x_.x), bf_hi(x_.x), bf_lo(x_.y), bf_hi(x_.y)}, b1 = {bf_lo(x_.z), bf_hi(x_.z), bf_lo(x_.w), bf_hi(x_.w)};
                    float* q = DRY ? trash + (off & ((8u << 20) - 1)) : out + off;
                    *(f32x4*)q = b0 + acc[ai][bj][m][0]; *(f32x4*)(q + 4) = b1 + acc[ai][bj][m][1]; } }
    }
};

constexpr int ATT_KROW = 144, ATT_VROW = 520, ATT_K_OFF = 0, ATT_V_OFF = 256 * ATT_KROW, ATT_B_OFF = ATT_V_OFF + 64 * ATT_VROW;
constexpr int ATT_TAB = 192;
static_assert(ATT_B_OFF + 4 * ATT_TAB * 4 <= RING_BYTES, "attention LDS");
template <int STG_REPS = 1, int TASK_REPS = 1>
__device__ __forceinline__ void attn_unit(Frame& F, int b, int qb, int kvh, float* ssq_real) {
    LAS unsigned char* lds = F.lds;
    const int lane = lane_id(), wave = F.wave, tid = wave * 64 + lane;
    const bf16_t* Q = (const bf16_t*)(F.ws + WS_Q); const bf16_t* Kb = (const bf16_t*)(F.ws + WS_K); const bf16_t* Vb = (const bf16_t*)(F.ws + WS_V);
    bf16_t* mixed = (bf16_t*)(F.ws + WS_MIX);
    const int T0 = b * SEQ + qb * 128;
    const int q = lane & 31, hh = lane >> 5;
    u32x4 qraw[2][4];
#pragma unroll
    for (int it = 0; it < 2; ++it) { const int task = wave + 8 * it; const bf16_t* qp = Q + (size_t)(T0 + 32 * (task & 3) + q) * ATTN_W + (kvh * 4 + (task >> 2)) * 64 + hh * 8;
#pragma unroll
        for (int ks = 0; ks < 4; ++ks) qraw[it][ks] = __builtin_nontemporal_load((const u32x4*)(qp + 16 * ks)); }
    for (int srep = 0; srep < STG_REPS; ++srep)
    {
        const int key = tid & 255; const bool valid = (qb > 0) || (key >= 128);
        const size_t tok = (size_t)(T0 - 128 + key);
        u32x4 c[8];
        const bf16_t* src = ((tid < 256) ? Kb : Vb) + tok * KV_W + kvh * 64;
#pragma unroll
        for (int i = 0; i < 8; ++i) c[i] = valid ? *(const u32x4*)(src + 8 * i) : (u32x4){0u, 0u, 0u, 0u};
        if (tid < 256) {
            float ss = 0.f;
#pragma unroll
            for (int i = 0; i < 8; ++i) { const float a0 = bf_lo(c[i].x), a1 = bf_hi(c[i].x), a2 = bf_lo(c[i].y), a3 = bf_hi(c[i].y), a4 = bf_lo(c[i].z), a5 = bf_hi(c[i].z), a6 = bf_lo(c[i].w), a7 = bf_hi(c[i].w);
                ss += (a0 * a0 + a1 * a1) + (a2 * a2 + a3 * a3) + (a4 * a4 + a5 * a5) + (a6 * a6 + a7 * a7); }
            const float rstd = 1.0f / sqrtf(ss * (1.0f / 64.0f) + EPS);
            const float* kg = F.in[5];
#pragma unroll
            for (int i = 0; i < 8; ++i) { const f32x4 g0 = *(const f32x4*)(kg + 8 * i), g1 = *(const f32x4*)(kg + 8 * i + 4);
                u32x4 w; w.x = cvt_pk_bf16(bf_lo(c[i].x) * rstd * g0[0], bf_hi(c[i].x) * rstd * g0[1]); w.y = cvt_pk_bf16(bf_lo(c[i].y) * rstd * g0[2], bf_hi(c[i].y) * rstd * g0[3]);
                w.z = cvt_pk_bf16(bf_lo(c[i].z) * rstd * g1[0], bf_hi(c[i].z) * rstd * g1[1]); w.w = cvt_pk_bf16(bf_lo(c[i].w) * rstd * g1[2], bf_hi(c[i].w) * rstd * g1[3]);
                *(LAS u32x4*)(lds + ATT_K_OFF + key * ATT_KROW + i * 16) = w; }
        } else {
#pragma unroll
            for (int i = 0; i < 8; ++i) { const unsigned w4[4] = {c[i].x, c[i].y, c[i].z, c[i].w};
#pragma unroll
                for (int j = 0; j < 4; ++j) { *(LAS unsigned short*)(lds + ATT_V_OFF + (8 * i + 2 * j) * ATT_VROW + key * 2) = (unsigned short)(w4[j] & 0xffffu);
                    *(LAS unsigned short*)(lds + ATT_V_OFF + (8 * i + 2 * j + 1) * ATT_VROW + key * 2) = (unsigned short)(w4[j] >> 16); } }
        }
        for (int e = tid; e < 4 * ATT_TAB; e += NWAVES * 64) { const int hl = e / ATT_TAB, dist = e % ATT_TAB - 32;
            ((LAS float*)(lds + ATT_B_OFF))[e] = ((unsigned)dist < 128u) ? F.in[1][(int)kBucket[dist & 127] * NQH + kvh * 4 + hl] * LOG2E : -INFINITY; }
    }
    bf16x8 qf2[2][4];
    { const float* qg = F.in[4]; f32x4 gq[4][2];
#pragma unroll
      for (int ks = 0; ks < 4; ++ks) { gq[ks][0] = *(const f32x4*)(qg + 16 * ks + 8 * hh); gq[ks][1] = *(const f32x4*)(qg + 16 * ks + 8 * hh + 4); }
#pragma unroll
      for (int it = 0; it < 2; ++it) { float ss = 0.f;
#pragma unroll
        for (int ks = 0; ks < 4; ++ks) { const u32x4 w_ = qraw[it][ks];
            const float a0 = bf_lo(w_.x), a1 = bf_hi(w_.x), a2 = bf_lo(w_.y), a3 = bf_hi(w_.y), a4 = bf_lo(w_.z), a5 = bf_hi(w_.z), a6 = bf_lo(w_.w), a7 = bf_hi(w_.w);
            ss += (a0 * a0 + a1 * a1) + (a2 * a2 + a3 * a3) + (a4 * a4 + a5 * a5) + (a6 * a6 + a7 * a7); }
        ss += __shfl_xor(ss, 32);
        const float sc = (1.0f / sqrtf(ss * (1.0f / 64.0f) + EPS)) * (0.125f * LOG2E);
#pragma unroll
        for (int ks = 0; ks < 4; ++ks) { const u32x4 w_ = qraw[it][ks]; const f32x4 g0 = gq[ks][0], g1 = gq[ks][1];
            u32x4 w; w.x = cvt_pk_bf16(bf_lo(w_.x) * sc * g0[0], bf_hi(w_.x) * sc * g0[1]); w.y = cvt_pk_bf16(bf_lo(w_.y) * sc * g0[2], bf_hi(w_.y) * sc * g0[3]);
            w.z = cvt_pk_bf16(bf_lo(w_.z) * sc * g1[0], bf_hi(w_.z) * sc * g1[1]); w.w = cvt_pk_bf16(bf_lo(w_.w) * sc * g1[2], bf_hi(w_.w) * sc * g1[3]);
            qf2[it][ks] = __builtin_bit_cast(bf16x8, w); } } }
    __syncthreads();
    for (int trep = 0; trep < TASK_REPS; ++trep)
#pragma unroll
    for (int it = 0; it < 2; ++it) {
        float* ssq_a = (trep == TASK_REPS - 1) ? ssq_real : (float*)(F.ws + WS_SSQ_T);
        const int task = wave + 8 * it, hl = task >> 2, grp = task & 3, hq = kvh * 4 + hl, qi = 32 * grp + q;
        const bf16x8 (&qf)[4] = qf2[it];
        const LAS float* tb = (const LAS float*)(lds + ATT_B_OFF) + hl * ATT_TAB + (q + 128 - 4 * hh + 32 - 155);
        const float sink2 = F.in[6][hq] * LOG2E;
        f32x16 s[5];
#pragma unroll
        for (int kt = 0; kt < 5; ++kt) {
            f32x16 a;
#pragma unroll
            for (int r = 0; r < 16; ++r) a[r] = tb[155 - 32 * kt - ((r & 3) + 8 * (r >> 2))];
#pragma unroll
            for (int ks = 0; ks < 4; ++ks) { const bf16x8 kf = *(const LAS bf16x8*)(lds + ATT_K_OFF + (32 * (grp + kt) + q) * ATT_KROW + (16 * ks + 8 * hh) * 2);
                a = __builtin_amdgcn_mfma_f32_32x32x16_bf16(kf, qf[ks], a, 0, 0, 0); }
            if (qb == 0 && grp + kt < 4) {
#pragma unroll
                for (int r = 0; r < 16; ++r) a[r] = -INFINITY; }
            s[kt] = a;
        }
        float mx = sink2;
#pragma unroll
        for (int kt = 0; kt < 5; ++kt)
#pragma unroll
            for (int r = 0; r < 16; ++r) mx = fmaxf(mx, s[kt][r]);
        mx = fmaxf(mx, __shfl_xor(mx, 32));
        float l = 0.f;
#pragma unroll
        for (int kt = 0; kt < 5; ++kt)
#pragma unroll
            for (int r = 0; r < 16; ++r) { const float p = fast_exp2(s[kt][r] - mx); s[kt][r] = p; l += p; }
        l += __shfl_xor(l, 32);
        l += fast_exp2(sink2 - mx);
        f32x16 o[2]; o[0] = (f32x16){}; o[1] = (f32x16){};
#pragma unroll
        for (int kt = 0; kt < 5; ++kt)
#pragma unroll
            for (int s2 = 0; s2 < 2; ++s2) {
                u32x4 pw; pw.x = cvt_pk_bf16(s[kt][8 * s2 + 0], s[kt][8 * s2 + 1]); pw.y = cvt_pk_bf16(s[kt][8 * s2 + 2], s[kt][8 * s2 + 3]); pw.z = cvt_pk_bf16(s[kt][8 * s2 + 4], s[kt][8 * s2 + 5]); pw.w = cvt_pk_bf16(s[kt][8 * s2 + 6], s[kt][8 * s2 + 7]);
                const bf16x8 pb = __builtin_bit_cast(bf16x8, pw);
#pragma unroll
                for (int d0 = 0; d0 < 2; ++d0) { const LAS unsigned char* vp = lds + ATT_V_OFF + (32 * d0 + q) * ATT_VROW + (32 * (grp + kt) + 16 * s2 + 4 * hh) * 2;
                    const u32x2 lo = *(const LAS u32x2*)vp, hi = *(const LAS u32x2*)(vp + 16);
                    const u32x4 vv = {lo.x, lo.y, hi.x, hi.y};
                    o[d0] = __builtin_amdgcn_mfma_f32_32x32x16_bf16(__builtin_bit_cast(bf16x8, vv), pb, o[d0], 0, 0, 0); }
            }
        const float inv = 1.0f / l; float sq = 0.f;
        bf16_t* op = mixed + (size_t)(T0 + qi) * 2048 + hq * 64 + 4 * hh;
#pragma unroll
        for (int d0 = 0; d0 < 2; ++d0)
#pragma unroll
            for (int r4 = 0; r4 < 4; ++r4) { const float v0 = o[d0][4 * r4] * inv, v1 = o[d0][4 * r4 + 1] * inv, v2 = o[d0][4 * r4 + 2] * inv, v3 = o[d0][4 * r4 + 3] * inv;
                sq += (v0 * v0 + v1 * v1) + (v2 * v2 + v3 * v3);
                u32x2 w; w.x = cvt_pk_bf16(v0, v1); w.y = cvt_pk_bf16(v2, v3); *(u32x2*)(op + 32 * d0 + 8 * r4) = w; }
        sq += __shfl_xor(sq, 32);
        if (hh == 0) atomicAdd(ssq_a + T0 + qi, sq);
    }
    __syncthreads();
}

template <int MODE = 7>
__device__ __forceinline__ void ssm_unit(Frame& F, int pm) {
    const int g = pm >> 2;
    bf16_t* Ag = (bf16_t*)(F.ws + WS_AG);
    if constexpr (MODE & 1) {
        int Kc = 256; asm volatile("" : "+s"(Kc));
        pg8::Gemm gm{(const char*)Ag, (const char*)(F.ws + WS_PG), Kc, SSM_KA * 2, 32, 128, 256 * 2};
        pg8::OneUnit S1{pm, g}; EpiS E{};
        pg8::gemm_phase<EpiS, pg8::OneUnit, false>(F.lds, F.wave, gm, S1, E);
    }
    asm volatile("s_waitcnt lgkmcnt(0)" ::: "memory");
    __syncthreads();
    if ((MODE & 2) && F.wave == 0) {
        const int n = lane_id();
        const f32x2 l16 = *((const f32x2*)(F.ws + WS_L16) + g * 64 + n);
        float hr = 0.f, hi = 0.f;
        unsigned* hp = (unsigned*)(Ag + (size_t)pm * 256 * SSM_KA + 256) + n;
        for (int c0 = 0; c0 < 256; c0 += 8) {
            f32x2 sv[8];
#pragma unroll
            for (int j = 0; j < 8; ++j) sv[j] = *(const LAS f32x2*)(F.lds + (c0 + j) * 512 + ((8 * n) ^ (j << 4)));
#pragma unroll
            for (int j = 0; j < 8; ++j) { hp[(size_t)(c0 + j) * (SSM_KA / 2)] = cvt_pk_bf16(hr, hi);
                const float nr = l16.x * hr - l16.y * hi + sv[j].x, ni = l16.x * hi + l16.y * hr + sv[j].y; hr = nr; hi = ni; }
        }
    }
    asm volatile("s_waitcnt vmcnt(0) lgkmcnt(0)" ::: "memory");
    __syncthreads();
    if constexpr (MODE & 4) {
        int Kc = SSM_KA; asm volatile("" : "+s"(Kc));
        pg8::Gemm gm{(const char*)Ag, (const char*)(F.ws + WS_BG), Kc, SSM_KA * 2, 32, 128, SSM_KA * 2};
        pg8::OneUnit S1{pm, g}; EpiY E{Ag, F.in[14], (bf16_t*)(F.ws + WS_YG)};
        pg8::gemm_phase<EpiY, pg8::OneUnit, false>(F.lds, F.wave, gm, S1, E);
    }
}


#define XB_TMO      128
#define XB_XCNT(j)  (256  + 64 * (j))
#define XB_XSUB(j)  (1280 + 64 * (j))
#define XB_XGEN(j)  (2304 + 64 * (j))
#define XB_TOP      3328
#define XB_TOPGEN   3392
#define XCD_BAR_WORDS 3456
#define XB_SPIN_CAP (1u << 22)
constexpr size_t WS_BAR = 16384;
__device__ __forceinline__ unsigned xb_ld(unsigned* p)              { return __hip_atomic_load(p, __ATOMIC_RELAXED, __HIP_MEMORY_SCOPE_AGENT); }
__device__ __forceinline__ unsigned xb_add(unsigned* p, unsigned v) { return __hip_atomic_fetch_add(p, v, __ATOMIC_RELAXED, __HIP_MEMORY_SCOPE_AGENT); }
__device__ __forceinline__ unsigned xb_xcc_id() { return (unsigned)__builtin_amdgcn_s_getreg((3 << 11) | 20) & 0xFu; }
#define XB_SPIN(cond, bar) do { unsigned _sp = 0; while (cond) { __builtin_amdgcn_s_sleep(1); \
    if ((++_sp & 255u) == 0u) { if (xb_ld(&(bar)[XB_TMO])) break; if (_sp > XB_SPIN_CAP) { atomicAdd(&(bar)[XB_TMO], 1u); break; } } } } while (0)
struct XcdBarrier { unsigned* bar; unsigned x; volatile LAS unsigned* st; };
__device__ __forceinline__ XcdBarrier xcd_barrier_post(unsigned* bar, volatile LAS unsigned* st) {
    XcdBarrier b; b.bar = bar; b.x = xb_xcc_id(); b.st = st;
    if (threadIdx.x == 0) (void)xb_add(&bar[XB_XCNT(b.x)], 1u);
    return b;
}
__device__ __forceinline__ void xcd_barrier_complete(unsigned* bar, unsigned x, unsigned& nloc, unsigned& nx) {
    const unsigned G = gridDim.x * gridDim.y * gridDim.z;
    unsigned sum, cnt, mine, sp = 0u;
    for (;;) {
        sum = 0u; cnt = 0u; mine = 0u;
#pragma unroll
        for (unsigned j = 0; j < 16; ++j) { const unsigned c = xb_ld(&bar[XB_XCNT(j)]); sum += c; cnt += (c > 0u) ? 1u : 0u; mine = (j == x) ? c : mine; }
        if (sum == G) break;
        __builtin_amdgcn_s_sleep(1);
        if ((++sp & 255u) == 0u) { if (xb_ld(&bar[XB_TMO])) break; if (sp > XB_SPIN_CAP) { atomicAdd(&bar[XB_TMO], 1u); break; } }
    }
    nloc = mine > 0u ? mine : 1u; nx = cnt > 0u ? cnt : 1u;
}
__device__ __forceinline__ void xcd_barrier(const XcdBarrier& b, int wave) {
    asm volatile("s_waitcnt vmcnt(0)" ::: "memory");
    __syncthreads();
    if (wave == 0 && lane_id() == 0) {
        unsigned* bar = b.bar;
        __builtin_amdgcn_s_waitcnt(0);
        unsigned nloc = b.st[0], nx = b.st[1];
        if (nloc == 0u) { xcd_barrier_complete(bar, b.x, nloc, nx); b.st[0] = nloc; b.st[1] = nx; }
        const unsigned old = xb_add(&bar[XB_XSUB(b.x)], 1u);
        const unsigned gen = old / nloc;
        if (old + 1u == (gen + 1u) * nloc) {
            __builtin_amdgcn_fence(__ATOMIC_RELEASE, "agent");
            asm volatile("s_waitcnt vmcnt(0)" ::: "memory");
            const unsigned og = xb_add(&bar[XB_TOP], 1u);
            const unsigned tg = og / nx;
            if (og + 1u == (tg + 1u) * nx) xb_add(&bar[XB_TOPGEN], 1u);
            else XB_SPIN(xb_ld(&bar[XB_TOPGEN]) == tg, bar);
            __builtin_amdgcn_fence(__ATOMIC_ACQUIRE, "agent");
            xb_add(&bar[XB_XGEN(b.x)], 1u);
            asm volatile("s_waitcnt vmcnt(0)" ::: "memory");
        } else {
            XB_SPIN(xb_ld(&bar[XB_XGEN(b.x)]) == gen, bar);
            __builtin_amdgcn_fence(__ATOMIC_ACQUIRE, "agent");
            asm volatile("s_waitcnt vmcnt(0)" ::: "memory");
        }
    }
    __syncthreads();
}

struct Args { const float* in[23]; float* out; unsigned char* ws; int ph_lo, ph_hi; };
__global__ void __launch_bounds__(NWAVES * 64, 2) hymba_fwd(Args args) {
    extern __shared__ __attribute__((aligned(16))) unsigned char lds_raw[];
    Frame F;
    F.lds = (LAS unsigned char*)lds_raw;
    F.wave = __builtin_amdgcn_readfirstlane((int)threadIdx.x >> 6);
    F.G = gridDim.x; { const int bx = blockIdx.x; F.vcu = (F.G % 8 == 0) ? (bx % 8) * (F.G / 8) + bx / 8 : bx; }
    F.in = args.in; F.out = args.out; F.ws = args.ws;
    const int lo = args.ph_lo, hi = args.ph_hi;
    for (int u = threadIdx.x; u < (LDS_BYTES - LDSCTL_OFF) / 4; u += NWAVES * 64) ((LAS unsigned*)(F.lds + LDSCTL_OFF))[u] = 0u;
    __syncthreads();
    XcdBarrier bar; bar.bar = (unsigned*)(F.ws + WS_BAR); bar.x = 0; bar.st = nullptr;
    if (MK_N_LAUNCHES == 1) bar = xcd_barrier_post((unsigned*)(F.ws + WS_BAR), (volatile LAS unsigned*)(F.lds + MISC_OFF) + 8);
#define IN(k) (lo <= (k) && (k) < hi)
#define GRID_BAR(k) do { if (IN(k) && IN((k) + 1)) xcd_barrier(bar, F.wave); } while (0)
    unsigned char* ws = F.ws;
    float* const ssq_trash = (float*)(ws + WS_SSQ_T);
#define PHASE0(DRY) { p0_prologue(F); }
#define PHASE1(DRY) {     \
        pg8::Gemm g{(const char*)(ws + WS_XN), (const char*)(ws + WS_WIN), D_MODEL, D_MODEL * 2, 32, 128, D_MODEL * 2}; \
        pg8::StaticOrder S; S.init(M, IN_W, F.G, (int)blockIdx.x, WGM_P1); \
        EpiIn E{(bf16_t*)(ws + WS_Q), (bf16_t*)(ws + WS_K), (bf16_t*)(ws + WS_V), (bf16_t*)(ws + WS_AG)}; \
        pg8::gemm_phase<EpiIn, pg8::StaticOrder, true>(F.lds, F.wave, g, S, E); \
        { const int nwg_ = (M / 256) * (IN_W / 256), maxu_ = (nwg_ + F.G - 1) / F.G, nheavy_ = nwg_ - (maxu_ - 1) * F.G, nlight_ = F.G - nheavy_, c_ = (int)blockIdx.x;     \
          if (nlight_ == 0) convert_late_weights(F, c_ * NWAVES + F.wave, F.G * NWAVES); \
          else if (c_ >= nheavy_) convert_late_weights(F, (c_ - nheavy_) * NWAVES + F.wave, nlight_ * NWAVES); } }
#define PHASE2(DRY) { \
        float* const sa_ = (DRY) ? ssq_trash : (float*)(ws + WS_SSQ_A); \
        for (int u = F.vcu; u < BATCH * 32 * NKVH; u += F.G) attn_unit<(PROBE_REP == 25 ? 2 : 1), (PROBE_REP == 26 ? 2 : 1)>(F, u >> 7, (u >> 2) & 31, u & 3, sa_); \
        if (F.vcu < 256) ssm_unit(F, F.vcu);     }
#define PHASE3(DRY) {     \
        pg8::Gemm g{(const char*)(ws + WS_YG), (const char*)(ws + WS_WGLU), SSM_W, 32, (unsigned)(M * 32), (unsigned)(4 * M * 32), SSM_W * 2}; \
        pg8::StaticOrder S; S.init(M, SSM_W, F.G, (int)blockIdx.x, WGM_P3); \
        EpiGlu E{(const bf16_t*)(ws + WS_YG), (bf16_t*)(ws + WS_MIX), (DRY) ? ssq_trash : (float*)(ws + WS_SSQ_S)}; \
        pg8::gemm_phase<EpiGlu, pg8::StaticOrder, true>(F.lds, F.wave, g, S, E); }
#define PHASE4(DRY) {     \
        pg8::Gemm g{(const char*)(ws + WS_MIX), (const char*)(ws + WS_WOUT), 2048, 2048 * 2, 32, 128, 2048 * 2}; \
        pg8::StaticOrder S; S.init(M, D_MODEL, F.G, (int)blockIdx.x, WGM_P4); \
        EpiOut E{(const bf16_t*)(ws + WS_XN), (const float*)(ws + WS_IRSTD1), (bf16_t*)(ws + WS_XN), (const float*)(ws + WS_SSQ_A), (const float*)(ws + WS_SSQ_S), (DRY) ? ssq_trash : (float*)(ws + WS_SSQ_X)}; \
        pg8::gemm_phase<EpiOut, pg8::StaticOrder, true>(F.lds, F.wave, g, S, E); }
#define PHASE5(DRY) {     \
        pg8::Gemm g{(const char*)(ws + WS_XN), (const char*)(ws + WS_WGU), D_MODEL, D_MODEL * 2, 32, 128, D_MODEL * 2}; \
        pg8::StaticOrder S; S.init(M, 2 * FF, F.G, (int)blockIdx.x, WGM_P5); \
        EpiGU E{(const float*)(ws + WS_SSQ_X), (bf16_t*)(ws + WS_H)}; \
        pg8::gemm_phase<EpiGU, pg8::StaticOrder, true>(F.lds, F.wave, g, S, E); }
#define PHASE6(DRY) {     \
        pg8::Gemm g{(const char*)(ws + WS_H), (const char*)(ws + WS_WDN), FF, FF * 2, 32, 128, FF * 2}; \
        pg8::StaticOrder S; S.init(M, D_MODEL, F.G, (int)blockIdx.x, WGM_P6); \
        EpiDown<(DRY)> E{(const bf16_t*)(ws + WS_XN), F.out, (float*)(ws + WS_SSCR)}; \
        pg8::gemm_phase<EpiDown<(DRY)>, pg8::StaticOrder, true>(F.lds, F.wave, g, S, E); }
#define PHASE2A(DRY) { for (int u = F.vcu; u < BATCH * 32 * NKVH; u += F.G) attn_unit(F, u >> 7, (u >> 2) & 31, u & 3, ssq_trash); }
#define PHASE2S(DRY) { if (F.vcu < 256) ssm_unit(F, F.vcu); }
#define RUN_PHASE(k, BODY) do { if (PROBE_REP == (k) && IN(k)) { BODY(1); xcd_barrier(bar, F.wave); } if (IN(k)) { BODY(0); } } while (0)
    RUN_PHASE(0, PHASE0);
    GRID_BAR(0);
    if (args.ph_lo < 0) cg::this_grid().sync();
    RUN_PHASE(1, PHASE1);
    GRID_BAR(1);
    if (PROBE_REP == 22 && IN(2)) { if (F.vcu < 256) ssm_unit<1>(F, F.vcu); xcd_barrier(bar, F.wave); }
    if (PROBE_REP == 23 && IN(2)) { if (F.vcu < 256) ssm_unit<2>(F, F.vcu); xcd_barrier(bar, F.wave); }
    if (PROBE_REP == 24 && IN(2)) { if (F.vcu < 256) ssm_unit<4>(F, F.vcu); xcd_barrier(bar, F.wave); }
    if (PROBE_REP == 20 && IN(2)) { PHASE2A(1); xcd_barrier(bar, F.wave); }
    if (PROBE_REP == 21 && IN(2)) { PHASE2S(1); xcd_barrier(bar, F.wave); }
    RUN_PHASE(2, PHASE2);
    GRID_BAR(2);
    RUN_PHASE(3, PHASE3);
    GRID_BAR(3);
    RUN_PHASE(4, PHASE4);
    GRID_BAR(4);
    RUN_PHASE(5, PHASE5);
    GRID_BAR(5);
    RUN_PHASE(6, PHASE6);
#undef IN
#undef GRID_BAR
}

extern "C" void kernel_launch(void* const* d_in, const int* in_sizes, int n_in, void* d_out, int out_size, void* d_ws, size_t ws_size, hipStream_t stream) {
    static int grid = 0;
    if (grid == 0) {
        if (n_in != 23 || in_sizes[0] != M * D_MODEL || out_size != M * D_MODEL || ws_size < WS_END) { fprintf(stderr, "kernel_launch: unexpected sizes (n_in %d, out %d, ws %zu); nothing launched\n", n_in, out_size, ws_size); grid = -1; return; }
        int dev = 0, cus = 0, per_cu = 0;
        if (hipGetDevice(&dev) != hipSuccess || hipDeviceGetAttribute(&cus, hipDeviceAttributeMultiprocessorCount, dev) != hipSuccess) { grid = -1; return; }
        if (hipFuncSetAttribute((const void*)hymba_fwd, hipFuncAttributeMaxDynamicSharedMemorySize, LDS_BYTES) != hipSuccess) { fprintf(stderr, "kernel_launch: hipFuncSetAttribute failed\n"); grid = -1; return; }
        if (hipOccupancyMaxActiveBlocksPerMultiprocessor(&per_cu, (const void*)hymba_fwd, NWAVES * 64, LDS_BYTES) != hipSuccess || per_cu < 1) { fprintf(stderr, "kernel_launch: occupancy query failed (%d)\n", per_cu); (void)hipGetLastError(); grid = -1; return; }
        grid = cus;
        if (grid < 256) { fprintf(stderr, "kernel_launch: this kernel needs >= 256 CUs (got %d); nothing launched\n", grid); grid = -1; return; }
    }
    if (grid < 0) return;
    (void)hipMemsetAsync((char*)d_ws + WS_CTL, 0, CTL_ZERO_BYTES, stream);
    Args a{};
    for (int i = 0; i < 23; ++i) a.in[i] = (const float*)d_in[i];
    a.out = (float*)d_out; a.ws = (unsigned char*)d_ws;
    constexpr int NPH = 7;
    for (int li = 0; li < MK_N_LAUNCHES; ++li) {
        a.ph_lo = (MK_N_LAUNCHES == 1) ? 0 : li; a.ph_hi = (MK_N_LAUNCHES == 1) ? NPH : li + 1;
        void* kargs[] = {&a};
        const hipError_t e = hipLaunchCooperativeKernel((const void*)hymba_fwd, dim3(grid), dim3(NWAVES * 64), kargs, LDS_BYTES, stream);
        if (e != hipSuccess) { fprintf(stderr, "kernel_launch: cooperative launch failed: %s (grid %d)\n", hipGetErrorString(e), grid); break; }
    }
}
```

```cpp
#include <hip/hip_runtime.h>
#include <hip/hip_cooperative_groups.h>
#include <cstdio>
#include <cstdint>
namespace cg = cooperative_groups;

#ifndef PROBE_REP
#define PROBE_REP -1
#endif
#ifndef WGM_P1
#define WGM_P1 4
#define WGM_P3 4
#define WGM_P4 4
#define WGM_P5 4
#define WGM_P6 4
#endif
#ifndef STAMP_ID
#define STAMP_ID -1
#define STAMP_BLK 0
#endif
#if STAMP_ID >= 0
#define ST_B(F, id) do { if (STAMP_ID == (id)) (F).st_t0 = __builtin_amdgcn_s_memrealtime(); } while (0)
#define ST_E(F, id) do { if (STAMP_ID == (id)) (F).st_acc += __builtin_amdgcn_s_memrealtime() - (F).st_t0; } while (0)
#else
#define ST_B(F, id) do {} while (0)
#define ST_E(F, id) do {} while (0)
#endif
#ifndef LATE_HEAVY
#define LATE_HEAVY 2048
#endif
#ifndef MK_N_LAUNCHES
#define MK_N_LAUNCHES 1
#endif

#define LAS __attribute__((address_space(3)))
typedef unsigned short bf16_t;
typedef short bf16x8 __attribute__((ext_vector_type(8)));
typedef short s16x4 __attribute__((ext_vector_type(4)));
typedef float f32x4 __attribute__((ext_vector_type(4)));
typedef float f32x2 __attribute__((ext_vector_type(2)));
typedef float f32x16 __attribute__((ext_vector_type(16)));
typedef unsigned u32x4 __attribute__((ext_vector_type(4)));
typedef unsigned u32x2 __attribute__((ext_vector_type(2)));

constexpr int D_MODEL = 2048, BATCH = 4, SEQ = 4096, M = BATCH * SEQ;
constexpr int HD = 64, NQH = 16, NKVH = 4, ATTN_W = 1024, KV_W = 256;
constexpr int SSM_W = 1024, SSM_P = 16, SSM_G = 64, SSM_N = 64, IN_W = 2560, FF = 5632;
constexpr int CH_T = 16;
constexpr int SSM_KA = CH_T * SSM_P + 2 * SSM_N;
constexpr float EPS = 1e-6f;
constexpr float LOG2E = 1.4426950408889634f;

__device__ const unsigned char kBucket[128] = {0, 1, 2, 3, 4, 5, 6, 7, 8, 9, 10, 11, 12, 13, 14, 15, 16, 16, 16, 17, 17, 18, 18, 18, 19, 19, 19, 20, 20, 20, 20, 21, 21, 21, 21, 22, 22, 22, 22, 22, 23, 23, 23, 23, 23, 23, 24, 24, 24, 24, 24, 24, 25, 25, 25, 25, 25, 25, 25, 26, 26, 26, 26, 26, 26, 26, 26, 27, 27, 27, 27, 27, 27, 27, 27, 27, 27, 28, 28, 28, 28, 28, 28, 28, 28, 28, 28, 29, 29, 29, 29, 29, 29, 29, 29, 29, 29, 29, 29, 30, 30, 30, 30, 30, 30, 30, 30, 30, 30, 30, 30, 30, 30, 31, 31, 31, 31, 31, 31, 31, 31, 31, 31, 31, 31, 31, 31, 31};

__device__ __forceinline__ unsigned cvt_pk_bf16(float lo, float hi) { unsigned r; asm volatile("v_cvt_pk_bf16_f32 %0, %1, %2" : "=v"(r) : "v"(lo), "v"(hi)); return r; }
__device__ __forceinline__ float bf_lo(unsigned w) { return __builtin_bit_cast(float, w << 16); }
__device__ __forceinline__ float bf_hi(unsigned w) { return __builtin_bit_cast(float, w & 0xffff0000u); }
__device__ __forceinline__ float fast_rcp(float x) { return __builtin_amdgcn_rcpf(x); }
__device__ __forceinline__ float fast_exp2(float x) { return __builtin_amdgcn_exp2f(x); }
__device__ __forceinline__ float sigmoidf_fast(float x) { return fast_rcp(1.0f + fast_exp2(-LOG2E * x)); }
typedef float f32x2_t __attribute__((ext_vector_type(2)));
__device__ __forceinline__ f32x2_t sigmoid2(f32x2_t x) { const f32x2_t c = {-LOG2E, -LOG2E}, one = {1.0f, 1.0f}; const f32x2_t a = x * c; f32x2_t e = {fast_exp2(a.x), fast_exp2(a.y)}; e = e + one; return (f32x2_t){fast_rcp(e.x), fast_rcp(e.y)}; }
__device__ __forceinline__ f32x2_t gelu_tanh2(f32x2_t x) {
    constexpr float A = -LOG2E * 1.5957691216057308f, B = A * 0.044715f; const f32x2_t a2 = {A, A}, b2 = {B, B}, one = {1.0f, 1.0f};
    f32x2_t p = x * x; p = p * b2 + a2; const f32x2_t t = x * p; f32x2_t e = {fast_exp2(t.x), fast_exp2(t.y)}; e = e + one; const f32x2_t r = {fast_rcp(e.x), fast_rcp(e.y)}; return x * r;
}
__device__ __forceinline__ float gelu_tanh(float x) {
    const float u2 = 1.5957691216057308f * (x + 0.044715f * x * x * x);
    return x * sigmoidf_fast(u2);
}

__device__ __forceinline__ int lane_id() { int l = __builtin_amdgcn_mbcnt_hi(~0u, __builtin_amdgcn_mbcnt_lo(~0u, 0u)); asm volatile("" : "+v"(l)); return l; }

namespace pg8 {
constexpr int BM = 256, BK = 64, HALF = 128, HTB = HALF * BK * 2  , STAGE_BYTES = 8 * HTB, NXCD = 8, WGM = 4;
__host__ __device__ __forceinline__ int lds_byte(int r, int c) { const int st = (r >> 4) * 2 + (c >> 5), rr = r & 15, cc = c & 31, ob = rr * 64 + cc * 2; return st * 1024 + (ob ^ (((ob >> 9) & 1) << 5)); }
__host__ __device__ __forceinline__ void stage_rc(int b, int& R, int& C) { const int st = b / 1024, sb = b % 1024, swz = sb ^ (((sb >> 9) & 1) << 5); R = (st >> 1) * 16 + swz / 64; C = (st & 1) * 32 + (swz % 64) / 2; }
__host__ __device__ __forceinline__ int perm32(int rho) { const int n = rho >> 4, i = rho & 15; return 8 * (i >> 2) + 4 * n + (i & 3); }

struct Unit { int pm, pn; unsigned aofs, bofs; int part; };
struct Gemm { const char* A; const char* B; int K; unsigned a_rs, a_cs, a_ks, b_rs; };

struct StaticOrder {
    int nM, nN, nwg, G, c, wgm;
    __device__ void init(int Mr, int N, int G_, int c_, int wgm_ = WGM) { nM = Mr / BM; nN = N / BM; nwg = nM * nN; G = G_; c = c_; wgm = wgm_; }
    __device__ bool next(int i, Unit& u) const {
        const long L = (long)i * G + c; if (L >= nwg) return false;
        int wgid = (int)L; { const int q = nwg / NXCD, r = nwg % NXCD, xcd = wgid % NXCD, off = wgid / NXCD; wgid = (xcd < r ? xcd * (q + 1) : r * (q + 1) + (xcd - r) * q) + off; }
        const int nig = wgm * nN, gid = wgid / nig, fm = gid * wgm, gsz = (nM - fm) < wgm ? (nM - fm) : wgm;
        u.pm = fm + ((wgid % nig) % gsz); u.pn = (wgid % nig) / gsz; u.aofs = 0; u.bofs = 0; u.part = 0; return true;
    }
};
struct TwoPartOrder {
    StaticOrder S; unsigned kofs;
    __device__ bool next(int i, Unit& u) const { if (!S.next(i >> 1, u)) return false; u.part = i & 1; u.aofs = u.bofs = (i & 1) ? kofs : 0u; return true; }
};
struct OneUnit {
    int pm, pn;
    __device__ bool next(int i, Unit& u) const { if (i) return false; u.pm = pm; u.pn = pn; u.aofs = 0; u.bofs = 0; u.part = 0; return true; }
};

template <class Epi, class Sched, bool ALIGN_EPI>
__device__ __forceinline__ void gemm_phase(LAS unsigned char* lds, const int wid  , const Gemm g, const Sched& S, const Epi& E) {
    const int lane = lane_id(), tid = wid * 64 + lane, wr = wid >> 2, wc = wid & 3, fr = lane & 15, fq = lane >> 4;
    const int nt = g.K / BK;
    unsigned voffA[2], voffB[2];
#pragma unroll
    for (int i = 0; i < 2; ++i) { int R, C; stage_rc(tid * 16 + i * 8192, R, C); const int Rb = Epi::PERM ? ((R & ~31) + perm32(R & 31)) : R;
        voffA[i] = (unsigned)R * g.a_rs + (unsigned)(C >> 4) * g.a_cs + (unsigned)(C & 15) * 2u; voffB[i] = (unsigned)Rb * g.b_rs + (unsigned)C * 2u; }
    const size_t kstepA = g.a_ks, kstepB = (size_t)(BK * 2);
    const size_t hstepA = (size_t)HALF * g.a_rs, hstepB = (size_t)HALF * g.b_rs, tstepA = 2 * hstepA, tstepB = 2 * hstepB;
    const unsigned ldsw = (unsigned)wid * 1024u;
    const int aoff = lds_byte(wr * 64 + fr, fq * 8), boff = lds_byte(wc * 32 + fr, fq * 8);
#define PG8_SA(b, h) (((b) * 2 + (h)) * HTB)
#define PG8_SB(b, h) ((4 + (b) * 2 + (h)) * HTB)
#define PG8_STAGE(bufoff, gbase, voff) do { _Pragma("unroll") for (int _i = 0; _i < 2; ++_i) \
        __builtin_amdgcn_global_load_lds((const unsigned*)((const char*)(gbase) + (voff)[_i]), (LAS unsigned*)(lds + (bufoff) + ldsw + _i * 8192), 16, 0, 0); } while (0)
#define PG8_LDA(dst, b, h) do { _Pragma("unroll") for (int m = 0; m < 4; ++m) _Pragma("unroll") for (int k = 0; k < 2; ++k) dst[m][k] = *(const LAS bf16x8*)(lds + PG8_SA(b, h) + aoff + m * 2048 + k * 1024); } while (0)
#define PG8_LDB(dst, b, h) do { _Pragma("unroll") for (int n = 0; n < 2; ++n) _Pragma("unroll") for (int k = 0; k < 2; ++k) dst[n][k] = *(const LAS bf16x8*)(lds + PG8_SB(b, h) + boff + n * 2048 + k * 1024); } while (0)
#define PG8_MMA(ai, bj, At, Bt) do { __builtin_amdgcn_s_setprio(1); _Pragma("unroll") for (int m = 0; m < 4; ++m) _Pragma("unroll") for (int n = 0; n < 2; ++n) _Pragma("unroll") for (int k = 0; k < 2; ++k) \
        acc[ai][bj][m][n] = __builtin_amdgcn_mfma_f32_16x16x32_bf16(Bt[n][k], At[m][k], acc[ai][bj][m][n], 0, 0, 0); __builtin_amdgcn_s_setprio(0); } while (0)
#define PG8_WAIT_V(n) asm volatile("s_waitcnt vmcnt(" #n ")" ::: "memory")
#define PG8_WAIT_L(n) asm volatile("s_waitcnt lgkmcnt(" #n ")" ::: "memory")
#define PG8_BAR __builtin_amdgcn_s_barrier()
#define PG8_SCHED __builtin_amdgcn_sched_barrier(0)
    Unit cur, nxt; int ui = 0;
    if (!S.next(0, cur)) return;
    f32x4 acc[2][2][4][2];
#pragma unroll
    for (int a = 0; a < 2; ++a)
#pragma unroll
        for (int b = 0; b < 2; ++b)
#pragma unroll
            for (int m = 0; m < 4; ++m)
#pragma unroll
                for (int n = 0; n < 2; ++n) acc[a][b][m][n] = (f32x4){0.f, 0.f, 0.f, 0.f};
    bf16x8 At[4][2], B0[2][2], B1[2][2];
    const char* cA = g.A + (size_t)cur.pm * tstepA + cur.aofs; const char* cB = g.B + (size_t)cur.pn * tstepB + cur.bofs;
    PG8_STAGE(PG8_SB(0, 0), cB, voffB); PG8_STAGE(PG8_SB(0, 1), cB + hstepB, voffB); PG8_STAGE(PG8_SA(0, 0), cA, voffA); PG8_STAGE(PG8_SA(0, 1), cA + hstepA, voffA);
    if (wr == 1) PG8_BAR;
    PG8_WAIT_V(2); PG8_BAR;
    PG8_STAGE(PG8_SB(1, 0), cB + kstepB, voffB); PG8_STAGE(PG8_SA(1, 0), cA + kstepA, voffA); PG8_STAGE(PG8_SB(1, 1), cB + hstepB + kstepB, voffB);
    PG8_WAIT_V(6); PG8_BAR;
    for (;;) {
        const bool has_next = S.next(ui + 1, nxt);
        const char* nA = has_next ? g.A + (size_t)nxt.pm * tstepA + nxt.aofs : cA; const char* nB = has_next ? g.B + (size_t)nxt.pn * tstepB + nxt.bofs : cB;
        for (int t = 0; t < nt; t += 2) {
            if constexpr (Epi::MID_T > 0) { if (t == Epi::MID_T) E.mid(acc, cur, wr, wc, fr, fq); }
            const bool last = (t == nt - 2);
            const char* a1 = cA + (size_t)(t + 1) * kstepA;
            const char* a2 = last ? nA : cA + (size_t)(t + 2) * kstepA; const char* b2 = last ? nB : cB + (size_t)(t + 2) * kstepB;
            const char* a3 = a2 + kstepA; const char* b3 = b2 + kstepB;
            PG8_LDB(B0, 0, 0); PG8_LDB(B1, 0, 1); PG8_SCHED; PG8_LDA(At, 0, 0); PG8_STAGE(PG8_SA(1, 1), a1 + hstepA, voffA);
            PG8_WAIT_V(8); PG8_WAIT_L(0); PG8_BAR; PG8_MMA(0, 0, At, B0); PG8_MMA(0, 1, At, B1); PG8_BAR; PG8_SCHED;
            PG8_LDA(At, 0, 1); PG8_STAGE(PG8_SB(0, 0), b2, voffB); PG8_STAGE(PG8_SB(0, 1), b2 + hstepB, voffB); PG8_STAGE(PG8_SA(0, 0), a2, voffA);
            PG8_WAIT_V(8); PG8_WAIT_L(0); PG8_BAR; PG8_MMA(1, 0, At, B0); PG8_MMA(1, 1, At, B1); PG8_BAR; PG8_SCHED;
            PG8_LDB(B0, 1, 0); PG8_LDB(B1, 1, 1); PG8_SCHED; PG8_LDA(At, 1, 0); PG8_STAGE(PG8_SA(0, 1), a2 + hstepA, voffA);
            PG8_WAIT_V(8); PG8_WAIT_L(0); PG8_BAR; PG8_MMA(0, 0, At, B0); PG8_MMA(0, 1, At, B1); PG8_BAR; PG8_SCHED;
            PG8_LDA(At, 1, 1); PG8_STAGE(PG8_SB(1, 0), b3, voffB); PG8_STAGE(PG8_SB(1, 1), b3 + hstepB, voffB); PG8_STAGE(PG8_SA(1, 0), a3, voffA);
            PG8_WAIT_V(8); PG8_WAIT_L(0); PG8_BAR; PG8_MMA(1, 0, At, B0); PG8_MMA(1, 1, At, B1); PG8_BAR; PG8_SCHED;
        }
        if constexpr (ALIGN_EPI) { if (wr == 0) PG8_BAR; }
        if constexpr (Epi::MARK_LAST) cur.part = has_next ? 0 : 1;
        if constexpr (!Epi::AFTER_DRAIN) E(acc, cur, wr, wc, fr, fq);
        if (!has_next) break;
#pragma unroll
        for (int a = 0; a < 2; ++a)
#pragma unroll
            for (int b = 0; b < 2; ++b)
#pragma unroll
                for (int m = 0; m < 4; ++m)
#pragma unroll
                    for (int n = 0; n < 2; ++n) acc[a][b][m][n] = (f32x4){0.f, 0.f, 0.f, 0.f};
        cur = nxt; cA = nA; cB = nB; ++ui;
        if constexpr (ALIGN_EPI) { if (wr == 1) PG8_BAR; }
    }
    PG8_WAIT_V(0);
    if constexpr (!ALIGN_EPI) { if (wr == 0) PG8_BAR; }
    PG8_BAR;
    if constexpr (Epi::AFTER_DRAIN) E.fused(acc, cur, wr, wc, fr, fq, lds);
#undef PG8_SA
#undef PG8_SB
#undef PG8_STAGE
#undef PG8_LDA
#undef PG8_LDB
#undef PG8_MMA
#undef PG8_WAIT_V
#undef PG8_WAIT_L
#undef PG8_BAR
#undef PG8_SCHED
}
}

constexpr size_t MiB = 1u << 20;
constexpr size_t WS_CTL = 0, CTL_ZERO_BYTES = 1 * MiB;
constexpr size_t WS_SSQ_A = 256 * 1024, WS_SSQ_S = 320 * 1024, WS_SSQ_X = 384 * 1024, WS_SSQ_T = 448 * 1024  ;
static_assert(WS_SSQ_S == WS_SSQ_A + (size_t)4 * 16384 && WS_SSQ_X == WS_SSQ_S + (size_t)4 * 16384, "the three accumulators are contiguous");
constexpr size_t WS_BIAS = 640 * 1024;
constexpr size_t WS_IRSTD1 = 512 * 1024;
constexpr size_t WS_WIN = 2 * MiB;
constexpr size_t WS_WGLU = 12 * MiB;
constexpr size_t WS_WOUT = 14 * MiB;
constexpr size_t WS_WGU = 22 * MiB;
constexpr size_t WS_WDN = 66 * MiB;
constexpr size_t WS_BG = 88 * MiB;
constexpr size_t WS_PG = 100 * MiB;
constexpr size_t WS_L16 = 108 * MiB;
constexpr size_t WS_SSCR = 109 * MiB;
constexpr size_t WS_XN = 141 * MiB;
constexpr size_t WS_Q = 205 * MiB;
constexpr size_t WS_K = 237 * MiB;
constexpr size_t WS_V = 245 * MiB;
constexpr size_t WS_AG = 253 * MiB;
constexpr size_t WS_YG = 301 * MiB;
constexpr size_t WS_MIX = 333 * MiB;
constexpr size_t WS_H = 205 * MiB;
constexpr size_t WS_END = 397 * MiB;
static_assert(WS_H + (size_t)M * FF * 2 <= WS_END, "ws map");

constexpr int RING_BYTES = 131072;
constexpr int LDS_BYTES = 147456;
constexpr int NWAVES = 8;
constexpr int LDSCTL_OFF = RING_BYTES, MISC_OFF = LDSCTL_OFF + 320;

constexpr int ATT_G_OFF = LDSCTL_OFF + 8192;
struct Frame {
    LAS unsigned char* lds;
    int wave, vcu, G;
    const float* const* in; float* out; unsigned char* ws;
#if STAMP_ID >= 0
    unsigned long long st_t0, st_acc;
#endif
};

__device__ __forceinline__ float wave_sum(float v) {
#define WS_DPP(x, ctrl) __builtin_bit_cast(float, __builtin_amdgcn_update_dpp(0, __builtin_bit_cast(int, x), ctrl, 0xf, 0xf, true))
    v += WS_DPP(v, 0xB1);
    v += WS_DPP(v, 0x4E);
    v += WS_DPP(v, 0x124);
    v += WS_DPP(v, 0x128);
#undef WS_DPP
    const int b = __builtin_bit_cast(int, v);
    return (__builtin_bit_cast(float, __builtin_amdgcn_readlane(b, 0)) + __builtin_bit_cast(float, __builtin_amdgcn_readlane(b, 16))) + (__builtin_bit_cast(float, __builtin_amdgcn_readlane(b, 32)) + __builtin_bit_cast(float, __builtin_amdgcn_readlane(b, 48)));
}
__device__ __forceinline__ unsigned f2bf(float f) { unsigned u = __builtin_bit_cast(unsigned, f); return (u + 0x7fffu + ((u >> 16) & 1u)) >> 16; }
__device__ __forceinline__ unsigned pk2(float lo, float hi) { return f2bf(lo) | (f2bf(hi) << 16); }

struct TItem { const float* W; bf16_t* WT; const float* gain; int K, N, rmul, radd, item; };
__device__ __forceinline__ void titem_load(const TItem& t, float (&v)[32], int lane) {
    const int nblk = t.N / 32, kb = t.item / nblk, nb = t.item % nblk, k0 = 64 * kb, n0 = 32 * nb;
    const float* p = t.W + (size_t)(k0 + (lane >> 5)) * t.N + n0 + (lane & 31);
#pragma unroll
    for (int i = 0; i < 32; ++i) v[i] = __builtin_nontemporal_load(p + (size_t)(2 * i) * t.N);
}
__device__ __forceinline__ void titem_store(const TItem& t, const float (&v)[32], LAS float* scr, int lane) {
    const int nblk = t.N / 32, kb = t.item / nblk, nb = t.item % nblk, k0 = 64 * kb, n0 = 32 * nb;
#pragma unroll
    for (int i = 0; i < 32; ++i) scr[(2 * i + (lane >> 5)) * 33 + (lane & 31)] = v[i];
    asm volatile("s_waitcnt lgkmcnt(0)" ::: "memory");
    const int c = lane & 7;
    float gv[8];
#pragma unroll
    for (int i = 0; i < 8; ++i) gv[i] = t.gain ? t.gain[k0 + 8 * c + i] : 1.0f;
#pragma unroll
    for (int j = 0; j < 4; ++j) { const int n = (lane >> 3) + 8 * j; const LAS float* s = scr + (8 * c) * 33 + n; const int nn = n0 + n; const int row = (nn >> 7) * t.rmul + t.radd + (nn & 127);
        u32x4 o; o.x = cvt_pk_bf16(s[0 * 33] * gv[0], s[1 * 33] * gv[1]); o.y = cvt_pk_bf16(s[2 * 33] * gv[2], s[3 * 33] * gv[3]); o.z = cvt_pk_bf16(s[4 * 33] * gv[4], s[5 * 33] * gv[5]); o.w = cvt_pk_bf16(s[6 * 33] * gv[6], s[7 * 33] * gv[7]);
        __builtin_nontemporal_store(o, (u32x4*)(t.WT + (size_t)row * t.K + k0 + 8 * c)); }
    asm volatile("s_waitcnt lgkmcnt(0)" ::: "memory");
}
__device__ __forceinline__ void rms_row_load(const float* xrow, f32x4 (&v)[8], int lane) {
    const f32x4* xr = (const f32x4*)xrow + lane;
#pragma unroll
    for (int j = 0; j < 8; ++j) v[j] = __builtin_nontemporal_load(xr + 64 * j);
}
__device__ __forceinline__ void rms_row_store(const f32x4 (&v)[8], float* irstd, bf16_t* orow, int lane) {
    float s = 0.f;
#pragma unroll
    for (int j = 0; j < 8; ++j) { const f32x2_t a = {v[j].x, v[j].y}, b = {v[j].z, v[j].w}; const f32x2_t q = a * a + b * b; s += q.x + q.y; }
    const float ms = wave_sum(s) * (1.0f / D_MODEL) + EPS; const float rstd = __builtin_amdgcn_rsqf(ms);
    if (lane == 0) *irstd = ms * rstd;
    u32x2* o8 = (u32x2*)orow + lane;
#pragma unroll
    for (int j = 0; j < 8; ++j) { const f32x2_t r2 = {rstd, rstd}; const f32x2_t a = (f32x2_t){v[j].x, v[j].y} * r2, b = (f32x2_t){v[j].z, v[j].w} * r2; u32x2 w; w.x = cvt_pk_bf16(a.x, a.y); w.y = cvt_pk_bf16(b.x, b.y); o8[64 * j] = w; }
}
#define P0_HIDDEN_ITEMS(G) (((G) * (NWAVES - 1)) < (D_MODEL / 64) * (IN_W / 32) ? ((G) * (NWAVES - 1)) : (D_MODEL / 64) * (IN_W / 32))
__device__ __forceinline__ void p0_ssm_tables(Frame& F, int g, int qr) {
    LAS float* LP = (LAS float*)F.lds; LAS float* BB = LP + 17 * 64 * 2; LAS float* CC = BB + 64 * 16 * 2; LAS float* KT = CC + 16 * 65 * 2;
    const float* a_re = F.in[7]; const float* a_im = F.in[8]; const float* log_dt = F.in[9]; const float* b_re = F.in[10]; const float* b_im = F.in[11]; const float* c_re = F.in[12]; const float* c_im = F.in[13];
    const int tid = F.wave * 64 + lane_id();
    ST_B(F, 61);
    if (tid < 64) {
        const int n = tid;
        const double dt = exp((double)log_dt[g]);
        const double are = (double)a_re[g * 64 + n], aim = (double)a_im[g * 64 + n];
        const double mag = exp(are * dt), ang = aim * dt;
        const double lre = mag * cos(ang), lim = mag * sin(ang);
        const double nr = lre - 1.0, ni = lim, den = are * are + aim * aim;
        const double fre = (nr * are + ni * aim) / den, fim = (ni * are - nr * aim) / den;
        double pr = 1.0, pi = 0.0;
        for (int t = 0; t <= 16; ++t) { LP[(t * 64 + n) * 2] = (float)pr; LP[(t * 64 + n) * 2 + 1] = (float)pi; const double nre = pr * lre - pi * lim, nim = pr * lim + pi * lre; pr = nre; pi = nim; }
        if (qr == 0) { float* l16 = (float*)(F.ws + WS_L16) + (g * 64 + n) * 2; l16[0] = LP[(16 * 64 + n) * 2]; l16[1] = LP[(16 * 64 + n) * 2 + 1]; }
        for (int p = 0; p < 16; ++p) { const double br = (double)b_re[(g * 64 + n) * 16 + p], bi = (double)b_im[(g * 64 + n) * 16 + p];
            BB[(n * 16 + p) * 2] = (float)(fre * br - fim * bi); BB[(n * 16 + p) * 2 + 1] = (float)(fre * bi + fim * br); }
    } else {
        const int hid = F.vcu * (NWAVES - 1) + (F.wave - 1);
        if (F.G <= 256 && hid < P0_HIDDEN_ITEMS(F.G)) { TItem t{F.in[3], (bf16_t*)(F.ws + WS_WIN), F.in[2], D_MODEL, IN_W, 128, 0, hid}; float v[32]; const int lane = lane_id();
            titem_load(t, v, lane); titem_store(t, v, (LAS float*)(F.lds + 65536 + (F.wave - 1) * 8704), lane); }
    }
    for (int e = tid; e < 1024; e += 512) { const int ce = (e >> 6) * 65 + (e & 63); CC[ce * 2] = c_re[g * 1024 + e]; CC[ce * 2 + 1] = c_im[g * 1024 + e]; }
    __syncthreads();
    ST_E(F, 61); ST_B(F, 62);
    {
        const int nh = F.wave >> 2, tl = F.wave & 3, p = (tid & 63) >> 2, qq = tid & 3; float ka[4] = {0.f, 0.f, 0.f, 0.f};
        const LAS float* lp = LP + ((4 * qr + tl) * 64) * 2;
#pragma unroll 8
        for (int n = 32 * nh; n < 32 * nh + 32; ++n) {
            const f32x2 c = *(const LAS f32x2*)(CC + (p * 65 + n) * 2), l = *(const LAS f32x2*)(lp + n * 2);
            const f32x4 b01 = *(const LAS f32x4*)(BB + (n * 16 + 4 * qq) * 2), b23 = *(const LAS f32x4*)(BB + (n * 16 + 4 * qq + 2) * 2);
            const float clr = c.x * l.x - c.y * l.y, cli = c.x * l.y + c.y * l.x;
            ka[0] += clr * b01[0] - cli * b01[1]; ka[1] += clr * b01[2] - cli * b01[3]; ka[2] += clr * b23[0] - cli * b23[1]; ka[3] += clr * b23[2] - cli * b23[3];
        }
        *(LAS f32x4*)(KT + nh * 1024 + (tl * 16 + p) * 16 + 4 * qq) = (f32x4){ka[0], ka[1], ka[2], ka[3]};
    }
    __syncthreads();
    for (int e = tid; e < 1024; e += 512) KT[e] += KT[1024 + e];
    __syncthreads();
    ST_E(F, 62); ST_B(F, 63);
    bf16_t* Bg = (bf16_t*)(F.ws + WS_BG) + (size_t)g * 256 * SSM_KA;
    for (int idx = tid; idx < 4 * 16 * 16 * 2; idx += 512) {
        const int tl = idx >> 9, t = (idx >> 5) & 15, p = (idx >> 1) & 15, h = idx & 1, tau = 4 * qr + tl;
        if (t >= tau) { const LAS float* kp = KT + (tl * 16 + p) * 16 + 8 * h;
            u32x4 o; o.x = pk2(kp[0], kp[1]); o.y = pk2(kp[2], kp[3]); o.z = pk2(kp[4], kp[5]); o.w = pk2(kp[6], kp[7]);
            *(u32x4*)(Bg + (size_t)(t * 16 + p) * SSM_KA + (t - tau) * 16 + 8 * h) = o; }
    }
    for (int idx = tid; idx < 4 * 16 * 16 * 2; idx += 512) {
        const int ol = idx >> 9, t = (idx >> 5) & 15, p = (idx >> 1) & 15, h = idx & 1, sb = t + 4 * (3 - qr) + 1 + ol;
        if (sb <= 15) *(u32x4*)(Bg + (size_t)(t * 16 + p) * SSM_KA + sb * 16 + 8 * h) = (u32x4){0u, 0u, 0u, 0u};
    }
    for (int ch = tid; ch < 64 * 16; ch += 512) {
        const int rl = ch >> 4, c8 = ch & 15, t = 4 * qr + (rl >> 4), p = rl & 15, n0 = c8 * 4; float v[8];
#pragma unroll
        for (int i = 0; i < 4; ++i) { const int n = n0 + i; const float cr = CC[(p * 65 + n) * 2], ci = CC[(p * 65 + n) * 2 + 1], lr = LP[((t + 1) * 64 + n) * 2], li = LP[((t + 1) * 64 + n) * 2 + 1];
            v[2 * i] = cr * lr - ci * li; v[2 * i + 1] = -(cr * li + ci * lr); }
        u32x4 o; o.x = pk2(v[0], v[1]); o.y = pk2(v[2], v[3]); o.z = pk2(v[4], v[5]); o.w = pk2(v[6], v[7]);
        *(u32x4*)(Bg + (size_t)(t * 16 + p) * SSM_KA + 256 + c8 * 8) = o;
    }
    bf16_t* Pg = (bf16_t*)(F.ws + WS_PG) + (size_t)g * 256 * 256;
    for (int ch = tid; ch < 32 * 32; ch += 512) {
        const int rl = ch >> 5, c8 = ch & 31, n = 16 * qr + (rl >> 1), ri = rl & 1, s = c8 >> 1, q0 = (c8 & 1) * 8; float v[8];
        const float lr = LP[((15 - s) * 64 + n) * 2], li = LP[((15 - s) * 64 + n) * 2 + 1];
#pragma unroll
        for (int i = 0; i < 8; ++i) { const float br = BB[(n * 16 + q0 + i) * 2], bi = BB[(n * 16 + q0 + i) * 2 + 1]; v[i] = ri ? (lr * bi + li * br) : (lr * br - li * bi); }
        u32x4 o; o.x = pk2(v[0], v[1]); o.y = pk2(v[2], v[3]); o.z = pk2(v[4], v[5]); o.w = pk2(v[6], v[7]);
        *(u32x4*)(Pg + (size_t)(2 * n + ri) * 256 + c8 * 8) = o;
        *(u32x4*)(Pg + (size_t)(128 + 32 * qr + rl) * 256 + c8 * 8) = (u32x4){0u, 0u, 0u, 0u};
    }
    __syncthreads();
    ST_E(F, 63);
}
__device__ __forceinline__ void p0_prologue(Frame& F) {
    const int lane = lane_id();
    const int gw = F.vcu * NWAVES + F.wave, NGW = F.G * NWAVES;
    const int be = gw * 64 + lane, bh = be / 192, bdist = be % 192 - 32; const bool bhas = be < NQH * 192, binw = bhas && (unsigned)bdist < 128u;
    const int bkt = binw ? (int)kBucket[bdist & 127] : 0;
    asm volatile("" ::: "memory");
    ST_B(F, 60); for (int it = F.vcu; it < 256; it += F.G) p0_ssm_tables(F, it >> 2, it & 3); ST_E(F, 60);
    LAS float* scr = (LAS float*)(F.lds + F.wave * 16384);
    const float bval = binw ? F.in[1][bkt * NQH + bh] : 0.f;
    asm volatile("" ::: "memory");
    constexpr int I_IN = (D_MODEL / 64) * (IN_W / 32);
    {
        TItem t{F.in[3], (bf16_t*)(F.ws + WS_WIN), F.in[2]  , D_MODEL, IN_W, 128, 0, 0};
        float va[32], vb[32];
        int it = ((F.G <= 256) ? P0_HIDDEN_ITEMS(F.G) : 0) + gw;
        if (it < I_IN) { t.item = it; titem_load(t, va, lane); }
        for (; it < I_IN; it += 2 * NGW) {
            TItem t2 = t; const bool h2 = it + NGW < I_IN;
            if (h2) { t2.item = it + NGW; titem_load(t2, vb, lane); }
            t.item = it; titem_store(t, va, scr, lane);
            if (h2) { if (it + 2 * NGW < I_IN) { t.item = it + 2 * NGW; titem_load(t, va, lane); } titem_store(t2, vb, scr, lane); }
        }
    }
    if (bhas) ((float*)(F.ws + WS_BIAS))[be] = binw ? bval * LOG2E : -INFINITY;
#if STAMP_ID < 0 && PROBE_REP < 0
    if (be < 3 * M) ((float*)(F.ws + WS_SSQ_A))[be] = 0.f;
#endif
    {
        bf16_t* xn = (bf16_t*)(F.ws + WS_XN); const float* x = F.in[0]; float* ir = (float*)(F.ws + WS_IRSTD1);
        f32x4 ra[8], rb[8];
        int m = gw;
        if (m < M) rms_row_load(x + (size_t)m * D_MODEL, ra, lane);
        for (; m < M; m += 2 * NGW) {
            const bool h2 = m + NGW < M;
            if (h2) rms_row_load(x + (size_t)(m + NGW) * D_MODEL, rb, lane);
            rms_row_store(ra, ir + m, xn + (size_t)m * D_MODEL, lane);
            if (h2) { if (m + 2 * NGW < M) rms_row_load(x + (size_t)(m + 2 * NGW) * D_MODEL, ra, lane); rms_row_store(rb, ir + m + NGW, xn + (size_t)(m + NGW) * D_MODEL, lane); }
        }
    }
    { const int tid_ = F.wave * 64 + lane; if (tid_ < 128) ((LAS float*)(F.lds + ATT_G_OFF))[tid_] = (tid_ < 64) ? F.in[5][tid_] : F.in[4][tid_ - 64]; }
}
__device__ __forceinline__ bool late_item(Frame& F, int r, TItem& t) {
    constexpr int I_GLU = (SSM_W / 64) * (SSM_W / 32), I_OUT = (2048 / 64) * (D_MODEL / 32), I_G = (D_MODEL / 64) * (FF / 32), I_D = (FF / 64) * (D_MODEL / 32);
    if (r >= I_GLU + I_OUT + 2 * I_G + I_D) return false;
    if (r < I_GLU) { t = TItem{F.in[15], (bf16_t*)(F.ws + WS_WGLU), nullptr, SSM_W, SSM_W, 128, 0, r}; return true; } r -= I_GLU;
    if (r < I_OUT) {
        const int kb = r / (D_MODEL / 32); t = TItem{F.in[18], (bf16_t*)(F.ws + WS_WOUT), (kb < 16) ? F.in[16] : (F.in[17] - 1024), 2048, D_MODEL, 128, 0, r}; return true; } r -= I_OUT;
    if (r < I_G) { t = TItem{F.in[20], (bf16_t*)(F.ws + WS_WGU), F.in[19], D_MODEL, FF, 256, 0, r}; return true; } r -= I_G;
    if (r < I_G) { t = TItem{F.in[21], (bf16_t*)(F.ws + WS_WGU), F.in[19], D_MODEL, FF, 256, 128, r}; return true; } r -= I_G;
    t = TItem{F.in[22], (bf16_t*)(F.ws + WS_WDN), nullptr, FF, D_MODEL, 128, 0, r}; return true;
}
constexpr int LATE_N = (SSM_W / 64) * (SSM_W / 32) + (2048 / 64) * (D_MODEL / 32) + 2 * (D_MODEL / 64) * (FF / 32) + (FF / 64) * (D_MODEL / 32);
__device__ __forceinline__ void convert_late_weights(Frame& F, int w, int nw, int lo, int hi) {
    LAS float* scr = (LAS float*)(F.lds + F.wave * 16384);
    const int lane = lane_id();
    TItem ta, tb; float va[32], vb[32];
    int it = lo + w;
    bool ha = it < hi && late_item(F, it, ta);
    if (ha) titem_load(ta, va, lane);
    while (ha) {
        const bool hb = it + nw < hi && late_item(F, it + nw, tb);
        if (hb) titem_load(tb, vb, lane);
        titem_store(ta, va, scr, lane);
        it += 2 * nw;
        ha = hb && it < hi && late_item(F, it, ta);
        if (hb) { if (ha) titem_load(ta, va, lane); titem_store(tb, vb, scr, lane); }
    }
}

using pg8::Unit;
struct EpiIn {
    static constexpr bool MARK_LAST = false;
    static constexpr bool PERM = true, AFTER_DRAIN = false; static constexpr int MID_T = 0;
    bf16_t* Q; bf16_t* Kb; bf16_t* Vb; bf16_t* Ag;
    __device__ __forceinline__ void operator()(const f32x4 (&acc)[2][2][4][2], const Unit& u, int wr, int wc, int fr, int fq) const {
        asm volatile("" : "+v"(fr), "+v"(fq));
        const int row0 = u.pm * 256 + wr * 64 + fr, pn = u.pn;
#pragma unroll
        for (int ai = 0; ai < 2; ++ai)
#pragma unroll
            for (int m = 0; m < 4; ++m) { const int row = row0 + ai * 128 + m * 16;
#pragma unroll
                for (int bj = 0; bj < 2; ++bj) { const int col = bj * 128 + wc * 32 + 8 * fq; const f32x4 v0 = acc[ai][bj][m][0], v1 = acc[ai][bj][m][1];
                    u32x4 w; w.x = cvt_pk_bf16(v0[0], v0[1]); w.y = cvt_pk_bf16(v0[2], v0[3]); w.z = cvt_pk_bf16(v1[0], v1[1]); w.w = cvt_pk_bf16(v1[2], v1[3]);
                    bf16_t* dst;
                    if (pn < 4) dst = Q + (size_t)row * ATTN_W + pn * 256 + col;
                    else if (pn == 4) dst = Kb + (size_t)row * KV_W + col;
                    else if (pn == 5) dst = Vb + (size_t)row * KV_W + col;
                    else { const int c = (pn - 6) * 256 + col; dst = Ag + ((size_t)(c >> 4) * 1024 + (row >> 4)) * SSM_KA + (row & 15) * 16 + (c & 15); }
                    *(u32x4*)dst = w; } }
    }
};
struct EpiS {
    static constexpr bool MARK_LAST = false;
    static constexpr bool PERM = false, AFTER_DRAIN = true; static constexpr int MID_T = 0;
    __device__ __forceinline__ void operator()(const f32x4 (&acc)[2][2][4][2], const Unit& u, int wr, int wc, int fr, int fq) const {}
    __device__ __forceinline__ void fused(const f32x4 (&acc)[2][2][4][2], const Unit& u, int wr, int wc, int fr, int fq, LAS unsigned char* lds) const {
        asm volatile("" : "+v"(fr), "+v"(fq));
#pragma unroll
        for (int ai = 0; ai < 2; ++ai)
#pragma unroll
            for (int m = 0; m < 4; ++m) { const int r = ai * 128 + wr * 64 + m * 16 + fr;
#pragma unroll
                for (int n = 0; n < 2; ++n) *(LAS f32x4*)(lds + r * 512 + (((wc * 32 + n * 16 + 4 * fq) * 4) ^ ((r & 7) << 4))) = acc[ai][0][m][n]; }
    }
};
struct EpiY {
    static constexpr bool MARK_LAST = false;
    static constexpr bool PERM = true, AFTER_DRAIN = false; static constexpr int MID_T = 0;
    const bf16_t* Ag; const float* dd; bf16_t* Yg;
    __device__ __forceinline__ void operator()(const f32x4 (&acc)[2][2][4][2], const Unit& u, int wr, int wc, int fr, int fq) const {
        asm volatile("" : "+v"(fr), "+v"(fq));
        const int g = u.pm >> 2; const int p0 = (8 * fq) & 15;
        const f32x4 d0 = *(const f32x4*)(dd + g * 16 + p0), d1 = *(const f32x4*)(dd + g * 16 + p0 + 4);
        const size_t grow0 = (size_t)u.pm * 256 + wr * 64 + fr; const int col0 = wc * 32 + 8 * fq;
        u32x4 uu[2][4][2];
#pragma unroll
        for (int ai = 0; ai < 2; ++ai)
#pragma unroll
            for (int m = 0; m < 4; ++m)
#pragma unroll
                for (int bj = 0; bj < 2; ++bj) uu[ai][m][bj] = __builtin_nontemporal_load((const u32x4*)(Ag + (grow0 + ai * 128 + m * 16) * SSM_KA + bj * 128 + col0));
#pragma unroll
        for (int ai = 0; ai < 2; ++ai)
#pragma unroll
            for (int m = 0; m < 4; ++m) { const size_t grow = grow0 + ai * 128 + m * 16;
#pragma unroll
                for (int bj = 0; bj < 2; ++bj) { const u32x4 w_ = uu[ai][m][bj]; const f32x4 v0 = acc[ai][bj][m][0], v1 = acc[ai][bj][m][1];
                    const f32x2_t ya = gelu_tanh2((f32x2_t){v0[0], v0[1]} + (f32x2_t){d0[0], d0[1]} * (f32x2_t){bf_lo(w_.x), bf_hi(w_.x)}), yb = gelu_tanh2((f32x2_t){v0[2], v0[3]} + (f32x2_t){d0[2], d0[3]} * (f32x2_t){bf_lo(w_.y), bf_hi(w_.y)});
                    const f32x2_t yc = gelu_tanh2((f32x2_t){v1[0], v1[1]} + (f32x2_t){d1[0], d1[1]} * (f32x2_t){bf_lo(w_.z), bf_hi(w_.z)}), yd = gelu_tanh2((f32x2_t){v1[2], v1[3]} + (f32x2_t){d1[2], d1[3]} * (f32x2_t){bf_lo(w_.w), bf_hi(w_.w)});
                    u32x4 w; w.x = cvt_pk_bf16(ya.x, ya.y); w.y = cvt_pk_bf16(yb.x, yb.y); w.z = cvt_pk_bf16(yc.x, yc.y); w.w = cvt_pk_bf16(yd.x, yd.y);
                    *(u32x4*)(Yg + grow * 256 + bj * 128 + col0) = w; } }
    }
};
struct EpiGlu {
    static constexpr bool MARK_LAST = false;
    static constexpr bool PERM = true, AFTER_DRAIN = false; static constexpr int MID_T = 0;
    const bf16_t* Yg; bf16_t* mixed; float* ssq;
    __device__ __forceinline__ void operator()(const f32x4 (&acc)[2][2][4][2], const Unit& u, int wr, int wc, int fr, int fq) const {
        asm volatile("" : "+v"(fr), "+v"(fq));
        const int row0 = u.pm * 256 + wr * 64 + fr, c0 = u.pn * 256 + wc * 32 + 8 * fq;
        u32x4 yy[2][4][2];
#pragma unroll
        for (int ai = 0; ai < 2; ++ai)
#pragma unroll
            for (int m = 0; m < 4; ++m)
#pragma unroll
                for (int bj = 0; bj < 2; ++bj) { const int c = c0 + bj * 128; yy[ai][m][bj] = __builtin_nontemporal_load((const u32x4*)(Yg + ((size_t)(c >> 4) * M + row0 + ai * 128 + m * 16) * 16 + (c & 15))); }
#pragma unroll
        for (int ai = 0; ai < 2; ++ai)
#pragma unroll
            for (int m = 0; m < 4; ++m) { const int row = row0 + ai * 128 + m * 16; float sq = 0.f;
#pragma unroll
                for (int bj = 0; bj < 2; ++bj) { const int c = c0 + bj * 128; const u32x4 y_ = yy[ai][m][bj]; const f32x4 v0 = acc[ai][bj][m][0], v1 = acc[ai][bj][m][1];
                    const f32x2_t sa = (f32x2_t){bf_lo(y_.x), bf_hi(y_.x)} * sigmoid2((f32x2_t){v0[0], v0[1]}), sb = (f32x2_t){bf_lo(y_.y), bf_hi(y_.y)} * sigmoid2((f32x2_t){v0[2], v0[3]});
                    const f32x2_t sc = (f32x2_t){bf_lo(y_.z), bf_hi(y_.z)} * sigmoid2((f32x2_t){v1[0], v1[1]}), sd = (f32x2_t){bf_lo(y_.w), bf_hi(y_.w)} * sigmoid2((f32x2_t){v1[2], v1[3]});
                    const f32x2_t q2 = (sa * sa + sb * sb) + (sc * sc + sd * sd); sq += q2.x + q2.y;
                    u32x4 w; w.x = cvt_pk_bf16(sa.x, sa.y); w.y = cvt_pk_bf16(sb.x, sb.y); w.z = cvt_pk_bf16(sc.x, sc.y); w.w = cvt_pk_bf16(sd.x, sd.y);
                    *(u32x4*)(mixed + (size_t)row * 2048 + 1024 + c) = w; }
                sq += __shfl_xor(sq, 16); sq += __shfl_xor(sq, 32);
                if (fq == 0) atomicAdd(ssq + row, sq); }
    }
};
struct EpiOut {
    static constexpr bool MARK_LAST = false;
    static constexpr bool PERM = true, AFTER_DRAIN = false; static constexpr int MID_T = 16;
    const bf16_t* xn; const float* irstd1; bf16_t* x1b; const float* ssq_a; const float* ssq_s; float* ssq_x;
    __device__ __forceinline__ void mid(f32x4 (&acc)[2][2][4][2], const Unit& u, int wr, int wc, int fr, int fq) const {
        asm volatile("" : "+v"(fr), "+v"(fq));
#pragma unroll
        for (int ai = 0; ai < 2; ++ai)
#pragma unroll
            for (int m = 0; m < 4; ++m) { const int row = u.pm * 256 + ai * 128 + wr * 64 + m * 16 + fr;
                const float ms_s = ssq_s[row] * (1.0f / 1024.0f) + EPS, ms_a = ssq_a[row] * (1.0f / 1024.0f) + EPS; const float f = (ms_s * __builtin_amdgcn_rsqf(ms_s)) * __builtin_amdgcn_rsqf(ms_a);
#pragma unroll
                for (int bj = 0; bj < 2; ++bj)
#pragma unroll
                    for (int n = 0; n < 2; ++n) acc[ai][bj][m][n] *= f; }
    }
    __device__ __forceinline__ void operator()(const f32x4 (&acc)[2][2][4][2], const Unit& u, int wr, int wc, int fr, int fq) const {
        asm volatile("" : "+v"(fr), "+v"(fq));
        const int row0 = u.pm * 256 + wr * 64 + fr; const size_t cofs = (size_t)u.pn * 256 + wc * 32 + 8 * fq;
#pragma unroll
        for (int ai = 0; ai < 2; ++ai) {
            float sv[4], iv[4]; u32x4 xb[4][2];
#pragma unroll
            for (int m = 0; m < 4; ++m) { const int row = row0 + ai * 128 + m * 16; sv[m] = ssq_s[row]; iv[m] = irstd1[row];
#pragma unroll
                for (int bj = 0; bj < 2; ++bj) xb[m][bj] = *(const u32x4*)(xn + (size_t)row * D_MODEL + cofs + bj * 128); }
#pragma unroll
            for (int m = 0; m < 4; ++m) { const int row = row0 + ai * 128 + m * 16; const float rstd = __builtin_amdgcn_rsqf(sv[m] * (1.0f / 1024.0f) + EPS), ir = iv[m]; float sq = 0.f;
#pragma unroll
                for (int bj = 0; bj < 2; ++bj) { const size_t off = (size_t)row * D_MODEL + cofs + bj * 128; const u32x4 x_ = xb[m][bj];
                    const f32x4 b0 = {bf_lo(x_.x), bf_hi(x_.x), bf_lo(x_.y), bf_hi(x_.y)}, b1 = {bf_lo(x_.z), bf_hi(x_.z), bf_lo(x_.w), bf_hi(x_.w)};
                    const f32x4 o0 = b0 * ir + acc[ai][bj][m][0] * rstd, o1 = b1 * ir + acc[ai][bj][m][1] * rstd;
                    sq += (o0[0] * o0[0] + o0[1] * o0[1]) + (o0[2] * o0[2] + o0[3] * o0[3]) + (o1[0] * o1[0] + o1[1] * o1[1]) + (o1[2] * o1[2] + o1[3] * o1[3]);
                    u32x4 w; w.x = cvt_pk_bf16(o0[0], o0[1]); w.y = cvt_pk_bf16(o0[2], o0[3]); w.z = cvt_pk_bf16(o1[0], o1[1]); w.w = cvt_pk_bf16(o1[2], o1[3]);
                    *(u32x4*)(x1b + off) = w; }
                sq += __shfl_xor(sq, 16); sq += __shfl_xor(sq, 32); if (fq == 0) atomicAdd(ssq_x + row, sq); }
        }
    }
};
struct EpiGU {
    static constexpr bool MARK_LAST = false;
    static constexpr bool PERM = true, AFTER_DRAIN = false; static constexpr int MID_T = 0;
    const float* ssq_x; bf16_t* H;
    __device__ __forceinline__ void operator()(const f32x4 (&acc)[2][2][4][2], const Unit& u, int wr, int wc, int fr, int fq) const {
        asm volatile("" : "+v"(fr), "+v"(fq));
        const int row0 = u.pm * 256 + wr * 64 + fr;
        float sv[2][4];
#pragma unroll
        for (int ai = 0; ai < 2; ++ai)
#pragma unroll
            for (int m = 0; m < 4; ++m) sv[ai][m] = ssq_x[row0 + ai * 128 + m * 16];
#pragma unroll
        for (int ai = 0; ai < 2; ++ai)
#pragma unroll
            for (int m = 0; m < 4; ++m) { const int row = row0 + ai * 128 + m * 16; const float ms = sv[ai][m] * (1.0f / 2048.0f) + EPS, rstd = __builtin_amdgcn_rsqf(ms);
                const float nr = -LOG2E * rstd;
                unsigned hw[4];
                const f32x2 nr2 = {nr, nr}, ms2 = {ms, ms};
#pragma unroll
                for (int n = 0; n < 2; ++n)
#pragma unroll
                    for (int hf = 0; hf < 2; ++hf) { const f32x2 g2 = {acc[ai][0][m][n][2 * hf], acc[ai][0][m][n][2 * hf + 1]}, u2 = {acc[ai][1][m][n][2 * hf], acc[ai][1][m][n][2 * hf + 1]};
                        const f32x2 t2 = g2 * nr2; f32x2 e2 = {fast_exp2(t2.x), fast_exp2(t2.y)}; e2 = e2 * ms2 + ms2;
                        const f32x2 q2 = {fast_rcp(e2.x), fast_rcp(e2.y)}; const f32x2 h2 = (g2 * u2) * q2;
                        hw[2 * n + hf] = cvt_pk_bf16(h2.x, h2.y); }
                u32x4 w; w.x = hw[0]; w.y = hw[1]; w.z = hw[2]; w.w = hw[3];
                *(u32x4*)(H + (size_t)row * FF + u.pn * 128 + wc * 32 + 8 * fq) = w; }
    }
};
template <bool DRY> struct EpiDown {
    static constexpr bool MARK_LAST = true;
    static constexpr bool PERM = true, AFTER_DRAIN = false; static constexpr int MID_T = 0;
    const bf16_t* x1b; float* out; float* trash;
    __device__ __forceinline__ void operator()(const f32x4 (&acc)[2][2][4][2], const Unit& u, int wr, int wc, int fr, int fq) const {
        if (u.part) body<true>(acc, u, wr, wc, fr, fq); else body<false>(acc, u, wr, wc, fr, fq);
    }
    template <bool NT> __device__ __forceinline__ void body(const f32x4 (&acc)[2][2][4][2], const Unit& u, int wr, int wc, int fr, int fq) const {
        asm volatile("" : "+v"(fr), "+v"(fq));
        const int row0 = u.pm * 256 + wr * 64 + fr; const size_t cofs = (size_t)u.pn * 256 + wc * 32 + 8 * fq;
        u32x4 xb[2][4][2];
#pragma unroll
        for (int ai = 0; ai < 2; ++ai)
#pragma unroll
            for (int m = 0; m < 4; ++m)
#pragma unroll
                for (int bj = 0; bj < 2; ++bj) xb[ai][m][bj] = __builtin_nontemporal_load((const u32x4*)(x1b + (size_t)(row0 + ai * 128 + m * 16) * D_MODEL + cofs + bj * 128));
#pragma unroll
        for (int ai = 0; ai < 2; ++ai)
#pragma unroll
            for (int m = 0; m < 4; ++m) { const int row = row0 + ai * 128 + m * 16;
#pragma unroll
                for (int bj = 0; bj < 2; ++bj) { const size_t off = (size_t)row * D_MODEL + cofs + bj * 128; const u32x4 x_ = xb[ai][m][bj];
                    const f32x4 b0 = {bf_lo(x_.x), bf_hi(x_.x), bf_lo(x_.y), bf_hi(x_.y)}, b1 = {bf_lo(x_.z), bf_hi(x_.z), bf_lo(x_.w), bf_hi(x_.w)};
                    float* q = DRY ? trash + (off & ((8u << 20) - 1)) : out + off;
                    const f32x4 r0 = b0 + acc[ai][bj][m][0], r1 = b1 + acc[ai][bj][m][1]; f32x4 s0, s1;
#pragma unroll
                    for (int i = 0; i < 4; ++i) { float a_ = r0[i], b_ = r1[i]; asm volatile("v_nop\n\tv_nop\n\tv_permlane16_swap_b32 %0, %1" : "+v"(a_), "+v"(b_)); s0[i] = a_; s1[i] = b_; }
                    const int e4 = 4 * (fq & 1);
                    if constexpr (NT) { __builtin_nontemporal_store(s0, (f32x4*)(q - e4)); __builtin_nontemporal_store(s1, (f32x4*)(q + 8 - e4)); } else { *(f32x4*)(q - e4) = s0; *(f32x4*)(q + 8 - e4) = s1; } } }
    }
};

constexpr int ATT_KROW = 144, ATT_VROW = 192  , ATT_K_OFF = 0, ATT_V_OFF = 256 * ATT_KROW, ATT_B_OFF = ATT_V_OFF + 256 * ATT_VROW;
constexpr int ATT_TAB = 192;
static_assert(ATT_B_OFF + 4 * ATT_TAB * 4 <= RING_BYTES && ATT_G_OFF + 512 <= LDS_BYTES, "attention LDS");
template <int STG_REPS = 1, int TASK_REPS = 1>
__device__ __forceinline__ void attn_unit(Frame& F, int b, int qb, int kvh, float* ssq_real) {
    LAS unsigned char* lds = F.lds;
    const int lane = lane_id(), wave = F.wave, tid = wave * 64 + lane;
    const bf16_t* Q = (const bf16_t*)(F.ws + WS_Q); const bf16_t* Kb = (const bf16_t*)(F.ws + WS_K); const bf16_t* Vb = (const bf16_t*)(F.ws + WS_V);
    bf16_t* mixed = (bf16_t*)(F.ws + WS_MIX);
    const int T0 = b * SEQ + qb * 128;
    ST_B(F, 21);
    const int q = lane & 31, hh = lane >> 5;
    u32x4 qraw[2][4];
#pragma unroll
    for (int it = 0; it < 2; ++it) { const int task = wave + 8 * it; const bf16_t* qp = Q + (size_t)(T0 + 32 * (task & 3) + q) * ATTN_W + (kvh * 4 + (task >> 2)) * 64 + hh * 8;
#pragma unroll
        for (int ks = 0; ks < 4; ++ks) qraw[it][ks] = __builtin_nontemporal_load((const u32x4*)(qp + 16 * ks)); }
    float tabv[2];
#pragma unroll
    for (int k = 0; k < 2; ++k) { const int e = tid + k * NWAVES * 64; tabv[k] = (e < 4 * ATT_TAB) ? ((const float*)(F.ws + WS_BIAS))[kvh * 4 * ATT_TAB + e] : 0.f; }
    for (int srep = 0; srep < STG_REPS; ++srep)
    {
        const int key = tid & 255; const bool valid = (qb > 0) || (key >= 128);
        const size_t tok = (size_t)(T0 - 128 + key);
        u32x4 c[8];
        const bf16_t* src = ((tid < 256) ? Kb : Vb) + tok * KV_W + kvh * 64;
#pragma unroll
        for (int i = 0; i < 8; ++i) c[i] = valid ? *(const u32x4*)(src + 8 * i) : (u32x4){0u, 0u, 0u, 0u};
        if (tid < 256) {
            float ss = 0.f;
#pragma unroll
            for (int i = 0; i < 8; ++i) { const float a0 = bf_lo(c[i].x), a1 = bf_hi(c[i].x), a2 = bf_lo(c[i].y), a3 = bf_hi(c[i].y), a4 = bf_lo(c[i].z), a5 = bf_hi(c[i].z), a6 = bf_lo(c[i].w), a7 = bf_hi(c[i].w);
                ss += (a0 * a0 + a1 * a1) + (a2 * a2 + a3 * a3) + (a4 * a4 + a5 * a5) + (a6 * a6 + a7 * a7); }
            const float rstd = 1.0f / sqrtf(ss * (1.0f / 64.0f) + EPS);
            const LAS float* kg = (const LAS float*)(lds + ATT_G_OFF);
#pragma unroll
            for (int i = 0; i < 8; ++i) { const f32x4 g0 = *(const LAS f32x4*)(kg + 8 * i), g1 = *(const LAS f32x4*)(kg + 8 * i + 4);
                u32x4 w; w.x = cvt_pk_bf16(bf_lo(c[i].x) * rstd * g0[0], bf_hi(c[i].x) * rstd * g0[1]); w.y = cvt_pk_bf16(bf_lo(c[i].y) * rstd * g0[2], bf_hi(c[i].y) * rstd * g0[3]);
                w.z = cvt_pk_bf16(bf_lo(c[i].z) * rstd * g1[0], bf_hi(c[i].z) * rstd * g1[1]); w.w = cvt_pk_bf16(bf_lo(c[i].w) * rstd * g1[2], bf_hi(c[i].w) * rstd * g1[3]);
                *(LAS u32x4*)(lds + ATT_K_OFF + key * ATT_KROW + i * 16) = w; }
        } else {
#pragma unroll
            for (int i = 0; i < 8; ++i) *(LAS u32x4*)(lds + ATT_V_OFF + key * ATT_VROW + i * 16) = c[i];
        }
#pragma unroll
        for (int k = 0; k < 2; ++k) { const int e = tid + k * NWAVES * 64; if (e < 4 * ATT_TAB) ((LAS float*)(lds + ATT_B_OFF))[e] = tabv[k]; }
    }
    bf16x8 qf2[2][4];
    { const LAS float* qg = (const LAS float*)(lds + ATT_G_OFF) + 64; f32x4 gq[4][2];
#pragma unroll
      for (int ks = 0; ks < 4; ++ks) { gq[ks][0] = *(const LAS f32x4*)(qg + 16 * ks + 8 * hh); gq[ks][1] = *(const LAS f32x4*)(qg + 16 * ks + 8 * hh + 4); }
#pragma unroll
      for (int it = 0; it < 2; ++it) { float ss = 0.f;
#pragma unroll
        for (int ks = 0; ks < 4; ++ks) { const u32x4 w_ = qraw[it][ks];
            const float a0 = bf_lo(w_.x), a1 = bf_hi(w_.x), a2 = bf_lo(w_.y), a3 = bf_hi(w_.y), a4 = bf_lo(w_.z), a5 = bf_hi(w_.z), a6 = bf_lo(w_.w), a7 = bf_hi(w_.w);
            ss += (a0 * a0 + a1 * a1) + (a2 * a2 + a3 * a3) + (a4 * a4 + a5 * a5) + (a6 * a6 + a7 * a7); }
        ss += __shfl_xor(ss, 32);
        const float sc = (1.0f / sqrtf(ss * (1.0f / 64.0f) + EPS)) * (0.125f * LOG2E);
#pragma unroll
        for (int ks = 0; ks < 4; ++ks) { const u32x4 w_ = qraw[it][ks]; const f32x4 g0 = gq[ks][0], g1 = gq[ks][1];
            u32x4 w; w.x = cvt_pk_bf16(bf_lo(w_.x) * sc * g0[0], bf_hi(w_.x) * sc * g0[1]); w.y = cvt_pk_bf16(bf_lo(w_.y) * sc * g0[2], bf_hi(w_.y) * sc * g0[3]);
            w.z = cvt_pk_bf16(bf_lo(w_.z) * sc * g1[0], bf_hi(w_.z) * sc * g1[1]); w.w = cvt_pk_bf16(bf_lo(w_.w) * sc * g1[2], bf_hi(w_.w) * sc * g1[3]);
            qf2[it][ks] = __builtin_bit_cast(bf16x8, w); } } }
    __syncthreads();
    ST_E(F, 21); ST_B(F, 22);
    for (int trep = 0; trep < TASK_REPS; ++trep)
#pragma unroll
    for (int it = 0; it < 2; ++it) {
        float* ssq_a = (trep == TASK_REPS - 1) ? ssq_real : (float*)(F.ws + WS_SSQ_T);
        const int task = wave + 8 * it, hl = task >> 2, grp = task & 3, hq = kvh * 4 + hl, qi = 32 * grp + q;
        const bf16x8 (&qf)[4] = qf2[it];
        const LAS float* tb = (const LAS float*)(lds + ATT_B_OFF) + hl * ATT_TAB + (q + 128 - 4 * hh + 32 - 155);
        const float sink2 = F.in[6][hq] * LOG2E;
        f32x16 s[5];
#pragma unroll
        for (int kt = 0; kt < 5; ++kt) {
            f32x16 a;
#pragma unroll
            for (int r = 0; r < 16; ++r) a[r] = tb[155 - 32 * kt - ((r & 3) + 8 * (r >> 2))];
#pragma unroll
            for (int ks = 0; ks < 4; ++ks) { const bf16x8 kf = *(const LAS bf16x8*)(lds + ATT_K_OFF + (32 * (grp + kt) + q) * ATT_KROW + (16 * ks + 8 * hh) * 2);
                a = __builtin_amdgcn_mfma_f32_32x32x16_bf16(kf, qf[ks], a, 0, 0, 0); }
            if (qb == 0 && grp + kt < 4) {
#pragma unroll
                for (int r = 0; r < 16; ++r) a[r] = -INFINITY; }
            s[kt] = a;
        }
        float mx = sink2;
#pragma unroll
        for (int kt = 0; kt < 5; ++kt)
#pragma unroll
            for (int r = 0; r < 16; r += 2) mx = fmaxf(fmaxf(s[kt][r], s[kt][r + 1]), mx);
        mx = fmaxf(mx, __shfl_xor(mx, 32));
        float l;
        { const f32x2_t nm = {-mx, -mx}; f32x2_t l2 = {0.f, 0.f};
#pragma unroll
          for (int kt = 0; kt < 5; ++kt)
#pragma unroll
            for (int r = 0; r < 16; r += 2) { const f32x2_t t = (f32x2_t){s[kt][r], s[kt][r + 1]} + nm; const f32x2_t p = {fast_exp2(t.x), fast_exp2(t.y)}; s[kt][r] = p.x; s[kt][r + 1] = p.y; l2 = l2 + p; }
          l = l2.x + l2.y; }
        l += __shfl_xor(l, 32);
        l += fast_exp2(sink2 - mx);
        f32x16 o[2]; o[0] = (f32x16){}; o[1] = (f32x16){};
        const LAS unsigned char* vtb = lds + ATT_V_OFF + (32 * grp + 4 * hh + ((lane & 15) >> 2)) * ATT_VROW + (16 * ((lane >> 4) & 1) + 4 * (lane & 3)) * 2;
#pragma unroll
        for (int kt = 0; kt < 5; ++kt)
#pragma unroll
            for (int s2 = 0; s2 < 2; ++s2) {
                u32x4 pw; pw.x = cvt_pk_bf16(s[kt][8 * s2 + 0], s[kt][8 * s2 + 1]); pw.y = cvt_pk_bf16(s[kt][8 * s2 + 2], s[kt][8 * s2 + 3]); pw.z = cvt_pk_bf16(s[kt][8 * s2 + 4], s[kt][8 * s2 + 5]); pw.w = cvt_pk_bf16(s[kt][8 * s2 + 6], s[kt][8 * s2 + 7]);
                const bf16x8 pb = __builtin_bit_cast(bf16x8, pw);
#pragma unroll
                for (int d0 = 0; d0 < 2; ++d0) {
                    const LAS unsigned char* vp = vtb + (32 * kt + 16 * s2) * ATT_VROW + 64 * d0;
                    const s16x4 lo = __builtin_amdgcn_ds_read_tr16_b64_v4i16((LAS s16x4*)vp), hi = __builtin_amdgcn_ds_read_tr16_b64_v4i16((LAS s16x4*)(vp + 8 * ATT_VROW));
                    const bf16x8 vv = {lo[0], lo[1], lo[2], lo[3], hi[0], hi[1], hi[2], hi[3]};
                    o[d0] = __builtin_amdgcn_mfma_f32_32x32x16_bf16(vv, pb, o[d0], 0, 0, 0); }
            }
        const float inv = 1.0f / l; float sq = 0.f;
        bf16_t* op = mixed + (size_t)(T0 + qi) * 2048 + hq * 64 + 4 * hh;
#pragma unroll
        for (int d0 = 0; d0 < 2; ++d0)
#pragma unroll
            for (int r4 = 0; r4 < 4; ++r4) { const f32x2_t i2 = {inv, inv}; const f32x2_t va = (f32x2_t){o[d0][4 * r4], o[d0][4 * r4 + 1]} * i2, vb = (f32x2_t){o[d0][4 * r4 + 2], o[d0][4 * r4 + 3]} * i2;
                const f32x2_t q2 = va * va + vb * vb; sq += q2.x + q2.y;
                u32x2 w; w.x = cvt_pk_bf16(va.x, va.y); w.y = cvt_pk_bf16(vb.x, vb.y); *(u32x2*)(op + 32 * d0 + 8 * r4) = w; }
        sq += __shfl_xor(sq, 32);
        if (hh == 0) atomicAdd(ssq_a + T0 + qi, sq);
    }
    __syncthreads();
    ST_E(F, 22);
}

template <int MODE = 7>
__device__ __forceinline__ void ssm_unit(Frame& F, int pm) {
    const int g = pm >> 2;
    bf16_t* Ag = (bf16_t*)(F.ws + WS_AG);
    if constexpr (MODE & 1) {
        int Kc = 256; asm volatile("" : "+s"(Kc));
        pg8::Gemm gm{(const char*)Ag, (const char*)(F.ws + WS_PG), Kc, SSM_KA * 2, 32, 128, 256 * 2};
        pg8::OneUnit S1{pm, g}; EpiS E{};
        ST_B(F, 30); pg8::gemm_phase<EpiS, pg8::OneUnit, false>(F.lds, F.wave, gm, S1, E); ST_E(F, 30);
    }
    ST_B(F, 31);
    asm volatile("s_waitcnt lgkmcnt(0)" ::: "memory");
    __syncthreads();
    if constexpr (MODE & 2) {
        const int n = lane_id(), w = F.wave;
        const f32x2 l16 = *((const f32x2*)(F.ws + WS_L16) + g * 64 + n);
        LAS f32x2* fin = (LAS f32x2*)(F.lds + LDSCTL_OFF + 1024);
        float hr = 0.f, hi = 0.f;
        for (int c0 = 32 * w; c0 < 32 * w + 32; c0 += 8) {
            f32x2 sv[8];
#pragma unroll
            for (int j = 0; j < 8; ++j) sv[j] = *(const LAS f32x2*)(F.lds + (c0 + j) * 512 + ((8 * n) ^ (j << 4)));
#pragma unroll
            for (int j = 0; j < 8; ++j) { const float nr = l16.x * hr - l16.y * hi + sv[j].x, ni = l16.x * hi + l16.y * hr + sv[j].y; hr = nr; hi = ni; }
        }
        fin[w * 64 + n] = (f32x2){hr, hi};
        float pr = l16.x, pi = l16.y;
#pragma unroll
        for (int k = 0; k < 5; ++k) { const float nr = pr * pr - pi * pi, ni = 2.f * pr * pi; pr = nr; pi = ni; }
        asm volatile("s_waitcnt lgkmcnt(0)" ::: "memory");
        __syncthreads();
        hr = 0.f; hi = 0.f;
        for (int j = 0; j < w; ++j) { const f32x2 f = fin[j * 64 + n]; const float nr = pr * hr - pi * hi + f.x, ni = pr * hi + pi * hr + f.y; hr = nr; hi = ni; }
        unsigned* hp = (unsigned*)(Ag + (size_t)pm * 256 * SSM_KA + 256) + n;
        for (int c0 = 32 * w; c0 < 32 * w + 32; c0 += 8) {
            f32x2 sv[8];
#pragma unroll
            for (int j = 0; j < 8; ++j) sv[j] = *(const LAS f32x2*)(F.lds + (c0 + j) * 512 + ((8 * n) ^ (j << 4)));
#pragma unroll
            for (int j = 0; j < 8; ++j) { hp[(size_t)(c0 + j) * (SSM_KA / 2)] = cvt_pk_bf16(hr, hi);
                const float nr = l16.x * hr - l16.y * hi + sv[j].x, ni = l16.x * hi + l16.y * hr + sv[j].y; hr = nr; hi = ni; }
        }
    }
    asm volatile("s_waitcnt vmcnt(0) lgkmcnt(0)" ::: "memory");
    __syncthreads();
    ST_E(F, 31);
    if constexpr (MODE & 4) {
        int Kc = SSM_KA; asm volatile("" : "+s"(Kc));
        pg8::Gemm gm{(const char*)Ag, (const char*)(F.ws + WS_BG), Kc, SSM_KA * 2, 32, 128, SSM_KA * 2};
        pg8::OneUnit S1{pm, g}; EpiY E{Ag, F.in[14], (bf16_t*)(F.ws + WS_YG)};
        ST_B(F, 32); pg8::gemm_phase<EpiY, pg8::OneUnit, false>(F.lds, F.wave, gm, S1, E); ST_E(F, 32);
    }
}


#define XB_TMO      128
#define XB_XCNT(j)  (256  + 64 * (j))
#define XB_XSUB(j)  (1280 + 64 * (j))
#define XB_XGEN(j)  (2304 + 64 * (j))
#define XB_TOP      3328
#define XB_TOPGEN   3392
#define XCD_BAR_WORDS 3456
#define XB_SPIN_CAP (1u << 22)
constexpr size_t WS_BAR = 16384;
__device__ __forceinline__ unsigned xb_ld(unsigned* p)              { return __hip_atomic_load(p, __ATOMIC_RELAXED, __HIP_MEMORY_SCOPE_AGENT); }
__device__ __forceinline__ unsigned xb_add(unsigned* p, unsigned v) { return __hip_atomic_fetch_add(p, v, __ATOMIC_RELAXED, __HIP_MEMORY_SCOPE_AGENT); }
__device__ __forceinline__ unsigned xb_xcc_id() { return (unsigned)__builtin_amdgcn_s_getreg((3 << 11) | 20) & 0xFu; }
#define XB_SPIN(cond, bar) do { unsigned _sp = 0; while (cond) { __builtin_amdgcn_s_sleep(1); \
    if ((++_sp & 255u) == 0u) { if (xb_ld(&(bar)[XB_TMO])) break; if (_sp > XB_SPIN_CAP) { atomicAdd(&(bar)[XB_TMO], 1u); break; } } } } while (0)
struct XcdBarrier { unsigned* bar; unsigned x; volatile LAS unsigned* st; };
__device__ __forceinline__ XcdBarrier xcd_barrier_post(unsigned* bar, volatile LAS unsigned* st) {
    XcdBarrier b; b.bar = bar; b.x = xb_xcc_id(); b.st = st;
    if (threadIdx.x == 0) (void)xb_add(&bar[XB_XCNT(b.x)], 1u);
    return b;
}
__device__ __forceinline__ void xcd_barrier_complete(unsigned* bar, unsigned x, unsigned& nloc, unsigned& nx) {
    const unsigned G = gridDim.x * gridDim.y * gridDim.z;
    unsigned sum, cnt, mine, sp = 0u;
    for (;;) {
        sum = 0u; cnt = 0u; mine = 0u;
#pragma unroll
        for (unsigned j = 0; j < 16; ++j) { const unsigned c = xb_ld(&bar[XB_XCNT(j)]); sum += c; cnt += (c > 0u) ? 1u : 0u; mine = (j == x) ? c : mine; }
        if (sum == G) break;
        __builtin_amdgcn_s_sleep(1);
        if ((++sp & 255u) == 0u) { if (xb_ld(&bar[XB_TMO])) break; if (sp > XB_SPIN_CAP) { atomicAdd(&bar[XB_TMO], 1u); break; } }
    }
    nloc = mine > 0u ? mine : 1u; nx = cnt > 0u ? cnt : 1u;
}
__device__ __forceinline__ void xcd_barrier(const XcdBarrier& b, int wave) {
    asm volatile("s_waitcnt vmcnt(0)" ::: "memory");
    __syncthreads();
    if (wave == 0 && lane_id() == 0) {
        unsigned* bar = b.bar;
        __builtin_amdgcn_s_waitcnt(0);
        unsigned nloc = b.st[0], nx = b.st[1];
        if (nloc == 0u) { xcd_barrier_complete(bar, b.x, nloc, nx); b.st[0] = nloc; b.st[1] = nx; }
        const unsigned old = xb_add(&bar[XB_XSUB(b.x)], 1u);
        const unsigned gen = old / nloc;
        if (old + 1u == (gen + 1u) * nloc) {
            __builtin_amdgcn_fence(__ATOMIC_RELEASE, "agent");
            asm volatile("s_waitcnt vmcnt(0)" ::: "memory");
            const unsigned og = xb_add(&bar[XB_TOP], 1u);
            const unsigned tg = og / nx;
            if (og + 1u == (tg + 1u) * nx) {
#pragma unroll
                for (unsigned j = 0; j < 16; ++j) (void)xb_add(&bar[XB_XGEN(j)], 1u);
            } else XB_SPIN(xb_ld(&bar[XB_XGEN(b.x)]) == gen, bar);
            __builtin_amdgcn_fence(__ATOMIC_ACQUIRE, "agent");
            asm volatile("s_waitcnt vmcnt(0)" ::: "memory");
        } else {
            XB_SPIN(xb_ld(&bar[XB_XGEN(b.x)]) == gen, bar);
            __builtin_amdgcn_fence(__ATOMIC_ACQUIRE, "agent");
            asm volatile("s_waitcnt vmcnt(0)" ::: "memory");
        }
    }
    __syncthreads();
}

struct Args { const float* in[23]; float* out; unsigned char* ws; int ph_lo, ph_hi; };
__global__ void __launch_bounds__(NWAVES * 64, 2) hymba_fwd(Args args) {
    extern __shared__ __attribute__((aligned(16))) unsigned char lds_raw[];
    Frame F;
    F.lds = (LAS unsigned char*)lds_raw;
    F.wave = __builtin_amdgcn_readfirstlane((int)threadIdx.x >> 6);
    F.G = gridDim.x; { const int bx = blockIdx.x; F.vcu = (F.G % 8 == 0) ? (bx % 8) * (F.G / 8) + bx / 8 : bx; }
    F.in = args.in; F.out = args.out; F.ws = args.ws;
#if STAMP_ID >= 0
    F.st_t0 = 0; F.st_acc = 0;
#endif
    const int lo = args.ph_lo, hi = args.ph_hi;
    for (int u = threadIdx.x; u < (LDS_BYTES - LDSCTL_OFF) / 4; u += NWAVES * 64) ((LAS unsigned*)(F.lds + LDSCTL_OFF))[u] = 0u;
    __syncthreads();
    XcdBarrier bar; bar.bar = (unsigned*)(F.ws + WS_BAR); bar.x = 0; bar.st = nullptr;
    if (MK_N_LAUNCHES == 1) bar = xcd_barrier_post((unsigned*)(F.ws + WS_BAR), (volatile LAS unsigned*)(F.lds + MISC_OFF) + 8);
#define IN(k) (lo <= (k) && (k) < hi)
#define GRID_BAR(k) do { if (IN(k) && IN((k) + 1)) xcd_barrier(bar, F.wave); } while (0)
    unsigned char* ws = F.ws;
    float* const ssq_trash = (float*)(ws + WS_SSQ_T);
#define PHASE0(DRY) { p0_prologue(F); }
#define PHASE1(DRY) {     \
        const int nwg_ = (M / 256) * (IN_W / 256), maxu_ = (nwg_ + F.G - 1) / F.G, nheavy_ = nwg_ - (maxu_ - 1) * F.G, nlight_ = F.G - nheavy_, c_ = (int)blockIdx.x;     \
        const int nh_ = nlight_ == 0 ? 0 : (LATE_HEAVY < LATE_N ? LATE_HEAVY : LATE_N); \
        if (nlight_ != 0 && c_ < nheavy_) { convert_late_weights(F, c_ * NWAVES + F.wave, nheavy_ * NWAVES, 0, nh_); __syncthreads(); } \
        pg8::Gemm g{(const char*)(ws + WS_XN), (const char*)(ws + WS_WIN), D_MODEL, D_MODEL * 2, 32, 128, D_MODEL * 2}; \
        pg8::StaticOrder S; S.init(M, IN_W, F.G, (int)blockIdx.x, WGM_P1); \
        EpiIn E{(bf16_t*)(ws + WS_Q), (bf16_t*)(ws + WS_K), (bf16_t*)(ws + WS_V), (bf16_t*)(ws + WS_AG)}; \
        pg8::gemm_phase<EpiIn, pg8::StaticOrder, true>(F.lds, F.wave, g, S, E); \
        if (nlight_ == 0) convert_late_weights(F, c_ * NWAVES + F.wave, F.G * NWAVES, 0, LATE_N); \
        else if (c_ >= nheavy_) convert_late_weights(F, (c_ - nheavy_) * NWAVES + F.wave, nlight_ * NWAVES, nh_, LATE_N); }
#define PHASE2(DRY) { \
        float* const sa_ = (DRY) ? ssq_trash : (float*)(ws + WS_SSQ_A); \
        ST_B(F, 20); for (int u = F.vcu; u < BATCH * 32 * NKVH; u += F.G) attn_unit<(PROBE_REP == 25 ? 2 : 1), (PROBE_REP == 26 ? 2 : 1)>(F, u >> 7, (u >> 2) & 31, u & 3, sa_); ST_E(F, 20); \
        if (F.vcu < 256) ssm_unit(F, F.vcu);     }
#define PHASE3(DRY) {     \
        pg8::Gemm g{(const char*)(ws + WS_YG), (const char*)(ws + WS_WGLU), SSM_W, 32, (unsigned)(M * 32), (unsigned)(4 * M * 32), SSM_W * 2}; \
        pg8::StaticOrder S; S.init(M, SSM_W, F.G, (int)blockIdx.x, WGM_P3); \
        EpiGlu E{(const bf16_t*)(ws + WS_YG), (bf16_t*)(ws + WS_MIX), (DRY) ? ssq_trash : (float*)(ws + WS_SSQ_S)}; \
        pg8::gemm_phase<EpiGlu, pg8::StaticOrder, true>(F.lds, F.wave, g, S, E); }
#define PHASE4(DRY) {     \
        pg8::Gemm g{(const char*)(ws + WS_MIX), (const char*)(ws + WS_WOUT), 2048, 2048 * 2, 32, 128, 2048 * 2}; \
        pg8::StaticOrder S; S.init(M, D_MODEL, F.G, (int)blockIdx.x, WGM_P4); \
        EpiOut E{(const bf16_t*)(ws + WS_XN), (const float*)(ws + WS_IRSTD1), (bf16_t*)(ws + WS_XN), (const float*)(ws + WS_SSQ_A), (const float*)(ws + WS_SSQ_S), (DRY) ? ssq_trash : (float*)(ws + WS_SSQ_X)}; \
        pg8::gemm_phase<EpiOut, pg8::StaticOrder, true>(F.lds, F.wave, g, S, E); }
#define PHASE5(DRY) {     \
        pg8::Gemm g{(const char*)(ws + WS_XN), (const char*)(ws + WS_WGU), D_MODEL, D_MODEL * 2, 32, 128, D_MODEL * 2}; \
        pg8::StaticOrder S; S.init(M, 2 * FF, F.G, (int)blockIdx.x, WGM_P5); \
        EpiGU E{(const float*)(ws + WS_SSQ_X), (bf16_t*)(ws + WS_H)}; \
        pg8::gemm_phase<EpiGU, pg8::StaticOrder, true>(F.lds, F.wave, g, S, E); }
#define PHASE6(DRY) {     \
        pg8::Gemm g{(const char*)(ws + WS_H), (const char*)(ws + WS_WDN), FF, FF * 2, 32, 128, FF * 2}; \
        pg8::StaticOrder S; S.init(M, D_MODEL, F.G, (int)blockIdx.x, WGM_P6); \
        EpiDown<(DRY)> E{(const bf16_t*)(ws + WS_XN), F.out, (float*)(ws + WS_SSCR)}; \
        pg8::gemm_phase<EpiDown<(DRY)>, pg8::StaticOrder, true>(F.lds, F.wave, g, S, E); }
#define PHASE2A(DRY) { for (int u = F.vcu; u < BATCH * 32 * NKVH; u += F.G) attn_unit(F, u >> 7, (u >> 2) & 31, u & 3, ssq_trash); }
#define PHASE2S(DRY) { if (F.vcu < 256) ssm_unit(F, F.vcu); }
#define RUN_PHASE(k, BODY) do { if (PROBE_REP == (k) && IN(k)) { BODY(1); xcd_barrier(bar, F.wave); } if (IN(k)) { BODY(0); } } while (0)
    ST_B(F, 0); RUN_PHASE(0, PHASE0); ST_E(F, 0);
    ST_B(F, 10); GRID_BAR(0); ST_E(F, 10);
    if (args.ph_lo < 0) cg::this_grid().sync();
    ST_B(F, 1); RUN_PHASE(1, PHASE1); ST_E(F, 1);
    ST_B(F, 11); GRID_BAR(1); ST_E(F, 11);
    if (PROBE_REP == 22 && IN(2)) { if (F.vcu < 256) ssm_unit<1>(F, F.vcu); xcd_barrier(bar, F.wave); }
    if (PROBE_REP == 23 && IN(2)) { if (F.vcu < 256) ssm_unit<2>(F, F.vcu); xcd_barrier(bar, F.wave); }
    if (PROBE_REP == 24 && IN(2)) { if (F.vcu < 256) ssm_unit<4>(F, F.vcu); xcd_barrier(bar, F.wave); }
    if (PROBE_REP == 20 && IN(2)) { PHASE2A(1); xcd_barrier(bar, F.wave); }
    if (PROBE_REP == 21 && IN(2)) { PHASE2S(1); xcd_barrier(bar, F.wave); }
    ST_B(F, 2); RUN_PHASE(2, PHASE2); ST_E(F, 2);
    ST_B(F, 12); GRID_BAR(2); ST_E(F, 12);
    ST_B(F, 3); RUN_PHASE(3, PHASE3); ST_E(F, 3);
    ST_B(F, 13); GRID_BAR(3); ST_E(F, 13);
    ST_B(F, 4); RUN_PHASE(4, PHASE4); ST_E(F, 4);
    ST_B(F, 14); GRID_BAR(4); ST_E(F, 14);
    ST_B(F, 5); RUN_PHASE(5, PHASE5); ST_E(F, 5);
    ST_B(F, 15); GRID_BAR(5); ST_E(F, 15);
    ST_B(F, 6); RUN_PHASE(6, PHASE6); ST_E(F, 6);
#if STAMP_ID >= 0
    if (STAMP_BLK >= 0) { if ((int)blockIdx.x == STAMP_BLK && F.wave == 0) { const unsigned long long te = __builtin_amdgcn_s_memrealtime(), w = 10ull * F.st_acc; while (__builtin_amdgcn_s_memrealtime() - te < w) __builtin_amdgcn_s_sleep(8); } }
    else {
        unsigned* mm = (unsigned*)(F.ws + WS_SSQ_T);
        if (F.wave == 0 && lane_id() == 0) { if (STAMP_BLK == -1) atomicMax(mm, (unsigned)F.st_acc); else atomicMax(mm + 1, 0xffffffffu - (unsigned)F.st_acc); }
        xcd_barrier(bar, F.wave);
        if (blockIdx.x == 0 && F.wave == 0) { const unsigned v = (STAMP_BLK == -1) ? __hip_atomic_load(mm, __ATOMIC_RELAXED, __HIP_MEMORY_SCOPE_AGENT) : 0xffffffffu - __hip_atomic_load(mm + 1, __ATOMIC_RELAXED, __HIP_MEMORY_SCOPE_AGENT);
            const unsigned long long te = __builtin_amdgcn_s_memrealtime(), w = 10ull * v; while (__builtin_amdgcn_s_memrealtime() - te < w) __builtin_amdgcn_s_sleep(8); }
    }
#endif
#undef IN
#undef GRID_BAR
}

extern "C" void kernel_launch(void* const* d_in, const int* in_sizes, int n_in, void* d_out, int out_size, void* d_ws, size_t ws_size, hipStream_t stream) {
    static int grid = 0;
    if (grid == 0) {
        if (n_in != 23 || in_sizes[0] != M * D_MODEL || out_size != M * D_MODEL || ws_size < WS_END) { fprintf(stderr, "kernel_launch: unexpected sizes (n_in %d, out %d, ws %zu); nothing launched\n", n_in, out_size, ws_size); grid = -1; return; }
        int dev = 0, cus = 0, per_cu = 0;
        if (hipGetDevice(&dev) != hipSuccess || hipDeviceGetAttribute(&cus, hipDeviceAttributeMultiprocessorCount, dev) != hipSuccess) { grid = -1; return; }
        if (hipFuncSetAttribute((const void*)hymba_fwd, hipFuncAttributeMaxDynamicSharedMemorySize, LDS_BYTES) != hipSuccess) { fprintf(stderr, "kernel_launch: hipFuncSetAttribute failed\n"); grid = -1; return; }
        if (hipOccupancyMaxActiveBlocksPerMultiprocessor(&per_cu, (const void*)hymba_fwd, NWAVES * 64, LDS_BYTES) != hipSuccess || per_cu < 1) { fprintf(stderr, "kernel_launch: occupancy query failed (%d)\n", per_cu); (void)hipGetLastError(); grid = -1; return; }
        grid = cus;
        if (grid < 256) { fprintf(stderr, "kernel_launch: this kernel needs >= 256 CUs (got %d); nothing launched\n", grid); grid = -1; return; }
    }
    if (grid < 0) return;
#if STAMP_ID < 0 && PROBE_REP < 0
    (void)hipMemsetAsync((char*)d_ws + WS_BAR, 0, 16384, stream);
#else
    (void)hipMemsetAsync((char*)d_ws + WS_CTL, 0, CTL_ZERO_BYTES, stream);
#endif
    Args a{};
    for (int i = 0; i < 23; ++i) a.in[i] = (const float*)d_in[i];
    a.out = (float*)d_out; a.ws = (unsigned char*)d_ws;
    constexpr int NPH = 7;
    for (int li = 0; li < MK_N_LAUNCHES; ++li) {
        a.ph_lo = (MK_N_LAUNCHES == 1) ? 0 : li; a.ph_hi = (MK_N_LAUNCHES == 1) ? NPH : li + 1;
        void* kargs[] = {&a};
        const hipError_t e = hipLaunchCooperativeKernel((const void*)hymba_fwd, dim3(grid), dim3(NWAVES * 64), kargs, LDS_BYTES, stream);
        if (e != hipSuccess) { fprintf(stderr, "kernel_launch: cooperative launch failed: %s (grid %d)\n", hipGetErrorString(e), grid); break; }
    }
}
```
